# Optimizing an MI355X kernel written in HIP

```python
import math
import jax, jax.numpy as jnp
from jax import lax
import numpy as np

D_MODEL = 4096
BATCH = 2
SEQ = 4096
DEPTH = 2

HEAD_DIM = 128
N_GROUPS = 4
MIX_WIDTH = D_MODEL
GROUP_HEADS = MIX_WIDTH // (N_GROUPS * HEAD_DIM)
GROUP_WIDTH = GROUP_HEADS * HEAD_DIM
DIFF_QK = HEAD_DIM // 2
MLA_Q_RANK = 1536
MLA_KV_RANK = 512
MLA_NOPE = 128
MLA_ROPE = 64
MLA_V = HEAD_DIM
ROPE_THETA = 10000.0
REL_BUCKETS = 32
REL_MAX_DIST = 128
MEM_TOKENS = 256
MEM_HEADS = 4
MEM_HEAD_DIM = 128
D_FF = 4 * D_MODEL
Q_BLOCK = 128
NORM_EPS = 1e-6
NEG_INF = -1e30

A_COLS = 3 * GROUP_WIDTH
B_COLS = MLA_Q_RANK + MLA_KV_RANK + MLA_ROPE
C_COLS = 3 * GROUP_WIDTH
D_COLS = 3 * GROUP_WIDTH + GROUP_HEADS
IN_COLS = A_COLS + B_COLS + C_COLS + D_COLS

kernel_name = "hybrid_parallel_groups_diff_mla_stickbreak_fox"


def _rmsnorm(x, g):
    xf = x.astype(jnp.float32)
    y = xf * lax.rsqrt(jnp.mean(xf * xf, axis=-1, keepdims=True) + NORM_EPS)
    return (y * g.astype(jnp.float32)).astype(x.dtype)


def _heads(t, n_heads, d):
    b, s, _ = t.shape
    return t.reshape(b, s, n_heads, d).transpose(0, 2, 1, 3)


def _rope(t, pos):
    d = t.shape[-1]
    half = d // 2
    inv = ROPE_THETA ** (-jnp.arange(half, dtype=jnp.float32) * 2.0 / d)
    ang = pos.astype(jnp.float32)[:, None, :, None] * inv
    cos, sin = jnp.cos(ang), jnp.sin(ang)
    t1 = t[..., :half].astype(jnp.float32)
    t2 = t[..., half:].astype(jnp.float32)
    return jnp.concatenate([t1 * cos - t2 * sin, t1 * sin + t2 * cos], axis=-1).astype(t.dtype)


def _rel_bucket(dist):
    max_exact = REL_BUCKETS // 2
    nf = jnp.maximum(dist, 1).astype(jnp.float32)
    large = max_exact + (jnp.log(nf / max_exact) / math.log(REL_MAX_DIST / max_exact)
                         * (REL_BUCKETS - max_exact)).astype(jnp.int32)
    large = jnp.minimum(large, REL_BUCKETS - 1)
    return jnp.where(dist < max_exact, dist, large)


def _t5_bias(pos, t0, table):
    pos_q = lax.dynamic_slice_in_dim(pos, t0, Q_BLOCK, axis=1)
    dist = jnp.maximum(pos_q[:, :, None] - pos[:, None, :], 0)
    bias = jnp.take(table, _rel_bucket(dist), axis=0)
    return bias.transpose(0, 3, 1, 2).astype(jnp.float32)


def _causal_mask(t0, s_len, strict=False):
    t_idx = t0 + jnp.arange(Q_BLOCK)
    s_idx = jnp.arange(s_len)
    if strict:
        return s_idx[None, :] < t_idx[:, None]
    return s_idx[None, :] <= t_idx[:, None]


def _sweep(block_fn, n_blocks):
    out = lax.map(block_fn, jnp.arange(n_blocks))
    nb, b, h, qb, dv = out.shape
    return out.transpose(1, 0, 3, 2, 4).reshape(b, nb * qb, h * dv)


def _causal_softmax_blocks(q, k, v, scale, bias_fn=None):
    s_len = q.shape[2]

    def block(i):
        t0 = i * Q_BLOCK
        qb = lax.dynamic_slice_in_dim(q, t0, Q_BLOCK, axis=2)
        logits = jnp.einsum('bhqd,bhkd->bhqk', qb, k).astype(jnp.float32) * scale
        if bias_fn is not None:
            logits = logits + bias_fn(t0)
        logits = jnp.where(_causal_mask(t0, s_len), logits, NEG_INF)
        p = jax.nn.softmax(logits, axis=-1)
        return jnp.einsum('bhqk,bhkd->bhqd', p.astype(v.dtype), v)

    return _sweep(block, s_len // Q_BLOCK)


def _diff_attention(a_in, pos, rel_table, lam, lam_init, sub_g):
    qa, ka, va = jnp.split(a_in, 3, axis=-1)
    q = _heads(qa, GROUP_HEADS, HEAD_DIM)
    k = _heads(ka, GROUP_HEADS, HEAD_DIM)
    v = _heads(va, GROUP_HEADS, HEAD_DIM)
    q1, q2 = q[..., :DIFF_QK], q[..., DIFF_QK:]
    k1, k2 = k[..., :DIFF_QK], k[..., DIFF_QK:]
    s_len = q.shape[2]
    scale = DIFF_QK ** -0.5

    def block(i):
        t0 = i * Q_BLOCK
        bias = _t5_bias(pos, t0, rel_table)
        mask = _causal_mask(t0, s_len)

        def probs(qh, kh):
            qb = lax.dynamic_slice_in_dim(qh, t0, Q_BLOCK, axis=2)
            logits = jnp.einsum('bhqd,bhkd->bhqk', qb, kh).astype(jnp.float32) * scale + bias
            return jax.nn.softmax(jnp.where(mask, logits, NEG_INF), axis=-1)

        p = probs(q1, k1) - lam * probs(q2, k2)
        o = jnp.einsum('bhqk,bhkd->bhqd', p.astype(v.dtype), v)
        return _rmsnorm(o, sub_g) * (1.0 - lam_init)

    return _sweep(block, s_len // Q_BLOCK)


def _mla(b_in, pos, q_norm_g, kv_norm_g, w_uq, w_ukv):
    c_q, c_kv, k_rope = jnp.split(b_in, [MLA_Q_RANK, MLA_Q_RANK + MLA_KV_RANK], axis=-1)
    q = _heads(_rmsnorm(c_q, q_norm_g) @ w_uq, GROUP_HEADS, MLA_NOPE + MLA_ROPE)
    kv = _heads(_rmsnorm(c_kv, kv_norm_g) @ w_ukv, GROUP_HEADS, MLA_NOPE + MLA_V)
    q_nope, q_pe = q[..., :MLA_NOPE], _rope(q[..., MLA_NOPE:], pos)
    k_nope, v = kv[..., :MLA_NOPE], kv[..., MLA_NOPE:]
    k_pe = jnp.broadcast_to(_rope(k_rope[:, None], pos), q_pe.shape)
    qf = jnp.concatenate([q_nope, q_pe], axis=-1)
    kf = jnp.concatenate([k_nope, k_pe], axis=-1)
    return _causal_softmax_blocks(qf, kf, v, (MLA_NOPE + MLA_ROPE) ** -0.5)


def _stick_breaking(c_in):
    qc, kc, vc = jnp.split(c_in, 3, axis=-1)
    q = _heads(qc, GROUP_HEADS, HEAD_DIM)
    k = _heads(kc, GROUP_HEADS, HEAD_DIM)
    v = _heads(vc, GROUP_HEADS, HEAD_DIM)
    s_len = q.shape[2]
    scale = HEAD_DIM ** -0.5

    def block(i):
        t0 = i * Q_BLOCK
        qb = lax.dynamic_slice_in_dim(q, t0, Q_BLOCK, axis=2)
        z = jnp.einsum('bhqd,bhkd->bhqk', qb, k).astype(jnp.float32) * scale
        strict = _causal_mask(t0, s_len, strict=True)
        log_1m = jnp.where(strict, jax.nn.log_sigmoid(-z), 0.0)
        suffix = lax.cumsum(log_1m, axis=3, reverse=True) - log_1m
        a = jnp.where(strict, jnp.exp(jax.nn.log_sigmoid(z) + suffix), 0.0)
        return jnp.einsum('bhqk,bhkd->bhqd', a.astype(v.dtype), v)

    return _sweep(block, s_len // Q_BLOCK)


def _forgetting_attention(d_in, b_f):
    qd, kd, vd, f_logit = jnp.split(d_in, [GROUP_WIDTH, 2 * GROUP_WIDTH, 3 * GROUP_WIDTH], axis=-1)
    q = _heads(qd, GROUP_HEADS, HEAD_DIM)
    k = _heads(kd, GROUP_HEADS, HEAD_DIM)
    v = _heads(vd, GROUP_HEADS, HEAD_DIM)
    log_f = jax.nn.log_sigmoid(f_logit.astype(jnp.float32) + b_f.astype(jnp.float32))
    cum = jnp.cumsum(log_f, axis=1).transpose(0, 2, 1)

    def decay_bias(t0):
        cq = lax.dynamic_slice_in_dim(cum, t0, Q_BLOCK, axis=2)
        return cq[..., None] - cum[:, :, None, :]

    return _causal_softmax_blocks(q, k, v, HEAD_DIM ** -0.5, decay_bias)


def _memory_attention(h, mem_n, w_q, w_k, w_v, w_o):
    b, s, _ = h.shape
    m = mem_n.shape[1]
    q = (h @ w_q).reshape(b, s, MEM_HEADS, MEM_HEAD_DIM)
    k = (mem_n @ w_k).reshape(b, m, MEM_HEADS, MEM_HEAD_DIM)
    v = (mem_n @ w_v).reshape(b, m, MEM_HEADS, MEM_HEAD_DIM)
    logits = jnp.einsum('bshd,bmhd->bhsm', q, k).astype(jnp.float32) * MEM_HEAD_DIM ** -0.5
    p = jax.nn.softmax(logits, axis=-1)
    o = jnp.einsum('bhsm,bmhd->bshd', p.astype(v.dtype), v).reshape(b, s, MEM_HEADS * MEM_HEAD_DIM)
    return o @ w_o


def setup_inputs(seed: int = 0) -> dict:
    key = jax.random.key(seed)
    ks = jax.random.split(key, 32)
    f32 = jnp.float32

    def nrm(k, shape, scale):
        return jax.random.normal(k, shape, f32) * scale

    def gain(k, shape):
        return 1.0 + 0.05 * jax.random.normal(k, shape, f32)

    L, D = DEPTH, D_MODEL
    start = jax.random.randint(ks[2], (BATCH, 1), 0, 1024, dtype=jnp.int32)
    positions = start + jnp.arange(SEQ, dtype=jnp.int32)[None, :]
    return {
        "x": nrm(ks[0], (BATCH, SEQ, D), 1.0),
        "mem": nrm(ks[1], (BATCH, MEM_TOKENS, D), 1.0),
        "positions": positions,
        "attn_norm_g": gain(ks[3], (L, D)),
        "w_in": nrm(ks[4], (L, D, IN_COLS), D ** -0.5),
        "w_out": nrm(ks[5], (L, MIX_WIDTH, D), MIX_WIDTH ** -0.5),
        "rel_table": nrm(ks[6], (REL_BUCKETS, GROUP_HEADS), 0.5),
        "diff_lam_q1": nrm(ks[7], (L, DIFF_QK), 0.1),
        "diff_lam_k1": nrm(ks[8], (L, DIFF_QK), 0.1),
        "diff_lam_q2": nrm(ks[9], (L, DIFF_QK), 0.1),
        "diff_lam_k2": nrm(ks[10], (L, DIFF_QK), 0.1),
        "diff_sub_g": gain(ks[11], (L, HEAD_DIM)),
        "mla_q_norm_g": gain(ks[12], (L, MLA_Q_RANK)),
        "mla_kv_norm_g": gain(ks[13], (L, MLA_KV_RANK)),
        "mla_w_uq": nrm(ks[14], (L, MLA_Q_RANK, GROUP_HEADS * (MLA_NOPE + MLA_ROPE)), MLA_Q_RANK ** -0.5),
        "mla_w_ukv": nrm(ks[15], (L, MLA_KV_RANK, GROUP_HEADS * (MLA_NOPE + MLA_V)), MLA_KV_RANK ** -0.5),
        "fox_b_f": 2.0 + 0.5 * jax.random.normal(ks[16], (L, GROUP_HEADS), f32),
        "mem_q_norm_g": gain(ks[17], (L, D)),
        "mem_kv_norm_g": gain(ks[18], (L, D)),
        "mem_w_q": nrm(ks[19], (L, D, MEM_HEADS * MEM_HEAD_DIM), D ** -0.5),
        "mem_w_k": nrm(ks[20], (L, D, MEM_HEADS * MEM_HEAD_DIM), D ** -0.5),
        "mem_w_v": nrm(ks[21], (L, D, MEM_HEADS * MEM_HEAD_DIM), D ** -0.5),
        "mem_w_o": nrm(ks[22], (L, MEM_HEADS * MEM_HEAD_DIM, D), (MEM_HEADS * MEM_HEAD_DIM) ** -0.5),
        "mlp_norm_g": gain(ks[23], (L, D)),
        "w_up": nrm(ks[24], (L, D, D_FF), D ** -0.5),
        "w_down": nrm(ks[25], (L, D_FF, D), D_FF ** -0.5),
        "final_norm_g": gain(ks[26], (D,)),
    }


def reference(x, mem, positions, attn_norm_g, w_in, w_out, rel_table,
              diff_lam_q1, diff_lam_k1, diff_lam_q2, diff_lam_k2, diff_sub_g,
              mla_q_norm_g, mla_kv_norm_g, mla_w_uq, mla_w_ukv, fox_b_f,
              mem_q_norm_g, mem_kv_norm_g, mem_w_q, mem_w_k, mem_w_v, mem_w_o,
              mlp_norm_g, w_up, w_down, final_norm_g):
    b_end = A_COLS + B_COLS
    c_end = b_end + C_COLS
    for l in range(DEPTH):
        h = _rmsnorm(x, attn_norm_g[l])
        proj = h @ w_in[l]
        a_in, b_in, c_in, d_in = jnp.split(proj, [A_COLS, b_end, c_end], axis=-1)

        lam_init = 0.8 - 0.6 * math.exp(-0.3 * l)
        lam = (jnp.exp(jnp.sum(diff_lam_q1[l].astype(jnp.float32) * diff_lam_k1[l].astype(jnp.float32)))
               - jnp.exp(jnp.sum(diff_lam_q2[l].astype(jnp.float32) * diff_lam_k2[l].astype(jnp.float32)))
               + lam_init)
        o_a = _diff_attention(a_in, positions, rel_table, lam, lam_init, diff_sub_g[l])
        o_b = _mla(b_in, positions, mla_q_norm_g[l], mla_kv_norm_g[l], mla_w_uq[l], mla_w_ukv[l])
        o_c = _stick_breaking(c_in)
        o_d = _forgetting_attention(d_in, fox_b_f[l])
        mix = jnp.concatenate([o_a, o_b, o_c, o_d], axis=-1)
        x = x + mix @ w_out[l]

        h = _rmsnorm(x, mem_q_norm_g[l])
        mem_n = _rmsnorm(mem, mem_kv_norm_g[l])
        x = x + _memory_attention(h, mem_n, mem_w_q[l], mem_w_k[l], mem_w_v[l], mem_w_o[l])

        h = _rmsnorm(x, mlp_norm_g[l])
        x = x + jnp.square(jax.nn.relu(h @ w_up[l])) @ w_down[l]
    return _rmsnorm(x, final_norm_g)
```

```cpp
#include <hip/hip_runtime.h>
#include <cstdio>
#include <cstdint>
#include <cstring>
#include <cmath>
__device__ __forceinline__ int fresh_lane() { unsigned z = 0u; asm volatile("" : "+v"(z)); return (int)__builtin_amdgcn_mbcnt_hi(~0u, __builtin_amdgcn_mbcnt_lo(~0u, z)); }
namespace pg8 {
#define PG8_LAS __attribute__((address_space(3)))
typedef unsigned short bf16_t;
typedef short bf16x8 __attribute__((ext_vector_type(8)));
typedef float f32x4 __attribute__((ext_vector_type(4)));
typedef unsigned u32x4 __attribute__((ext_vector_type(4)));
constexpr int BM = 256, BK = 64, HALF = 128, HTB = HALF * BK * 2  , STAGE_BYTES = 8 * HTB, NXCD = 8, WGM = 8;

__host__ __device__ __forceinline__ int lds_byte(int r, int c) { const int st = (r >> 4) * 2 + (c >> 5), rr = r & 15, cc = c & 31, ob = rr * 64 + cc * 2; return st * 1024 + (ob ^ (((ob >> 9) & 1) << 5)); }
__host__ __device__ __forceinline__ void stage_rc(int b, int& R, int& C) { const int st = b / 1024, sb = b % 1024, swz = sb ^ (((sb >> 9) & 1) << 5); R = (st >> 1) * 16 + swz / 64; C = (st & 1) * 32 + (swz % 64) / 2; }
__host__ __device__ __forceinline__ int perm32(int rho) { const int n = rho >> 4, i = rho & 15; return 8 * (i >> 2) + 4 * n + (i & 3); }

struct Unit { int pm, pn; };
struct Gemm { const bf16_t* A; const bf16_t* Bt; int M, N, K; };

struct StaticOrder {
    int nM, nN, nwg, G, c;
    __host__ __device__ void init(int M, int N, int G_, int c_) { nM = M / BM; nN = N / BM; nwg = nM * nN; G = G_; c = c_; }
    __host__ __device__ bool next(int i, Unit& u) const {
        const long L = (long)i * G + c; if (L >= nwg) return false;
        int wgid = (int)L; { const int q = nwg / NXCD, r = nwg % NXCD, xcd = wgid % NXCD, off = wgid / NXCD; wgid = (xcd < r ? xcd * (q + 1) : r * (q + 1) + (xcd - r) * q) + off; }
        const int nig = WGM * nN, gid = wgid / nig, fm = gid * WGM, gsz = (nM - fm) < WGM ? (nM - fm) : WGM;
        u.pm = fm + ((wgid % nig) % gsz); u.pn = (wgid % nig) / gsz; return true;
    }
    __device__ __forceinline__ void a_ready(const Unit&) const {}
    __device__ __forceinline__ void done(const Unit&) const {}
};

__device__ __forceinline__ unsigned cvt_pk_bf16(float lo, float hi) { unsigned r; asm volatile("v_cvt_pk_bf16_f32 %0, %1, %2" : "=v"(r) : "v"(lo), "v"(hi)); return r; }
typedef float f32x2 __attribute__((ext_vector_type(2)));
template <int ACT> struct EpiBf16 {
    static constexpr bool PERM = true, AFTER_DRAIN = false;
    bf16_t* O; int ldc;
    __device__ __forceinline__ void operator()(const f32x4 (&acc)[2][2][4][2], const Unit& u, int wr, int wc, int fr, int fq) const {
        const int row0 = u.pm * BM + wr * 64 + fr, col0 = u.pn * BM + wc * 32 + 8 * fq;
#pragma unroll
        for (int ai = 0; ai < 2; ++ai)
#pragma unroll
            for (int m = 0; m < 4; ++m) { bf16_t* rowp = O + (size_t)(row0 + ai * HALF + m * 16) * ldc + col0;
#pragma unroll
                for (int bj = 0; bj < 2; ++bj) { f32x4 v0 = acc[ai][bj][m][0], v1 = acc[ai][bj][m][1];
                    if (ACT == 1) {
#pragma unroll
                        for (int e = 0; e < 4; ++e) { const float a = fmaxf(v0[e], 0.f), b = fmaxf(v1[e], 0.f); v0[e] = a * a; v1[e] = b * b; } }
                    u32x4 w; w.x = cvt_pk_bf16(v0[0], v0[1]); w.y = cvt_pk_bf16(v0[2], v0[3]); w.z = cvt_pk_bf16(v1[0], v1[1]); w.w = cvt_pk_bf16(v1[2], v1[3]);
                    *(u32x4*)(rowp + bj * HALF) = w; } }
    }
};
struct EpiRes {
    static constexpr bool PERM = false, AFTER_DRAIN = false;
    const float* base; float* out; int ldc;
    __device__ __forceinline__ void operator()(const f32x4 (&acc)[2][2][4][2], const Unit& u, int wr, int wc, int fr, int fq) const {
        const int row0 = u.pm * BM + wr * 64 + fr, col0 = u.pn * BM + wc * 32 + 4 * fq;
#pragma unroll
        for (int ai = 0; ai < 2; ++ai)
#pragma unroll
            for (int m = 0; m < 4; ++m) { const size_t off = (size_t)(row0 + ai * HALF + m * 16) * ldc + col0;
#pragma unroll
                for (int bj = 0; bj < 2; ++bj)
#pragma unroll
                    for (int n = 0; n < 2; ++n) { const f32x4 bs = *(const f32x4*)(base + off + bj * HALF + n * 16); *(f32x4*)(out + off + bj * HALF + n * 16) = bs + acc[ai][bj][m][n]; } }
    }
};
template <class Epi, class Sched, bool ALIGN_EPI = false, bool SP2 = false>
__device__ __forceinline__ void gemm_phase(PG8_LAS unsigned char* lds, const Gemm g, const Sched& S, const Epi& E, const int wid0) {
    const int wid = wid0, lane = fresh_lane(), tid = wid * 64 + lane, wr = wid >> 2, wc = wid & 3, fr = lane & 15, fq = lane >> 4;
    const int K = g.K, nt = K / BK;
    unsigned voffA[2], voffB[2];
#pragma unroll
    for (int i = 0; i < 2; ++i) { int R, C; stage_rc(tid * 16 + i * 8192, R, C); const int Rb = Epi::PERM ? ((R & ~31) + perm32(R & 31)) : R;
        voffA[i] = (unsigned)(R * K + C) * 2u; voffB[i] = (unsigned)(Rb * K + C) * 2u; }
    const size_t kstep = (size_t)(BK * 2);
    const size_t hstep = (size_t)HALF * K * 2;
    const size_t tstep = 2 * hstep;
    const unsigned ldsw = (unsigned)wid * 1024u;
    const int aoff = lds_byte(wr * 64 + fr, fq * 8), boff = lds_byte(wc * 32 + fr, fq * 8);
#define PG8_SA(b, h) (((b) * 2 + (h)) * HTB)
#define PG8_SB(b, h) ((4 + (b) * 2 + (h)) * HTB)
#define PG8_STAGE(bufoff, gbase, voff) do { _Pragma("unroll") for (int _i = 0; _i < 2; ++_i) \
        __builtin_amdgcn_global_load_lds((const unsigned*)((const char*)(gbase) + (voff)[_i]), (PG8_LAS unsigned*)(lds + (bufoff) + ldsw + _i * 8192), 16, 0, 0); } while (0)
#define PG8_LDA(dst, b, h) do { _Pragma("unroll") for (int m = 0; m < 4; ++m) _Pragma("unroll") for (int k = 0; k < 2; ++k) dst[m][k] = *(const PG8_LAS bf16x8*)(lds + PG8_SA(b, h) + aoff + m * 2048 + k * 1024); } while (0)
#define PG8_LDB(dst, b, h) do { _Pragma("unroll") for (int n = 0; n < 2; ++n) _Pragma("unroll") for (int k = 0; k < 2; ++k) dst[n][k] = *(const PG8_LAS bf16x8*)(lds + PG8_SB(b, h) + boff + n * 2048 + k * 1024); } while (0)
#define PG8_MMA(ai, bj, At, Bt) do { __builtin_amdgcn_s_setprio(1); _Pragma("unroll") for (int m = 0; m < 4; ++m) _Pragma("unroll") for (int n = 0; n < 2; ++n) _Pragma("unroll") for (int k = 0; k < 2; ++k) \
        acc[ai][bj][m][n] = __builtin_amdgcn_mfma_f32_16x16x32_bf16(Bt[n][k], At[m][k], acc[ai][bj][m][n], 0, 0, 0); __builtin_amdgcn_s_setprio(0); } while (0)
#define PG8_WAIT_V(n) asm volatile("s_waitcnt vmcnt(" #n ")" ::: "memory")
#define PG8_WAIT_L(n) asm volatile("s_waitcnt lgkmcnt(" #n ")" ::: "memory")
#define PG8_BAR __builtin_amdgcn_s_barrier()
#define PG8_SCHED __builtin_amdgcn_sched_barrier(0)
    Unit cur, nxt; int ui = 0;
    if (!S.next(0, cur)) return;
    f32x4 acc[2][2][4][2];
#pragma unroll
    for (int a = 0; a < 2; ++a)
#pragma unroll
        for (int b = 0; b < 2; ++b)
#pragma unroll
            for (int m = 0; m < 4; ++m)
#pragma unroll
                for (int n = 0; n < 2; ++n) acc[a][b][m][n] = (f32x4){0.f, 0.f, 0.f, 0.f};
    bf16x8 At[4][2], B0[2][2], B1[2][2];
    const char* cA = (const char*)g.A + (size_t)cur.pm * tstep; const char* cB = (const char*)g.Bt + (size_t)cur.pn * tstep;
    S.a_ready(cur);
    if constexpr (SP2) {
        PG8_STAGE(PG8_SB(0, 0), cB, voffB); PG8_STAGE(PG8_SB(0, 1), cB + hstep, voffB); PG8_STAGE(PG8_SA(0, 0), cA, voffA); PG8_STAGE(PG8_SA(0, 1), cA + hstep, voffA);
        if (wr == 1) PG8_BAR;
        PG8_WAIT_V(2); PG8_BAR;
        PG8_STAGE(PG8_SB(1, 0), cB + kstep, voffB); PG8_STAGE(PG8_SA(1, 0), cA + kstep, voffA); PG8_STAGE(PG8_SB(1, 1), cB + hstep + kstep, voffB);
        PG8_WAIT_V(6); PG8_BAR;
    } else {
        PG8_STAGE(PG8_SB(0, 0), cB, voffB); PG8_STAGE(PG8_SA(0, 0), cA, voffA); PG8_STAGE(PG8_SB(0, 1), cB + hstep, voffB); PG8_STAGE(PG8_SA(0, 1), cA + hstep, voffA);
        if (wr == 1) PG8_BAR;
        PG8_WAIT_V(4); PG8_BAR;
        PG8_STAGE(PG8_SB(1, 0), cB + kstep, voffB); PG8_STAGE(PG8_SA(1, 0), cA + kstep, voffA); PG8_STAGE(PG8_SB(1, 1), cB + hstep + kstep, voffB);
        PG8_WAIT_V(6); PG8_BAR;
    }
    for (;;) {
        const bool has_next = S.next(ui + 1, nxt);
        const char* nA = has_next ? (const char*)g.A + (size_t)nxt.pm * tstep : cA; const char* nB = has_next ? (const char*)g.Bt + (size_t)nxt.pn * tstep : cB;
        for (int t = 0; t < nt; t += 2) {
            const bool last = (t == nt - 2);
            const char* a1 = cA + (size_t)(t + 1) * kstep;
            const char* a2 = last ? nA : cA + (size_t)(t + 2) * kstep; const char* b2 = last ? nB : cB + (size_t)(t + 2) * kstep;
            const char* a3 = a2 + kstep; const char* b3 = b2 + kstep;
            if (last && has_next) S.a_ready(nxt);
            if constexpr (SP2) {
            PG8_LDB(B0, 0, 0); PG8_LDB(B1, 0, 1); PG8_SCHED; PG8_LDA(At, 0, 0); PG8_STAGE(PG8_SA(1, 1), a1 + hstep, voffA);
            PG8_WAIT_V(8); PG8_WAIT_L(0); PG8_BAR; PG8_MMA(0, 0, At, B0); PG8_MMA(0, 1, At, B1); PG8_BAR; PG8_SCHED;
            PG8_LDA(At, 0, 1); PG8_STAGE(PG8_SB(0, 0), b2, voffB); PG8_STAGE(PG8_SB(0, 1), b2 + hstep, voffB); PG8_STAGE(PG8_SA(0, 0), a2, voffA);
            PG8_WAIT_V(8); PG8_WAIT_L(0); PG8_BAR; PG8_MMA(1, 0, At, B0); PG8_MMA(1, 1, At, B1); PG8_BAR; PG8_SCHED;
            PG8_LDB(B0, 1, 0); PG8_LDB(B1, 1, 1); PG8_SCHED; PG8_LDA(At, 1, 0); PG8_STAGE(PG8_SA(0, 1), a2 + hstep, voffA);
            PG8_WAIT_V(8); PG8_WAIT_L(0); PG8_BAR; PG8_MMA(0, 0, At, B0); PG8_MMA(0, 1, At, B1); PG8_BAR; PG8_SCHED;
            PG8_LDA(At, 1, 1); PG8_STAGE(PG8_SB(1, 0), b3, voffB); PG8_STAGE(PG8_SB(1, 1), b3 + hstep, voffB); PG8_STAGE(PG8_SA(1, 0), a3, voffA);
            PG8_WAIT_V(8); PG8_WAIT_L(0); PG8_BAR; PG8_MMA(1, 0, At, B0); PG8_MMA(1, 1, At, B1); PG8_BAR; PG8_SCHED;
            } else {
            PG8_LDB(B0, 0, 0); PG8_SCHED; PG8_LDA(At, 0, 0); PG8_STAGE(PG8_SA(1, 1), a1 + hstep, voffA);
            PG8_WAIT_L(8); PG8_BAR; PG8_WAIT_L(0); PG8_MMA(0, 0, At, B0); PG8_BAR; PG8_SCHED;
            PG8_LDB(B1, 0, 1); PG8_STAGE(PG8_SB(0, 0), b2, voffB);
            PG8_BAR; PG8_WAIT_L(0); PG8_MMA(0, 1, At, B1); PG8_BAR;
            PG8_LDA(At, 0, 1); PG8_STAGE(PG8_SA(0, 0), a2, voffA);
            PG8_BAR; PG8_WAIT_L(0); PG8_MMA(1, 0, At, B0); PG8_BAR; PG8_SCHED;
            PG8_STAGE(PG8_SB(0, 1), b2 + hstep, voffB);
            PG8_WAIT_V(6); PG8_BAR; PG8_MMA(1, 1, At, B1); PG8_BAR;
            PG8_LDB(B0, 1, 0); PG8_SCHED; PG8_LDA(At, 1, 0); PG8_STAGE(PG8_SA(0, 1), a2 + hstep, voffA);
            PG8_WAIT_L(8); PG8_BAR; PG8_WAIT_L(0); PG8_MMA(0, 0, At, B0); PG8_BAR; PG8_SCHED;
            PG8_LDB(B1, 1, 1); PG8_STAGE(PG8_SB(1, 0), b3, voffB);
            PG8_BAR; PG8_WAIT_L(0); PG8_MMA(0, 1, At, B1); PG8_BAR;
            PG8_LDA(At, 1, 1); PG8_STAGE(PG8_SA(1, 0), a3, voffA);
            PG8_BAR; PG8_WAIT_L(0); PG8_MMA(1, 0, At, B0); PG8_BAR; PG8_SCHED;
            PG8_STAGE(PG8_SB(1, 1), b3 + hstep, voffB);
            PG8_WAIT_V(6); PG8_BAR; PG8_MMA(1, 1, At, B1); PG8_BAR;
            }
        }
        if constexpr (ALIGN_EPI) { if (wr == 0) PG8_BAR; }
        if constexpr (!Epi::AFTER_DRAIN) { E(acc, cur, wr, wc, fr, fq); S.done(cur); }
        if (!has_next) break;
#pragma unroll
        for (int a = 0; a < 2; ++a)
#pragma unroll
            for (int b = 0; b < 2; ++b)
#pragma unroll
                for (int m = 0; m < 4; ++m)
#pragma unroll
                    for (int n = 0; n < 2; ++n) acc[a][b][m][n] = (f32x4){0.f, 0.f, 0.f, 0.f};
        cur = nxt; cA = nA; cB = nB; ++ui;
        if constexpr (ALIGN_EPI) { if (wr == 1) PG8_BAR; }
    }
    PG8_WAIT_V(0);
    if constexpr (!ALIGN_EPI) { if (wr == 0) PG8_BAR; }
    PG8_BAR;
    if constexpr (Epi::AFTER_DRAIN) { E.fused(acc, cur, wr, wc, fr, fq, lds, wid, lane); S.done(cur); }
#undef PG8_SA
#undef PG8_SB
#undef PG8_STAGE
#undef PG8_LDA
#undef PG8_LDB
#undef PG8_MMA
#undef PG8_WAIT_V
#undef PG8_WAIT_L
#undef PG8_BAR
#undef PG8_SCHED
}
}
#define GAS __attribute__((address_space(1)))
#define LAS __attribute__((address_space(3)))
typedef unsigned short bf16;
typedef unsigned v4u __attribute__((ext_vector_type(4)));
typedef float f32x4 __attribute__((ext_vector_type(4)));
typedef short bf16x8 __attribute__((ext_vector_type(8)));
typedef GAS unsigned gu32;
typedef GAS unsigned long long gu64;
#define RLX_AGENT __ATOMIC_RELAXED, __HIP_MEMORY_SCOPE_AGENT
#define LDS_WAIT() asm volatile("s_waitcnt lgkmcnt(0)" ::: "memory")
#define VM_WAIT() asm volatile("s_waitcnt vmcnt(0)" ::: "memory")
__device__ __forceinline__ unsigned long long rt() { return __builtin_amdgcn_s_memrealtime(); }
__device__ __forceinline__ unsigned f2bf(float f) { unsigned u = __builtin_bit_cast(unsigned, f); return (u + 0x7fffu + ((u >> 16) & 1u)) >> 16; }
__device__ __forceinline__ unsigned pk2(float lo, float hi) { return f2bf(lo) | (f2bf(hi) << 16); }

#define XB_TMO      128
#define XB_XCNT(j)  (256  + 64 * (j))
#define XB_XSUB(j)  (1280 + 64 * (j))
#define XB_XGEN(j)  (2304 + 64 * (j))
#define XB_TOP      3328
#define XB_TOPGEN   3392
#define XCD_BAR_WORDS 3456
#define XB_SPIN_CAP (1u << 18)

__device__ __forceinline__ unsigned xb_ld(unsigned* p)              { return __hip_atomic_load(p, __ATOMIC_RELAXED, __HIP_MEMORY_SCOPE_AGENT); }
__device__ __forceinline__ unsigned xb_add(unsigned* p, unsigned v) { return __hip_atomic_fetch_add(p, v, __ATOMIC_RELAXED, __HIP_MEMORY_SCOPE_AGENT); }
__device__ __forceinline__ unsigned xb_xcc_id() { return (unsigned)__builtin_amdgcn_s_getreg((3 << 11) | 20) & 0xFu; }
#define XB_SPIN(cond, bar) do { unsigned _sp = 0; while (cond) { __builtin_amdgcn_s_sleep(1); \
    if ((++_sp & 255u) == 0u) { if (xb_ld(&(bar)[XB_TMO])) break; if (_sp > XB_SPIN_CAP) { atomicAdd(&(bar)[XB_TMO], 1u); break; } } } } while (0)

struct XcdBarrier {
    unsigned* bar; unsigned x;
    volatile LAS unsigned* st;
};

__device__ __forceinline__ XcdBarrier xcd_barrier_post(unsigned* bar, volatile LAS unsigned* st, const int wid0) {
    XcdBarrier b; b.bar = bar; b.x = xb_xcc_id(); b.st = st;
    if (wid0 == 0 && fresh_lane() == 0) (void)xb_add(&bar[XB_XCNT(b.x)], 1u);
    return b;
}
__device__ __forceinline__ void xcd_barrier_complete(unsigned* bar, unsigned x, unsigned& nloc, unsigned& nx) {
    const unsigned G = gridDim.x * gridDim.y * gridDim.z;
    unsigned sum, cnt, mine, sp = 0u;
    for (;;) {
        sum = 0u; cnt = 0u; mine = 0u;
#pragma unroll 1
        for (unsigned j = 0; j < 16; ++j) { const unsigned c = xb_ld(&bar[XB_XCNT(j)]); sum += c; cnt += (c > 0u) ? 1u : 0u; mine = (j == x) ? c : mine; }
        if (sum == G) break;
        __builtin_amdgcn_s_sleep(1);
        if ((++sp & 255u) == 0u) { if (xb_ld(&bar[XB_TMO])) break; if (sp > XB_SPIN_CAP) { atomicAdd(&bar[XB_TMO], 1u); break; } }
    }
    nloc = mine > 0u ? mine : 1u; nx = cnt > 0u ? cnt : 1u;
}

__device__ __forceinline__ void xcd_barrier(const XcdBarrier& b, const int wid0) {
    asm volatile("s_waitcnt vmcnt(0)" ::: "memory");
    __syncthreads();
    if (wid0 == 0 && fresh_lane() == 0) {
        unsigned* bar = b.bar;
        __builtin_amdgcn_s_waitcnt(0);
        unsigned nloc = b.st[0], nx = b.st[1];
        const unsigned bx_ = xb_xcc_id();
        if (nloc == 0u) { xcd_barrier_complete(bar, bx_, nloc, nx); b.st[0] = nloc; b.st[1] = nx; }
        const unsigned old = xb_add(&bar[XB_XSUB(bx_)], 1u);
        const unsigned gen = old / nloc;
        if (old + 1u == (gen + 1u) * nloc) {
            __builtin_amdgcn_fence(__ATOMIC_RELEASE, "agent");
            asm volatile("s_waitcnt vmcnt(0)" ::: "memory");
            const unsigned og = xb_add(&bar[XB_TOP], 1u);
            const unsigned tg = og / nx;
            if (og + 1u == (tg + 1u) * nx) xb_add(&bar[XB_TOPGEN], 1u);
            else XB_SPIN(xb_ld(&bar[XB_TOPGEN]) == tg, bar);
            __builtin_amdgcn_fence(__ATOMIC_ACQUIRE, "agent");
            xb_add(&bar[XB_XGEN(bx_)], 1u);
            asm volatile("s_waitcnt vmcnt(0)" ::: "memory");
        } else {
            XB_SPIN(xb_ld(&bar[XB_XGEN(bx_)]) == gen, bar);
            __builtin_amdgcn_fence(__ATOMIC_ACQUIRE, "agent");
            asm volatile("s_waitcnt vmcnt(0)" ::: "memory");
        }
    }
    __syncthreads();
}
constexpr int NWAVES = 8;
constexpr int NB = 2, SEQ = 4096, DM = 4096, NL = 2, M = NB * SEQ;
constexpr int INC = 11336, INP = 11520;
constexpr int A_Q = 0, B_CQ = 3072, B_CKV = 4608, B_KR = 5120, C_Q = 5184, D_Q = 8256, D_F = 11328;
constexpr int QRANK = 1536, KVRANK = 512, DFF = 16384, MEMT = 256;
constexpr float EPS = 1e-6f;

constexpr size_t MiB = 1u << 20;
constexpr size_t WS_CTL = 0, CTL_ZERO_BYTES = 1 * MiB;
constexpr size_t WS_COS = 1 * MiB, WS_SIN = 2 * MiB;
constexpr size_t WS_LUT = 3 * MiB;
constexpr size_t WS_TPMAX = 3 * MiB + 8192;
constexpr size_t WS_LAM = 3 * MiB + 12288;
constexpr size_t WS_LOGF = 4 * MiB, WS_NEGC = 4 * MiB + 512 * 1024;
constexpr size_t WS_W = 8 * MiB;
constexpr size_t SZ_IN = (size_t)INP * DM * 2, SZ_OUT = (size_t)DM * DM * 2, SZ_UQ = (size_t)1536 * 1536 * 2, SZ_UKV = (size_t)2048 * 512 * 2,
                 SZ_MQ = (size_t)512 * DM * 2, SZ_MKV = (size_t)1024 * DM * 2, SZ_MO = (size_t)DM * 512 * 2, SZ_UP = (size_t)DFF * DM * 2, SZ_DN = SZ_UP;
constexpr size_t W_IN = 0, W_OUT = W_IN + SZ_IN, W_UQ = W_OUT + SZ_OUT, W_UKV = W_UQ + SZ_UQ, W_MQ = W_UKV + SZ_UKV, W_MKV = W_MQ + SZ_MQ, W_MO = W_MKV + SZ_MKV,
                 W_UP = W_MO + SZ_MO, W_DN = W_UP + SZ_UP, W_LAYER = W_DN + SZ_DN;
static_assert(W_LAYER % 256 == 0, "weight block alignment");
constexpr size_t WS_MEMN = WS_W + NL * W_LAYER;
constexpr size_t WS_KVMEM = WS_MEMN + (size_t)NL * 512 * DM * 2;
constexpr size_t WS_H = WS_KVMEM + (size_t)NL * 512 * 1024 * 2;
constexpr size_t WS_CQN = WS_H + (size_t)M * DM * 2;
constexpr size_t WS_CKVN = WS_CQN + (size_t)M * 1536 * 2;
constexpr size_t WS_KPE = WS_CKVN + (size_t)M * 512 * 2;
constexpr size_t WS_QMLA = WS_KPE + (size_t)M * 64 * 2;
constexpr size_t WS_KVMLA = WS_QMLA + (size_t)M * 1536 * 2;
constexpr size_t WS_QMEM = WS_KVMLA + (size_t)M * 2048 * 2;
constexpr size_t WS_OMEM = WS_QMEM + (size_t)M * 512 * 2;
constexpr size_t WS_U = WS_OMEM + (size_t)M * 512 * 2;
constexpr size_t WS_PROJ = WS_U;
constexpr size_t WS_MIX = WS_PROJ + (size_t)M * INP * 2;
static_assert(WS_MIX + (size_t)M * DM * 2 <= WS_U + (size_t)M * DFF * 2, "PROJ + MIX fit inside U");
constexpr size_t WS_END = WS_U + (size_t)M * DFF * 2;
constexpr int CW_BAR = 4096;
constexpr int CW_TKT = 16384;

constexpr int RING_OFF = 0, RING_BYTES = 137216;
constexpr int LDSCTL_OFF = RING_BYTES, MISC_OFF = LDSCTL_OFF + 320;
constexpr int LDS_BYTES = 147456;

typedef unsigned short bf16;
typedef short bf16x8 __attribute__((ext_vector_type(8)));
typedef short s16x4 __attribute__((ext_vector_type(4)));
typedef float f32x4 __attribute__((ext_vector_type(4)));
typedef float f32x16 __attribute__((ext_vector_type(16)));
typedef unsigned v4u __attribute__((ext_vector_type(4)));
typedef unsigned v2u __attribute__((ext_vector_type(2)));
typedef int i32x4 __attribute__((ext_vector_type(4)));

__device__ __forceinline__ unsigned cvtpk(float lo, float hi) { unsigned r; asm volatile("v_cvt_pk_bf16_f32 %0, %1, %2" : "=v"(r) : "v"(lo), "v"(hi)); return r; }
__device__ __forceinline__ float bf2f(short s) { return __uint_as_float(((unsigned)(unsigned short)s) << 16); }
template <int X> __device__ __forceinline__ float shx(float v) { return __int_as_float(__builtin_amdgcn_ds_swizzle(__float_as_int(v), 0x1f | (X << 10))); }
template <int X> __device__ __forceinline__ int shxi(int v) { return __builtin_amdgcn_ds_swizzle(v, 0x1f | (X << 10)); }
__device__ __forceinline__ float half_sum(float v) { v += shx<1>(v); v += shx<2>(v); v += shx<4>(v); v += shx<8>(v); v += shx<16>(v); return v; }
__device__ __forceinline__ float wave_sum(float v) { v = half_sum(v);
    auto rr = __builtin_amdgcn_permlane32_swap(__float_as_uint(v), __float_as_uint(v), false, false); return __uint_as_float(rr[0]) + __uint_as_float(rr[1]); }
#define FRESH_LANE(name) const int name = fresh_lane()
#define WAITBAR() asm volatile("s_waitcnt vmcnt(0) lgkmcnt(0)\n\ts_barrier" ::: "memory")

__device__ __forceinline__ void tr_item(const float* W, int K, int N, int nblk, bf16* WT, int row_off, LAS float* scr, int item, int lane) {
    const int kb = item / nblk, nb = item - kb * nblk, k0 = 64 * kb, n0 = 32 * nb;
    const int n = n0 + (lane & 31); const bool ok = n < N;
#pragma unroll 8
    for (int i = 0; i < 32; ++i) { const int kk = 2 * i + (lane >> 5); scr[kk * 33 + (lane & 31)] = ok ? W[(size_t)(k0 + kk) * N + n] : 0.f; }
    LDS_WAIT(); asm volatile("" ::: "memory");
    const int c = lane & 7;
#pragma unroll
    for (int j = 0; j < 4; ++j) { const int nn = (lane >> 3) + 8 * j; const LAS float* s = scr + (8 * c) * 33 + nn;
        v4u o; o.x = cvtpk(s[0 * 33], s[1 * 33]); o.y = cvtpk(s[2 * 33], s[3 * 33]); o.z = cvtpk(s[4 * 33], s[5 * 33]); o.w = cvtpk(s[6 * 33], s[7 * 33]);
        *(GAS v4u*)(WT + (size_t)(row_off + n0 + nn) * K + k0 + 8 * c) = o; }
    LDS_WAIT(); asm volatile("" ::: "memory");
}
template <bool BF> __device__ __forceinline__ void rms_row(const float* xrow, const float* g, void* orow, int lane) {
    const GAS f32x4* xr = (const GAS f32x4*)xrow + lane; const GAS f32x4* gr = (const GAS f32x4*)g + lane;
    f32x4 v[16]; float s = 0.f;
#pragma unroll
    for (int j = 0; j < 16; ++j) { v[j] = xr[64 * j]; s += (v[j].x * v[j].x + v[j].y * v[j].y) + (v[j].z * v[j].z + v[j].w * v[j].w); }
    const float rstd = 1.0f / sqrtf(wave_sum(s) * (1.f / DM) + EPS);
#pragma unroll
    for (int j = 0; j < 16; ++j) { const f32x4 gg = gr[64 * j]; const f32x4 y = v[j] * rstd * gg;
        if (BF) { v2u w; w.x = cvtpk(y.x, y.y); w.y = cvtpk(y.z, y.w); ((GAS v2u*)orow)[64 * j + lane] = w; }
        else ((GAS f32x4*)orow)[64 * j + lane] = y; }
}
__device__ __forceinline__ float logsigmoidf_(float x) {
    const float e = __expf(-fabsf(x)); return fminf(x, 0.f) - __logf(1.f + e);
}
__device__ __forceinline__ void prep_row(const bf16* proj, int m, const float* gq, const float* gkv, const float* bf, const float* COS, const float* SIN,
                                         bf16* CQN, bf16* CKVN, bf16* KPE, float* LOGF, int lane) {
    const bf16* pr = proj + (size_t)m * INP;
    bf16x8 q[3]; float sq = 0.f;
#pragma unroll
    for (int j = 0; j < 3; ++j) { q[j] = *(const GAS bf16x8*)(pr + B_CQ + (j * 64 + lane) * 8);
#pragma unroll
        for (int e = 0; e < 8; ++e) { const float f = bf2f(q[j][e]); sq += f * f; } }
    const bf16x8 kv = *(const GAS bf16x8*)(pr + B_CKV + lane * 8); float skv = 0.f;
#pragma unroll
    for (int e = 0; e < 8; ++e) { const float f = bf2f(kv[e]); skv += f * f; }
    const float rq = 1.0f / sqrtf(wave_sum(sq) * (1.f / QRANK) + EPS), rkv = 1.0f / sqrtf(wave_sum(skv) * (1.f / KVRANK) + EPS);
#pragma unroll
    for (int j = 0; j < 3; ++j) { const int c0 = (j * 64 + lane) * 8; const f32x4 g0 = *(const GAS f32x4*)(gq + c0), g1 = *(const GAS f32x4*)(gq + c0 + 4);
        v4u w; w.x = cvtpk(bf2f(q[j][0]) * rq * g0.x, bf2f(q[j][1]) * rq * g0.y); w.y = cvtpk(bf2f(q[j][2]) * rq * g0.z, bf2f(q[j][3]) * rq * g0.w);
        w.z = cvtpk(bf2f(q[j][4]) * rq * g1.x, bf2f(q[j][5]) * rq * g1.y); w.w = cvtpk(bf2f(q[j][6]) * rq * g1.z, bf2f(q[j][7]) * rq * g1.w);
        *(GAS v4u*)(CQN + (size_t)m * QRANK + c0) = w; }
    { const int c0 = lane * 8; const f32x4 g0 = *(const GAS f32x4*)(gkv + c0), g1 = *(const GAS f32x4*)(gkv + c0 + 4);
        v4u w; w.x = cvtpk(bf2f(kv[0]) * rkv * g0.x, bf2f(kv[1]) * rkv * g0.y); w.y = cvtpk(bf2f(kv[2]) * rkv * g0.z, bf2f(kv[3]) * rkv * g0.w);
        w.z = cvtpk(bf2f(kv[4]) * rkv * g1.x, bf2f(kv[5]) * rkv * g1.y); w.w = cvtpk(bf2f(kv[6]) * rkv * g1.z, bf2f(kv[7]) * rkv * g1.w);
        *(GAS v4u*)(CKVN + (size_t)m * KVRANK + c0) = w; }
    { const float v = bf2f((short)pr[B_KR + lane]); float pv; { auto rr = __builtin_amdgcn_permlane32_swap(__float_as_uint(v), __float_as_uint(v), false, false); pv = __uint_as_float(lane >= 32 ? rr[0] : rr[1]); } const int i = lane & 31;
      const float c = COS[(size_t)m * 32 + i], s = SIN[(size_t)m * 32 + i];
      const float o = lane < 32 ? v * c - pv * s : pv * s + v * c;
      const float on = shx<1>(o);
      if ((lane & 1) == 0) *(GAS unsigned*)(KPE + (size_t)m * 64 + lane) = cvtpk(o, on); }
    if (lane < 8) { const float f = bf2f((short)pr[D_F + lane]) + bf[lane]; const int b = m / SEQ, s = m - b * SEQ; LOGF[(size_t)(b * 8 + lane) * SEQ + s] = logsigmoidf_(f); }
}
__device__ __forceinline__ void fox_scan(const float* logf, float* negc, int lane) {
    const GAS f32x4* src = (const GAS f32x4*)(logf + lane * 64); f32x4 v[16]; float tot = 0.f;
#pragma unroll
    for (int j = 0; j < 16; ++j) { v[j] = src[j]; tot += (v[j].x + v[j].y) + (v[j].z + v[j].w); }
    float inc = tot;
#pragma unroll
    for (int o = 1; o < 64; o <<= 1) { const float t = __int_as_float(__builtin_amdgcn_ds_bpermute((lane - o) << 2, __float_as_int(inc))); if (lane >= o) inc += t; }
    float run = inc - tot; const float k = -11.313708498984761f;
    GAS f32x4* dst = (GAS f32x4*)(negc + lane * 64);
#pragma unroll
    for (int j = 0; j < 16; ++j) { f32x4 o; run += v[j].x; o.x = run * k; run += v[j].y; o.y = run * k; run += v[j].z; o.z = run * k; run += v[j].w; o.w = run * k; dst[j] = o; }
}

namespace att {
constexpr int VA = 0, VB = 1, VC = 2, VD = 3, VE = 4;
constexpr int K_OFF = 0, V_OFF = 32768, B_OFF = 65536, WS_OFF = 67584, LUT_OFF = 69632, FLG_OFF = 70656, TKT_OFF = 70784, KPE_OFF = 71680, QF_OFF = 71680, ATT_END = QF_OFF + 65536;
constexpr float LOG2E = 1.4426950408889634f, LN2 = 0.6931471805599453f, THR = 8.f;
struct Ctx { const bf16* PROJ; const bf16* QMLA; const bf16* KVMLA; const bf16* KPE; bf16* MIX; const bf16* QMEM; const bf16* KVMEM; bf16* OMEM;
             const float* COS; const float* SIN; const float* LUT; const int* TPMAX; const int* pos; const float* NEGC; const float* sub_g; float lam, oml; };

__device__ __forceinline__ int crow(int r, int hi) { return (r & 3) + 8 * (r >> 2) + 4 * hi; }
__device__ __forceinline__ int swap23(int k) { return (k & ~0xC) | ((k & 4) << 1) | ((k & 8) >> 1); }
__device__ __forceinline__ float pmaxf(float v) { auto rr = __builtin_amdgcn_permlane32_swap(__float_as_uint(v), __float_as_uint(v), false, false); return fmaxf(__uint_as_float(rr[0]), __uint_as_float(rr[1])); }
__device__ __forceinline__ float psumf(float v) { auto rr = __builtin_amdgcn_permlane32_swap(__float_as_uint(v), __float_as_uint(v), false, false); return __uint_as_float(rr[0]) + __uint_as_float(rr[1]); }
__device__ __forceinline__ float partnerf(float v, int hi) { auto rr = __builtin_amdgcn_permlane32_swap(__float_as_uint(v), __float_as_uint(v), false, false); return __uint_as_float(hi ? rr[0] : rr[1]); }
__device__ __forceinline__ void dma16(const void* sbase, unsigned voff, unsigned ldsaddr) { unsigned keep;
    asm volatile("s_mov_b32 %0, m0\n\ts_mov_b32 m0, %3\n\ts_nop 0\n\tglobal_load_lds_dwordx4 %1, %2\n\ts_mov_b32 m0, %0" : "=&s"(keep) : "v"(voff), "s"(sbase), "s"(ldsaddr) : "memory"); }

template <int NK> __device__ __forceinline__ void qk(f32x16& p0, f32x16& p1, const LAS unsigned char* krow, int xr, int hx, const bf16x8* qf, int dstart) {
#pragma unroll
    for (int d0 = 0; d0 < NK; ++d0) { const int off = (((dstart + d0) * 32 + hx) ^ xr);
        const bf16x8 b0 = *(const LAS bf16x8*)(krow + off), b1 = *(const LAS bf16x8*)(krow + off + 8192);
        p0 = __builtin_amdgcn_mfma_f32_32x32x16_bf16(b0, qf[d0], p0, 0, 0, 0); p1 = __builtin_amdgcn_mfma_f32_32x32x16_bf16(b1, qf[d0], p1, 0, 0, 0); }
}
template <int NK> __device__ __forceinline__ void qk_l(f32x16& p0, f32x16& p1, const LAS unsigned char* krow, int xr, int hx, const LAS unsigned char* qlds, int dstart) {
#pragma unroll
    for (int d0 = 0; d0 < NK; ++d0) { const int off = (((dstart + d0) * 32 + hx) ^ xr);
        const bf16x8 b0 = *(const LAS bf16x8*)(krow + off), b1 = *(const LAS bf16x8*)(krow + off + 8192), q = *(const LAS bf16x8*)(qlds + (dstart + d0) * 1024);
        p0 = __builtin_amdgcn_mfma_f32_32x32x16_bf16(b0, q, p0, 0, 0, 0); p1 = __builtin_amdgcn_mfma_f32_32x32x16_bf16(b1, q, p1, 0, 0, 0); }
}
__device__ __forceinline__ void qk_pe(f32x16& p0, f32x16& p1, const LAS unsigned char* perow, int xpe, int hx, const bf16x8* qf) {
#pragma unroll
    for (int d0 = 0; d0 < 4; ++d0) { const int off = ((d0 * 32 + hx) ^ xpe);
        const bf16x8 b0 = *(const LAS bf16x8*)(perow + off), b1 = *(const LAS bf16x8*)(perow + off + 4096);
        p0 = __builtin_amdgcn_mfma_f32_32x32x16_bf16(b0, qf[d0], p0, 0, 0, 0); p1 = __builtin_amdgcn_mfma_f32_32x32x16_bf16(b1, qf[d0], p1, 0, 0, 0); }
}
__device__ __forceinline__ void pv(f32x16* o, unsigned vb, bf16x8 pa0, bf16x8 pa1, bf16x8 pa2, bf16x8 pa3) {
#define TRRD(dst, off) asm volatile("ds_read_b64_tr_b16 %0, %1 offset:%2" : "=&v"(dst) : "v"(vb), "i"(off) : "memory")
#define PV_D0(d0) do { s16x4 l0, l1, l2, l3, h0, h1, h2, h3; constexpr int b_ = (d0) * 512; \
        TRRD(l0, b_); TRRD(h0, b_ + 2048); TRRD(l1, b_ + 4096); TRRD(h1, b_ + 6144); TRRD(l2, b_ + 8192); TRRD(h2, b_ + 10240); TRRD(l3, b_ + 12288); TRRD(h3, b_ + 14336); \
        asm volatile("s_waitcnt lgkmcnt(0)" ::: "memory"); __builtin_amdgcn_sched_barrier(0); \
        o[d0] = __builtin_amdgcn_mfma_f32_32x32x16_bf16(pa0, (bf16x8){l0[0], l0[1], l0[2], l0[3], h0[0], h0[1], h0[2], h0[3]}, o[d0], 0, 0, 0); \
        o[d0] = __builtin_amdgcn_mfma_f32_32x32x16_bf16(pa1, (bf16x8){l1[0], l1[1], l1[2], l1[3], h1[0], h1[1], h1[2], h1[3]}, o[d0], 0, 0, 0); \
        o[d0] = __builtin_amdgcn_mfma_f32_32x32x16_bf16(pa2, (bf16x8){l2[0], l2[1], l2[2], l2[3], h2[0], h2[1], h2[2], h2[3]}, o[d0], 0, 0, 0); \
        o[d0] = __builtin_amdgcn_mfma_f32_32x32x16_bf16(pa3, (bf16x8){l3[0], l3[1], l3[2], l3[3], h3[0], h3[1], h3[2], h3[3]}, o[d0], 0, 0, 0); } while (0)
    PV_D0(0); PV_D0(1); PV_D0(2); PV_D0(3);
#undef PV_D0
#undef TRRD
}
__device__ __forceinline__ void pack_p(const f32x16& p0, const f32x16& p1, bf16x8& pa0, bf16x8& pa1, bf16x8& pa2, bf16x8& pa3) {
#define PK4(P, B_, OUT) do { unsigned a0 = cvtpk(P[B_ + 0], P[B_ + 1]), a1 = cvtpk(P[B_ + 2], P[B_ + 3]), b0 = cvtpk(P[B_ + 4], P[B_ + 5]), b1 = cvtpk(P[B_ + 6], P[B_ + 7]); \
        auto r0 = __builtin_amdgcn_permlane32_swap(a0, b0, false, false); auto r1 = __builtin_amdgcn_permlane32_swap(a1, b1, false, false); \
        v4u w = {r0[0], r1[0], r0[1], r1[1]}; OUT = __builtin_bit_cast(bf16x8, w); } while (0)
    PK4(p0, 0, pa0); PK4(p0, 8, pa1); PK4(p1, 0, pa2); PK4(p1, 8, pa3);
#undef PK4
}
__device__ __forceinline__ void softmax_pv(f32x16& p0, f32x16& p1, float& m, float& l, f32x16* o, LAS float* wsf, unsigned vb, int r32, int hi, const float SCALE, const float C2) {
    float pmax = p0[0];
#pragma unroll
    for (int r = 1; r < 16; ++r) pmax = fmaxf(pmax, p0[r]);
#pragma unroll
    for (int r = 0; r < 16; ++r) pmax = fmaxf(pmax, p1[r]);
    pmax = pmaxf(pmax);
    float mn, alpha;
    if (__all((pmax - m) * SCALE <= THR)) { mn = m; alpha = 1.f; }
    else { mn = fmaxf(m, pmax); alpha = __builtin_amdgcn_exp2f((m - mn) * C2); m = mn; }
    const float mnL = -mn * C2;
#pragma unroll
    for (int r = 0; r < 16; ++r) { p0[r] = __builtin_amdgcn_exp2f(fmaf(p0[r], C2, mnL)); p1[r] = __builtin_amdgcn_exp2f(fmaf(p1[r], C2, mnL)); }
    float ps = 0.f;
#pragma unroll
    for (int r = 0; r < 16; ++r) ps += p0[r] + p1[r];
    ps = psumf(ps); l = l * alpha + ps;
    bf16x8 pa0, pa1, pa2, pa3; pack_p(p0, p1, pa0, pa1, pa2, pa3);
    if (__any(alpha < 1.f)) { const int fl = fresh_lane(), fh = fl >> 5;
        if (fh == 0) wsf[fl] = alpha; asm volatile("s_waitcnt lgkmcnt(0)" ::: "memory");
#pragma unroll
        for (int r = 0; r < 16; ++r) { const float a = wsf[crow(r, fh)];
#pragma unroll
            for (int d = 0; d < 4; ++d) o[d][r] *= a; } }
    pv(o, vb, pa0, pa1, pa2, pa3);
}

template <int VAR>
__device__ __forceinline__ void attn_unit(const Ctx& C, int b, int h, int qb, LAS unsigned char* lds, int tid, int wid, int lane) {
    constexpr bool CAUSAL = VAR != VE, DESC = (VAR == VC || VAR == VD), MLA = (VAR == VB), DIFF = (VAR == VA), STICK = (VAR == VC), HASB = (VAR == VA || VAR == VD);
    constexpr int NQF = MLA ? 12 : 8;
    constexpr float SCALE = DIFF ? 0.125f : (MLA ? 0.07216878364870323f : 0.08838834764831845f);
    constexpr float C2 = SCALE * LOG2E;
    const int r32 = lane & 31, hi = lane >> 5;
    const int q0 = qb * 256, qw = q0 + wid * 32, trow = qw + r32;
    const size_t rb = (size_t)b * SEQ;
    const bf16 *Qp, *Kp, *Vp; bf16* Op; int qpitch, kpitch, opitch;
    if constexpr (VAR == VA || VAR == VC || VAR == VD) {
        constexpr int base = VAR == VA ? A_Q : (VAR == VC ? C_Q : D_Q);
        Qp = C.PROJ + rb * INP + base + h * 128; Kp = Qp + 1024; Vp = Qp + 2048; qpitch = INP; kpitch = INP;
        Op = C.MIX + rb * DM + VAR * 1024 + h * 128; opitch = DM;
    } else if constexpr (VAR == VB) {
        Qp = C.QMLA + rb * 1536 + h * 192; qpitch = 1536; Kp = C.KVMLA + rb * 2048 + h * 256; Vp = Kp + 128; kpitch = 2048;
        Op = C.MIX + rb * DM + 1024 + h * 128; opitch = DM;
    } else {
        Qp = C.QMEM + rb * 512 + h * 128; qpitch = 512; Kp = C.KVMEM + (size_t)b * MEMT * 1024 + h * 128; Vp = Kp + 512; kpitch = 1024;
        Op = C.OMEM + rb * 512 + h * 128; opitch = 512;
    }
    const char* Bp = nullptr;
    if constexpr (VAR == VA) Bp = (const char*)(C.pos + rb);
    if constexpr (VAR == VD) Bp = (const char*)(C.NEGC + (size_t)(b * 8 + h) * SEQ);
    const char* KPEp = nullptr;
    if constexpr (MLA) KPEp = (const char*)(C.KPE + rb * 64);
    bf16x8 qr[DIFF ? 1 : NQF];
    const LAS unsigned char* qlds = lds + QF_OFF + wid * 8192 + lane * 16;
    { const bf16* qrow = Qp + (size_t)trow * qpitch + hi * 8;
      if constexpr (DIFF) {
#pragma unroll
          for (int d0 = 0; d0 < 8; ++d0) { const bf16x8 q = *(const GAS bf16x8*)(qrow + d0 * 16); *(LAS bf16x8*)(lds + QF_OFF + wid * 8192 + lane * 16 + d0 * 1024) = q; }
      } else {
#pragma unroll
          for (int d0 = 0; d0 < NQF; ++d0) qr[d0] = *(const GAS bf16x8*)(qrow + d0 * 16); } }
    if constexpr (MLA) {
        const float* cs = C.COS + (rb + trow) * 32 + hi * 8; const float* sn = C.SIN + (rb + trow) * 32 + hi * 8;
#pragma unroll
        for (int j = 0; j < 2; ++j) {
            const f32x4 c0 = *(const GAS f32x4*)(cs + j * 16), c1 = *(const GAS f32x4*)(cs + j * 16 + 4), s0 = *(const GAS f32x4*)(sn + j * 16), s1 = *(const GAS f32x4*)(sn + j * 16 + 4);
            const bf16x8 a = qr[8 + j], bb = qr[10 + j]; float lo[8], hh[8];
#pragma unroll
            for (int e = 0; e < 8; ++e) { const float t1 = bf2f(a[e]), t2 = bf2f(bb[e]), c = e < 4 ? c0[e & 3] : c1[e & 3], s = e < 4 ? s0[e & 3] : s1[e & 3]; lo[e] = t1 * c - t2 * s; hh[e] = t1 * s + t2 * c; }
            v4u wl = {cvtpk(lo[0], lo[1]), cvtpk(lo[2], lo[3]), cvtpk(lo[4], lo[5]), cvtpk(lo[6], lo[7])}, wh = {cvtpk(hh[0], hh[1]), cvtpk(hh[2], hh[3]), cvtpk(hh[4], hh[5]), cvtpk(hh[6], hh[7])};
            qr[8 + j] = __builtin_bit_cast(bf16x8, wl); qr[10 + j] = __builtin_bit_cast(bf16x8, wh); }
    }
    unsigned koff[2], voff[2], peoff = 0;
#pragma unroll
    for (int i = 0; i < 2; ++i) { const int j = wid * 2 + i, row = 4 * j + (lane >> 4); koff[i] = (unsigned)(row * kpitch + (((lane & 15) ^ (row & 15)) << 3)) * 2u;
        const int st = 2 * j + (lane >> 5), kk = (st >> 2) * 8 + ((lane & 31) >> 2), c = (st & 3) * 32 + (lane & 3) * 8; voff[i] = (unsigned)(swap23(kk) * kpitch + c) * 2u; }
    if constexpr (MLA) { const int row = 8 * wid + (lane >> 3); peoff = (unsigned)(row * 64 + (((lane & 7) ^ ((row >> 1) & 7)) << 3)) * 2u; }
    const unsigned boff = (unsigned)(lane & 15) * 16u;
    const unsigned ldsbase = (unsigned)(unsigned long long)lds;
#define ISSUE(t_, buf_) do { const size_t tb_ = (size_t)(t_) * 64 * kpitch * 2; const char* kg_ = (const char*)Kp + tb_; const char* vg_ = (const char*)Vp + tb_; \
        _Pragma("unroll") for (int i_ = 0; i_ < 2; ++i_) dma16(kg_, koff[i_], ldsbase + K_OFF + (buf_) * 16384 + (wid * 2 + i_) * 1024); \
        _Pragma("unroll") for (int i_ = 0; i_ < 2; ++i_) dma16(vg_, voff[i_], ldsbase + V_OFF + (buf_) * 16384 + (wid * 2 + i_) * 1024); \
        if constexpr (MLA) dma16(KPEp + (size_t)(t_) * 64 * 64 * 2, peoff, ldsbase + KPE_OFF + (buf_) * 8192 + wid * 1024); \
        if constexpr (HASB) { if (wid == 0) dma16(Bp + (size_t)(t_) * 64 * 4, boff, ldsbase + B_OFF + (buf_) * 1024); } } while (0)
    const int NT = CAUSAL ? (q0 + 256) / 64 : MEMT / 64;
    LAS float* wsf = (LAS float*)(lds + WS_OFF) + wid * 64;
    LAS float* lut = (LAS float*)(lds + LUT_OFF);
    int pos_t = 0, wmin = 0; float lut_far = 0.f;
    if constexpr (DIFF) { if (tid < 132) lut[tid] = C.LUT[h * 132 + tid];
        pos_t = C.pos[rb + trow]; int mnp = pos_t;
        mnp = min(mnp, shxi<1>(mnp)); mnp = min(mnp, shxi<2>(mnp)); mnp = min(mnp, shxi<4>(mnp)); mnp = min(mnp, shxi<8>(mnp)); mnp = min(mnp, shxi<16>(mnp));
        wmin = __builtin_amdgcn_readfirstlane(mnp); lut_far = C.LUT[h * 132 + 128]; }
    const int xr = (r32 & 15) << 4, hx = hi << 4, xpe = ((r32 >> 1) & 7) << 4;
    const unsigned vrd = (unsigned)(((lane & 3) << 3) | (((lane >> 2) & 3) << 6) | (((lane >> 4) & 1) << 5) | (((lane >> 5) & 1) << 8));
    f32x16 o[4]; f32x16 o2[DIFF ? 4 : 1];
#pragma unroll
    for (int d = 0; d < 4; ++d) { o[d] = f32x16{}; if constexpr (DIFF) o2[d] = f32x16{}; }
    float m1 = -1e30f, l1 = 0.f, m2 = -1e30f, l2 = 0.f, R = 0.f;
    ISSUE(DESC ? NT - 1 : 0, 0);
    WAITBAR();
    int cur = 0;
    for (int i = 0; i < NT; ++i) {
        const int t = DESC ? NT - 1 - i : i, kb = t * 64;
        if (i + 1 < NT) ISSUE(DESC ? t - 1 : t + 1, cur ^ 1);
        const bool act = !CAUSAL || (STICK ? (kb < qw + 31) : (kb <= qw + 31));
        if (act) {
            const LAS unsigned char* krow = lds + K_OFF + cur * 16384 + r32 * 256;
            const unsigned vb = ldsbase + V_OFF + cur * 16384 + vrd;
            if constexpr (STICK) {
                f32x16 p0 = f32x16{}, p1 = f32x16{};
                qk<8>(p0, p1, krow, xr, hx, qr, 0);
                float L0[16], L1[16];
#pragma unroll
                for (int r = 0; r < 16; ++r) { const int key = kb + crow(r, hi);
                    { const float z = p0[r] * SCALE, e = __builtin_amdgcn_exp2f(-fabsf(z) * LOG2E), sp = fmaxf(z, 0.f) + __builtin_amdgcn_logf(1.f + e) * LN2; L0[r] = key < trow ? -sp : 0.f; p0[r] = z; }
                    { const float z = p1[r] * SCALE, e = __builtin_amdgcn_exp2f(-fabsf(z) * LOG2E), sp = fmaxf(z, 0.f) + __builtin_amdgcn_logf(1.f + e) * LN2; L1[r] = key + 32 < trow ? -sp : 0.f; p1[r] = z; } }
                float T[8], mb[8];
#pragma unroll
                for (int g = 0; g < 4; ++g) { T[g] = (L0[4 * g] + L0[4 * g + 1]) + (L0[4 * g + 2] + L0[4 * g + 3]); T[4 + g] = (L1[4 * g] + L1[4 * g + 1]) + (L1[4 * g + 2] + L1[4 * g + 3]); }
                float run = R;
#pragma unroll
                for (int k = 7; k >= 0; --k) { const float pt = partnerf(T[k], hi); const float T1 = hi ? T[k] : pt, T0 = hi ? pt : T[k];
                    const float b1 = run; run += T1; const float b0 = run; run += T0; mb[k] = hi ? b1 : b0; }
                R = run;
#pragma unroll
                for (int g = 0; g < 4; ++g) { float s0 = mb[g], s1 = mb[4 + g];
#pragma unroll
                    for (int e = 3; e >= 0; --e) { const int r = 4 * g + e, key = kb + crow(r, hi);
                        const float a0 = key < trow ? __builtin_amdgcn_exp2f((p0[r] + L0[r] + s0) * LOG2E) : 0.f; s0 += L0[r]; p0[r] = a0;
                        const float a1 = key + 32 < trow ? __builtin_amdgcn_exp2f((p1[r] + L1[r] + s1) * LOG2E) : 0.f; s1 += L1[r]; p1[r] = a1; } }
                bf16x8 pa0, pa1, pa2, pa3; pack_p(p0, p1, pa0, pa1, pa2, pa3);
                pv(o, vb, pa0, pa1, pa2, pa3);
            } else {
#pragma unroll
                for (int mp = 0; mp < (DIFF ? 2 : 1); ++mp) {
                    f32x16 p0, p1;
                    int xr_t = xr;
                    if constexpr (DIFF) { __builtin_amdgcn_sched_barrier(0); asm volatile("" : "+v"(pos_t), "+v"(xr_t)); }
                    if constexpr (VAR == VD) { const LAS float* nb = (const LAS float*)(lds + B_OFF + cur * 1024) + 4 * hi;
#pragma unroll
                        for (int g = 0; g < 4; ++g) { const f32x4 v0 = *(const LAS f32x4*)(nb + 8 * g), v1 = *(const LAS f32x4*)(nb + 32 + 8 * g);
#pragma unroll
                            for (int e = 0; e < 4; ++e) { p0[4 * g + e] = v0[e]; p1[4 * g + e] = v1[e]; } } }
                    else if constexpr (DIFF) {
                        if (wmin - C.TPMAX[b * 64 + t] >= 128) {
#pragma unroll
                            for (int r = 0; r < 16; ++r) { p0[r] = lut_far; p1[r] = lut_far; } }
                        else { const LAS int* pb = (const LAS int*)(lds + B_OFF + cur * 1024) + 4 * hi;
#pragma unroll
                            for (int g = 0; g < 4; ++g) { const i32x4 v0 = *(const LAS i32x4*)(pb + 8 * g), v1 = *(const LAS i32x4*)(pb + 32 + 8 * g);
#pragma unroll
                                for (int e = 0; e < 4; ++e) { p0[4 * g + e] = lut[min(max(pos_t - v0[e], 0), 128)]; p1[4 * g + e] = lut[min(max(pos_t - v1[e], 0), 128)]; }
                                __builtin_amdgcn_sched_barrier(0); } } }
                    else { p0 = f32x16{}; p1 = f32x16{}; }
                    if constexpr (DIFF) qk_l<4>(p0, p1, krow, xr_t, hx, qlds, 4 * mp);
                    else qk<8>(p0, p1, krow, xr, hx, qr, 0);
                    if constexpr (MLA) qk_pe(p0, p1, lds + KPE_OFF + cur * 8192 + r32 * 128, xpe, hx, qr + 8);
                    if (CAUSAL && kb + 63 > qw) { const float NEG = -__builtin_inff();
#pragma unroll
                        for (int r = 0; r < 16; ++r) { const int key = kb + crow(r, hi); if (key > trow) p0[r] = NEG; if (key + 32 > trow) p1[r] = NEG; } }
                    if (mp == 0) softmax_pv(p0, p1, m1, l1, o, wsf, vb, r32, hi, SCALE, C2);
                    else softmax_pv(p0, p1, m2, l2, o2, wsf, vb, r32, hi, SCALE, C2);
                }
            }
        }
        if constexpr (STICK) { const int dn_ = __all(R < -100.f) ? 1 : 0; if (lane == 0) ((LAS int*)(lds + FLG_OFF))[(i & 1) * 8 + wid] = dn_; }
        WAITBAR(); cur ^= 1;
        if constexpr (STICK) { const LAS i32x4* fl = (const LAS i32x4*)(lds + FLG_OFF + (i & 1) * 32); const i32x4 f0 = fl[0], f1 = fl[1];
            const int alld = (f0.x & f0.y & f0.z & f0.w) & (f1.x & f1.y & f1.z & f1.w); if (__builtin_amdgcn_readfirstlane(alld)) break; }
    }
#undef ISSUE
    const int lane_e = fresh_lane();
    const int r32e = lane_e & 31, hie = lane_e >> 5;
    bf16* Ob = Op + (size_t)(qw + 4 * hie) * opitch + r32e;
    if constexpr (DIFF) {
        if (hie == 0) { wsf[r32e] = l1; wsf[32 + r32e] = l2; } asm volatile("s_waitcnt lgkmcnt(0)" ::: "memory");
        const float lam = C.lam;
#pragma unroll
        for (int r = 0; r < 16; ++r) { const float i1 = __builtin_amdgcn_rcpf(wsf[crow(r, hie)]), i2 = lam * __builtin_amdgcn_rcpf(wsf[32 + crow(r, hie)]); float ss = 0.f;
#pragma unroll
            for (int d = 0; d < 4; ++d) { const float x = o[d][r] * i1 - o2[d][r] * i2; o[d][r] = x; ss += x * x; }
            ss = half_sum(ss);
            const float rstd = (1.0f / sqrtf(ss * (1.f / 128.f) + EPS)) * C.oml;
#pragma unroll
            for (int d = 0; d < 4; ++d) o[d][r] *= rstd; }
#pragma unroll
        for (int d = 0; d < 4; ++d) { const float g = C.sub_g[d * 32 + r32e];
#pragma unroll
            for (int r = 0; r < 16; ++r) o[d][r] *= g; }
    } else if constexpr (!STICK) {
        if (hie == 0) wsf[r32e] = l1; asm volatile("s_waitcnt lgkmcnt(0)" ::: "memory");
#pragma unroll
        for (int r = 0; r < 16; ++r) { const float i1 = __builtin_amdgcn_rcpf(wsf[crow(r, hie)]);
#pragma unroll
            for (int d = 0; d < 4; ++d) o[d][r] *= i1; }
    }
#pragma unroll
    for (int r = 0; r < 16; ++r) { const int orr = (r & 3) + 8 * (r >> 2);
#pragma unroll
        for (int d = 0; d < 4; ++d) { const float v = o[d][r], vn = shx<1>(v);
            if ((r32e & 1) == 0) *(GAS unsigned*)(Ob + (size_t)orr * opitch + d * 32) = cvtpk(v, vn); } }
}
template <int VAR> __device__ __forceinline__ void attn_queue(const Ctx& C, gu32* head, LAS unsigned char* lds, const int wid) {
    constexpr int NH = VAR == VE ? 4 : 8, NU = NB * NH * 16;
    const int lane = fresh_lane(), tid = wid * 64 + lane;
    volatile LAS int* tk = (volatile LAS int*)(lds + TKT_OFF);
    for (;;) {
        if (tid == 0) tk[0] = (int)__hip_atomic_fetch_add(head, 1u, RLX_AGENT);
        WAITBAR();
        const int n = __builtin_amdgcn_readfirstlane(tk[0]);
        if (n >= NU) break;
        const int qb = 15 - n / (NB * NH), bh = n % (NB * NH);
        attn_unit<VAR>(C, bh / NH, bh % NH, qb, lds, tid, wid, lane);
    }
}
}

struct Args { const void* in[27]; float* out; unsigned char* ws; float inv_freq[32]; float lam_init[2]; };
static_assert(sizeof(Args) == 27 * 8 + 16 + 128 + 8, "Args has no padding");
typedef const unsigned char __attribute__((address_space(4)))* kaptr_t;
__device__ __forceinline__ kaptr_t ka_fresh() { kaptr_t p = (kaptr_t)__builtin_amdgcn_kernarg_segment_ptr(); asm volatile("" : "+s"(p)); return p; }
#define KIN(ka, i) (*(const void* const __attribute__((address_space(4)))*)((ka) + 8 * (i)))
#define KOUT(ka) ((float*)KIN(ka, 27))
#define KWS(ka) ((unsigned char*)KIN(ka, 28))
#define KINVF(ka, i) (*(const float __attribute__((address_space(4)))*)((ka) + 232 + 4 * (i)))
#define KLAMI(ka, l) (*(const float __attribute__((address_space(4)))*)((ka) + 360 + 4 * (l)))

namespace att {
template <int VAR> __device__ __forceinline__ void attn_phase(int l, int q, LAS unsigned char* lds, const int wid0) {
    const kaptr_t ka = ka_fresh(); unsigned char* ws = KWS(ka);
    const Ctx C{(const bf16*)(ws + WS_PROJ), (const bf16*)(ws + WS_QMLA), (const bf16*)(ws + WS_KVMLA), (const bf16*)(ws + WS_KPE), (bf16*)(ws + WS_MIX), (const bf16*)(ws + WS_QMEM),
                (const bf16*)(ws + WS_KVMEM) + (size_t)l * 512 * 1024, (bf16*)(ws + WS_OMEM), (const float*)(ws + WS_COS), (const float*)(ws + WS_SIN), (const float*)(ws + WS_LUT),
                (const int*)(ws + WS_TPMAX), (const int*)KIN(ka, 2), (const float*)(ws + WS_NEGC), (const float*)KIN(ka, 11) + l * 128, ((const float*)(ws + WS_LAM))[l], 1.0f - KLAMI(ka, l)};
    attn_queue<VAR>(C, (gu32*)(ws + WS_CTL) + CW_TKT + (l * 8 + q) * 64, lds, wid0);
}
}

__global__ void __launch_bounds__(NWAVES * 64, 2) mk_fwd(Args args) {
    extern __shared__ __attribute__((aligned(16))) unsigned char lds_raw[];
    LAS unsigned char* lds = (LAS unsigned char*)lds_raw;
    const int G = gridDim.x, bx = blockIdx.x;
    const int vcu = (G % 8 == 0) ? (bx % 8) * (G / 8) + bx / 8 : bx;
    const int wid0 = __builtin_amdgcn_readfirstlane((int)threadIdx.x >> 6);
    const int gw = vcu * NWAVES + wid0, NGW = G * NWAVES;
    { const int tid = wid0 * 64 + fresh_lane();
      for (int u = tid; u < (LDS_BYTES - LDSCTL_OFF) / 4; u += NWAVES * 64) ((LAS unsigned*)(lds + LDSCTL_OFF))[u] = 0u; }
    __syncthreads();
    volatile LAS unsigned* MISC = (volatile LAS unsigned*)(lds + MISC_OFF);
    XcdBarrier bar = xcd_barrier_post((unsigned*)(args.ws + WS_CTL) + CW_BAR, MISC + 8, wid0);

    {
        const kaptr_t ka = ka_fresh(); unsigned char* ws = KWS(ka);
        const int lane = fresh_lane(), wid = wid0, tid = wid * 64 + lane;
        LAS float* scr = (LAS float*)(lds + RING_OFF + wid * 16384);
        for (int l = 0; l < NL; ++l) {
            unsigned char* wl = ws + WS_W + (size_t)l * W_LAYER;
#define TR_MAT(idx_, K_, N_, NP_, dst_, roff_) do { const float* s_ = (const float*)KIN(ka, idx_) + (size_t)l * (K_) * (N_); const int nblk_ = (NP_) / 32, nit_ = ((K_) / 64) * nblk_; \
            for (int it = gw; it < nit_; it += NGW) tr_item(s_, (K_), (N_), nblk_, (bf16*)(dst_), (roff_), scr, it, lane); } while (0)
            TR_MAT(4, DM, INC, INP, wl + W_IN, 0);
            TR_MAT(5, DM, DM, DM, wl + W_OUT, 0);
            TR_MAT(14, QRANK, 1536, 1536, wl + W_UQ, 0);
            TR_MAT(15, KVRANK, 2048, 2048, wl + W_UKV, 0);
            TR_MAT(19, DM, 512, 512, wl + W_MQ, 0);
            TR_MAT(20, DM, 512, 512, wl + W_MKV, 0);
            TR_MAT(21, DM, 512, 512, wl + W_MKV, 512);
            TR_MAT(22, 512, DM, DM, wl + W_MO, 0);
            TR_MAT(24, DM, DFF, DFF, wl + W_UP, 0);
            TR_MAT(25, DFF, DM, DM, wl + W_DN, 0);
#undef TR_MAT
        }
        { const float* mem = (const float*)KIN(ka, 1); bf16* MEMN = (bf16*)(ws + WS_MEMN);
          for (int r = gw; r < NL * NB * MEMT; r += NGW) { const int l = r / (NB * MEMT), mr = r - l * (NB * MEMT);
            rms_row<true>(mem + (size_t)mr * DM, (const float*)KIN(ka, 18) + (size_t)l * DM, MEMN + (size_t)r * DM, lane); } }
        const int* pos = (const int*)KIN(ka, 2);
        float* COS = (float*)(ws + WS_COS); float* SIN = (float*)(ws + WS_SIN); float* LUT = (float*)(ws + WS_LUT); int* TPMAX = (int*)(ws + WS_TPMAX); float* LAM = (float*)(ws + WS_LAM);
        const int gt = vcu * (NWAVES * 64) + tid, NGT = G * NWAVES * 64;
        for (int i = gt; i < M * 32; i += NGT) { const int row = i >> 5, f = i & 31; const float ang = (float)pos[row] * KINVF(ka, f);
            double rv = (double)ang * 0.15915494309189535; rv -= floor(rv); const float fr = (float)rv;
            COS[i] = __builtin_amdgcn_cosf(fr); SIN[i] = __builtin_amdgcn_sinf(fr); }
        for (int i = gt; i < 8 * 132; i += NGT) { const int h = i / 132, dd0 = i - h * 132; const int dd = dd0 > 128 ? 128 : dd0; int bk;
            if (dd < 16) bk = dd; else { bk = 16 + (int)(logf((float)dd / 16.0f) / 2.0794415416798357f * 16.0f); bk = bk > 31 ? 31 : bk; }
            LUT[i] = 8.0f * ((const float*)KIN(ka, 6))[bk * 8 + h]; }
        for (int i = gt; i < NB * 64; i += NGT) { int mx = pos[i * 64];
            for (int k = 1; k < 64; ++k) mx = max(mx, pos[i * 64 + k]);
            TPMAX[i] = mx; }
        if (gt < NL) { const int l = gt; float s1 = 0.f, s2 = 0.f;
            for (int k = 0; k < 64; ++k) { s1 += ((const float*)KIN(ka, 7))[l * 64 + k] * ((const float*)KIN(ka, 8))[l * 64 + k]; s2 += ((const float*)KIN(ka, 9))[l * 64 + k] * ((const float*)KIN(ka, 10))[l * 64 + k]; }
            LAM[l] = expf(s1) - expf(s2) + KLAMI(ka, l); }
    }
    xcd_barrier(bar, wid0);

    for (int l = 0; l < NL; ++l) {
        { const kaptr_t ka = ka_fresh(); unsigned char* ws = KWS(ka); FRESH_LANE(ln);
          const float* xsrc = (l == 0) ? (const float*)KIN(ka, 0) : KOUT(ka); bf16* H = (bf16*)(ws + WS_H);
          for (int m = gw; m < M; m += NGW) rms_row<true>(xsrc + (size_t)m * DM, (const float*)KIN(ka, 3) + (size_t)l * DM, H + (size_t)m * DM, ln); }
        xcd_barrier(bar, wid0);
        { const kaptr_t ka = ka_fresh(); unsigned char* ws = KWS(ka); unsigned char* wl = ws + WS_W + (size_t)l * W_LAYER;
          { pg8::Gemm g{(const bf16*)(ws + WS_H), (const bf16*)(wl + W_IN), M, INP, DM}; pg8::StaticOrder S; S.init(M, INP, G, bx);
            pg8::EpiBf16<0> E{(bf16*)(ws + WS_PROJ), INP};
            pg8::gemm_phase<pg8::EpiBf16<0>, pg8::StaticOrder, true, true>(lds + RING_OFF, g, S, E, wid0); }
          { pg8::Gemm g{(const bf16*)(ws + WS_MEMN) + (size_t)l * 512 * DM, (const bf16*)(wl + W_MKV), 512, 1024, DM}; pg8::StaticOrder S; S.init(512, 1024, G, G - 1 - bx);
            pg8::EpiBf16<0> E{(bf16*)(ws + WS_KVMEM) + (size_t)l * 512 * 1024, 1024};
            pg8::gemm_phase<pg8::EpiBf16<0>, pg8::StaticOrder, true, true>(lds + RING_OFF, g, S, E, wid0); } }
        xcd_barrier(bar, wid0);
        { const kaptr_t ka = ka_fresh(); unsigned char* ws = KWS(ka); FRESH_LANE(ln);
          for (int m = gw; m < M; m += NGW)
            prep_row((const bf16*)(ws + WS_PROJ), m, (const float*)KIN(ka, 12) + (size_t)l * QRANK, (const float*)KIN(ka, 13) + (size_t)l * KVRANK, (const float*)KIN(ka, 16) + l * 8,
                     (const float*)(ws + WS_COS), (const float*)(ws + WS_SIN), (bf16*)(ws + WS_CQN), (bf16*)(ws + WS_CKVN), (bf16*)(ws + WS_KPE), (float*)(ws + WS_LOGF), ln); }
        xcd_barrier(bar, wid0);
        { const kaptr_t ka = ka_fresh(); unsigned char* ws = KWS(ka); unsigned char* wl = ws + WS_W + (size_t)l * W_LAYER;
          if (gw < 16) { FRESH_LANE(ln); fox_scan((const float*)(ws + WS_LOGF) + (size_t)gw * SEQ, (float*)(ws + WS_NEGC) + (size_t)gw * SEQ, ln); }
          { pg8::Gemm g{(const bf16*)(ws + WS_CQN), (const bf16*)(wl + W_UQ), M, 1536, QRANK}; pg8::StaticOrder S; S.init(M, 1536, G, bx);
            pg8::EpiBf16<0> E{(bf16*)(ws + WS_QMLA), 1536};
            pg8::gemm_phase<pg8::EpiBf16<0>, pg8::StaticOrder, true, true>(lds + RING_OFF, g, S, E, wid0); }
          { pg8::Gemm g{(const bf16*)(ws + WS_CKVN), (const bf16*)(wl + W_UKV), M, 2048, KVRANK}; pg8::StaticOrder S; S.init(M, 2048, G, G - 1 - bx);
            pg8::EpiBf16<0> E{(bf16*)(ws + WS_KVMLA), 2048};
            pg8::gemm_phase<pg8::EpiBf16<0>, pg8::StaticOrder, true, true>(lds + RING_OFF, g, S, E, wid0); } }
        xcd_barrier(bar, wid0);
        att::attn_phase<att::VA>(l, 0, lds, wid0);
        att::attn_phase<att::VB>(l, 1, lds, wid0);
        att::attn_phase<att::VD>(l, 2, lds, wid0);
        att::attn_phase<att::VC>(l, 3, lds, wid0);
        xcd_barrier(bar, wid0);
        { const kaptr_t ka = ka_fresh(); unsigned char* ws = KWS(ka); unsigned char* wl = ws + WS_W + (size_t)l * W_LAYER;
          const float* xsrc = (l == 0) ? (const float*)KIN(ka, 0) : KOUT(ka);
          pg8::Gemm g{(const bf16*)(ws + WS_MIX), (const bf16*)(wl + W_OUT), M, DM, DM}; pg8::StaticOrder S; S.init(M, DM, G, bx);
          pg8::EpiRes E{xsrc, KOUT(ka), DM};
          pg8::gemm_phase<pg8::EpiRes, pg8::StaticOrder, true, true>(lds + RING_OFF, g, S, E, wid0); }
        xcd_barrier(bar, wid0);
        { const kaptr_t ka = ka_fresh(); unsigned char* ws = KWS(ka); FRESH_LANE(ln); const float* X = KOUT(ka); bf16* H = (bf16*)(ws + WS_H);
          for (int m = gw; m < M; m += NGW) rms_row<true>(X + (size_t)m * DM, (const float*)KIN(ka, 17) + (size_t)l * DM, H + (size_t)m * DM, ln); }
        xcd_barrier(bar, wid0);
        { const kaptr_t ka = ka_fresh(); unsigned char* ws = KWS(ka); unsigned char* wl = ws + WS_W + (size_t)l * W_LAYER;
          pg8::Gemm g{(const bf16*)(ws + WS_H), (const bf16*)(wl + W_MQ), M, 512, DM}; pg8::StaticOrder S; S.init(M, 512, G, bx);
          pg8::EpiBf16<0> E{(bf16*)(ws + WS_QMEM), 512};
          pg8::gemm_phase<pg8::EpiBf16<0>, pg8::StaticOrder, true, true>(lds + RING_OFF, g, S, E, wid0); }
        xcd_barrier(bar, wid0);
        att::attn_phase<att::VE>(l, 4, lds, wid0);
        xcd_barrier(bar, wid0);
        { const kaptr_t ka = ka_fresh(); unsigned char* ws = KWS(ka); unsigned char* wl = ws + WS_W + (size_t)l * W_LAYER;
          pg8::Gemm g{(const bf16*)(ws + WS_OMEM), (const bf16*)(wl + W_MO), M, DM, 512}; pg8::StaticOrder S; S.init(M, DM, G, bx);
          pg8::EpiRes E{KOUT(ka), KOUT(ka), DM};
          pg8::gemm_phase<pg8::EpiRes, pg8::StaticOrder, true, true>(lds + RING_OFF, g, S, E, wid0); }
        xcd_barrier(bar, wid0);
        { const kaptr_t ka = ka_fresh(); unsigned char* ws = KWS(ka); FRESH_LANE(ln); const float* X = KOUT(ka); bf16* H = (bf16*)(ws + WS_H);
          for (int m = gw; m < M; m += NGW) rms_row<true>(X + (size_t)m * DM, (const float*)KIN(ka, 23) + (size_t)l * DM, H + (size_t)m * DM, ln); }
        xcd_barrier(bar, wid0);
        { const kaptr_t ka = ka_fresh(); unsigned char* ws = KWS(ka); unsigned char* wl = ws + WS_W + (size_t)l * W_LAYER;
          pg8::Gemm g{(const bf16*)(ws + WS_H), (const bf16*)(wl + W_UP), M, DFF, DM}; pg8::StaticOrder S; S.init(M, DFF, G, bx);
          pg8::EpiBf16<1> E{(bf16*)(ws + WS_U), DFF};
          pg8::gemm_phase<pg8::EpiBf16<1>, pg8::StaticOrder, true, true>(lds + RING_OFF, g, S, E, wid0); }
        xcd_barrier(bar, wid0);
        { const kaptr_t ka = ka_fresh(); unsigned char* ws = KWS(ka); unsigned char* wl = ws + WS_W + (size_t)l * W_LAYER;
          pg8::Gemm g{(const bf16*)(ws + WS_U), (const bf16*)(wl + W_DN), M, DM, DFF}; pg8::StaticOrder S; S.init(M, DM, G, bx);
          pg8::EpiRes E{KOUT(ka), KOUT(ka), DM};
          pg8::gemm_phase<pg8::EpiRes, pg8::StaticOrder, true, true>(lds + RING_OFF, g, S, E, wid0); }
        xcd_barrier(bar, wid0);
    }
    { const kaptr_t ka = ka_fresh(); FRESH_LANE(ln); float* X = KOUT(ka);
      for (int m = gw; m < M; m += NGW) rms_row<false>(X + (size_t)m * DM, (const float*)KIN(ka, 26), X + (size_t)m * DM, ln); }
}

extern "C" void kernel_launch(void* const* d_in, const int* in_sizes, int n_in, void* d_out, int out_size, void* d_ws, size_t ws_size, hipStream_t stream) {
    static int grid = 0;
    if (grid == 0) {
        if (n_in != 27 || in_sizes[0] != M * DM || out_size != M * DM || ws_size < WS_END) {
            fprintf(stderr, "kernel_launch: built for 27 inputs, x/out of %d floats, >= %zu bytes of workspace; got n_in %d, in0 %d, out %d, ws %zu; nothing launched\n", M * DM, (size_t)WS_END, n_in, n_in > 0 ? in_sizes[0] : -1, out_size, ws_size);
            grid = -1; return; }
        int dev = 0, cus = 0, per_cu = 0;
        if (hipGetDevice(&dev) != hipSuccess || hipDeviceGetAttribute(&cus, hipDeviceAttributeMultiprocessorCount, dev) != hipSuccess) { fprintf(stderr, "kernel_launch: device query failed\n"); grid = -1; return; }
        if (hipFuncSetAttribute((const void*)mk_fwd, hipFuncAttributeMaxDynamicSharedMemorySize, LDS_BYTES) != hipSuccess) { fprintf(stderr, "kernel_launch: hipFuncSetAttribute failed\n"); grid = -1; return; }
        if (hipOccupancyMaxActiveBlocksPerMultiprocessor(&per_cu, (const void*)mk_fwd, NWAVES * 64, LDS_BYTES) != hipSuccess || per_cu < 1)
            fprintf(stderr, "kernel_launch: note: occupancy query reports %d workgroups per CU\n", per_cu);
        (void)hipGetLastError();
        grid = cus;
    }
    if (grid < 0) return;
    if (hipMemsetAsync((char*)d_ws + WS_CTL, 0, CTL_ZERO_BYTES, stream) != hipSuccess) { fprintf(stderr, "kernel_launch: memset failed\n"); return; }
    Args a; memset(&a, 0, sizeof(a));
    for (int i = 0; i < 27; ++i) a.in[i] = d_in[i];
    a.out = (float*)d_out; a.ws = (unsigned char*)d_ws;
    for (int i = 0; i < 32; ++i) a.inv_freq[i] = (float)pow(10000.0, -(double)i / 32.0);
    for (int l = 0; l < NL; ++l) a.lam_init[l] = (float)(0.8 - 0.6 * exp(-0.3 * (double)l));
    hipLaunchKernelGGL(mk_fwd, dim3(grid), dim3(NWAVES * 64), LDS_BYTES, stream, a);
    const hipError_t le = hipPeekAtLastError();
    if (le != hipSuccess) fprintf(stderr, "kernel_launch: launch failed: %s\n", hipGetErrorName(le));
}
```

```cpp
#include <hip/hip_runtime.h>
#include <cstdio>
#include <cstdint>
#include <cstring>
#include <cmath>
__device__ __forceinline__ int fresh_lane() { unsigned z = 0u; asm volatile("" : "+v"(z)); return (int)__builtin_amdgcn_mbcnt_hi(~0u, __builtin_amdgcn_mbcnt_lo(~0u, z)); }
namespace pg8 {
#define PG8_LAS __attribute__((address_space(3)))
typedef unsigned short bf16_t;
typedef short bf16x8 __attribute__((ext_vector_type(8)));
typedef float f32x4 __attribute__((ext_vector_type(4)));
typedef unsigned u32x4 __attribute__((ext_vector_type(4)));
constexpr int BM = 256, BK = 64, HALF = 128, HTB = HALF * BK * 2  , STAGE_BYTES = 8 * HTB, NXCD = 8, WGM = 8;

__host__ __device__ __forceinline__ int lds_byte(int r, int c) { const int st = (r >> 4) * 2 + (c >> 5), rr = r & 15, cc = c & 31, ob = rr * 64 + cc * 2; return st * 1024 + (ob ^ (((ob >> 9) & 1) << 5)); }
__host__ __device__ __forceinline__ void stage_rc(int b, int& R, int& C) { const int st = b / 1024, sb = b % 1024, swz = sb ^ (((sb >> 9) & 1) << 5); R = (st >> 1) * 16 + swz / 64; C = (st & 1) * 32 + (swz % 64) / 2; }
__host__ __device__ __forceinline__ int perm32(int rho) { const int n = rho >> 4, i = rho & 15; return 8 * (i >> 2) + 4 * n + (i & 3); }

struct Unit { int pm, pn; };
struct Gemm { const bf16_t* A; const bf16_t* Bt; int M, N, K; };

struct StaticOrder {
    int nM, nN, nwg, G, c;
    __host__ __device__ void init(int M, int N, int G_, int c_) { nM = M / BM; nN = N / BM; nwg = nM * nN; G = G_; c = c_; }
    __host__ __device__ bool next(int i, Unit& u) const {
        const long L = (long)i * G + c; if (L >= nwg) return false;
        int wgid = (int)L; { const int q = nwg / NXCD, r = nwg % NXCD, xcd = wgid % NXCD, off = wgid / NXCD; wgid = (xcd < r ? xcd * (q + 1) : r * (q + 1) + (xcd - r) * q) + off; }
        const int nig = WGM * nN, gid = wgid / nig, fm = gid * WGM, gsz = (nM - fm) < WGM ? (nM - fm) : WGM;
        u.pm = fm + ((wgid % nig) % gsz); u.pn = (wgid % nig) / gsz; return true;
    }
    __device__ __forceinline__ void a_ready(const Unit&) const {}
    __device__ __forceinline__ void done(const Unit&) const {}
};

__device__ __forceinline__ unsigned cvt_pk_bf16(float lo, float hi) { unsigned r; asm volatile("v_cvt_pk_bf16_f32 %0, %1, %2" : "=v"(r) : "v"(lo), "v"(hi)); return r; }
typedef float f32x2 __attribute__((ext_vector_type(2)));
template <int ACT, bool RS> struct EpiBf16 {
    static constexpr bool PERM = true, AFTER_DRAIN = false;
    bf16_t* O; int ldc; const float* ss;
    __device__ __forceinline__ void operator()(const f32x4 (&acc)[2][2][4][2], const Unit& u, int wr, int wc, int fr, int fq) const {
        const int row0 = u.pm * BM + wr * 64 + fr, col0 = u.pn * BM + wc * 32 + 8 * fq;
#pragma unroll
        for (int ai = 0; ai < 2; ++ai)
#pragma unroll
            for (int m = 0; m < 4; ++m) { const int row = row0 + ai * HALF + m * 16; bf16_t* rowp = O + (size_t)row * ldc + col0;
                float rs = 1.f; if (RS) rs = 1.0f / sqrtf(ss[row] * (1.f / 4096.f) + 1e-6f);
#pragma unroll
                for (int bj = 0; bj < 2; ++bj) { f32x4 v0 = acc[ai][bj][m][0], v1 = acc[ai][bj][m][1];
                    if (RS) { v0 = v0 * rs; v1 = v1 * rs; }
                    if (ACT == 1) {
#pragma unroll
                        for (int e = 0; e < 4; ++e) { const float a = fmaxf(v0[e], 0.f), b = fmaxf(v1[e], 0.f); v0[e] = a * a; v1[e] = b * b; } }
                    u32x4 w; w.x = cvt_pk_bf16(v0[0], v0[1]); w.y = cvt_pk_bf16(v0[2], v0[3]); w.z = cvt_pk_bf16(v1[0], v1[1]); w.w = cvt_pk_bf16(v1[2], v1[3]);
                    *(u32x4*)(rowp + bj * HALF) = w; } }
    }
};
struct EpiRes {
    static constexpr bool PERM = true, AFTER_DRAIN = false;
    bf16_t* xh; bf16_t* xl; int ldc; float* ss;
    __device__ __forceinline__ void operator()(const f32x4 (&acc)[2][2][4][2], const Unit& u, int wr, int wc, int fr, int fq) const {
        const int row0 = u.pm * BM + wr * 64 + fr, col0 = u.pn * BM + wc * 32 + 8 * fq;
#pragma unroll
        for (int ai = 0; ai < 2; ++ai)
#pragma unroll
            for (int m = 0; m < 4; ++m) { const int row = row0 + ai * HALF + m * 16; const size_t off = (size_t)row * ldc + col0; float sq = 0.f;
#pragma unroll
                for (int bj = 0; bj < 2; ++bj) { const u32x4 hv = *(const u32x4*)(xh + off + bj * HALF), lv = *(const u32x4*)(xl + off + bj * HALF); u32x4 ho, lo;
#pragma unroll
                    for (int e = 0; e < 4; ++e) { const f32x4& a = acc[ai][bj][m][e >> 1]; const int j = (e & 1) * 2;
                        const float v0 = (__uint_as_float(hv[e] << 16) + __uint_as_float(lv[e] << 16)) + a[j], v1 = (__uint_as_float(hv[e] & 0xffff0000u) + __uint_as_float(lv[e] & 0xffff0000u)) + a[j + 1];
                        const unsigned h = cvt_pk_bf16(v0, v1); ho[e] = h;
                        lo[e] = cvt_pk_bf16(v0 - __uint_as_float(h << 16), v1 - __uint_as_float(h & 0xffff0000u)); sq += v0 * v0 + v1 * v1; }
                    *(u32x4*)(xh + off + bj * HALF) = ho; *(u32x4*)(xl + off + bj * HALF) = lo; }
                sq += __int_as_float(__builtin_amdgcn_ds_swizzle(__float_as_int(sq), 0x1f | (16 << 10)));
                { auto rr = __builtin_amdgcn_permlane32_swap(__float_as_uint(sq), __float_as_uint(sq), false, false); sq = __uint_as_float(rr[0]) + __uint_as_float(rr[1]); }
                if (fq == 0) __hip_atomic_fetch_add(ss + row, sq, __ATOMIC_RELAXED, __HIP_MEMORY_SCOPE_AGENT); }
    }
};
template <class Epi, class Sched, bool ALIGN_EPI = false, bool SP2 = false>
__device__ __forceinline__ void gemm_phase(PG8_LAS unsigned char* lds, const Gemm g, const Sched& S, const Epi& E, const int wid0) {
    const int wid = wid0, lane = fresh_lane(), tid = wid * 64 + lane, wr = wid >> 2, wc = wid & 3, fr = lane & 15, fq = lane >> 4;
    const int K = g.K, nt = K / BK;
    unsigned voffA[2], voffB[2];
#pragma unroll
    for (int i = 0; i < 2; ++i) { int R, C; stage_rc(tid * 16 + i * 8192, R, C); const int Rb = Epi::PERM ? ((R & ~31) + perm32(R & 31)) : R;
        voffA[i] = (unsigned)(R * K + C) * 2u; voffB[i] = (unsigned)(Rb * K + C) * 2u; }
    const size_t kstep = (size_t)(BK * 2);
    const size_t hstep = (size_t)HALF * K * 2;
    const size_t tstep = 2 * hstep;
    const unsigned ldsw = (unsigned)wid * 1024u;
    const int aoff = lds_byte(wr * 64 + fr, fq * 8), boff = lds_byte(wc * 32 + fr, fq * 8);
#define PG8_SA(b, h) (((b) * 2 + (h)) * HTB)
#define PG8_SB(b, h) ((4 + (b) * 2 + (h)) * HTB)
#define PG8_STAGE(bufoff, gbase, voff) do { _Pragma("unroll") for (int _i = 0; _i < 2; ++_i) \
        __builtin_amdgcn_global_load_lds((const unsigned*)((const char*)(gbase) + (voff)[_i]), (PG8_LAS unsigned*)(lds + (bufoff) + ldsw + _i * 8192), 16, 0, 0); } while (0)
#define PG8_LDA(dst, b, h) do { _Pragma("unroll") for (int m = 0; m < 4; ++m) _Pragma("unroll") for (int k = 0; k < 2; ++k) dst[m][k] = *(const PG8_LAS bf16x8*)(lds + PG8_SA(b, h) + aoff + m * 2048 + k * 1024); } while (0)
#define PG8_LDB(dst, b, h) do { _Pragma("unroll") for (int n = 0; n < 2; ++n) _Pragma("unroll") for (int k = 0; k < 2; ++k) dst[n][k] = *(const PG8_LAS bf16x8*)(lds + PG8_SB(b, h) + boff + n * 2048 + k * 1024); } while (0)
#define PG8_MMA(ai, bj, At, Bt) do { __builtin_amdgcn_s_setprio(1); _Pragma("unroll") for (int m = 0; m < 4; ++m) _Pragma("unroll") for (int n = 0; n < 2; ++n) _Pragma("unroll") for (int k = 0; k < 2; ++k) \
        acc[ai][bj][m][n] = __builtin_amdgcn_mfma_f32_16x16x32_bf16(Bt[n][k], At[m][k], acc[ai][bj][m][n], 0, 0, 0); __builtin_amdgcn_s_setprio(0); } while (0)
#define PG8_WAIT_V(n) asm volatile("s_waitcnt vmcnt(" #n ")" ::: "memory")
#define PG8_WAIT_L(n) asm volatile("s_waitcnt lgkmcnt(" #n ")" ::: "memory")
#define PG8_BAR __builtin_amdgcn_s_barrier()
#define PG8_SCHED __builtin_amdgcn_sched_barrier(0)
    Unit cur, nxt; int ui = 0;
    if (!S.next(0, cur)) return;
    f32x4 acc[2][2][4][2];
#pragma unroll
    for (int a = 0; a < 2; ++a)
#pragma unroll
        for (int b = 0; b < 2; ++b)
#pragma unroll
            for (int m = 0; m < 4; ++m)
#pragma unroll
                for (int n = 0; n < 2; ++n) acc[a][b][m][n] = (f32x4){0.f, 0.f, 0.f, 0.f};
    bf16x8 At[4][2], B0[2][2], B1[2][2];
    const char* cA = (const char*)g.A + (size_t)cur.pm * tstep; const char* cB = (const char*)g.Bt + (size_t)cur.pn * tstep;
    S.a_ready(cur);
    if constexpr (SP2) {
        PG8_STAGE(PG8_SB(0, 0), cB, voffB); PG8_STAGE(PG8_SB(0, 1), cB + hstep, voffB); PG8_STAGE(PG8_SA(0, 0), cA, voffA); PG8_STAGE(PG8_SA(0, 1), cA + hstep, voffA);
        if (wr == 1) PG8_BAR;
        PG8_WAIT_V(2); PG8_BAR;
        PG8_STAGE(PG8_SB(1, 0), cB + kstep, voffB); PG8_STAGE(PG8_SA(1, 0), cA + kstep, voffA); PG8_STAGE(PG8_SB(1, 1), cB + hstep + kstep, voffB);
        PG8_WAIT_V(6); PG8_BAR;
    } else {
        PG8_STAGE(PG8_SB(0, 0), cB, voffB); PG8_STAGE(PG8_SA(0, 0), cA, voffA); PG8_STAGE(PG8_SB(0, 1), cB + hstep, voffB); PG8_STAGE(PG8_SA(0, 1), cA + hstep, voffA);
        if (wr == 1) PG8_BAR;
        PG8_WAIT_V(4); PG8_BAR;
        PG8_STAGE(PG8_SB(1, 0), cB + kstep, voffB); PG8_STAGE(PG8_SA(1, 0), cA + kstep, voffA); PG8_STAGE(PG8_SB(1, 1), cB + hstep + kstep, voffB);
        PG8_WAIT_V(6); PG8_BAR;
    }
    for (;;) {
        const bool has_next = S.next(ui + 1, nxt);
        const char* nA = has_next ? (const char*)g.A + (size_t)nxt.pm * tstep : cA; const char* nB = has_next ? (const char*)g.Bt + (size_t)nxt.pn * tstep : cB;
        for (int t = 0; t < nt; t += 2) {
            const bool last = (t == nt - 2);
            const char* a1 = cA + (size_t)(t + 1) * kstep;
            const char* a2 = last ? nA : cA + (size_t)(t + 2) * kstep; const char* b2 = last ? nB : cB + (size_t)(t + 2) * kstep;
            const char* a3 = a2 + kstep; const char* b3 = b2 + kstep;
            if (last && has_next) S.a_ready(nxt);
            if constexpr (SP2) {
            PG8_LDB(B0, 0, 0); PG8_LDB(B1, 0, 1); PG8_SCHED; PG8_LDA(At, 0, 0); PG8_STAGE(PG8_SA(1, 1), a1 + hstep, voffA);
            PG8_WAIT_V(8); PG8_WAIT_L(0); PG8_BAR; PG8_MMA(0, 0, At, B0); PG8_MMA(0, 1, At, B1); PG8_BAR; PG8_SCHED;
            PG8_LDA(At, 0, 1); PG8_STAGE(PG8_SB(0, 0), b2, voffB); PG8_STAGE(PG8_SB(0, 1), b2 + hstep, voffB); PG8_STAGE(PG8_SA(0, 0), a2, voffA);
            PG8_WAIT_V(8); PG8_WAIT_L(0); PG8_BAR; PG8_MMA(1, 0, At, B0); PG8_MMA(1, 1, At, B1); PG8_BAR; PG8_SCHED;
            PG8_LDB(B0, 1, 0); PG8_LDB(B1, 1, 1); PG8_SCHED; PG8_LDA(At, 1, 0); PG8_STAGE(PG8_SA(0, 1), a2 + hstep, voffA);
            PG8_WAIT_V(8); PG8_WAIT_L(0); PG8_BAR; PG8_MMA(0, 0, At, B0); PG8_MMA(0, 1, At, B1); PG8_BAR; PG8_SCHED;
            PG8_LDA(At, 1, 1); PG8_STAGE(PG8_SB(1, 0), b3, voffB); PG8_STAGE(PG8_SB(1, 1), b3 + hstep, voffB); PG8_STAGE(PG8_SA(1, 0), a3, voffA);
            PG8_WAIT_V(8); PG8_WAIT_L(0); PG8_BAR; PG8_MMA(1, 0, At, B0); PG8_MMA(1, 1, At, B1); PG8_BAR; PG8_SCHED;
            } else {
            PG8_LDB(B0, 0, 0); PG8_SCHED; PG8_LDA(At, 0, 0); PG8_STAGE(PG8_SA(1, 1), a1 + hstep, voffA);
            PG8_WAIT_L(8); PG8_BAR; PG8_WAIT_L(0); PG8_MMA(0, 0, At, B0); PG8_BAR; PG8_SCHED;
            PG8_LDB(B1, 0, 1); PG8_STAGE(PG8_SB(0, 0), b2, voffB);
            PG8_BAR; PG8_WAIT_L(0); PG8_MMA(0, 1, At, B1); PG8_BAR;
            PG8_LDA(At, 0, 1); PG8_STAGE(PG8_SA(0, 0), a2, voffA);
            PG8_BAR; PG8_WAIT_L(0); PG8_MMA(1, 0, At, B0); PG8_BAR; PG8_SCHED;
            PG8_STAGE(PG8_SB(0, 1), b2 + hstep, voffB);
            PG8_WAIT_V(6); PG8_BAR; PG8_MMA(1, 1, At, B1); PG8_BAR;
            PG8_LDB(B0, 1, 0); PG8_SCHED; PG8_LDA(At, 1, 0); PG8_STAGE(PG8_SA(0, 1), a2 + hstep, voffA);
            PG8_WAIT_L(8); PG8_BAR; PG8_WAIT_L(0); PG8_MMA(0, 0, At, B0); PG8_BAR; PG8_SCHED;
            PG8_LDB(B1, 1, 1); PG8_STAGE(PG8_SB(1, 0), b3, voffB);
            PG8_BAR; PG8_WAIT_L(0); PG8_MMA(0, 1, At, B1); PG8_BAR;
            PG8_LDA(At, 1, 1); PG8_STAGE(PG8_SA(1, 0), a3, voffA);
            PG8_BAR; PG8_WAIT_L(0); PG8_MMA(1, 0, At, B0); PG8_BAR; PG8_SCHED;
            PG8_STAGE(PG8_SB(1, 1), b3 + hstep, voffB);
            PG8_WAIT_V(6); PG8_BAR; PG8_MMA(1, 1, At, B1); PG8_BAR;
            }
        }
        if constexpr (ALIGN_EPI) { if (wr == 0) PG8_BAR; }
        if constexpr (!Epi::AFTER_DRAIN) { E(acc, cur, wr, wc, fr, fq); S.done(cur); }
        if (!has_next) break;
#pragma unroll
        for (int a = 0; a < 2; ++a)
#pragma unroll
            for (int b = 0; b < 2; ++b)
#pragma unroll
                for (int m = 0; m < 4; ++m)
#pragma unroll
                    for (int n = 0; n < 2; ++n) acc[a][b][m][n] = (f32x4){0.f, 0.f, 0.f, 0.f};
        cur = nxt; cA = nA; cB = nB; ++ui;
        if constexpr (ALIGN_EPI) { if (wr == 1) PG8_BAR; }
    }
    PG8_WAIT_V(0);
    if constexpr (!ALIGN_EPI) { if (wr == 0) PG8_BAR; }
    PG8_BAR;
    if constexpr (Epi::AFTER_DRAIN) { E.fused(acc, cur, wr, wc, fr, fq, lds, wid, lane); S.done(cur); }
#undef PG8_SA
#undef PG8_SB
#undef PG8_STAGE
#undef PG8_LDA
#undef PG8_LDB
#undef PG8_MMA
#undef PG8_WAIT_V
#undef PG8_WAIT_L
#undef PG8_BAR
#undef PG8_SCHED
}
}
#define GAS __attribute__((address_space(1)))
#define LAS __attribute__((address_space(3)))
typedef unsigned short bf16;
typedef unsigned v4u __attribute__((ext_vector_type(4)));
typedef float f32x4 __attribute__((ext_vector_type(4)));
typedef short bf16x8 __attribute__((ext_vector_type(8)));
typedef GAS unsigned gu32;
typedef GAS unsigned long long gu64;
#define RLX_AGENT __ATOMIC_RELAXED, __HIP_MEMORY_SCOPE_AGENT
#define LDS_WAIT() asm volatile("s_waitcnt lgkmcnt(0)" ::: "memory")
#define VM_WAIT() asm volatile("s_waitcnt vmcnt(0)" ::: "memory")
__device__ __forceinline__ unsigned long long rt() { return __builtin_amdgcn_s_memrealtime(); }
__device__ __forceinline__ unsigned f2bf(float f) { unsigned u = __builtin_bit_cast(unsigned, f); return (u + 0x7fffu + ((u >> 16) & 1u)) >> 16; }
__device__ __forceinline__ unsigned pk2(float lo, float hi) { return f2bf(lo) | (f2bf(hi) << 16); }

#define XB_TMO      128
#define XB_XCNT(j)  (256  + 64 * (j))
#define XB_XSUB(j)  (1280 + 64 * (j))
#define XB_XGEN(j)  (2304 + 64 * (j))
#define XB_TOP      3328
#define XB_TOPGEN   3392
#define XCD_BAR_WORDS 3456
#define XB_SPIN_CAP (1u << 18)

__device__ __forceinline__ unsigned xb_ld(unsigned* p)              { return __hip_atomic_load(p, __ATOMIC_RELAXED, __HIP_MEMORY_SCOPE_AGENT); }
__device__ __forceinline__ unsigned xb_add(unsigned* p, unsigned v) { return __hip_atomic_fetch_add(p, v, __ATOMIC_RELAXED, __HIP_MEMORY_SCOPE_AGENT); }
__device__ __forceinline__ unsigned xb_xcc_id() { return (unsigned)__builtin_amdgcn_s_getreg((3 << 11) | 20) & 0xFu; }
#define XB_SPIN(cond, bar) do { unsigned _sp = 0; while (cond) { __builtin_amdgcn_s_sleep(1); \
    if ((++_sp & 255u) == 0u) { if (xb_ld(&(bar)[XB_TMO])) break; if (_sp > XB_SPIN_CAP) { atomicAdd(&(bar)[XB_TMO], 1u); break; } } } } while (0)

struct XcdBarrier {
    unsigned* bar; unsigned x;
    volatile LAS unsigned* st;
};

__device__ __forceinline__ XcdBarrier xcd_barrier_post(unsigned* bar, volatile LAS unsigned* st, const int wid0) {
    XcdBarrier b; b.bar = bar; b.x = xb_xcc_id(); b.st = st;
    if (wid0 == 0 && fresh_lane() == 0) (void)xb_add(&bar[XB_XCNT(b.x)], 1u);
    return b;
}
__device__ __forceinline__ void xcd_barrier_complete(unsigned* bar, unsigned x, unsigned& nloc, unsigned& nx) {
    const unsigned G = gridDim.x * gridDim.y * gridDim.z;
    unsigned sum, cnt, mine, sp = 0u;
    for (;;) {
        sum = 0u; cnt = 0u; mine = 0u;
#pragma unroll 1
        for (unsigned j = 0; j < 16; ++j) { const unsigned c = xb_ld(&bar[XB_XCNT(j)]); sum += c; cnt += (c > 0u) ? 1u : 0u; mine = (j == x) ? c : mine; }
        if (sum == G) break;
        __builtin_amdgcn_s_sleep(1);
        if ((++sp & 255u) == 0u) { if (xb_ld(&bar[XB_TMO])) break; if (sp > XB_SPIN_CAP) { atomicAdd(&bar[XB_TMO], 1u); break; } }
    }
    nloc = mine > 0u ? mine : 1u; nx = cnt > 0u ? cnt : 1u;
}

__device__ __forceinline__ void xcd_barrier(const XcdBarrier& b, const int wid0) {
    asm volatile("s_waitcnt vmcnt(0)" ::: "memory");
    __syncthreads();
    if (wid0 == 0 && fresh_lane() == 0) {
        unsigned* bar = b.bar;
        __builtin_amdgcn_s_waitcnt(0);
        unsigned nloc = b.st[0], nx = b.st[1];
        const unsigned bx_ = xb_xcc_id();
        if (nloc == 0u) { xcd_barrier_complete(bar, bx_, nloc, nx); b.st[0] = nloc; b.st[1] = nx; }
        const unsigned old = xb_add(&bar[XB_XSUB(bx_)], 1u);
        const unsigned gen = old / nloc;
        if (old + 1u == (gen + 1u) * nloc) {
            __builtin_amdgcn_fence(__ATOMIC_RELEASE, "agent");
            asm volatile("s_waitcnt vmcnt(0)" ::: "memory");
            const unsigned og = xb_add(&bar[XB_TOP], 1u);
            const unsigned tg = og / nx;
            if (og + 1u == (tg + 1u) * nx) xb_add(&bar[XB_TOPGEN], 1u);
            else XB_SPIN(xb_ld(&bar[XB_TOPGEN]) == tg, bar);
            __builtin_amdgcn_fence(__ATOMIC_ACQUIRE, "agent");
            xb_add(&bar[XB_XGEN(bx_)], 1u);
            asm volatile("s_waitcnt vmcnt(0)" ::: "memory");
        } else {
            XB_SPIN(xb_ld(&bar[XB_XGEN(bx_)]) == gen, bar);
            __builtin_amdgcn_fence(__ATOMIC_ACQUIRE, "agent");
            asm volatile("s_waitcnt vmcnt(0)" ::: "memory");
        }
    }
    __syncthreads();
}
constexpr int NWAVES = 8;
constexpr int NB = 2, SEQ = 4096, DM = 4096, NL = 2, M = NB * SEQ;
constexpr int INC = 11336, INP = 11520;
constexpr int A_Q = 0, B_CQ = 3072, B_CKV = 4608, B_KR = 5120, C_Q = 5184, D_Q = 8256, D_F = 11328;
constexpr int QRANK = 1536, KVRANK = 512, DFF = 16384, MEMT = 256;
constexpr int P4DEF = 64 * 8 * 4;
constexpr int UPDEF = 88 * 8 * 8;
constexpr float EPS = 1e-6f;

constexpr size_t MiB = 1u << 20;
constexpr size_t WS_CTL = 0, CTL_ZERO_BYTES = 1 * MiB;
constexpr size_t WS_COS = 1 * MiB, WS_SIN = 2 * MiB;
constexpr size_t WS_LUT = 3 * MiB;
constexpr size_t WS_TPMAX = 3 * MiB + 8192;
constexpr size_t WS_LAM = 3 * MiB + 12288;
constexpr size_t WS_LOGF = 4 * MiB, WS_NEGC = 4 * MiB + 512 * 1024;
constexpr size_t WS_W = 8 * MiB;
constexpr size_t SZ_IN = (size_t)INP * DM * 2, SZ_OUT = (size_t)DM * DM * 2, SZ_UQ = (size_t)1536 * 1536 * 2, SZ_UKV = (size_t)2048 * 512 * 2,
                 SZ_MQ = (size_t)512 * DM * 2, SZ_MKV = (size_t)1024 * DM * 2, SZ_MO = (size_t)DM * 512 * 2, SZ_UP = (size_t)DFF * DM * 2, SZ_DN = SZ_UP;
constexpr size_t W_IN = 0, W_OUT = W_IN + SZ_IN, W_UQ = W_OUT + SZ_OUT, W_UKV = W_UQ + SZ_UQ, W_MQ = W_UKV + SZ_UKV, W_MKV = W_MQ + SZ_MQ, W_MO = W_MKV + SZ_MKV,
                 W_UP = W_MO + SZ_MO, W_DN = W_UP + SZ_UP, W_LAYER = W_DN + SZ_DN;
static_assert(W_LAYER % 256 == 0, "weight block alignment");
constexpr size_t WS_MEMN = WS_W + NL * W_LAYER;
constexpr size_t WS_KVMEM = WS_MEMN + (size_t)NL * 512 * DM * 2;
constexpr size_t WS_H = WS_KVMEM + (size_t)NL * 512 * 1024 * 2;
constexpr size_t WS_CQN = WS_H + (size_t)M * DM * 2;
constexpr size_t WS_CKVN = WS_CQN + (size_t)M * 1536 * 2;
constexpr size_t WS_KPE = WS_CKVN + (size_t)M * 512 * 2;
constexpr size_t WS_QMLA = WS_KPE + (size_t)M * 64 * 2;
constexpr size_t WS_KVMLA = WS_QMLA + (size_t)M * 1536 * 2;
constexpr size_t WS_QMEM = WS_KVMLA + (size_t)M * 2048 * 2;
constexpr size_t WS_OMEM = WS_QMEM + (size_t)M * 512 * 2;
constexpr size_t WS_XL = WS_OMEM + (size_t)M * 512 * 2;
constexpr size_t WS_U = WS_XL + (size_t)M * DM * 2;
constexpr size_t WS_PROJ = WS_U;
constexpr size_t WS_MIX = WS_PROJ + (size_t)M * INP * 2;
static_assert(WS_MIX + (size_t)M * DM * 2 <= WS_U + (size_t)M * DFF * 2, "PROJ + MIX fit inside U");
constexpr size_t WS_END = WS_U + (size_t)M * DFF * 2;
constexpr int CW_BAR = 4096;
constexpr int CW_SS = 32768;
constexpr int CW_KN = 24576;
constexpr int CW_TKT = 16384;

constexpr int RING_OFF = 0, RING_BYTES = 137216;
constexpr int LDSCTL_OFF = RING_BYTES, MISC_OFF = LDSCTL_OFF + 320;
constexpr int LDS_BYTES = 147456;

typedef unsigned short bf16;
typedef short bf16x8 __attribute__((ext_vector_type(8)));
typedef short s16x4 __attribute__((ext_vector_type(4)));
typedef float f32x4 __attribute__((ext_vector_type(4)));
typedef float f32x16 __attribute__((ext_vector_type(16)));
typedef unsigned v4u __attribute__((ext_vector_type(4)));
typedef unsigned v2u __attribute__((ext_vector_type(2)));
typedef int i32x4 __attribute__((ext_vector_type(4)));

__device__ __forceinline__ unsigned cvtpk(float lo, float hi) { unsigned r; asm volatile("v_cvt_pk_bf16_f32 %0, %1, %2" : "=v"(r) : "v"(lo), "v"(hi)); return r; }
__device__ __forceinline__ float bf2f(short s) { return __uint_as_float(((unsigned)(unsigned short)s) << 16); }
template <int X> __device__ __forceinline__ float shx(float v) { return __int_as_float(__builtin_amdgcn_ds_swizzle(__float_as_int(v), 0x1f | (X << 10))); }
template <int X> __device__ __forceinline__ int shxi(int v) { return __builtin_amdgcn_ds_swizzle(v, 0x1f | (X << 10)); }
__device__ __forceinline__ float half_sum(float v) { v += shx<1>(v); v += shx<2>(v); v += shx<4>(v); v += shx<8>(v); v += shx<16>(v); return v; }
__device__ __forceinline__ float wave_sum(float v) { v = half_sum(v);
    auto rr = __builtin_amdgcn_permlane32_swap(__float_as_uint(v), __float_as_uint(v), false, false); return __uint_as_float(rr[0]) + __uint_as_float(rr[1]); }
#define FRESH_LANE(name) const int name = fresh_lane()
#define WAITBAR() asm volatile("s_waitcnt vmcnt(0) lgkmcnt(0)\n\ts_barrier" ::: "memory")

__device__ __forceinline__ void tr_item(const float* W, int K, int N, int nblk, bf16* WT, int row_off, LAS float* scr, int item, int lane, const float* gk) {
    const int kb = item / nblk, nb = item - kb * nblk, k0 = 64 * kb, n0 = 64 * nb;
    const int c4 = (lane & 15) * 4, rr = lane >> 4; const bool ok = n0 + c4 < N;
    const GAS f32x4* src = (const GAS f32x4*)(W + (size_t)(k0 + rr) * N + n0 + c4);
    f32x4 v[16];
#pragma unroll
    for (int i = 0; i < 16; ++i) v[i] = ok ? __builtin_nontemporal_load((const GAS f32x4*)((const GAS float*)src + (size_t)(4 * i) * N)) : (f32x4){0.f, 0.f, 0.f, 0.f};
    if (gk) {
#pragma unroll
        for (int i = 0; i < 16; ++i) v[i] = v[i] * gk[k0 + 4 * i + rr]; }
#pragma unroll
    for (int i = 0; i < 16; ++i) { LAS float* s = scr + (4 * i + rr) * 65 + c4; s[0] = v[i].x; s[1] = v[i].y; s[2] = v[i].z; s[3] = v[i].w; }
    LDS_WAIT(); asm volatile("" ::: "memory");
    const int c = lane & 7;
#pragma unroll
    for (int j = 0; j < 8; ++j) { const int nn = (lane >> 3) + 8 * j; const LAS float* s = scr + (8 * c) * 65 + nn;
        v4u o; o.x = cvtpk(s[0 * 65], s[1 * 65]); o.y = cvtpk(s[2 * 65], s[3 * 65]); o.z = cvtpk(s[4 * 65], s[5 * 65]); o.w = cvtpk(s[6 * 65], s[7 * 65]);
        *(GAS v4u*)(WT + (size_t)(row_off + n0 + nn) * K + k0 + 8 * c) = o; }
    LDS_WAIT(); asm volatile("" ::: "memory");
}
template <bool BF> __device__ __forceinline__ void rms_row(const float* xrow, const float* g, void* orow, int lane) {
    const GAS f32x4* xr = (const GAS f32x4*)xrow + lane; const GAS f32x4* gr = (const GAS f32x4*)g + lane;
    f32x4 v[16]; float s = 0.f;
#pragma unroll
    for (int j = 0; j < 16; ++j) { v[j] = xr[64 * j]; s += (v[j].x * v[j].x + v[j].y * v[j].y) + (v[j].z * v[j].z + v[j].w * v[j].w); }
    const float rstd = 1.0f / sqrtf(wave_sum(s) * (1.f / DM) + EPS);
#pragma unroll
    for (int j = 0; j < 16; ++j) { const f32x4 gg = gr[64 * j]; const f32x4 y = v[j] * rstd * gg;
        if (BF) { v2u w; w.x = cvtpk(y.x, y.y); w.y = cvtpk(y.z, y.w); ((GAS v2u*)orow)[64 * j + lane] = w; }
        else ((GAS f32x4*)orow)[64 * j + lane] = y; }
}
__device__ __forceinline__ void cast_row(const float* xrow, bf16* hrow, bf16* lrow, float* ss, int lane) {
    const GAS f32x4* xr = (const GAS f32x4*)xrow + lane; float s = 0.f;
#pragma unroll
    for (int j = 0; j < 16; ++j) { const f32x4 v = xr[64 * j]; s += (v.x * v.x + v.y * v.y) + (v.z * v.z + v.w * v.w);
        v2u h; h.x = cvtpk(v.x, v.y); h.y = cvtpk(v.z, v.w); ((GAS v2u*)hrow)[64 * j + lane] = h;
        v2u w; w.x = cvtpk(v.x - __uint_as_float(h.x << 16), v.y - __uint_as_float(h.x & 0xffff0000u)); w.y = cvtpk(v.z - __uint_as_float(h.y << 16), v.w - __uint_as_float(h.y & 0xffff0000u)); ((GAS v2u*)lrow)[64 * j + lane] = w; }
    s = wave_sum(s); if (lane == 0) *ss = s;
}
__device__ __forceinline__ void final_row(const bf16* hrow, const bf16* lrow, const float* g, float* orow, int lane) {
    f32x4 v[16]; float s = 0.f;
#pragma unroll
    for (int j = 0; j < 16; ++j) { const v2u h = ((const GAS v2u*)hrow)[64 * j + lane], w = ((const GAS v2u*)lrow)[64 * j + lane];
        v[j].x = __uint_as_float(h.x << 16) + __uint_as_float(w.x << 16); v[j].y = __uint_as_float(h.x & 0xffff0000u) + __uint_as_float(w.x & 0xffff0000u);
        v[j].z = __uint_as_float(h.y << 16) + __uint_as_float(w.y << 16); v[j].w = __uint_as_float(h.y & 0xffff0000u) + __uint_as_float(w.y & 0xffff0000u);
        s += (v[j].x * v[j].x + v[j].y * v[j].y) + (v[j].z * v[j].z + v[j].w * v[j].w); }
    const float rstd = 1.0f / sqrtf(wave_sum(s) * (1.f / DM) + EPS);
#pragma unroll
    for (int j = 0; j < 16; ++j) { const f32x4 gg = ((const GAS f32x4*)g)[64 * j + lane]; ((GAS f32x4*)orow)[64 * j + lane] = v[j] * rstd * gg; }
}
__device__ __forceinline__ float logsigmoidf_(float x) {
    const float e = __expf(-fabsf(x)); return fminf(x, 0.f) - __logf(1.f + e);
}
__device__ __forceinline__ void prep_row(const bf16* proj, int m, const float* gq, const float* gkv, const float* bf, const float* COS, const float* SIN,
                                         bf16* CQN, bf16* CKVN, bf16* KPE, float* LOGF, unsigned* KN2, int lane) {
    const bf16* pr = proj + (size_t)m * INP;
    bf16x8 q[3]; float sq = 0.f;
#pragma unroll
    for (int j = 0; j < 3; ++j) { q[j] = *(const GAS bf16x8*)(pr + B_CQ + (j * 64 + lane) * 8);
#pragma unroll
        for (int e = 0; e < 8; ++e) { const float f = bf2f(q[j][e]); sq += f * f; } }
    const bf16x8 kv = *(const GAS bf16x8*)(pr + B_CKV + lane * 8); float skv = 0.f;
#pragma unroll
    for (int e = 0; e < 8; ++e) { const float f = bf2f(kv[e]); skv += f * f; }
    const float rq = 1.0f / sqrtf(wave_sum(sq) * (1.f / QRANK) + EPS), rkv = 1.0f / sqrtf(wave_sum(skv) * (1.f / KVRANK) + EPS);
#pragma unroll
    for (int j = 0; j < 3; ++j) { const int c0 = (j * 64 + lane) * 8; const f32x4 g0 = *(const GAS f32x4*)(gq + c0), g1 = *(const GAS f32x4*)(gq + c0 + 4);
        v4u w; w.x = cvtpk(bf2f(q[j][0]) * rq * g0.x, bf2f(q[j][1]) * rq * g0.y); w.y = cvtpk(bf2f(q[j][2]) * rq * g0.z, bf2f(q[j][3]) * rq * g0.w);
        w.z = cvtpk(bf2f(q[j][4]) * rq * g1.x, bf2f(q[j][5]) * rq * g1.y); w.w = cvtpk(bf2f(q[j][6]) * rq * g1.z, bf2f(q[j][7]) * rq * g1.w);
        *(GAS v4u*)(CQN + (size_t)m * QRANK + c0) = w; }
    { const int c0 = lane * 8; const f32x4 g0 = *(const GAS f32x4*)(gkv + c0), g1 = *(const GAS f32x4*)(gkv + c0 + 4);
        v4u w; w.x = cvtpk(bf2f(kv[0]) * rkv * g0.x, bf2f(kv[1]) * rkv * g0.y); w.y = cvtpk(bf2f(kv[2]) * rkv * g0.z, bf2f(kv[3]) * rkv * g0.w);
        w.z = cvtpk(bf2f(kv[4]) * rkv * g1.x, bf2f(kv[5]) * rkv * g1.y); w.w = cvtpk(bf2f(kv[6]) * rkv * g1.z, bf2f(kv[7]) * rkv * g1.w);
        *(GAS v4u*)(CKVN + (size_t)m * KVRANK + c0) = w; }
    { const float v = bf2f((short)pr[B_KR + lane]); float pv; { auto rr = __builtin_amdgcn_permlane32_swap(__float_as_uint(v), __float_as_uint(v), false, false); pv = __uint_as_float(lane >= 32 ? rr[0] : rr[1]); } const int i = lane & 31;
      const float c = COS[(size_t)m * 32 + i], s = SIN[(size_t)m * 32 + i];
      const float o = lane < 32 ? v * c - pv * s : pv * s + v * c;
      const float on = shx<1>(o);
      if ((lane & 1) == 0) *(GAS unsigned*)(KPE + (size_t)m * 64 + lane) = cvtpk(o, on); }
    if (lane < 8) { const float f = bf2f((short)pr[D_F + lane]) + bf[lane]; const int b = m / SEQ, s = m - b * SEQ; LOGF[(size_t)(b * 8 + lane) * SEQ + s] = logsigmoidf_(f); }
    { const bf16x8 k0 = *(const GAS bf16x8*)(pr + D_Q + 1024 + lane * 16), k1 = *(const GAS bf16x8*)(pr + D_Q + 1024 + lane * 16 + 8); float s = 0.f;
#pragma unroll
      for (int e = 0; e < 8; ++e) { const float a = bf2f(k0[e]), c = bf2f(k1[e]); s += a * a + c * c; }
      s += shx<1>(s); s += shx<2>(s); s += shx<4>(s);
      if ((lane & 7) == 0) { unsigned* p = KN2 + (m / SEQ) * 8 + (lane >> 3); const unsigned v = __float_as_uint(s);
          if (v > __hip_atomic_load(p, __ATOMIC_RELAXED, __HIP_MEMORY_SCOPE_AGENT)) __hip_atomic_fetch_max(p, v, __ATOMIC_RELAXED, __HIP_MEMORY_SCOPE_AGENT); } }
}
__device__ __forceinline__ void fox_scan(const float* logf, float* negc, int lane) {
    const GAS f32x4* src = (const GAS f32x4*)(logf + lane * 64); f32x4 v[16]; float tot = 0.f;
#pragma unroll
    for (int j = 0; j < 16; ++j) { v[j] = src[j]; tot += (v[j].x + v[j].y) + (v[j].z + v[j].w); }
    float inc = tot;
#pragma unroll
    for (int o = 1; o < 64; o <<= 1) { const float t = __int_as_float(__builtin_amdgcn_ds_bpermute((lane - o) << 2, __float_as_int(inc))); if (lane >= o) inc += t; }
    float run = inc - tot; const float k = -11.313708498984761f;
    GAS f32x4* dst = (GAS f32x4*)(negc + lane * 64);
#pragma unroll
    for (int j = 0; j < 16; ++j) { f32x4 o; run += v[j].x; o.x = run * k; run += v[j].y; o.y = run * k; run += v[j].z; o.z = run * k; run += v[j].w; o.w = run * k; dst[j] = o; }
}

namespace att {
constexpr int VA = 0, VB = 1, VC = 2, VD = 3, VE = 4;
constexpr int K_OFF = 0, V_OFF = 32768, B_OFF = 65536, WS_OFF = 67584, LUT_OFF = 69632, FLG_OFF = 70656, TKT_OFF = 70784, KPE_OFF = 71680, QF_OFF = 71680, ATT_END = QF_OFF + 65536;
constexpr float LOG2E = 1.4426950408889634f, LN2 = 0.6931471805599453f, THR = 8.f;
struct Ctx { const bf16* PROJ; const bf16* QMLA; const bf16* KVMLA; const bf16* KPE; bf16* MIX; const bf16* QMEM; const bf16* KVMEM; bf16* OMEM;
             const float* COS; const float* SIN; const float* LUT; const int* TPMAX; const int* pos; const float* NEGC; const float* sub_g; const unsigned* KN2; float lam, oml; };

__device__ __forceinline__ int crow(int r, int hi) { return (r & 3) + 8 * (r >> 2) + 4 * hi; }
__device__ __forceinline__ int swap23(int k) { return (k & ~0xC) | ((k & 4) << 1) | ((k & 8) >> 1); }
__device__ __forceinline__ float pmaxf(float v) { auto rr = __builtin_amdgcn_permlane32_swap(__float_as_uint(v), __float_as_uint(v), false, false); return fmaxf(__uint_as_float(rr[0]), __uint_as_float(rr[1])); }
__device__ __forceinline__ float psumf(float v) { auto rr = __builtin_amdgcn_permlane32_swap(__float_as_uint(v), __float_as_uint(v), false, false); return __uint_as_float(rr[0]) + __uint_as_float(rr[1]); }
__device__ __forceinline__ float partnerf(float v, int hi) { auto rr = __builtin_amdgcn_permlane32_swap(__float_as_uint(v), __float_as_uint(v), false, false); return __uint_as_float(hi ? rr[0] : rr[1]); }
__device__ __forceinline__ void dma16(const void* sbase, unsigned voff, unsigned ldsaddr) { unsigned keep;
    asm volatile("s_mov_b32 %0, m0\n\ts_mov_b32 m0, %3\n\ts_nop 0\n\tglobal_load_lds_dwordx4 %1, %2\n\ts_mov_b32 m0, %0" : "=&s"(keep) : "v"(voff), "s"(sbase), "s"(ldsaddr) : "memory"); }

template <int NK> __device__ __forceinline__ void qk(f32x16& p0, f32x16& p1, const LAS unsigned char* krow, int xr, int hx, const bf16x8* qf, int dstart) {
#pragma unroll
    for (int d0 = 0; d0 < NK; ++d0) { const int off = (((dstart + d0) * 32 + hx) ^ xr);
        const bf16x8 b0 = *(const LAS bf16x8*)(krow + off), b1 = *(const LAS bf16x8*)(krow + off + 8192);
        p0 = __builtin_amdgcn_mfma_f32_32x32x16_bf16(b0, qf[d0], p0, 0, 0, 0); p1 = __builtin_amdgcn_mfma_f32_32x32x16_bf16(b1, qf[d0], p1, 0, 0, 0); }
}
template <int NK> __device__ __forceinline__ void qk_l(f32x16& p0, f32x16& p1, const LAS unsigned char* krow, int xr, int hx, const LAS unsigned char* qlds, int dstart) {
#pragma unroll
    for (int d0 = 0; d0 < NK; ++d0) { const int off = (((dstart + d0) * 32 + hx) ^ xr);
        const bf16x8 b0 = *(const LAS bf16x8*)(krow + off), b1 = *(const LAS bf16x8*)(krow + off + 8192), q = *(const LAS bf16x8*)(qlds + (dstart + d0) * 1024);
        p0 = __builtin_amdgcn_mfma_f32_32x32x16_bf16(b0, q, p0, 0, 0, 0); p1 = __builtin_amdgcn_mfma_f32_32x32x16_bf16(b1, q, p1, 0, 0, 0); }
}
__device__ __forceinline__ void qk_pe(f32x16& p0, f32x16& p1, const LAS unsigned char* perow, int xpe, int hx, const bf16x8* qf) {
#pragma unroll
    for (int d0 = 0; d0 < 4; ++d0) { const int off = ((d0 * 32 + hx) ^ xpe);
        const bf16x8 b0 = *(const LAS bf16x8*)(perow + off), b1 = *(const LAS bf16x8*)(perow + off + 4096);
        p0 = __builtin_amdgcn_mfma_f32_32x32x16_bf16(b0, qf[d0], p0, 0, 0, 0); p1 = __builtin_amdgcn_mfma_f32_32x32x16_bf16(b1, qf[d0], p1, 0, 0, 0); }
}
__device__ __forceinline__ void pv(f32x16* o, unsigned vb, bf16x8 pa0, bf16x8 pa1, bf16x8 pa2, bf16x8 pa3) {
#define TRRD(dst, off) asm volatile("ds_read_b64_tr_b16 %0, %1 offset:%2" : "=&v"(dst) : "v"(vb), "i"(off) : "memory")
#define PV_D0(d0) do { s16x4 l0, l1, l2, l3, h0, h1, h2, h3; constexpr int b_ = (d0) * 512; \
        TRRD(l0, b_); TRRD(h0, b_ + 2048); TRRD(l1, b_ + 4096); TRRD(h1, b_ + 6144); TRRD(l2, b_ + 8192); TRRD(h2, b_ + 10240); TRRD(l3, b_ + 12288); TRRD(h3, b_ + 14336); \
        asm volatile("s_waitcnt lgkmcnt(0)" ::: "memory"); __builtin_amdgcn_sched_barrier(0); \
        o[d0] = __builtin_amdgcn_mfma_f32_32x32x16_bf16(pa0, (bf16x8){l0[0], l0[1], l0[2], l0[3], h0[0], h0[1], h0[2], h0[3]}, o[d0], 0, 0, 0); \
        o[d0] = __builtin_amdgcn_mfma_f32_32x32x16_bf16(pa1, (bf16x8){l1[0], l1[1], l1[2], l1[3], h1[0], h1[1], h1[2], h1[3]}, o[d0], 0, 0, 0); \
        o[d0] = __builtin_amdgcn_mfma_f32_32x32x16_bf16(pa2, (bf16x8){l2[0], l2[1], l2[2], l2[3], h2[0], h2[1], h2[2], h2[3]}, o[d0], 0, 0, 0); \
        o[d0] = __builtin_amdgcn_mfma_f32_32x32x16_bf16(pa3, (bf16x8){l3[0], l3[1], l3[2], l3[3], h3[0], h3[1], h3[2], h3[3]}, o[d0], 0, 0, 0); } while (0)
    PV_D0(0); PV_D0(1); PV_D0(2); PV_D0(3);
#undef PV_D0
#undef TRRD
}
__device__ __forceinline__ void pack_p(const f32x16& p0, const f32x16& p1, bf16x8& pa0, bf16x8& pa1, bf16x8& pa2, bf16x8& pa3) {
#define PK4(P, B_, OUT) do { unsigned a0 = cvtpk(P[B_ + 0], P[B_ + 1]), a1 = cvtpk(P[B_ + 2], P[B_ + 3]), b0 = cvtpk(P[B_ + 4], P[B_ + 5]), b1 = cvtpk(P[B_ + 6], P[B_ + 7]); \
        auto r0 = __builtin_amdgcn_permlane32_swap(a0, b0, false, false); auto r1 = __builtin_amdgcn_permlane32_swap(a1, b1, false, false); \
        v4u w = {r0[0], r1[0], r0[1], r1[1]}; OUT = __builtin_bit_cast(bf16x8, w); } while (0)
    PK4(p0, 0, pa0); PK4(p0, 8, pa1); PK4(p1, 0, pa2); PK4(p1, 8, pa3);
#undef PK4
}
__device__ __forceinline__ void softmax_pv(f32x16& p0, f32x16& p1, float& m, float& l, f32x16* o, LAS float* wsf, unsigned vb, int r32, int hi, const float SCALE, const float C2) {
    float pmax = p0[0];
#pragma unroll
    for (int r = 1; r < 16; ++r) pmax = fmaxf(pmax, p0[r]);
#pragma unroll
    for (int r = 0; r < 16; ++r) pmax = fmaxf(pmax, p1[r]);
    pmax = pmaxf(pmax);
    float mn, alpha;
    if (__all((pmax - m) * SCALE <= THR)) { mn = m; alpha = 1.f; }
    else { mn = fmaxf(m, pmax); alpha = __builtin_amdgcn_exp2f((m - mn) * C2); m = mn; }
    const float mnL = -mn * C2;
#pragma unroll
    for (int r = 0; r < 16; ++r) { p0[r] = __builtin_amdgcn_exp2f(fmaf(p0[r], C2, mnL)); p1[r] = __builtin_amdgcn_exp2f(fmaf(p1[r], C2, mnL)); }
    float ps = 0.f;
#pragma unroll
    for (int r = 0; r < 16; ++r) ps += p0[r] + p1[r];
    ps = psumf(ps); l = l * alpha + ps;
    bf16x8 pa0, pa1, pa2, pa3; pack_p(p0, p1, pa0, pa1, pa2, pa3);
    if (__any(alpha < 1.f)) { const int fl = fresh_lane(), fh = fl >> 5;
        if (fh == 0) wsf[fl] = alpha; asm volatile("s_waitcnt lgkmcnt(0)" ::: "memory");
#pragma unroll
        for (int r = 0; r < 16; ++r) { const float a = wsf[crow(r, fh)];
#pragma unroll
            for (int d = 0; d < 4; ++d) o[d][r] *= a; } }
    pv(o, vb, pa0, pa1, pa2, pa3);
}

template <int VAR>
__device__ __forceinline__ void attn_unit(const Ctx& C, int b, int h, int qb, LAS unsigned char* lds, int tid, int wid, int lane) {
    constexpr bool CAUSAL = VAR != VE, DESC = (VAR == VC || VAR == VD), MLA = (VAR == VB), DIFF = (VAR == VA), STICK = (VAR == VC), HASB = (VAR == VA || VAR == VD);
    constexpr int NQF = MLA ? 12 : 8;
    constexpr float SCALE = DIFF ? 0.125f : (MLA ? 0.07216878364870323f : 0.08838834764831845f);
    constexpr float C2 = SCALE * LOG2E;
    const int r32 = lane & 31, hi = lane >> 5;
    const int q0 = qb * 256, qw = q0 + wid * 32, trow = qw + r32;
    const size_t rb = (size_t)b * SEQ;
    const bf16 *Qp, *Kp, *Vp; bf16* Op; int qpitch, kpitch, opitch;
    if constexpr (VAR == VA || VAR == VC || VAR == VD) {
        constexpr int base = VAR == VA ? A_Q : (VAR == VC ? C_Q : D_Q);
        Qp = C.PROJ + rb * INP + base + h * 128; Kp = Qp + 1024; Vp = Qp + 2048; qpitch = INP; kpitch = INP;
        Op = C.MIX + rb * DM + VAR * 1024 + h * 128; opitch = DM;
    } else if constexpr (VAR == VB) {
        Qp = C.QMLA + rb * 1536 + h * 192; qpitch = 1536; Kp = C.KVMLA + rb * 2048 + h * 256; Vp = Kp + 128; kpitch = 2048;
        Op = C.MIX + rb * DM + 1024 + h * 128; opitch = DM;
    } else {
        Qp = C.QMEM + rb * 512 + h * 128; qpitch = 512; Kp = C.KVMEM + (size_t)b * MEMT * 1024 + h * 128; Vp = Kp + 512; kpitch = 1024;
        Op = C.OMEM + rb * 512 + h * 128; opitch = 512;
    }
    const char* Bp = nullptr;
    if constexpr (VAR == VA) Bp = (const char*)(C.pos + rb);
    if constexpr (VAR == VD) Bp = (const char*)(C.NEGC + (size_t)(b * 8 + h) * SEQ);
    const char* KPEp = nullptr;
    if constexpr (MLA) KPEp = (const char*)(C.KPE + rb * 64);
    bf16x8 qr[DIFF ? 1 : NQF];
    const LAS unsigned char* qlds = lds + QF_OFF + wid * 8192 + lane * 16;
    { const bf16* qrow = Qp + (size_t)trow * qpitch + hi * 8;
      if constexpr (DIFF) {
#pragma unroll
          for (int d0 = 0; d0 < 8; ++d0) { const bf16x8 q = *(const GAS bf16x8*)(qrow + d0 * 16); *(LAS bf16x8*)(lds + QF_OFF + wid * 8192 + lane * 16 + d0 * 1024) = q; }
      } else {
#pragma unroll
          for (int d0 = 0; d0 < NQF; ++d0) qr[d0] = *(const GAS bf16x8*)(qrow + d0 * 16); } }
    if constexpr (MLA) {
        const float* cs = C.COS + (rb + trow) * 32 + hi * 8; const float* sn = C.SIN + (rb + trow) * 32 + hi * 8;
#pragma unroll
        for (int j = 0; j < 2; ++j) {
            const f32x4 c0 = *(const GAS f32x4*)(cs + j * 16), c1 = *(const GAS f32x4*)(cs + j * 16 + 4), s0 = *(const GAS f32x4*)(sn + j * 16), s1 = *(const GAS f32x4*)(sn + j * 16 + 4);
            const bf16x8 a = qr[8 + j], bb = qr[10 + j]; float lo[8], hh[8];
#pragma unroll
            for (int e = 0; e < 8; ++e) { const float t1 = bf2f(a[e]), t2 = bf2f(bb[e]), c = e < 4 ? c0[e & 3] : c1[e & 3], s = e < 4 ? s0[e & 3] : s1[e & 3]; lo[e] = t1 * c - t2 * s; hh[e] = t1 * s + t2 * c; }
            v4u wl = {cvtpk(lo[0], lo[1]), cvtpk(lo[2], lo[3]), cvtpk(lo[4], lo[5]), cvtpk(lo[6], lo[7])}, wh = {cvtpk(hh[0], hh[1]), cvtpk(hh[2], hh[3]), cvtpk(hh[4], hh[5]), cvtpk(hh[6], hh[7])};
            qr[8 + j] = __builtin_bit_cast(bf16x8, wl); qr[10 + j] = __builtin_bit_cast(bf16x8, wh); }
    }
    unsigned koff[2], voff[2], peoff = 0;
#pragma unroll
    for (int i = 0; i < 2; ++i) { const int j = wid * 2 + i, row = 4 * j + (lane >> 4); koff[i] = (unsigned)(row * kpitch + (((lane & 15) ^ (row & 15)) << 3)) * 2u;
        const int st = 2 * j + (lane >> 5), kk = (st >> 2) * 8 + ((lane & 31) >> 2), c = (st & 3) * 32 + (lane & 3) * 8; voff[i] = (unsigned)(swap23(kk) * kpitch + c) * 2u; }
    if constexpr (MLA) { const int row = 8 * wid + (lane >> 3); peoff = (unsigned)(row * 64 + (((lane & 7) ^ ((row >> 1) & 7)) << 3)) * 2u; }
    const unsigned boff = (unsigned)(lane & 15) * 16u;
    const unsigned ldsbase = (unsigned)(unsigned long long)lds;
#define ISSUE(t_, buf_) do { const size_t tb_ = (size_t)(t_) * 64 * kpitch * 2; const char* kg_ = (const char*)Kp + tb_; const char* vg_ = (const char*)Vp + tb_; \
        _Pragma("unroll") for (int i_ = 0; i_ < 2; ++i_) dma16(kg_, koff[i_], ldsbase + K_OFF + (buf_) * 16384 + (wid * 2 + i_) * 1024); \
        _Pragma("unroll") for (int i_ = 0; i_ < 2; ++i_) dma16(vg_, voff[i_], ldsbase + V_OFF + (buf_) * 16384 + (wid * 2 + i_) * 1024); \
        if constexpr (MLA) dma16(KPEp + (size_t)(t_) * 64 * 64 * 2, peoff, ldsbase + KPE_OFF + (buf_) * 8192 + wid * 1024); \
        if constexpr (HASB) { if (wid == 0) dma16(Bp + (size_t)(t_) * 64 * 4, boff, ldsbase + B_OFF + (buf_) * 1024); } } while (0)
    const int NT = CAUSAL ? (q0 + 256) / 64 : MEMT / 64;
    LAS float* wsf = (LAS float*)(lds + WS_OFF) + wid * 64;
    LAS float* lut = (LAS float*)(lds + LUT_OFF);
    int pos_t = 0, wmin = 0; float lut_far = 0.f;
    if constexpr (DIFF) { if (tid < 132) lut[tid] = C.LUT[h * 132 + tid];
        pos_t = C.pos[rb + trow]; int mnp = pos_t;
        mnp = min(mnp, shxi<1>(mnp)); mnp = min(mnp, shxi<2>(mnp)); mnp = min(mnp, shxi<4>(mnp)); mnp = min(mnp, shxi<8>(mnp)); mnp = min(mnp, shxi<16>(mnp));
        wmin = __builtin_amdgcn_readfirstlane(mnp); lut_far = C.LUT[h * 132 + 128]; }
    const int xr = (r32 & 15) << 4, hx = hi << 4, xpe = ((r32 >> 1) & 7) << 4;
    const unsigned vrd = (unsigned)(((lane & 3) << 3) | (((lane >> 2) & 3) << 6) | (((lane >> 4) & 1) << 5) | (((lane >> 5) & 1) << 8));
    f32x16 o[4]; f32x16 o2[DIFF ? 4 : 1];
#pragma unroll
    for (int d = 0; d < 4; ++d) { o[d] = f32x16{}; if constexpr (DIFF) o2[d] = f32x16{}; }
    float m1 = -1e30f, l1 = 0.f, m2 = -1e30f, l2 = 0.f, R = 0.f;
    float qnkn = 0.f;
    if constexpr (VAR == VD) { float s = 0.f;
#pragma unroll
        for (int d0 = 0; d0 < 8; ++d0)
#pragma unroll
            for (int e = 0; e < 8; ++e) { const float a = bf2f(qr[d0][e]); s += a * a; }
        s = psumf(s); qnkn = sqrtf(s) * sqrtf(__uint_as_float(C.KN2[b * 8 + h])) * 1.001f + 1.f; }
    ISSUE(DESC ? NT - 1 : 0, 0);
    WAITBAR();
    int cur = 0;
    for (int i = 0; i < NT; ++i) {
        const int t = DESC ? NT - 1 - i : i, kb = t * 64;
        if (i + 1 < NT) ISSUE(DESC ? t - 1 : t + 1, cur ^ 1);
        const bool act = !CAUSAL || (STICK ? (kb < qw + 31) : (kb <= qw + 31));
        bool wdone = false;
        if constexpr (VAR == VD) {
            if (act) { const float nmax = ((const LAS float*)(lds + B_OFF + cur * 1024))[63]; wdone = __all((qnkn + nmax - m1) * SCALE < -40.f); } }
        if (act && !wdone) {
            const LAS unsigned char* krow = lds + K_OFF + cur * 16384 + r32 * 256;
            const unsigned vb = ldsbase + V_OFF + cur * 16384 + vrd;
            if constexpr (STICK) {
                f32x16 p0 = f32x16{}, p1 = f32x16{};
                qk<8>(p0, p1, krow, xr, hx, qr, 0);
                float L0[16], L1[16];
#pragma unroll
                for (int r = 0; r < 16; ++r) { const int key = kb + crow(r, hi);
                    { const float z = p0[r] * SCALE, e = __builtin_amdgcn_exp2f(-fabsf(z) * LOG2E), sp = fmaxf(z, 0.f) + __builtin_amdgcn_logf(1.f + e) * LN2; L0[r] = key < trow ? -sp : 0.f; p0[r] = z; }
                    { const float z = p1[r] * SCALE, e = __builtin_amdgcn_exp2f(-fabsf(z) * LOG2E), sp = fmaxf(z, 0.f) + __builtin_amdgcn_logf(1.f + e) * LN2; L1[r] = key + 32 < trow ? -sp : 0.f; p1[r] = z; } }
                float T[8], mb[8];
#pragma unroll
                for (int g = 0; g < 4; ++g) { T[g] = (L0[4 * g] + L0[4 * g + 1]) + (L0[4 * g + 2] + L0[4 * g + 3]); T[4 + g] = (L1[4 * g] + L1[4 * g + 1]) + (L1[4 * g + 2] + L1[4 * g + 3]); }
                float run = R;
#pragma unroll
                for (int k = 7; k >= 0; --k) { const float pt = partnerf(T[k], hi); const float T1 = hi ? T[k] : pt, T0 = hi ? pt : T[k];
                    const float b1 = run; run += T1; const float b0 = run; run += T0; mb[k] = hi ? b1 : b0; }
                R = run;
#pragma unroll
                for (int g = 0; g < 4; ++g) { float s0 = mb[g], s1 = mb[4 + g];
#pragma unroll
                    for (int e = 3; e >= 0; --e) { const int r = 4 * g + e, key = kb + crow(r, hi);
                        const float a0 = key < trow ? __builtin_amdgcn_exp2f((p0[r] + L0[r] + s0) * LOG2E) : 0.f; s0 += L0[r]; p0[r] = a0;
                        const float a1 = key + 32 < trow ? __builtin_amdgcn_exp2f((p1[r] + L1[r] + s1) * LOG2E) : 0.f; s1 += L1[r]; p1[r] = a1; } }
                bf16x8 pa0, pa1, pa2, pa3; pack_p(p0, p1, pa0, pa1, pa2, pa3);
                pv(o, vb, pa0, pa1, pa2, pa3);
            } else {
#pragma unroll
                for (int mp = 0; mp < (DIFF ? 2 : 1); ++mp) {
                    f32x16 p0, p1;
                    int xr_t = xr;
                    if constexpr (DIFF) { __builtin_amdgcn_sched_barrier(0); asm volatile("" : "+v"(pos_t), "+v"(xr_t)); }
                    if constexpr (VAR == VD) { const LAS float* nb = (const LAS float*)(lds + B_OFF + cur * 1024) + 4 * hi;
#pragma unroll
                        for (int g = 0; g < 4; ++g) { const f32x4 v0 = *(const LAS f32x4*)(nb + 8 * g), v1 = *(const LAS f32x4*)(nb + 32 + 8 * g);
#pragma unroll
                            for (int e = 0; e < 4; ++e) { p0[4 * g + e] = v0[e]; p1[4 * g + e] = v1[e]; } } }
                    else if constexpr (DIFF) {
                        if (wmin - C.TPMAX[b * 64 + t] >= 128) {
#pragma unroll
                            for (int r = 0; r < 16; ++r) { p0[r] = lut_far; p1[r] = lut_far; } }
                        else { const LAS int* pb = (const LAS int*)(lds + B_OFF + cur * 1024) + 4 * hi;
#pragma unroll
                            for (int g = 0; g < 4; ++g) { const i32x4 v0 = *(const LAS i32x4*)(pb + 8 * g), v1 = *(const LAS i32x4*)(pb + 32 + 8 * g);
#pragma unroll
                                for (int e = 0; e < 4; ++e) { p0[4 * g + e] = lut[min(max(pos_t - v0[e], 0), 128)]; p1[4 * g + e] = lut[min(max(pos_t - v1[e], 0), 128)]; }
                                __builtin_amdgcn_sched_barrier(0); } } }
                    else { p0 = f32x16{}; p1 = f32x16{}; }
                    if constexpr (DIFF) qk_l<4>(p0, p1, krow, xr_t, hx, qlds, 4 * mp);
                    else qk<8>(p0, p1, krow, xr, hx, qr, 0);
                    if constexpr (MLA) qk_pe(p0, p1, lds + KPE_OFF + cur * 8192 + r32 * 128, xpe, hx, qr + 8);
                    if (CAUSAL && kb + 63 > qw) { const float NEG = -__builtin_inff();
#pragma unroll
                        for (int r = 0; r < 16; ++r) { const int key = kb + crow(r, hi); if (key > trow) p0[r] = NEG; if (key + 32 > trow) p1[r] = NEG; } }
                    if (mp == 0) softmax_pv(p0, p1, m1, l1, o, wsf, vb, r32, hi, SCALE, C2);
                    else softmax_pv(p0, p1, m2, l2, o2, wsf, vb, r32, hi, SCALE, C2);
                }
            }
        }
        if constexpr (STICK) { const int dn_ = __all(R < -100.f) ? 1 : 0; if (lane == 0) ((LAS int*)(lds + FLG_OFF))[(i & 1) * 8 + wid] = dn_; }
        if constexpr (VAR == VD) { if (lane == 0) ((LAS int*)(lds + FLG_OFF))[(i & 1) * 8 + wid] = wdone ? 1 : 0; }
        WAITBAR(); cur ^= 1;
        if constexpr (STICK || VAR == VD) { const LAS i32x4* fl = (const LAS i32x4*)(lds + FLG_OFF + (i & 1) * 32); const i32x4 f0 = fl[0], f1 = fl[1];
            const int alld = (f0.x & f0.y & f0.z & f0.w) & (f1.x & f1.y & f1.z & f1.w); if (__builtin_amdgcn_readfirstlane(alld)) break; }
    }
#undef ISSUE
    const int lane_e = fresh_lane();
    const int r32e = lane_e & 31, hie = lane_e >> 5;
    bf16* Ob = Op + (size_t)(qw + 4 * hie) * opitch + r32e;
    if constexpr (DIFF) {
        if (hie == 0) { wsf[r32e] = l1; wsf[32 + r32e] = l2; } asm volatile("s_waitcnt lgkmcnt(0)" ::: "memory");
        const float lam = C.lam;
#pragma unroll
        for (int r = 0; r < 16; ++r) { const float i1 = __builtin_amdgcn_rcpf(wsf[crow(r, hie)]), i2 = lam * __builtin_amdgcn_rcpf(wsf[32 + crow(r, hie)]); float ss = 0.f;
#pragma unroll
            for (int d = 0; d < 4; ++d) { const float x = o[d][r] * i1 - o2[d][r] * i2; o[d][r] = x; ss += x * x; }
            ss = half_sum(ss);
            const float rstd = (1.0f / sqrtf(ss * (1.f / 128.f) + EPS)) * C.oml;
#pragma unroll
            for (int d = 0; d < 4; ++d) o[d][r] *= rstd; }
#pragma unroll
        for (int d = 0; d < 4; ++d) { const float g = C.sub_g[d * 32 + r32e];
#pragma unroll
            for (int r = 0; r < 16; ++r) o[d][r] *= g; }
    } else if constexpr (!STICK) {
        if (hie == 0) wsf[r32e] = l1; asm volatile("s_waitcnt lgkmcnt(0)" ::: "memory");
#pragma unroll
        for (int r = 0; r < 16; ++r) { const float i1 = __builtin_amdgcn_rcpf(wsf[crow(r, hie)]);
#pragma unroll
            for (int d = 0; d < 4; ++d) o[d][r] *= i1; }
    }
#pragma unroll
    for (int r = 0; r < 16; ++r) { const int orr = (r & 3) + 8 * (r >> 2);
#pragma unroll
        for (int d = 0; d < 4; ++d) { const float v = o[d][r], vn = shx<1>(v);
            if ((r32e & 1) == 0) *(GAS unsigned*)(Ob + (size_t)orr * opitch + d * 32) = cvtpk(v, vn); } }
}
template <int VAR> __device__ __forceinline__ void attn_queue(const Ctx& C, gu32* head, LAS unsigned char* lds, const int wid) {
    constexpr int NH = VAR == VE ? 4 : 8, NU = NB * NH * 16;
    const int lane = fresh_lane(), tid = wid * 64 + lane;
    volatile LAS int* tk = (volatile LAS int*)(lds + TKT_OFF);
    for (;;) {
        if (tid == 0) tk[0] = (int)__hip_atomic_fetch_add(head, 1u, RLX_AGENT);
        WAITBAR();
        const int n = __builtin_amdgcn_readfirstlane(tk[0]);
        if (n >= NU) break;
        const int qb = 15 - n / (NB * NH), bh = n % (NB * NH);
        attn_unit<VAR>(C, bh / NH, bh % NH, qb, lds, tid, wid, lane);
    }
}
}

struct Args { const void* in[27]; float* out; unsigned char* ws; float inv_freq[32]; float lam_init[2]; };
static_assert(sizeof(Args) == 27 * 8 + 16 + 128 + 8, "Args has no padding");
typedef const unsigned char __attribute__((address_space(4)))* kaptr_t;
__device__ __forceinline__ kaptr_t ka_fresh() { kaptr_t p = (kaptr_t)__builtin_amdgcn_kernarg_segment_ptr(); asm volatile("" : "+s"(p)); return p; }
#define KIN(ka, i) (*(const void* const __attribute__((address_space(4)))*)((ka) + 8 * (i)))
#define KOUT(ka) ((float*)KIN(ka, 27))
#define KWS(ka) ((unsigned char*)KIN(ka, 28))
#define KINVF(ka, i) (*(const float __attribute__((address_space(4)))*)((ka) + 232 + 4 * (i)))
#define KLAMI(ka, l) (*(const float __attribute__((address_space(4)))*)((ka) + 360 + 4 * (l)))

namespace att {
template <int VAR> __device__ __forceinline__ void attn_phase(int l, int q, LAS unsigned char* lds, const int wid0) {
    const kaptr_t ka = ka_fresh(); unsigned char* ws = KWS(ka);
    const Ctx C{(const bf16*)(ws + WS_PROJ), (const bf16*)(ws + WS_QMLA), (const bf16*)(ws + WS_KVMLA), (const bf16*)(ws + WS_KPE), (bf16*)(ws + WS_MIX), (const bf16*)(ws + WS_QMEM),
                (const bf16*)(ws + WS_KVMEM) + (size_t)l * 512 * 1024, (bf16*)(ws + WS_OMEM), (const float*)(ws + WS_COS), (const float*)(ws + WS_SIN), (const float*)(ws + WS_LUT),
                (const int*)(ws + WS_TPMAX), (const int*)KIN(ka, 2), (const float*)(ws + WS_NEGC), (const float*)KIN(ka, 11) + l * 128, (const unsigned*)((gu32*)(ws + WS_CTL) + CW_KN + l * 64), ((const float*)(ws + WS_LAM))[l], 1.0f - KLAMI(ka, l)};
    attn_queue<VAR>(C, (gu32*)(ws + WS_CTL) + CW_TKT + (l * 16 + q) * 64, lds, wid0);
}
}

__global__ void __launch_bounds__(NWAVES * 64, 2) mk_fwd(Args args) {
    extern __shared__ __attribute__((aligned(16))) unsigned char lds_raw[];
    LAS unsigned char* lds = (LAS unsigned char*)lds_raw;
    const int G = gridDim.x, bx = blockIdx.x;
    const int vcu = (G % 8 == 0) ? (bx % 8) * (G / 8) + bx / 8 : bx;
    const int wid0 = __builtin_amdgcn_readfirstlane((int)threadIdx.x >> 6);
    const int gw = vcu * NWAVES + wid0, NGW = G * NWAVES;
    { const int tid = wid0 * 64 + fresh_lane();
      for (int u = tid; u < (LDS_BYTES - LDSCTL_OFF) / 4; u += NWAVES * 64) ((LAS unsigned*)(lds + LDSCTL_OFF))[u] = 0u; }
    __syncthreads();
    volatile LAS unsigned* MISC = (volatile LAS unsigned*)(lds + MISC_OFF);
    XcdBarrier bar = xcd_barrier_post((unsigned*)(args.ws + WS_CTL) + CW_BAR, MISC + 8, wid0);

    {
        const kaptr_t ka = ka_fresh(); unsigned char* ws = KWS(ka);
        const int lane = fresh_lane(), wid = wid0, tid = wid * 64 + lane;
        LAS float* scr = (LAS float*)(lds + RING_OFF + wid * 16640);
        for (int l = 0; l < NL; ++l) {
            unsigned char* wl = ws + WS_W + (size_t)l * W_LAYER;
#define TR_MAT(idx_, K_, N_, NP_, dst_, roff_, gain_) do { const float* s_ = (const float*)KIN(ka, idx_) + (size_t)l * (K_) * (N_); const int nblk_ = (NP_) / 64, nit_ = ((K_) / 64) * nblk_; \
            const float* gk_ = (gain_) >= 0 ? (const float*)KIN(ka, (gain_) >= 0 ? (gain_) : 0) + (size_t)l * (K_) : nullptr; \
            for (int it = gw; it < nit_; it += NGW) tr_item(s_, (K_), (N_), nblk_, (bf16*)(dst_), (roff_), scr, it, lane, gk_); } while (0)
            TR_MAT(4, DM, INC, INP, wl + W_IN, 0, 3);
            TR_MAT(5, DM, DM, DM, wl + W_OUT, 0, -1);
            TR_MAT(14, QRANK, 1536, 1536, wl + W_UQ, 0, -1);
            TR_MAT(15, KVRANK, 2048, 2048, wl + W_UKV, 0, -1);
            TR_MAT(19, DM, 512, 512, wl + W_MQ, 0, 17);
            TR_MAT(20, DM, 512, 512, wl + W_MKV, 0, -1);
            TR_MAT(21, DM, 512, 512, wl + W_MKV, 512, -1);
            TR_MAT(22, 512, DM, DM, wl + W_MO, 0, -1);
            if (l == NL - 1 && G == 256) {
                const float* s_ = (const float*)KIN(ka, 24) + (size_t)l * DM * DFF; const float* gk_ = (const float*)KIN(ka, 23) + (size_t)l * DM;
                for (int it = 2 * UPDEF + 2 * P4DEF + gw; it < (DM / 64) * (DFF / 64); it += NGW) tr_item(s_, DM, DFF, DFF / 64, (bf16*)(wl + W_UP), 0, scr, it, lane, gk_);
            } else TR_MAT(24, DM, DFF, DFF, wl + W_UP, 0, 23);
            if (l == 0 || G <= 64) TR_MAT(25, DFF, DM, DM, wl + W_DN, 0, -1);
#undef TR_MAT
        }
        { const float* x0 = (const float*)KIN(ka, 0); bf16* H = (bf16*)(ws + WS_H); float* SS = (float*)((gu32*)(ws + WS_CTL) + CW_SS);
          for (int m = gw; m < M; m += NGW) cast_row(x0 + (size_t)m * DM, H + (size_t)m * DM, (bf16*)(ws + WS_XL) + (size_t)m * DM, SS + m, lane); }
        { const float* mem = (const float*)KIN(ka, 1); bf16* MEMN = (bf16*)(ws + WS_MEMN);
          for (int r = gw; r < NL * NB * MEMT; r += NGW) { const int l = r / (NB * MEMT), mr = r - l * (NB * MEMT);
            rms_row<true>(mem + (size_t)mr * DM, (const float*)KIN(ka, 18) + (size_t)l * DM, MEMN + (size_t)r * DM, lane); } }
        const int* pos = (const int*)KIN(ka, 2);
        float* COS = (float*)(ws + WS_COS); float* SIN = (float*)(ws + WS_SIN); float* LUT = (float*)(ws + WS_LUT); int* TPMAX = (int*)(ws + WS_TPMAX); float* LAM = (float*)(ws + WS_LAM);
        const int gt = vcu * (NWAVES * 64) + tid, NGT = G * NWAVES * 64;
        for (int i = gt; i < M * 32; i += NGT) { const int row = i >> 5, f = i & 31; const float ang = (float)pos[row] * KINVF(ka, f);
            double rv = (double)ang * 0.15915494309189535; rv -= floor(rv); const float fr = (float)rv;
            COS[i] = __builtin_amdgcn_cosf(fr); SIN[i] = __builtin_amdgcn_sinf(fr); }
        for (int i = gt; i < 8 * 132; i += NGT) { const int h = i / 132, dd0 = i - h * 132; const int dd = dd0 > 128 ? 128 : dd0; int bk;
            if (dd < 16) bk = dd; else { bk = 16 + (int)(logf((float)dd / 16.0f) / 2.0794415416798357f * 16.0f); bk = bk > 31 ? 31 : bk; }
            LUT[i] = 8.0f * ((const float*)KIN(ka, 6))[bk * 8 + h]; }
        for (int i = gt; i < NB * 64; i += NGT) { int mx = pos[i * 64];
            for (int k = 1; k < 64; ++k) mx = max(mx, pos[i * 64 + k]);
            TPMAX[i] = mx; }
        if (gt < NL) { const int l = gt; float s1 = 0.f, s2 = 0.f;
            for (int k = 0; k < 64; ++k) { s1 += ((const float*)KIN(ka, 7))[l * 64 + k] * ((const float*)KIN(ka, 8))[l * 64 + k]; s2 += ((const float*)KIN(ka, 9))[l * 64 + k] * ((const float*)KIN(ka, 10))[l * 64 + k]; }
            LAM[l] = expf(s1) - expf(s2) + KLAMI(ka, l); }
    }
    xcd_barrier(bar, wid0);

    for (int l = 0; l < NL; ++l) {
        { const kaptr_t ka = ka_fresh(); unsigned char* ws = KWS(ka); unsigned char* wl = ws + WS_W + (size_t)l * W_LAYER;
          { pg8::Gemm g{(const bf16*)(ws + WS_H), (const bf16*)(wl + W_IN), M, INP, DM}; pg8::StaticOrder S; S.init(M, INP, G, bx);
            pg8::EpiBf16<0, true> E{(bf16*)(ws + WS_PROJ), INP, (const float*)((gu32*)(ws + WS_CTL) + CW_SS) + (size_t)(3 * l) * M};
            pg8::gemm_phase<pg8::EpiBf16<0, true>, pg8::StaticOrder, true, true>(lds + RING_OFF, g, S, E, wid0); }
          { pg8::Gemm g{(const bf16*)(ws + WS_MEMN) + (size_t)l * 512 * DM, (const bf16*)(wl + W_MKV), 512, 1024, DM}; pg8::StaticOrder S; S.init(512, 1024, G, G - 1 - bx);
            pg8::EpiBf16<0, false> E{(bf16*)(ws + WS_KVMEM) + (size_t)l * 512 * 1024, 1024, nullptr};
            pg8::gemm_phase<pg8::EpiBf16<0, false>, pg8::StaticOrder, true, true>(lds + RING_OFF, g, S, E, wid0); }
          if (G == 256 && bx >= 160 && bx < 248) {
              const int lane = fresh_lane(); LAS float* scr = (LAS float*)(lds + RING_OFF + wid0 * 16640);
              const float* s_ = (const float*)KIN(ka, 24) + (size_t)(NL - 1) * DM * DFF; const float* gk_ = (const float*)KIN(ka, 23) + (size_t)(NL - 1) * DM;
              bf16* dst = (bf16*)(ws + WS_W + (size_t)(NL - 1) * W_LAYER + W_UP);
              for (int it = l * UPDEF + (bx - 160) * NWAVES + wid0; it < (l + 1) * UPDEF; it += 88 * NWAVES) tr_item(s_, DM, DFF, DFF / 64, dst, 0, scr, it, lane, gk_); } }
        xcd_barrier(bar, wid0);
        { const kaptr_t ka = ka_fresh(); unsigned char* ws = KWS(ka); FRESH_LANE(ln);
          for (int m = gw; m < M; m += NGW)
            prep_row((const bf16*)(ws + WS_PROJ), m, (const float*)KIN(ka, 12) + (size_t)l * QRANK, (const float*)KIN(ka, 13) + (size_t)l * KVRANK, (const float*)KIN(ka, 16) + l * 8,
                     (const float*)(ws + WS_COS), (const float*)(ws + WS_SIN), (bf16*)(ws + WS_CQN), (bf16*)(ws + WS_CKVN), (bf16*)(ws + WS_KPE), (float*)(ws + WS_LOGF), (unsigned*)((gu32*)(ws + WS_CTL) + CW_KN + l * 64), ln); }
        xcd_barrier(bar, wid0);
        { const kaptr_t ka = ka_fresh(); unsigned char* ws = KWS(ka); unsigned char* wl = ws + WS_W + (size_t)l * W_LAYER;
          if (gw < 16) { FRESH_LANE(ln); fox_scan((const float*)(ws + WS_LOGF) + (size_t)gw * SEQ, (float*)(ws + WS_NEGC) + (size_t)gw * SEQ, ln); }
          { pg8::Gemm g{(const bf16*)(ws + WS_CQN), (const bf16*)(wl + W_UQ), M, 1536, QRANK}; pg8::StaticOrder S; S.init(M, 1536, G, bx);
            pg8::EpiBf16<0, false> E{(bf16*)(ws + WS_QMLA), 1536, nullptr};
            pg8::gemm_phase<pg8::EpiBf16<0, false>, pg8::StaticOrder, true, true>(lds + RING_OFF, g, S, E, wid0); }
          { pg8::Gemm g{(const bf16*)(ws + WS_CKVN), (const bf16*)(wl + W_UKV), M, 2048, KVRANK}; pg8::StaticOrder S; S.init(M, 2048, G, G - 1 - bx);
            pg8::EpiBf16<0, false> E{(bf16*)(ws + WS_KVMLA), 2048, nullptr};
            pg8::gemm_phase<pg8::EpiBf16<0, false>, pg8::StaticOrder, true, true>(lds + RING_OFF, g, S, E, wid0); }
          if (G == 256 && bx >= 192) {
              const int lane = fresh_lane(); LAS float* scr = (LAS float*)(lds + RING_OFF + wid0 * 16640);
              const float* s_ = (const float*)KIN(ka, 24) + (size_t)(NL - 1) * DM * DFF; const float* gk_ = (const float*)KIN(ka, 23) + (size_t)(NL - 1) * DM;
              bf16* dst = (bf16*)(ws + WS_W + (size_t)(NL - 1) * W_LAYER + W_UP);
              for (int it = 2 * UPDEF + l * P4DEF + (bx - 192) * NWAVES + wid0; it < 2 * UPDEF + (l + 1) * P4DEF; it += 64 * NWAVES) tr_item(s_, DM, DFF, DFF / 64, dst, 0, scr, it, lane, gk_); } }
        xcd_barrier(bar, wid0);
        att::attn_phase<att::VA>(l, 0, lds, wid0);
        att::attn_phase<att::VB>(l, 1, lds, wid0);
        att::attn_phase<att::VD>(l, 2, lds, wid0);
        att::attn_phase<att::VC>(l, 3, lds, wid0);
        xcd_barrier(bar, wid0);
        { const kaptr_t ka = ka_fresh(); unsigned char* ws = KWS(ka); unsigned char* wl = ws + WS_W + (size_t)l * W_LAYER;
          pg8::Gemm g{(const bf16*)(ws + WS_MIX), (const bf16*)(wl + W_OUT), M, DM, DM}; pg8::StaticOrder S; S.init(M, DM, G, bx);
          pg8::EpiRes E{(bf16*)(ws + WS_H), (bf16*)(ws + WS_XL), DM, (float*)((gu32*)(ws + WS_CTL) + CW_SS) + (size_t)(3 * l + 1) * M};
          pg8::gemm_phase<pg8::EpiRes, pg8::StaticOrder, true, true>(lds + RING_OFF, g, S, E, wid0); }
        xcd_barrier(bar, wid0);
        { const kaptr_t ka = ka_fresh(); unsigned char* ws = KWS(ka); unsigned char* wl = ws + WS_W + (size_t)l * W_LAYER;
          pg8::Gemm g{(const bf16*)(ws + WS_H), (const bf16*)(wl + W_MQ), M, 512, DM}; pg8::StaticOrder S; S.init(M, 512, G, bx);
          pg8::EpiBf16<0, true> E{(bf16*)(ws + WS_QMEM), 512, (const float*)((gu32*)(ws + WS_CTL) + CW_SS) + (size_t)(3 * l + 1) * M};
          pg8::gemm_phase<pg8::EpiBf16<0, true>, pg8::StaticOrder, true, true>(lds + RING_OFF, g, S, E, wid0);
          if (G > 64 && bx >= 64) {
              const int lane = fresh_lane(); LAS float* scr = (LAS float*)(lds + RING_OFF + wid0 * 16640);
              const float* s_ = (const float*)KIN(ka, 25) + (size_t)(NL - 1) * DFF * DM; bf16* dst = (bf16*)(ws + WS_W + (size_t)(NL - 1) * W_LAYER + W_DN);
              constexpr int nblk = DM / 64, nit = (DFF / 64) * nblk, per = nit / NL;
              for (int it = l * per + (bx - 64) * NWAVES + wid0; it < (l + 1) * per; it += (G - 64) * NWAVES) tr_item(s_, DFF, DM, nblk, dst, 0, scr, it, lane, nullptr); } }
        xcd_barrier(bar, wid0);
        att::attn_phase<att::VE>(l, 4, lds, wid0);
        xcd_barrier(bar, wid0);
        { const kaptr_t ka = ka_fresh(); unsigned char* ws = KWS(ka); unsigned char* wl = ws + WS_W + (size_t)l * W_LAYER;
          pg8::Gemm g{(const bf16*)(ws + WS_OMEM), (const bf16*)(wl + W_MO), M, DM, 512}; pg8::StaticOrder S; S.init(M, DM, G, bx);
          pg8::EpiRes E{(bf16*)(ws + WS_H), (bf16*)(ws + WS_XL), DM, (float*)((gu32*)(ws + WS_CTL) + CW_SS) + (size_t)(3 * l + 2) * M};
          pg8::gemm_phase<pg8::EpiRes, pg8::StaticOrder, true, true>(lds + RING_OFF, g, S, E, wid0); }
        xcd_barrier(bar, wid0);
        { const kaptr_t ka = ka_fresh(); unsigned char* ws = KWS(ka); unsigned char* wl = ws + WS_W + (size_t)l * W_LAYER;
          pg8::Gemm g{(const bf16*)(ws + WS_H), (const bf16*)(wl + W_UP), M, DFF, DM}; pg8::StaticOrder S; S.init(M, DFF, G, bx);
          pg8::EpiBf16<1, true> E{(bf16*)(ws + WS_U), DFF, (const float*)((gu32*)(ws + WS_CTL) + CW_SS) + (size_t)(3 * l + 2) * M};
          pg8::gemm_phase<pg8::EpiBf16<1, true>, pg8::StaticOrder, true, true>(lds + RING_OFF, g, S, E, wid0); }
        xcd_barrier(bar, wid0);
        { const kaptr_t ka = ka_fresh(); unsigned char* ws = KWS(ka); unsigned char* wl = ws + WS_W + (size_t)l * W_LAYER;
          pg8::Gemm g{(const bf16*)(ws + WS_U), (const bf16*)(wl + W_DN), M, DM, DFF}; pg8::StaticOrder S; S.init(M, DM, G, bx);
          pg8::EpiRes E{(bf16*)(ws + WS_H), (bf16*)(ws + WS_XL), DM, (float*)((gu32*)(ws + WS_CTL) + CW_SS) + (size_t)(3 * l + 3) * M};
          pg8::gemm_phase<pg8::EpiRes, pg8::StaticOrder, true, true>(lds + RING_OFF, g, S, E, wid0); }
        xcd_barrier(bar, wid0);
    }
    { const kaptr_t ka = ka_fresh(); unsigned char* ws = KWS(ka); FRESH_LANE(ln); float* O = KOUT(ka);
      for (int m = gw; m < M; m += NGW) final_row((const bf16*)(ws + WS_H) + (size_t)m * DM, (const bf16*)(ws + WS_XL) + (size_t)m * DM, (const float*)KIN(ka, 26), O + (size_t)m * DM, ln); }
}

extern "C" void kernel_launch(void* const* d_in, const int* in_sizes, int n_in, void* d_out, int out_size, void* d_ws, size_t ws_size, hipStream_t stream) {
    static int grid = 0;
    if (grid == 0) {
        if (n_in != 27 || in_sizes[0] != M * DM || out_size != M * DM || ws_size < WS_END) {
            fprintf(stderr, "kernel_launch: built for 27 inputs, x/out of %d floats, >= %zu bytes of workspace; got n_in %d, in0 %d, out %d, ws %zu; nothing launched\n", M * DM, (size_t)WS_END, n_in, n_in > 0 ? in_sizes[0] : -1, out_size, ws_size);
            grid = -1; return; }
        int dev = 0, cus = 0, per_cu = 0;
        if (hipGetDevice(&dev) != hipSuccess || hipDeviceGetAttribute(&cus, hipDeviceAttributeMultiprocessorCount, dev) != hipSuccess) { fprintf(stderr, "kernel_launch: device query failed\n"); grid = -1; return; }
        if (hipFuncSetAttribute((const void*)mk_fwd, hipFuncAttributeMaxDynamicSharedMemorySize, LDS_BYTES) != hipSuccess) { fprintf(stderr, "kernel_launch: hipFuncSetAttribute failed\n"); grid = -1; return; }
        if (hipOccupancyMaxActiveBlocksPerMultiprocessor(&per_cu, (const void*)mk_fwd, NWAVES * 64, LDS_BYTES) != hipSuccess || per_cu < 1)
            fprintf(stderr, "kernel_launch: note: occupancy query reports %d workgroups per CU\n", per_cu);
        (void)hipGetLastError();
        grid = cus;
    }
    if (grid < 0) return;
    if (hipMemsetAsync((char*)d_ws + WS_CTL, 0, CTL_ZERO_BYTES, stream) != hipSuccess) { fprintf(stderr, "kernel_launch: memset failed\n"); return; }
    Args a; memset(&a, 0, sizeof(a));
    for (int i = 0; i < 27; ++i) a.in[i] = d_in[i];
    a.out = (float*)d_out; a.ws = (unsigned char*)d_ws;
    for (int i = 0; i < 32; ++i) a.inv_freq[i] = (float)pow(10000.0, -(double)i / 32.0);
    for (int l = 0; l < NL; ++l) a.lam_init[l] = (float)(0.8 - 0.6 * exp(-0.3 * (double)l));
    hipLaunchKernelGGL(mk_fwd, dim3(grid), dim3(NWAVES * 64), LDS_BYTES, stream, a);
    const hipError_t le = hipPeekAtLastError();
    if (le != hipSuccess) fprintf(stderr, "kernel_launch: launch failed: %s\n", hipGetErrorName(le));
}
```

```cpp
#include <hip/hip_runtime.h>
#include <cstdio>
#include <cstdint>
#include <cstring>
#include <cmath>
__device__ __forceinline__ int fresh_lane() { unsigned z = 0u; asm volatile("" : "+v"(z)); return (int)__builtin_amdgcn_mbcnt_hi(~0u, __builtin_amdgcn_mbcnt_lo(~0u, z)); }
namespace pg8 {
#define PG8_LAS __attribute__((address_space(3)))
typedef unsigned short bf16_t;
typedef short bf16x8 __attribute__((ext_vector_type(8)));
typedef float f32x4 __attribute__((ext_vector_type(4)));
typedef unsigned u32x4 __attribute__((ext_vector_type(4)));
constexpr int BM = 256, BK = 64, HALF = 128, HTB = HALF * BK * 2  , STAGE_BYTES = 8 * HTB, NXCD = 8, WGM = 8;

__host__ __device__ __forceinline__ int lds_byte(int r, int c) { const int st = (r >> 4) * 2 + (c >> 5), rr = r & 15, cc = c & 31, ob = rr * 64 + cc * 2; return st * 1024 + (ob ^ (((ob >> 9) & 1) << 5)); }
__host__ __device__ __forceinline__ void stage_rc(int b, int& R, int& C) { const int st = b / 1024, sb = b % 1024, swz = sb ^ (((sb >> 9) & 1) << 5); R = (st >> 1) * 16 + swz / 64; C = (st & 1) * 32 + (swz % 64) / 2; }
__host__ __device__ __forceinline__ int perm32(int rho) { const int n = rho >> 4, i = rho & 15; return 8 * (i >> 2) + 4 * n + (i & 3); }

struct Unit { int pm, pn; };
struct Gemm { const bf16_t* A; const bf16_t* Bt; int M, N, K; };

struct StaticOrder {
    int nM, nN, nwg, G, c;
    __host__ __device__ void init(int M, int N, int G_, int c_) { nM = M / BM; nN = N / BM; nwg = nM * nN; G = G_; c = c_; }
    __host__ __device__ bool next(int i, Unit& u) const {
        const long L = (long)i * G + c; if (L >= nwg) return false;
        int wgid = (int)L; { const int q = nwg / NXCD, r = nwg % NXCD, xcd = wgid % NXCD, off = wgid / NXCD; wgid = (xcd < r ? xcd * (q + 1) : r * (q + 1) + (xcd - r) * q) + off; }
        const int nig = WGM * nN, gid = wgid / nig, fm = gid * WGM, gsz = (nM - fm) < WGM ? (nM - fm) : WGM;
        u.pm = fm + ((wgid % nig) % gsz); u.pn = (wgid % nig) / gsz; return true;
    }
    __device__ __forceinline__ void a_ready(const Unit&) const {}
    __device__ __forceinline__ void done(const Unit&) const {}
};

__device__ __forceinline__ unsigned cvt_pk_bf16(float lo, float hi) { unsigned r; asm volatile("v_cvt_pk_bf16_f32 %0, %1, %2" : "=v"(r) : "v"(lo), "v"(hi)); return r; }
typedef float f32x2 __attribute__((ext_vector_type(2)));
template <int ACT, bool RS> struct EpiBf16 {
    static constexpr bool PERM = true, AFTER_DRAIN = false;
    bf16_t* O; int ldc; const float* ss;
    __device__ __forceinline__ void operator()(const f32x4 (&acc)[2][2][4][2], const Unit& u, int wr, int wc, int fr, int fq) const {
        const int row0 = u.pm * BM + wr * 64 + fr, col0 = u.pn * BM + wc * 32 + 8 * fq;
#pragma unroll
        for (int ai = 0; ai < 2; ++ai)
#pragma unroll
            for (int m = 0; m < 4; ++m) { const int row = row0 + ai * HALF + m * 16; bf16_t* rowp = O + (size_t)row * ldc + col0;
                float rs = 1.f; if (RS) rs = 1.0f / sqrtf(ss[row] * (1.f / 4096.f) + 1e-6f);
#pragma unroll
                for (int bj = 0; bj < 2; ++bj) { f32x4 v0 = acc[ai][bj][m][0], v1 = acc[ai][bj][m][1];
                    if (RS) { v0 = v0 * rs; v1 = v1 * rs; }
                    if (ACT == 1) {
#pragma unroll
                        for (int e = 0; e < 4; ++e) { const float a = fmaxf(v0[e], 0.f), b = fmaxf(v1[e], 0.f); v0[e] = a * a; v1[e] = b * b; } }
                    u32x4 w; w.x = cvt_pk_bf16(v0[0], v0[1]); w.y = cvt_pk_bf16(v0[2], v0[3]); w.z = cvt_pk_bf16(v1[0], v1[1]); w.w = cvt_pk_bf16(v1[2], v1[3]);
                    *(u32x4*)(rowp + bj * HALF) = w; } }
    }
};
struct EpiRes {
    static constexpr bool PERM = true, AFTER_DRAIN = false;
    bf16_t* xh; bf16_t* xl; int ldc; float* ss;
    __device__ __forceinline__ void operator()(const f32x4 (&acc)[2][2][4][2], const Unit& u, int wr, int wc, int fr, int fq) const {
        const int row0 = u.pm * BM + wr * 64 + fr, col0 = u.pn * BM + wc * 32 + 8 * fq;
#pragma unroll
        for (int ai = 0; ai < 2; ++ai)
#pragma unroll
            for (int m = 0; m < 4; ++m) { const int row = row0 + ai * HALF + m * 16; const size_t off = (size_t)row * ldc + col0; float sq = 0.f;
#pragma unroll
                for (int bj = 0; bj < 2; ++bj) { const u32x4 hv = *(const u32x4*)(xh + off + bj * HALF), lv = *(const u32x4*)(xl + off + bj * HALF); u32x4 ho, lo;
#pragma unroll
                    for (int e = 0; e < 4; ++e) { const f32x4& a = acc[ai][bj][m][e >> 1]; const int j = (e & 1) * 2;
                        const float v0 = (__uint_as_float(hv[e] << 16) + __uint_as_float(lv[e] << 16)) + a[j], v1 = (__uint_as_float(hv[e] & 0xffff0000u) + __uint_as_float(lv[e] & 0xffff0000u)) + a[j + 1];
                        const unsigned h = cvt_pk_bf16(v0, v1); ho[e] = h;
                        lo[e] = cvt_pk_bf16(v0 - __uint_as_float(h << 16), v1 - __uint_as_float(h & 0xffff0000u)); sq += v0 * v0 + v1 * v1; }
                    *(u32x4*)(xh + off + bj * HALF) = ho; *(u32x4*)(xl + off + bj * HALF) = lo; }
                sq += __int_as_float(__builtin_amdgcn_ds_swizzle(__float_as_int(sq), 0x1f | (16 << 10)));
                { auto rr = __builtin_amdgcn_permlane32_swap(__float_as_uint(sq), __float_as_uint(sq), false, false); sq = __uint_as_float(rr[0]) + __uint_as_float(rr[1]); }
                if (fq == 0) __hip_atomic_fetch_add(ss + row, sq, __ATOMIC_RELAXED, __HIP_MEMORY_SCOPE_AGENT); }
    }
};
template <class Epi, class Sched, bool ALIGN_EPI = false, bool SP2 = false>
__device__ __forceinline__ void gemm_phase(PG8_LAS unsigned char* lds, const Gemm g, const Sched& S, const Epi& E, const int wid0) {
    const int wid = wid0, lane = fresh_lane(), tid = wid * 64 + lane, wr = wid >> 2, wc = wid & 3, fr = lane & 15, fq = lane >> 4;
    const int K = g.K, nt = K / BK;
    unsigned voffA[2], voffB[2];
#pragma unroll
    for (int i = 0; i < 2; ++i) { int R, C; stage_rc(tid * 16 + i * 8192, R, C); const int Rb = Epi::PERM ? ((R & ~31) + perm32(R & 31)) : R;
        voffA[i] = (unsigned)(R * K + C) * 2u; voffB[i] = (unsigned)(Rb * K + C) * 2u; }
    const size_t kstep = (size_t)(BK * 2);
    const size_t hstep = (size_t)HALF * K * 2;
    const size_t tstep = 2 * hstep;
    const unsigned ldsw = (unsigned)wid * 1024u;
    const int aoff = lds_byte(wr * 64 + fr, fq * 8), boff = lds_byte(wc * 32 + fr, fq * 8);
#define PG8_SA(b, h) (((b) * 2 + (h)) * HTB)
#define PG8_SB(b, h) ((4 + (b) * 2 + (h)) * HTB)
#define PG8_STAGE(bufoff, gbase, voff) do { _Pragma("unroll") for (int _i = 0; _i < 2; ++_i) \
        __builtin_amdgcn_global_load_lds((const unsigned*)((const char*)(gbase) + (voff)[_i]), (PG8_LAS unsigned*)(lds + (bufoff) + ldsw + _i * 8192), 16, 0, 0); } while (0)
#define PG8_LDA(dst, b, h) do { _Pragma("unroll") for (int m = 0; m < 4; ++m) _Pragma("unroll") for (int k = 0; k < 2; ++k) dst[m][k] = *(const PG8_LAS bf16x8*)(lds + PG8_SA(b, h) + aoff + m * 2048 + k * 1024); } while (0)
#define PG8_LDB(dst, b, h) do { _Pragma("unroll") for (int n = 0; n < 2; ++n) _Pragma("unroll") for (int k = 0; k < 2; ++k) dst[n][k] = *(const PG8_LAS bf16x8*)(lds + PG8_SB(b, h) + boff + n * 2048 + k * 1024); } while (0)
#define PG8_MMA(ai, bj, At, Bt) do { __builtin_amdgcn_s_setprio(1); _Pragma("unroll") for (int m = 0; m < 4; ++m) _Pragma("unroll") for (int n = 0; n < 2; ++n) _Pragma("unroll") for (int k = 0; k < 2; ++k) \
        acc[ai][bj][m][n] = __builtin_amdgcn_mfma_f32_16x16x32_bf16(Bt[n][k], At[m][k], acc[ai][bj][m][n], 0, 0, 0); __builtin_amdgcn_s_setprio(0); } while (0)
#define PG8_WAIT_V(n) asm volatile("s_waitcnt vmcnt(" #n ")" ::: "memory")
#define PG8_WAIT_L(n) asm volatile("s_waitcnt lgkmcnt(" #n ")" ::: "memory")
#define PG8_BAR __builtin_amdgcn_s_barrier()
#define PG8_SCHED __builtin_amdgcn_sched_barrier(0)
    Unit cur, nxt; int ui = 0;
    if (!S.next(0, cur)) return;
    f32x4 acc[2][2][4][2];
#pragma unroll
    for (int a = 0; a < 2; ++a)
#pragma unroll
        for (int b = 0; b < 2; ++b)
#pragma unroll
            for (int m = 0; m < 4; ++m)
#pragma unroll
                for (int n = 0; n < 2; ++n) acc[a][b][m][n] = (f32x4){0.f, 0.f, 0.f, 0.f};
    bf16x8 At[4][2], B0[2][2], B1[2][2];
    const char* cA = (const char*)g.A + (size_t)cur.pm * tstep; const char* cB = (const char*)g.Bt + (size_t)cur.pn * tstep;
    S.a_ready(cur);
    if constexpr (SP2) {
        PG8_STAGE(PG8_SB(0, 0), cB, voffB); PG8_STAGE(PG8_SB(0, 1), cB + hstep, voffB); PG8_STAGE(PG8_SA(0, 0), cA, voffA); PG8_STAGE(PG8_SA(0, 1), cA + hstep, voffA);
        if (wr == 1) PG8_BAR;
        PG8_WAIT_V(2); PG8_BAR;
        PG8_STAGE(PG8_SB(1, 0), cB + kstep, voffB); PG8_STAGE(PG8_SA(1, 0), cA + kstep, voffA); PG8_STAGE(PG8_SB(1, 1), cB + hstep + kstep, voffB);
        PG8_WAIT_V(6); PG8_BAR;
    } else {
        PG8_STAGE(PG8_SB(0, 0), cB, voffB); PG8_STAGE(PG8_SA(0, 0), cA, voffA); PG8_STAGE(PG8_SB(0, 1), cB + hstep, voffB); PG8_STAGE(PG8_SA(0, 1), cA + hstep, voffA);
        if (wr == 1) PG8_BAR;
        PG8_WAIT_V(4); PG8_BAR;
        PG8_STAGE(PG8_SB(1, 0), cB + kstep, voffB); PG8_STAGE(PG8_SA(1, 0), cA + kstep, voffA); PG8_STAGE(PG8_SB(1, 1), cB + hstep + kstep, voffB);
        PG8_WAIT_V(6); PG8_BAR;
    }
    for (;;) {
        const bool has_next = S.next(ui + 1, nxt);
        const char* nA = has_next ? (const char*)g.A + (size_t)nxt.pm * tstep : cA; const char* nB = has_next ? (const char*)g.Bt + (size_t)nxt.pn * tstep : cB;
        for (int t = 0; t < nt; t += 2) {
            const bool last = (t == nt - 2);
            const char* a1 = cA + (size_t)(t + 1) * kstep;
            const char* a2 = last ? nA : cA + (size_t)(t + 2) * kstep; const char* b2 = last ? nB : cB + (size_t)(t + 2) * kstep;
            const char* a3 = a2 + kstep; const char* b3 = b2 + kstep;
            if (last && has_next) S.a_ready(nxt);
            if constexpr (SP2) {
            PG8_LDB(B0, 0, 0); PG8_LDB(B1, 0, 1); PG8_SCHED; PG8_LDA(At, 0, 0); PG8_STAGE(PG8_SA(1, 1), a1 + hstep, voffA);
            PG8_WAIT_V(8); PG8_WAIT_L(0); PG8_BAR; PG8_MMA(0, 0, At, B0); PG8_MMA(0, 1, At, B1); PG8_BAR; PG8_SCHED;
            PG8_LDA(At, 0, 1); PG8_STAGE(PG8_SB(0, 0), b2, voffB); PG8_STAGE(PG8_SB(0, 1), b2 + hstep, voffB); PG8_STAGE(PG8_SA(0, 0), a2, voffA);
            PG8_WAIT_V(8); PG8_WAIT_L(0); PG8_BAR; PG8_MMA(1, 0, At, B0); PG8_MMA(1, 1, At, B1); PG8_BAR; PG8_SCHED;
            PG8_LDB(B0, 1, 0); PG8_LDB(B1, 1, 1); PG8_SCHED; PG8_LDA(At, 1, 0); PG8_STAGE(PG8_SA(0, 1), a2 + hstep, voffA);
            PG8_WAIT_V(8); PG8_WAIT_L(0); PG8_BAR; PG8_MMA(0, 0, At, B0); PG8_MMA(0, 1, At, B1); PG8_BAR; PG8_SCHED;
            PG8_LDA(At, 1, 1); PG8_STAGE(PG8_SB(1, 0), b3, voffB); PG8_STAGE(PG8_SB(1, 1), b3 + hstep, voffB); PG8_STAGE(PG8_SA(1, 0), a3, voffA);
            PG8_WAIT_V(8); PG8_WAIT_L(0); PG8_BAR; PG8_MMA(1, 0, At, B0); PG8_MMA(1, 1, At, B1); PG8_BAR; PG8_SCHED;
            } else {
            PG8_LDB(B0, 0, 0); PG8_SCHED; PG8_LDA(At, 0, 0); PG8_STAGE(PG8_SA(1, 1), a1 + hstep, voffA);
            PG8_WAIT_L(8); PG8_BAR; PG8_WAIT_L(0); PG8_MMA(0, 0, At, B0); PG8_BAR; PG8_SCHED;
            PG8_LDB(B1, 0, 1); PG8_STAGE(PG8_SB(0, 0), b2, voffB);
            PG8_BAR; PG8_WAIT_L(0); PG8_MMA(0, 1, At, B1); PG8_BAR;
            PG8_LDA(At, 0, 1); PG8_STAGE(PG8_SA(0, 0), a2, voffA);
            PG8_BAR; PG8_WAIT_L(0); PG8_MMA(1, 0, At, B0); PG8_BAR; PG8_SCHED;
            PG8_STAGE(PG8_SB(0, 1), b2 + hstep, voffB);
            PG8_WAIT_V(6); PG8_BAR; PG8_MMA(1, 1, At, B1); PG8_BAR;
            PG8_LDB(B0, 1, 0); PG8_SCHED; PG8_LDA(At, 1, 0); PG8_STAGE(PG8_SA(0, 1), a2 + hstep, voffA);
            PG8_WAIT_L(8); PG8_BAR; PG8_WAIT_L(0); PG8_MMA(0, 0, At, B0); PG8_BAR; PG8_SCHED;
            PG8_LDB(B1, 1, 1); PG8_STAGE(PG8_SB(1, 0), b3, voffB);
            PG8_BAR; PG8_WAIT_L(0); PG8_MMA(0, 1, At, B1); PG8_BAR;
            PG8_LDA(At, 1, 1); PG8_STAGE(PG8_SA(1, 0), a3, voffA);
            PG8_BAR; PG8_WAIT_L(0); PG8_MMA(1, 0, At, B0); PG8_BAR; PG8_SCHED;
            PG8_STAGE(PG8_SB(1, 1), b3 + hstep, voffB);
            PG8_WAIT_V(6); PG8_BAR; PG8_MMA(1, 1, At, B1); PG8_BAR;
            }
        }
        if constexpr (ALIGN_EPI) { if (wr == 0) PG8_BAR; }
        if constexpr (!Epi::AFTER_DRAIN) { E(acc, cur, wr, wc, fr, fq); S.done(cur); }
        if (!has_next) break;
#pragma unroll
        for (int a = 0; a < 2; ++a)
#pragma unroll
            for (int b = 0; b < 2; ++b)
#pragma unroll
                for (int m = 0; m < 4; ++m)
#pragma unroll
                    for (int n = 0; n < 2; ++n) acc[a][b][m][n] = (f32x4){0.f, 0.f, 0.f, 0.f};
        cur = nxt; cA = nA; cB = nB; ++ui;
        if constexpr (ALIGN_EPI) { if (wr == 1) PG8_BAR; }
    }
    PG8_WAIT_V(0);
    if constexpr (!ALIGN_EPI) { if (wr == 0) PG8_BAR; }
    PG8_BAR;
    if constexpr (Epi::AFTER_DRAIN) { E.fused(acc, cur, wr, wc, fr, fq, lds, wid, lane); S.done(cur); }
#undef PG8_SA
#undef PG8_SB
#undef PG8_STAGE
#undef PG8_LDA
#undef PG8_LDB
#undef PG8_MMA
#undef PG8_WAIT_V
#undef PG8_WAIT_L
#undef PG8_BAR
#undef PG8_SCHED
}
}
#define GAS __attribute__((address_space(1)))
#define LAS __attribute__((address_space(3)))
typedef unsigned short bf16;
typedef unsigned v4u __attribute__((ext_vector_type(4)));
typedef float f32x4 __attribute__((ext_vector_type(4)));
typedef short bf16x8 __attribute__((ext_vector_type(8)));
typedef GAS unsigned gu32;
typedef GAS unsigned long long gu64;
#define RLX_AGENT __ATOMIC_RELAXED, __HIP_MEMORY_SCOPE_AGENT
#define LDS_WAIT() asm volatile("s_waitcnt lgkmcnt(0)" ::: "memory")
#define VM_WAIT() asm volatile("s_waitcnt vmcnt(0)" ::: "memory")
__device__ __forceinline__ unsigned long long rt() { return __builtin_amdgcn_s_memrealtime(); }
__device__ __forceinline__ unsigned f2bf(float f) { unsigned u = __builtin_bit_cast(unsigned, f); return (u + 0x7fffu + ((u >> 16) & 1u)) >> 16; }
__device__ __forceinline__ unsigned pk2(float lo, float hi) { return f2bf(lo) | (f2bf(hi) << 16); }

#define XB_TMO      128
#define XB_XCNT(j)  (256  + 64 * (j))
#define XB_XSUB(j)  (1280 + 64 * (j))
#define XB_XGEN(j)  (2304 + 64 * (j))
#define XB_TOP      3328
#define XB_TOPGEN   3392
#define XCD_BAR_WORDS 3456
#define XB_SPIN_CAP (1u << 18)

__device__ __forceinline__ unsigned xb_ld(unsigned* p)              { return __hip_atomic_load(p, __ATOMIC_RELAXED, __HIP_MEMORY_SCOPE_AGENT); }
__device__ __forceinline__ unsigned xb_add(unsigned* p, unsigned v) { return __hip_atomic_fetch_add(p, v, __ATOMIC_RELAXED, __HIP_MEMORY_SCOPE_AGENT); }
__device__ __forceinline__ unsigned xb_xcc_id() { return (unsigned)__builtin_amdgcn_s_getreg((3 << 11) | 20) & 0xFu; }
#define XB_SPIN(cond, bar) do { unsigned _sp = 0; while (cond) { __builtin_amdgcn_s_sleep(1); \
    if ((++_sp & 255u) == 0u) { if (xb_ld(&(bar)[XB_TMO])) break; if (_sp > XB_SPIN_CAP) { atomicAdd(&(bar)[XB_TMO], 1u); break; } } } } while (0)

struct XcdBarrier {
    unsigned* bar; unsigned x;
    volatile LAS unsigned* st;
};

__device__ __forceinline__ XcdBarrier xcd_barrier_post(unsigned* bar, volatile LAS unsigned* st, const int wid0) {
    XcdBarrier b; b.bar = bar; b.x = xb_xcc_id(); b.st = st;
    if (wid0 == 0 && fresh_lane() == 0) (void)xb_add(&bar[XB_XCNT(b.x)], 1u);
    return b;
}
__device__ __forceinline__ void xcd_barrier_complete(unsigned* bar, unsigned x, unsigned& nloc, unsigned& nx) {
    const unsigned G = gridDim.x * gridDim.y * gridDim.z;
    unsigned sum, cnt, mine, sp = 0u;
    for (;;) {
        sum = 0u; cnt = 0u; mine = 0u;
#pragma unroll 1
        for (unsigned j = 0; j < 16; ++j) { const unsigned c = xb_ld(&bar[XB_XCNT(j)]); sum += c; cnt += (c > 0u) ? 1u : 0u; mine = (j == x) ? c : mine; }
        if (sum == G) break;
        __builtin_amdgcn_s_sleep(1);
        if ((++sp & 255u) == 0u) { if (xb_ld(&bar[XB_TMO])) break; if (sp > XB_SPIN_CAP) { atomicAdd(&bar[XB_TMO], 1u); break; } }
    }
    nloc = mine > 0u ? mine : 1u; nx = cnt > 0u ? cnt : 1u;
}

__device__ __forceinline__ void xcd_barrier(const XcdBarrier& b, const int wid0) {
    asm volatile("s_waitcnt vmcnt(0)" ::: "memory");
    __syncthreads();
    if (wid0 == 0 && fresh_lane() == 0) {
        unsigned* bar = b.bar;
        __builtin_amdgcn_s_waitcnt(0);
        unsigned nloc = b.st[0], nx = b.st[1];
        const unsigned bx_ = xb_xcc_id();
        if (nloc == 0u) { xcd_barrier_complete(bar, bx_, nloc, nx); b.st[0] = nloc; b.st[1] = nx; }
        const unsigned old = xb_add(&bar[XB_XSUB(bx_)], 1u);
        const unsigned gen = old / nloc;
        if (old + 1u == (gen + 1u) * nloc) {
            __builtin_amdgcn_fence(__ATOMIC_RELEASE, "agent");
            asm volatile("s_waitcnt vmcnt(0)" ::: "memory");
            const unsigned og = xb_add(&bar[XB_TOP], 1u);
            const unsigned tg = og / nx;
            if (og + 1u == (tg + 1u) * nx) xb_add(&bar[XB_TOPGEN], 1u);
            else XB_SPIN(xb_ld(&bar[XB_TOPGEN]) == tg, bar);
            __builtin_amdgcn_fence(__ATOMIC_ACQUIRE, "agent");
            xb_add(&bar[XB_XGEN(bx_)], 1u);
            asm volatile("s_waitcnt vmcnt(0)" ::: "memory");
        } else {
            XB_SPIN(xb_ld(&bar[XB_XGEN(bx_)]) == gen, bar);
            __builtin_amdgcn_fence(__ATOMIC_ACQUIRE, "agent");
            asm volatile("s_waitcnt vmcnt(0)" ::: "memory");
        }
    }
    __syncthreads();
}
constexpr int NWAVES = 8;
constexpr int NB = 2, SEQ = 4096, DM = 4096, NL = 2, M = NB * SEQ;
constexpr int INC = 11336, INP = 11520;
constexpr int A_Q = 0, B_CQ = 3072, B_CKV = 4608, B_KR = 5120, C_Q = 5184, D_Q = 8256, D_F = 11328;
constexpr int QRANK = 1536, KVRANK = 512, DFF = 16384, MEMT = 256;
constexpr int P4DEF = 64 * 8 * 4;
constexpr int UPDEF = 88 * 8 * 8;
constexpr float EPS = 1e-6f;

constexpr size_t MiB = 1u << 20;
constexpr size_t WS_CTL = 0, CTL_ZERO_BYTES = 1 * MiB;
constexpr size_t WS_COS = 1 * MiB, WS_SIN = 2 * MiB;
constexpr size_t WS_LUT = 3 * MiB;
constexpr size_t WS_TPMAX = 3 * MiB + 8192;
constexpr size_t WS_LAM = 3 * MiB + 12288;
constexpr size_t WS_LOGF = 4 * MiB, WS_NEGC = 4 * MiB + 512 * 1024;
constexpr size_t WS_W = 8 * MiB;
constexpr size_t SZ_IN = (size_t)INP * DM * 2, SZ_OUT = (size_t)DM * DM * 2, SZ_UQ = (size_t)1536 * 1536 * 2, SZ_UKV = (size_t)2048 * 512 * 2,
                 SZ_MQ = (size_t)512 * DM * 2, SZ_MKV = (size_t)1024 * DM * 2, SZ_MO = (size_t)DM * 512 * 2, SZ_UP = (size_t)DFF * DM * 2, SZ_DN = SZ_UP;
constexpr size_t W_IN = 0, W_OUT = W_IN + SZ_IN, W_UQ = W_OUT + SZ_OUT, W_UKV = W_UQ + SZ_UQ, W_MQ = W_UKV + SZ_UKV, W_MKV = W_MQ + SZ_MQ, W_MO = W_MKV + SZ_MKV,
                 W_UP = W_MO + SZ_MO, W_DN = W_UP + SZ_UP, W_LAYER = W_DN + SZ_DN;
static_assert(W_LAYER % 256 == 0, "weight block alignment");
constexpr size_t WS_MEMN = WS_W + NL * W_LAYER;
constexpr size_t WS_KVMEM = WS_MEMN + (size_t)NL * 512 * DM * 2;
constexpr size_t WS_H = WS_KVMEM + (size_t)NL * 512 * 1024 * 2;
constexpr size_t WS_CQN = WS_H + (size_t)M * DM * 2;
constexpr size_t WS_CKVN = WS_CQN + (size_t)M * 1536 * 2;
constexpr size_t WS_KPE = WS_CKVN + (size_t)M * 512 * 2;
constexpr size_t WS_QMLA = WS_KPE + (size_t)M * 64 * 2;
constexpr size_t WS_KVMLA = WS_QMLA + (size_t)M * 1536 * 2;
constexpr size_t WS_QMEM = WS_KVMLA + (size_t)M * 2048 * 2;
constexpr size_t WS_OMEM = WS_QMEM + (size_t)M * 512 * 2;
constexpr size_t WS_XL = WS_OMEM + (size_t)M * 512 * 2;
constexpr size_t WS_U = WS_XL + (size_t)M * DM * 2;
constexpr size_t WS_PROJ = WS_U;
constexpr size_t WS_MIX = WS_PROJ + (size_t)M * INP * 2;
static_assert(WS_MIX + (size_t)M * DM * 2 <= WS_U + (size_t)M * DFF * 2, "PROJ + MIX fit inside U");
constexpr size_t WS_END = WS_U + (size_t)M * DFF * 2;
constexpr int CW_BAR = 4096;
constexpr int CW_SS = 32768;
constexpr int CW_KN = 24576;
constexpr int CW_TKT = 16384;

constexpr int RING_OFF = 0, RING_BYTES = 137216;
constexpr int LDSCTL_OFF = RING_BYTES, MISC_OFF = LDSCTL_OFF + 320;
constexpr int LDS_BYTES = 147456;

typedef unsigned short bf16;
typedef short bf16x8 __attribute__((ext_vector_type(8)));
typedef short s16x4 __attribute__((ext_vector_type(4)));
typedef float f32x4 __attribute__((ext_vector_type(4)));
typedef float f32x16 __attribute__((ext_vector_type(16)));
typedef unsigned v4u __attribute__((ext_vector_type(4)));
typedef unsigned v2u __attribute__((ext_vector_type(2)));
typedef int i32x4 __attribute__((ext_vector_type(4)));

__device__ __forceinline__ unsigned cvtpk(float lo, float hi) { unsigned r; asm volatile("v_cvt_pk_bf16_f32 %0, %1, %2" : "=v"(r) : "v"(lo), "v"(hi)); return r; }
__device__ __forceinline__ float bf2f(short s) { return __uint_as_float(((unsigned)(unsigned short)s) << 16); }
template <int X> __device__ __forceinline__ float shx(float v) { return __int_as_float(__builtin_amdgcn_ds_swizzle(__float_as_int(v), 0x1f | (X << 10))); }
template <int X> __device__ __forceinline__ int shxi(int v) { return __builtin_amdgcn_ds_swizzle(v, 0x1f | (X << 10)); }
__device__ __forceinline__ float half_sum(float v) { v += shx<1>(v); v += shx<2>(v); v += shx<4>(v); v += shx<8>(v); v += shx<16>(v); return v; }
__device__ __forceinline__ float wave_sum(float v) { v = half_sum(v);
    auto rr = __builtin_amdgcn_permlane32_swap(__float_as_uint(v), __float_as_uint(v), false, false); return __uint_as_float(rr[0]) + __uint_as_float(rr[1]); }
#define FRESH_LANE(name) const int name = fresh_lane()
#define WAITBAR() asm volatile("s_waitcnt vmcnt(0) lgkmcnt(0)\n\ts_barrier" ::: "memory")

__device__ __forceinline__ void tr_item(const float* W, int K, int N, int nblk, bf16* WT, int row_off, LAS float* scr, int item, int lane, const float* gk) {
    const int kb = item / nblk, nb = item - kb * nblk, k0 = 64 * kb, n0 = 64 * nb;
    const int c4 = (lane & 15) * 4, rr = lane >> 4; const bool ok = n0 + c4 < N;
    const GAS f32x4* src = (const GAS f32x4*)(W + (size_t)(k0 + rr) * N + n0 + c4);
    f32x4 v[16];
#pragma unroll
    for (int i = 0; i < 16; ++i) v[i] = ok ? __builtin_nontemporal_load((const GAS f32x4*)((const GAS float*)src + (size_t)(4 * i) * N)) : (f32x4){0.f, 0.f, 0.f, 0.f};
    if (gk) {
#pragma unroll
        for (int i = 0; i < 16; ++i) v[i] = v[i] * gk[k0 + 4 * i + rr]; }
#pragma unroll
    for (int i = 0; i < 16; ++i) { LAS float* s = scr + (4 * i + rr) * 65 + c4; s[0] = v[i].x; s[1] = v[i].y; s[2] = v[i].z; s[3] = v[i].w; }
    LDS_WAIT(); asm volatile("" ::: "memory");
    const int c = lane & 7;
#pragma unroll
    for (int j = 0; j < 8; ++j) { const int nn = (lane >> 3) + 8 * j; const LAS float* s = scr + (8 * c) * 65 + nn;
        v4u o; o.x = cvtpk(s[0 * 65], s[1 * 65]); o.y = cvtpk(s[2 * 65], s[3 * 65]); o.z = cvtpk(s[4 * 65], s[5 * 65]); o.w = cvtpk(s[6 * 65], s[7 * 65]);
        *(GAS v4u*)(WT + (size_t)(row_off + n0 + nn) * K + k0 + 8 * c) = o; }
    LDS_WAIT(); asm volatile("" ::: "memory");
}
template <bool BF> __device__ __forceinline__ void rms_row(const float* xrow, const float* g, void* orow, int lane) {
    const GAS f32x4* xr = (const GAS f32x4*)xrow + lane; const GAS f32x4* gr = (const GAS f32x4*)g + lane;
    f32x4 v[16]; float s = 0.f;
#pragma unroll
    for (int j = 0; j < 16; ++j) { v[j] = xr[64 * j]; s += (v[j].x * v[j].x + v[j].y * v[j].y) + (v[j].z * v[j].z + v[j].w * v[j].w); }
    const float rstd = 1.0f / sqrtf(wave_sum(s) * (1.f / DM) + EPS);
#pragma unroll
    for (int j = 0; j < 16; ++j) { const f32x4 gg = gr[64 * j]; const f32x4 y = v[j] * rstd * gg;
        if (BF) { v2u w; w.x = cvtpk(y.x, y.y); w.y = cvtpk(y.z, y.w); ((GAS v2u*)orow)[64 * j + lane] = w; }
        else ((GAS f32x4*)orow)[64 * j + lane] = y; }
}
__device__ __forceinline__ void cast_row(const float* xrow, bf16* hrow, bf16* lrow, float* ss, int lane) {
    const GAS f32x4* xr = (const GAS f32x4*)xrow + lane; float s = 0.f;
#pragma unroll
    for (int j = 0; j < 16; ++j) { const f32x4 v = xr[64 * j]; s += (v.x * v.x + v.y * v.y) + (v.z * v.z + v.w * v.w);
        v2u h; h.x = cvtpk(v.x, v.y); h.y = cvtpk(v.z, v.w); ((GAS v2u*)hrow)[64 * j + lane] = h;
        v2u w; w.x = cvtpk(v.x - __uint_as_float(h.x << 16), v.y - __uint_as_float(h.x & 0xffff0000u)); w.y = cvtpk(v.z - __uint_as_float(h.y << 16), v.w - __uint_as_float(h.y & 0xffff0000u)); ((GAS v2u*)lrow)[64 * j + lane] = w; }
    s = wave_sum(s); if (lane == 0) *ss = s;
}
__device__ __forceinline__ void final_row(const bf16* hrow, const bf16* lrow, const float* g, float* orow, int lane) {
    f32x4 v[16]; float s = 0.f;
#pragma unroll
    for (int j = 0; j < 16; ++j) { const v2u h = ((const GAS v2u*)hrow)[64 * j + lane], w = ((const GAS v2u*)lrow)[64 * j + lane];
        v[j].x = __uint_as_float(h.x << 16) + __uint_as_float(w.x << 16); v[j].y = __uint_as_float(h.x & 0xffff0000u) + __uint_as_float(w.x & 0xffff0000u);
        v[j].z = __uint_as_float(h.y << 16) + __uint_as_float(w.y << 16); v[j].w = __uint_as_float(h.y & 0xffff0000u) + __uint_as_float(w.y & 0xffff0000u);
        s += (v[j].x * v[j].x + v[j].y * v[j].y) + (v[j].z * v[j].z + v[j].w * v[j].w); }
    const float rstd = 1.0f / sqrtf(wave_sum(s) * (1.f / DM) + EPS);
#pragma unroll
    for (int j = 0; j < 16; ++j) { const f32x4 gg = ((const GAS f32x4*)g)[64 * j + lane]; ((GAS f32x4*)orow)[64 * j + lane] = v[j] * rstd * gg; }
}
__device__ __forceinline__ float logsigmoidf_(float x) {
    const float e = __expf(-fabsf(x)); return fminf(x, 0.f) - __logf(1.f + e);
}
__device__ __forceinline__ void prep_row(const bf16* proj, int m, const float* gq, const float* gkv, const float* bf, const float* COS, const float* SIN,
                                         bf16* CQN, bf16* CKVN, bf16* KPE, float* LOGF, unsigned* KN2, int lane) {
    const bf16* pr = proj + (size_t)m * INP;
    bf16x8 q[3]; float sq = 0.f;
#pragma unroll
    for (int j = 0; j < 3; ++j) { q[j] = *(const GAS bf16x8*)(pr + B_CQ + (j * 64 + lane) * 8);
#pragma unroll
        for (int e = 0; e < 8; ++e) { const float f = bf2f(q[j][e]); sq += f * f; } }
    const bf16x8 kv = *(const GAS bf16x8*)(pr + B_CKV + lane * 8); float skv = 0.f;
#pragma unroll
    for (int e = 0; e < 8; ++e) { const float f = bf2f(kv[e]); skv += f * f; }
    const float rq = 1.0f / sqrtf(wave_sum(sq) * (1.f / QRANK) + EPS), rkv = 1.0f / sqrtf(wave_sum(skv) * (1.f / KVRANK) + EPS);
#pragma unroll
    for (int j = 0; j < 3; ++j) { const int c0 = (j * 64 + lane) * 8; const f32x4 g0 = *(const GAS f32x4*)(gq + c0), g1 = *(const GAS f32x4*)(gq + c0 + 4);
        v4u w; w.x = cvtpk(bf2f(q[j][0]) * rq * g0.x, bf2f(q[j][1]) * rq * g0.y); w.y = cvtpk(bf2f(q[j][2]) * rq * g0.z, bf2f(q[j][3]) * rq * g0.w);
        w.z = cvtpk(bf2f(q[j][4]) * rq * g1.x, bf2f(q[j][5]) * rq * g1.y); w.w = cvtpk(bf2f(q[j][6]) * rq * g1.z, bf2f(q[j][7]) * rq * g1.w);
        *(GAS v4u*)(CQN + (size_t)m * QRANK + c0) = w; }
    { const int c0 = lane * 8; const f32x4 g0 = *(const GAS f32x4*)(gkv + c0), g1 = *(const GAS f32x4*)(gkv + c0 + 4);
        v4u w; w.x = cvtpk(bf2f(kv[0]) * rkv * g0.x, bf2f(kv[1]) * rkv * g0.y); w.y = cvtpk(bf2f(kv[2]) * rkv * g0.z, bf2f(kv[3]) * rkv * g0.w);
        w.z = cvtpk(bf2f(kv[4]) * rkv * g1.x, bf2f(kv[5]) * rkv * g1.y); w.w = cvtpk(bf2f(kv[6]) * rkv * g1.z, bf2f(kv[7]) * rkv * g1.w);
        *(GAS v4u*)(CKVN + (size_t)m * KVRANK + c0) = w; }
    { const float v = bf2f((short)pr[B_KR + lane]); float pv; { auto rr = __builtin_amdgcn_permlane32_swap(__float_as_uint(v), __float_as_uint(v), false, false); pv = __uint_as_float(lane >= 32 ? rr[0] : rr[1]); } const int i = lane & 31;
      const float c = COS[(size_t)m * 32 + i], s = SIN[(size_t)m * 32 + i];
      const float o = lane < 32 ? v * c - pv * s : pv * s + v * c;
      const float on = shx<1>(o);
      if ((lane & 1) == 0) *(GAS unsigned*)(KPE + (size_t)m * 64 + lane) = cvtpk(o, on); }
    if (lane < 8) { const float f = bf2f((short)pr[D_F + lane]) + bf[lane]; const int b = m / SEQ, s = m - b * SEQ; LOGF[(size_t)(b * 8 + lane) * SEQ + s] = logsigmoidf_(f); }
    { const bf16x8 k0 = *(const GAS bf16x8*)(pr + D_Q + 1024 + lane * 16), k1 = *(const GAS bf16x8*)(pr + D_Q + 1024 + lane * 16 + 8); float s = 0.f;
#pragma unroll
      for (int e = 0; e < 8; ++e) { const float a = bf2f(k0[e]), c = bf2f(k1[e]); s += a * a + c * c; }
      s += shx<1>(s); s += shx<2>(s); s += shx<4>(s);
      if ((lane & 7) == 0) { unsigned* p = KN2 + (m / SEQ) * 8 + (lane >> 3); const unsigned v = __float_as_uint(s);
          if (v > __hip_atomic_load(p, __ATOMIC_RELAXED, __HIP_MEMORY_SCOPE_AGENT)) __hip_atomic_fetch_max(p, v, __ATOMIC_RELAXED, __HIP_MEMORY_SCOPE_AGENT); } }
}
__device__ __forceinline__ void fox_scan(const float* logf, float* negc, int lane) {
    const GAS f32x4* src = (const GAS f32x4*)(logf + lane * 64); f32x4 v[16]; float tot = 0.f;
#pragma unroll
    for (int j = 0; j < 16; ++j) { v[j] = src[j]; tot += (v[j].x + v[j].y) + (v[j].z + v[j].w); }
    float inc = tot;
#pragma unroll
    for (int o = 1; o < 64; o <<= 1) { const float t = __int_as_float(__builtin_amdgcn_ds_bpermute((lane - o) << 2, __float_as_int(inc))); if (lane >= o) inc += t; }
    float run = inc - tot; const float k = -11.313708498984761f;
    GAS f32x4* dst = (GAS f32x4*)(negc + lane * 64);
#pragma unroll
    for (int j = 0; j < 16; ++j) { f32x4 o; run += v[j].x; o.x = run * k; run += v[j].y; o.y = run * k; run += v[j].z; o.z = run * k; run += v[j].w; o.w = run * k; dst[j] = o; }
}

namespace att {
constexpr int VA = 0, VB = 1, VC = 2, VD = 3, VE = 4;
constexpr int K_OFF = 0, V_OFF = 32768, B_OFF = 65536, WS_OFF = 67584, LUT_OFF = 69632, FLG_OFF = 70656, TKT_OFF = 70784, KPE_OFF = 71680, QF_OFF = 71680, ATT_END = QF_OFF + 65536;
constexpr float LOG2E = 1.4426950408889634f, LN2 = 0.6931471805599453f, THR = 8.f;
struct Ctx { const bf16* PROJ; const bf16* QMLA; const bf16* KVMLA; const bf16* KPE; bf16* MIX; const bf16* QMEM; const bf16* KVMEM; bf16* OMEM;
             const float* COS; const float* SIN; const float* LUT; const int* TPMAX; const int* pos; const float* NEGC; const float* sub_g; const unsigned* KN2; float lam, oml; };

__device__ __forceinline__ int crow(int r, int hi) { return (r & 3) + 8 * (r >> 2) + 4 * hi; }
__device__ __forceinline__ int swap23(int k) { return (k & ~0xC) | ((k & 4) << 1) | ((k & 8) >> 1); }
__device__ __forceinline__ float pmaxf(float v) { auto rr = __builtin_amdgcn_permlane32_swap(__float_as_uint(v), __float_as_uint(v), false, false); return fmaxf(__uint_as_float(rr[0]), __uint_as_float(rr[1])); }
__device__ __forceinline__ float psumf(float v) { auto rr = __builtin_amdgcn_permlane32_swap(__float_as_uint(v), __float_as_uint(v), false, false); return __uint_as_float(rr[0]) + __uint_as_float(rr[1]); }
__device__ __forceinline__ float partnerf(float v, int hi) { auto rr = __builtin_amdgcn_permlane32_swap(__float_as_uint(v), __float_as_uint(v), false, false); return __uint_as_float(hi ? rr[0] : rr[1]); }
__device__ __forceinline__ void dma16(const void* sbase, unsigned voff, unsigned ldsaddr) { unsigned keep;
    asm volatile("s_mov_b32 %0, m0\n\ts_mov_b32 m0, %3\n\ts_nop 0\n\tglobal_load_lds_dwordx4 %1, %2\n\ts_mov_b32 m0, %0" : "=&s"(keep) : "v"(voff), "s"(sbase), "s"(ldsaddr) : "memory"); }

template <int NK> __device__ __forceinline__ void qk(f32x16& p0, f32x16& p1, const LAS unsigned char* krow, int xr, int hx, const bf16x8* qf, int dstart) {
#pragma unroll
    for (int d0 = 0; d0 < NK; ++d0) { const int off = (((dstart + d0) * 32 + hx) ^ xr);
        const bf16x8 b0 = *(const LAS bf16x8*)(krow + off), b1 = *(const LAS bf16x8*)(krow + off + 8192);
        p0 = __builtin_amdgcn_mfma_f32_32x32x16_bf16(b0, qf[d0], p0, 0, 0, 0); p1 = __builtin_amdgcn_mfma_f32_32x32x16_bf16(b1, qf[d0], p1, 0, 0, 0); }
}
template <int NK> __device__ __forceinline__ void qk_l(f32x16& p0, f32x16& p1, const LAS unsigned char* krow, int xr, int hx, const LAS unsigned char* qlds, int dstart) {
#pragma unroll
    for (int d0 = 0; d0 < NK; ++d0) { const int off = (((dstart + d0) * 32 + hx) ^ xr);
        const bf16x8 b0 = *(const LAS bf16x8*)(krow + off), b1 = *(const LAS bf16x8*)(krow + off + 8192), q = *(const LAS bf16x8*)(qlds + (dstart + d0) * 1024);
        p0 = __builtin_amdgcn_mfma_f32_32x32x16_bf16(b0, q, p0, 0, 0, 0); p1 = __builtin_amdgcn_mfma_f32_32x32x16_bf16(b1, q, p1, 0, 0, 0); }
}
__device__ __forceinline__ void qk_pe(f32x16& p0, f32x16& p1, const LAS unsigned char* perow, int xpe, int hx, const bf16x8* qf) {
#pragma unroll
    for (int d0 = 0; d0 < 4; ++d0) { const int off = ((d0 * 32 + hx) ^ xpe);
        const bf16x8 b0 = *(const LAS bf16x8*)(perow + off), b1 = *(const LAS bf16x8*)(perow + off + 4096);
        p0 = __builtin_amdgcn_mfma_f32_32x32x16_bf16(b0, qf[d0], p0, 0, 0, 0); p1 = __builtin_amdgcn_mfma_f32_32x32x16_bf16(b1, qf[d0], p1, 0, 0, 0); }
}
__device__ __forceinline__ void pv(f32x16* o, unsigned vb, bf16x8 pa0, bf16x8 pa1, bf16x8 pa2, bf16x8 pa3) {
#define TRRD(dst, off) asm volatile("ds_read_b64_tr_b16 %0, %1 offset:%2" : "=&v"(dst) : "v"(vb), "i"(off) : "memory")
#define PV_D0(d0) do { s16x4 l0, l1, l2, l3, h0, h1, h2, h3; constexpr int b_ = (d0) * 512; \
        TRRD(l0, b_); TRRD(h0, b_ + 2048); TRRD(l1, b_ + 4096); TRRD(h1, b_ + 6144); TRRD(l2, b_ + 8192); TRRD(h2, b_ + 10240); TRRD(l3, b_ + 12288); TRRD(h3, b_ + 14336); \
        asm volatile("s_waitcnt lgkmcnt(0)" ::: "memory"); __builtin_amdgcn_sched_barrier(0); \
        o[d0] = __builtin_amdgcn_mfma_f32_32x32x16_bf16(pa0, (bf16x8){l0[0], l0[1], l0[2], l0[3], h0[0], h0[1], h0[2], h0[3]}, o[d0], 0, 0, 0); \
        o[d0] = __builtin_amdgcn_mfma_f32_32x32x16_bf16(pa1, (bf16x8){l1[0], l1[1], l1[2], l1[3], h1[0], h1[1], h1[2], h1[3]}, o[d0], 0, 0, 0); \
        o[d0] = __builtin_amdgcn_mfma_f32_32x32x16_bf16(pa2, (bf16x8){l2[0], l2[1], l2[2], l2[3], h2[0], h2[1], h2[2], h2[3]}, o[d0], 0, 0, 0); \
        o[d0] = __builtin_amdgcn_mfma_f32_32x32x16_bf16(pa3, (bf16x8){l3[0], l3[1], l3[2], l3[3], h3[0], h3[1], h3[2], h3[3]}, o[d0], 0, 0, 0); } while (0)
    PV_D0(0); PV_D0(1); PV_D0(2); PV_D0(3);
#undef PV_D0
#undef TRRD
}
__device__ __forceinline__ void pack_p(const f32x16& p0, const f32x16& p1, bf16x8& pa0, bf16x8& pa1, bf16x8& pa2, bf16x8& pa3) {
#define PK4(P, B_, OUT) do { unsigned a0 = cvtpk(P[B_ + 0], P[B_ + 1]), a1 = cvtpk(P[B_ + 2], P[B_ + 3]), b0 = cvtpk(P[B_ + 4], P[B_ + 5]), b1 = cvtpk(P[B_ + 6], P[B_ + 7]); \
        auto r0 = __builtin_amdgcn_permlane32_swap(a0, b0, false, false); auto r1 = __builtin_amdgcn_permlane32_swap(a1, b1, false, false); \
        v4u w = {r0[0], r1[0], r0[1], r1[1]}; OUT = __builtin_bit_cast(bf16x8, w); } while (0)
    PK4(p0, 0, pa0); PK4(p0, 8, pa1); PK4(p1, 0, pa2); PK4(p1, 8, pa3);
#undef PK4
}
__device__ __forceinline__ void softmax_pv(f32x16& p0, f32x16& p1, float& m, float& l, f32x16* o, LAS float* wsf, unsigned vb, int r32, int hi, const float SCALE, const float C2) {
    float mx0 = fmaxf(p0[0], p1[0]), mx1 = fmaxf(p0[1], p1[1]), mx2 = fmaxf(p0[2], p1[2]), mx3 = fmaxf(p0[3], p1[3]);
#pragma unroll
    for (int r = 4; r < 16; r += 4) { mx0 = fmaxf(fmaxf(mx0, p0[r]), p1[r]); mx1 = fmaxf(fmaxf(mx1, p0[r + 1]), p1[r + 1]); mx2 = fmaxf(fmaxf(mx2, p0[r + 2]), p1[r + 2]); mx3 = fmaxf(fmaxf(mx3, p0[r + 3]), p1[r + 3]); }
    float pmax = pmaxf(fmaxf(fmaxf(mx0, mx1), fmaxf(mx2, mx3)));
    float mn, alpha;
    if (__all((pmax - m) * SCALE <= THR)) { mn = m; alpha = 1.f; }
    else { mn = fmaxf(m, pmax); alpha = __builtin_amdgcn_exp2f((m - mn) * C2); m = mn; }
    const float mnL = -mn * C2;
#pragma unroll
    for (int r = 0; r < 16; ++r) { p0[r] = __builtin_amdgcn_exp2f(fmaf(p0[r], C2, mnL)); p1[r] = __builtin_amdgcn_exp2f(fmaf(p1[r], C2, mnL)); }
    float s0 = p0[0] + p1[0], s1 = p0[1] + p1[1], s2 = p0[2] + p1[2], s3 = p0[3] + p1[3];
#pragma unroll
    for (int r = 4; r < 16; r += 4) { s0 += p0[r] + p1[r]; s1 += p0[r + 1] + p1[r + 1]; s2 += p0[r + 2] + p1[r + 2]; s3 += p0[r + 3] + p1[r + 3]; }
    const float ps = psumf((s0 + s1) + (s2 + s3)); l = l * alpha + ps;
    bf16x8 pa0, pa1, pa2, pa3; pack_p(p0, p1, pa0, pa1, pa2, pa3);
    if (__any(alpha < 1.f)) { const int fl = fresh_lane(), fh = fl >> 5;
        if (fh == 0) wsf[fl] = alpha; asm volatile("s_waitcnt lgkmcnt(0)" ::: "memory");
#pragma unroll
        for (int r = 0; r < 16; ++r) { const float a = wsf[crow(r, fh)];
#pragma unroll
            for (int d = 0; d < 4; ++d) o[d][r] *= a; } }
    pv(o, vb, pa0, pa1, pa2, pa3);
}

template <int VAR>
__device__ __forceinline__ void attn_unit(const Ctx& C, int b, int h, int qb, LAS unsigned char* lds, int tid, int wid, int lane) {
    constexpr bool CAUSAL = VAR != VE, DESC = (VAR == VC || VAR == VD), MLA = (VAR == VB), DIFF = (VAR == VA), STICK = (VAR == VC), HASB = (VAR == VA || VAR == VD);
    constexpr int NQF = MLA ? 12 : 8;
    constexpr float SCALE = DIFF ? 0.125f : (MLA ? 0.07216878364870323f : 0.08838834764831845f);
    constexpr float C2 = SCALE * LOG2E;
    const int r32 = lane & 31, hi = lane >> 5;
    const int q0 = qb * 256, qw = q0 + wid * 32, trow = qw + r32;
    const size_t rb = (size_t)b * SEQ;
    const bf16 *Qp, *Kp, *Vp; bf16* Op; int qpitch, kpitch, opitch;
    if constexpr (VAR == VA || VAR == VC || VAR == VD) {
        constexpr int base = VAR == VA ? A_Q : (VAR == VC ? C_Q : D_Q);
        Qp = C.PROJ + rb * INP + base + h * 128; Kp = Qp + 1024; Vp = Qp + 2048; qpitch = INP; kpitch = INP;
        Op = C.MIX + rb * DM + VAR * 1024 + h * 128; opitch = DM;
    } else if constexpr (VAR == VB) {
        Qp = C.QMLA + rb * 1536 + h * 192; qpitch = 1536; Kp = C.KVMLA + rb * 2048 + h * 256; Vp = Kp + 128; kpitch = 2048;
        Op = C.MIX + rb * DM + 1024 + h * 128; opitch = DM;
    } else {
        Qp = C.QMEM + rb * 512 + h * 128; qpitch = 512; Kp = C.KVMEM + (size_t)b * MEMT * 1024 + h * 128; Vp = Kp + 512; kpitch = 1024;
        Op = C.OMEM + rb * 512 + h * 128; opitch = 512;
    }
    const char* Bp = nullptr;
    if constexpr (VAR == VA) Bp = (const char*)(C.pos + rb);
    if constexpr (VAR == VD) Bp = (const char*)(C.NEGC + (size_t)(b * 8 + h) * SEQ);
    const char* KPEp = nullptr;
    if constexpr (MLA) KPEp = (const char*)(C.KPE + rb * 64);
    bf16x8 qr[DIFF ? 1 : NQF];
    const LAS unsigned char* qlds = lds + QF_OFF + wid * 8192 + lane * 16;
    { const bf16* qrow = Qp + (size_t)trow * qpitch + hi * 8;
      if constexpr (DIFF) {
#pragma unroll
          for (int d0 = 0; d0 < 8; ++d0) { const bf16x8 q = *(const GAS bf16x8*)(qrow + d0 * 16); *(LAS bf16x8*)(lds + QF_OFF + wid * 8192 + lane * 16 + d0 * 1024) = q; }
      } else {
#pragma unroll
          for (int d0 = 0; d0 < NQF; ++d0) qr[d0] = *(const GAS bf16x8*)(qrow + d0 * 16); } }
    if constexpr (MLA) {
        const float* cs = C.COS + (rb + trow) * 32 + hi * 8; const float* sn = C.SIN + (rb + trow) * 32 + hi * 8;
#pragma unroll
        for (int j = 0; j < 2; ++j) {
            const f32x4 c0 = *(const GAS f32x4*)(cs + j * 16), c1 = *(const GAS f32x4*)(cs + j * 16 + 4), s0 = *(const GAS f32x4*)(sn + j * 16), s1 = *(const GAS f32x4*)(sn + j * 16 + 4);
            const bf16x8 a = qr[8 + j], bb = qr[10 + j]; float lo[8], hh[8];
#pragma unroll
            for (int e = 0; e < 8; ++e) { const float t1 = bf2f(a[e]), t2 = bf2f(bb[e]), c = e < 4 ? c0[e & 3] : c1[e & 3], s = e < 4 ? s0[e & 3] : s1[e & 3]; lo[e] = t1 * c - t2 * s; hh[e] = t1 * s + t2 * c; }
            v4u wl = {cvtpk(lo[0], lo[1]), cvtpk(lo[2], lo[3]), cvtpk(lo[4], lo[5]), cvtpk(lo[6], lo[7])}, wh = {cvtpk(hh[0], hh[1]), cvtpk(hh[2], hh[3]), cvtpk(hh[4], hh[5]), cvtpk(hh[6], hh[7])};
            qr[8 + j] = __builtin_bit_cast(bf16x8, wl); qr[10 + j] = __builtin_bit_cast(bf16x8, wh); }
    }
    unsigned koff[2], voff[2], peoff = 0;
#pragma unroll
    for (int i = 0; i < 2; ++i) { const int j = wid * 2 + i, row = 4 * j + (lane >> 4); koff[i] = (unsigned)(row * kpitch + (((lane & 15) ^ (row & 15)) << 3)) * 2u;
        const int st = 2 * j + (lane >> 5), kk = (st >> 2) * 8 + ((lane & 31) >> 2), c = (st & 3) * 32 + (lane & 3) * 8; voff[i] = (unsigned)(swap23(kk) * kpitch + c) * 2u; }
    if constexpr (MLA) { const int row = 8 * wid + (lane >> 3); peoff = (unsigned)(row * 64 + (((lane & 7) ^ ((row >> 1) & 7)) << 3)) * 2u; }
    const unsigned boff = (unsigned)(lane & 15) * 16u;
    const unsigned ldsbase = (unsigned)(unsigned long long)lds;
#define ISSUE(t_, buf_) do { const size_t tb_ = (size_t)(t_) * 64 * kpitch * 2; const char* kg_ = (const char*)Kp + tb_; const char* vg_ = (const char*)Vp + tb_; \
        _Pragma("unroll") for (int i_ = 0; i_ < 2; ++i_) dma16(kg_, koff[i_], ldsbase + K_OFF + (buf_) * 16384 + (wid * 2 + i_) * 1024); \
        _Pragma("unroll") for (int i_ = 0; i_ < 2; ++i_) dma16(vg_, voff[i_], ldsbase + V_OFF + (buf_) * 16384 + (wid * 2 + i_) * 1024); \
        if constexpr (MLA) dma16(KPEp + (size_t)(t_) * 64 * 64 * 2, peoff, ldsbase + KPE_OFF + (buf_) * 8192 + wid * 1024); \
        if constexpr (HASB) { if (wid == 0) dma16(Bp + (size_t)(t_) * 64 * 4, boff, ldsbase + B_OFF + (buf_) * 1024); } } while (0)
    const int NT = CAUSAL ? (q0 + 256) / 64 : MEMT / 64;
    LAS float* wsf = (LAS float*)(lds + WS_OFF) + wid * 64;
    LAS float* lut = (LAS float*)(lds + LUT_OFF);
    int pos_t = 0, wmin = 0; float lut_far = 0.f;
    if constexpr (DIFF) { if (tid < 132) lut[tid] = C.LUT[h * 132 + tid];
        pos_t = C.pos[rb + trow]; int mnp = pos_t;
        mnp = min(mnp, shxi<1>(mnp)); mnp = min(mnp, shxi<2>(mnp)); mnp = min(mnp, shxi<4>(mnp)); mnp = min(mnp, shxi<8>(mnp)); mnp = min(mnp, shxi<16>(mnp));
        wmin = __builtin_amdgcn_readfirstlane(mnp); lut_far = C.LUT[h * 132 + 128]; }
    const int xr = (r32 & 15) << 4, hx = hi << 4, xpe = ((r32 >> 1) & 7) << 4;
    const unsigned vrd = (unsigned)(((lane & 3) << 3) | (((lane >> 2) & 3) << 6) | (((lane >> 4) & 1) << 5) | (((lane >> 5) & 1) << 8));
    f32x16 o[4]; f32x16 o2[DIFF ? 4 : 1];
#pragma unroll
    for (int d = 0; d < 4; ++d) { o[d] = f32x16{}; if constexpr (DIFF) o2[d] = f32x16{}; }
    float m1 = -1e30f, l1 = 0.f, m2 = -1e30f, l2 = 0.f, R = 0.f;
    float qnkn = 0.f;
    if constexpr (VAR == VD) { float s = 0.f;
#pragma unroll
        for (int d0 = 0; d0 < 8; ++d0)
#pragma unroll
            for (int e = 0; e < 8; ++e) { const float a = bf2f(qr[d0][e]); s += a * a; }
        s = psumf(s); qnkn = sqrtf(s) * sqrtf(__uint_as_float(C.KN2[b * 8 + h])) * 1.001f + 1.f; }
    ISSUE(DESC ? NT - 1 : 0, 0);
    WAITBAR();
    int cur = 0;
    for (int i = 0; i < NT; ++i) {
        const int t = DESC ? NT - 1 - i : i, kb = t * 64;
        if (i + 1 < NT) ISSUE(DESC ? t - 1 : t + 1, cur ^ 1);
        const bool act = !CAUSAL || (STICK ? (kb < qw + 31) : (kb <= qw + 31));
        bool wdone = false;
        if constexpr (VAR == VD) {
            if (act) { const float nmax = ((const LAS float*)(lds + B_OFF + cur * 1024))[63]; wdone = __all((qnkn + nmax - m1) * SCALE < -40.f); } }
        if (act && !wdone) {
            const LAS unsigned char* krow = lds + K_OFF + cur * 16384 + r32 * 256;
            const unsigned vb = ldsbase + V_OFF + cur * 16384 + vrd;
            if constexpr (STICK) {
                f32x16 p0 = f32x16{}, p1 = f32x16{};
                qk<8>(p0, p1, krow, xr, hx, qr, 0);
                float L0[16], L1[16];
#pragma unroll
                for (int r = 0; r < 16; ++r) { const int key = kb + crow(r, hi);
                    { const float z = p0[r] * SCALE, e = __builtin_amdgcn_exp2f(-fabsf(z) * LOG2E), sp = fmaxf(z, 0.f) + __builtin_amdgcn_logf(1.f + e) * LN2; L0[r] = key < trow ? -sp : 0.f; p0[r] = z; }
                    { const float z = p1[r] * SCALE, e = __builtin_amdgcn_exp2f(-fabsf(z) * LOG2E), sp = fmaxf(z, 0.f) + __builtin_amdgcn_logf(1.f + e) * LN2; L1[r] = key + 32 < trow ? -sp : 0.f; p1[r] = z; } }
                float T[8], mb[8];
#pragma unroll
                for (int g = 0; g < 4; ++g) { T[g] = (L0[4 * g] + L0[4 * g + 1]) + (L0[4 * g + 2] + L0[4 * g + 3]); T[4 + g] = (L1[4 * g] + L1[4 * g + 1]) + (L1[4 * g + 2] + L1[4 * g + 3]); }
                float run = R;
#pragma unroll
                for (int k = 7; k >= 0; --k) { const float pt = partnerf(T[k], hi); const float T1 = hi ? T[k] : pt, T0 = hi ? pt : T[k];
                    const float b1 = run; run += T1; const float b0 = run; run += T0; mb[k] = hi ? b1 : b0; }
                R = run;
#pragma unroll
                for (int g = 0; g < 4; ++g) { float s0 = mb[g], s1 = mb[4 + g];
#pragma unroll
                    for (int e = 3; e >= 0; --e) { const int r = 4 * g + e, key = kb + crow(r, hi);
                        const float a0 = key < trow ? __builtin_amdgcn_exp2f((p0[r] + L0[r] + s0) * LOG2E) : 0.f; s0 += L0[r]; p0[r] = a0;
                        const float a1 = key + 32 < trow ? __builtin_amdgcn_exp2f((p1[r] + L1[r] + s1) * LOG2E) : 0.f; s1 += L1[r]; p1[r] = a1; } }
                bf16x8 pa0, pa1, pa2, pa3; pack_p(p0, p1, pa0, pa1, pa2, pa3);
                pv(o, vb, pa0, pa1, pa2, pa3);
            } else {
#pragma unroll
                for (int mp = 0; mp < (DIFF ? 2 : 1); ++mp) {
                    f32x16 p0, p1;
                    int xr_t = xr;
                    if constexpr (DIFF) { __builtin_amdgcn_sched_barrier(0); asm volatile("" : "+v"(pos_t), "+v"(xr_t)); }
                    if constexpr (VAR == VD) { const LAS float* nb = (const LAS float*)(lds + B_OFF + cur * 1024) + 4 * hi;
#pragma unroll
                        for (int g = 0; g < 4; ++g) { const f32x4 v0 = *(const LAS f32x4*)(nb + 8 * g), v1 = *(const LAS f32x4*)(nb + 32 + 8 * g);
#pragma unroll
                            for (int e = 0; e < 4; ++e) { p0[4 * g + e] = v0[e]; p1[4 * g + e] = v1[e]; } } }
                    else if constexpr (DIFF) {
                        if (wmin - C.TPMAX[b * 64 + t] >= 128) {
#pragma unroll
                            for (int r = 0; r < 16; ++r) { p0[r] = lut_far; p1[r] = lut_far; } }
                        else { const LAS int* pb = (const LAS int*)(lds + B_OFF + cur * 1024) + 4 * hi;
#pragma unroll
                            for (int g = 0; g < 4; ++g) { const i32x4 v0 = *(const LAS i32x4*)(pb + 8 * g), v1 = *(const LAS i32x4*)(pb + 32 + 8 * g);
#pragma unroll
                                for (int e = 0; e < 4; ++e) { p0[4 * g + e] = lut[min(max(pos_t - v0[e], 0), 128)]; p1[4 * g + e] = lut[min(max(pos_t - v1[e], 0), 128)]; }
                                __builtin_amdgcn_sched_barrier(0); } } }
                    else { p0 = f32x16{}; p1 = f32x16{}; }
                    if constexpr (DIFF) qk_l<4>(p0, p1, krow, xr_t, hx, qlds, 4 * mp);
                    else qk<8>(p0, p1, krow, xr, hx, qr, 0);
                    if constexpr (MLA) qk_pe(p0, p1, lds + KPE_OFF + cur * 8192 + r32 * 128, xpe, hx, qr + 8);
                    if (CAUSAL && kb + 63 > qw) { const float NEG = -__builtin_inff();
#pragma unroll
                        for (int r = 0; r < 16; ++r) { const int key = kb + crow(r, hi); if (key > trow) p0[r] = NEG; if (key + 32 > trow) p1[r] = NEG; } }
                    if (mp == 0) softmax_pv(p0, p1, m1, l1, o, wsf, vb, r32, hi, SCALE, C2);
                    else softmax_pv(p0, p1, m2, l2, o2, wsf, vb, r32, hi, SCALE, C2);
                }
            }
        }
        if constexpr (STICK) { const int dn_ = __all(R < -100.f) ? 1 : 0; if (lane == 0) ((LAS int*)(lds + FLG_OFF))[(i & 1) * 8 + wid] = dn_; }
        if constexpr (VAR == VD) { if (lane == 0) ((LAS int*)(lds + FLG_OFF))[(i & 1) * 8 + wid] = wdone ? 1 : 0; }
        WAITBAR(); cur ^= 1;
        if constexpr (STICK || VAR == VD) { const LAS i32x4* fl = (const LAS i32x4*)(lds + FLG_OFF + (i & 1) * 32); const i32x4 f0 = fl[0], f1 = fl[1];
            const int alld = (f0.x & f0.y & f0.z & f0.w) & (f1.x & f1.y & f1.z & f1.w); if (__builtin_amdgcn_readfirstlane(alld)) break; }
    }
#undef ISSUE
    const int lane_e = fresh_lane();
    const int r32e = lane_e & 31, hie = lane_e >> 5;
    bf16* Ob = Op + (size_t)(qw + 4 * hie) * opitch + r32e;
    if constexpr (DIFF) {
        if (hie == 0) { wsf[r32e] = l1; wsf[32 + r32e] = l2; } asm volatile("s_waitcnt lgkmcnt(0)" ::: "memory");
        const float lam = C.lam;
#pragma unroll
        for (int r = 0; r < 16; ++r) { const float i1 = __builtin_amdgcn_rcpf(wsf[crow(r, hie)]), i2 = lam * __builtin_amdgcn_rcpf(wsf[32 + crow(r, hie)]); float ss = 0.f;
#pragma unroll
            for (int d = 0; d < 4; ++d) { const float x = o[d][r] * i1 - o2[d][r] * i2; o[d][r] = x; ss += x * x; }
            ss = half_sum(ss);
            const float rstd = (1.0f / sqrtf(ss * (1.f / 128.f) + EPS)) * C.oml;
#pragma unroll
            for (int d = 0; d < 4; ++d) o[d][r] *= rstd; }
#pragma unroll
        for (int d = 0; d < 4; ++d) { const float g = C.sub_g[d * 32 + r32e];
#pragma unroll
            for (int r = 0; r < 16; ++r) o[d][r] *= g; }
    } else if constexpr (!STICK) {
        if (hie == 0) wsf[r32e] = l1; asm volatile("s_waitcnt lgkmcnt(0)" ::: "memory");
#pragma unroll
        for (int r = 0; r < 16; ++r) { const float i1 = __builtin_amdgcn_rcpf(wsf[crow(r, hie)]);
#pragma unroll
            for (int d = 0; d < 4; ++d) o[d][r] *= i1; }
    }
#pragma unroll
    for (int r = 0; r < 16; ++r) { const int orr = (r & 3) + 8 * (r >> 2);
#pragma unroll
        for (int d = 0; d < 4; ++d) { const float v = o[d][r], vn = shx<1>(v);
            if ((r32e & 1) == 0) *(GAS unsigned*)(Ob + (size_t)orr * opitch + d * 32) = cvtpk(v, vn); } }
}
template <int VAR> __device__ __forceinline__ void attn_queue(const Ctx& C, gu32* head, LAS unsigned char* lds, const int wid) {
    constexpr int NH = VAR == VE ? 4 : 8, NU = NB * NH * 16;
    const int lane = fresh_lane(), tid = wid * 64 + lane;
    volatile LAS int* tk = (volatile LAS int*)(lds + TKT_OFF);
    for (;;) {
        if (tid == 0) tk[0] = (int)__hip_atomic_fetch_add(head, 1u, RLX_AGENT);
        WAITBAR();
        const int n = __builtin_amdgcn_readfirstlane(tk[0]);
        if (n >= NU) break;
        const int qb = 15 - n / (NB * NH), bh = n % (NB * NH);
        attn_unit<VAR>(C, bh / NH, bh % NH, qb, lds, tid, wid, lane);
    }
}
}

struct Args { const void* in[27]; float* out; unsigned char* ws; float inv_freq[32]; float lam_init[2]; };
static_assert(sizeof(Args) == 27 * 8 + 16 + 128 + 8, "Args has no padding");
typedef const unsigned char __attribute__((address_space(4)))* kaptr_t;
__device__ __forceinline__ kaptr_t ka_fresh() { kaptr_t p = (kaptr_t)__builtin_amdgcn_kernarg_segment_ptr(); asm volatile("" : "+s"(p)); return p; }
#define KIN(ka, i) (*(const void* const __attribute__((address_space(4)))*)((ka) + 8 * (i)))
#define KOUT(ka) ((float*)KIN(ka, 27))
#define KWS(ka) ((unsigned char*)KIN(ka, 28))
#define KINVF(ka, i) (*(const float __attribute__((address_space(4)))*)((ka) + 232 + 4 * (i)))
#define KLAMI(ka, l) (*(const float __attribute__((address_space(4)))*)((ka) + 360 + 4 * (l)))

namespace att {
template <int VAR> __device__ __forceinline__ void attn_phase(int l, int q, LAS unsigned char* lds, const int wid0) {
    const kaptr_t ka = ka_fresh(); unsigned char* ws = KWS(ka);
    const Ctx C{(const bf16*)(ws + WS_PROJ), (const bf16*)(ws + WS_QMLA), (const bf16*)(ws + WS_KVMLA), (const bf16*)(ws + WS_KPE), (bf16*)(ws + WS_MIX), (const bf16*)(ws + WS_QMEM),
                (const bf16*)(ws + WS_KVMEM) + (size_t)l * 512 * 1024, (bf16*)(ws + WS_OMEM), (const float*)(ws + WS_COS), (const float*)(ws + WS_SIN), (const float*)(ws + WS_LUT),
                (const int*)(ws + WS_TPMAX), (const int*)KIN(ka, 2), (const float*)(ws + WS_NEGC), (const float*)KIN(ka, 11) + l * 128, (const unsigned*)((gu32*)(ws + WS_CTL) + CW_KN + l * 64), ((const float*)(ws + WS_LAM))[l], 1.0f - KLAMI(ka, l)};
    attn_queue<VAR>(C, (gu32*)(ws + WS_CTL) + CW_TKT + (l * 16 + q) * 64, lds, wid0);
}
}

__global__ void __launch_bounds__(NWAVES * 64, 2) mk_fwd(Args args) {
    extern __shared__ __attribute__((aligned(16))) unsigned char lds_raw[];
    LAS unsigned char* lds = (LAS unsigned char*)lds_raw;
    const int G = gridDim.x, bx = blockIdx.x;
    const int vcu = (G % 8 == 0) ? (bx % 8) * (G / 8) + bx / 8 : bx;
    const int wid0 = __builtin_amdgcn_readfirstlane((int)threadIdx.x >> 6);
    const int gw = vcu * NWAVES + wid0, NGW = G * NWAVES;
    { const int tid = wid0 * 64 + fresh_lane();
      for (int u = tid; u < (LDS_BYTES - LDSCTL_OFF) / 4; u += NWAVES * 64) ((LAS unsigned*)(lds + LDSCTL_OFF))[u] = 0u; }
    __syncthreads();
    volatile LAS unsigned* MISC = (volatile LAS unsigned*)(lds + MISC_OFF);
    XcdBarrier bar = xcd_barrier_post((unsigned*)(args.ws + WS_CTL) + CW_BAR, MISC + 8, wid0);

    {
        const kaptr_t ka = ka_fresh(); unsigned char* ws = KWS(ka);
        const int lane = fresh_lane(), wid = wid0, tid = wid * 64 + lane;
        LAS float* scr = (LAS float*)(lds + RING_OFF + wid * 16640);
        for (int l = 0; l < NL; ++l) {
            unsigned char* wl = ws + WS_W + (size_t)l * W_LAYER;
#define TR_MAT(idx_, K_, N_, NP_, dst_, roff_, gain_) do { const float* s_ = (const float*)KIN(ka, idx_) + (size_t)l * (K_) * (N_); const int nblk_ = (NP_) / 64, nit_ = ((K_) / 64) * nblk_; \
            const float* gk_ = (gain_) >= 0 ? (const float*)KIN(ka, (gain_) >= 0 ? (gain_) : 0) + (size_t)l * (K_) : nullptr; \
            for (int it = gw; it < nit_; it += NGW) tr_item(s_, (K_), (N_), nblk_, (bf16*)(dst_), (roff_), scr, it, lane, gk_); } while (0)
            TR_MAT(4, DM, INC, INP, wl + W_IN, 0, 3);
            TR_MAT(5, DM, DM, DM, wl + W_OUT, 0, -1);
            TR_MAT(14, QRANK, 1536, 1536, wl + W_UQ, 0, -1);
            TR_MAT(15, KVRANK, 2048, 2048, wl + W_UKV, 0, -1);
            TR_MAT(19, DM, 512, 512, wl + W_MQ, 0, 17);
            TR_MAT(20, DM, 512, 512, wl + W_MKV, 0, -1);
            TR_MAT(21, DM, 512, 512, wl + W_MKV, 512, -1);
            TR_MAT(22, 512, DM, DM, wl + W_MO, 0, -1);
            if (l == NL - 1 && G == 256) {
                const float* s_ = (const float*)KIN(ka, 24) + (size_t)l * DM * DFF; const float* gk_ = (const float*)KIN(ka, 23) + (size_t)l * DM;
                for (int it = 2 * UPDEF + 2 * P4DEF + gw; it < (DM / 64) * (DFF / 64); it += NGW) tr_item(s_, DM, DFF, DFF / 64, (bf16*)(wl + W_UP), 0, scr, it, lane, gk_);
            } else TR_MAT(24, DM, DFF, DFF, wl + W_UP, 0, 23);
            if (l == 0 || G <= 64) TR_MAT(25, DFF, DM, DM, wl + W_DN, 0, -1);
#undef TR_MAT
        }
        { const float* x0 = (const float*)KIN(ka, 0); bf16* H = (bf16*)(ws + WS_H); float* SS = (float*)((gu32*)(ws + WS_CTL) + CW_SS);
          for (int m = gw; m < M; m += NGW) cast_row(x0 + (size_t)m * DM, H + (size_t)m * DM, (bf16*)(ws + WS_XL) + (size_t)m * DM, SS + m, lane); }
        { const float* mem = (const float*)KIN(ka, 1); bf16* MEMN = (bf16*)(ws + WS_MEMN);
          for (int r = gw; r < NL * NB * MEMT; r += NGW) { const int l = r / (NB * MEMT), mr = r - l * (NB * MEMT);
            rms_row<true>(mem + (size_t)mr * DM, (const float*)KIN(ka, 18) + (size_t)l * DM, MEMN + (size_t)r * DM, lane); } }
        const int* pos = (const int*)KIN(ka, 2);
        float* COS = (float*)(ws + WS_COS); float* SIN = (float*)(ws + WS_SIN); float* LUT = (float*)(ws + WS_LUT); int* TPMAX = (int*)(ws + WS_TPMAX); float* LAM = (float*)(ws + WS_LAM);
        const int gt = vcu * (NWAVES * 64) + tid, NGT = G * NWAVES * 64;
        for (int i = gt; i < M * 32; i += NGT) { const int row = i >> 5, f = i & 31; const float ang = (float)pos[row] * KINVF(ka, f);
            double rv = (double)ang * 0.15915494309189535; rv -= floor(rv); const float fr = (float)rv;
            COS[i] = __builtin_amdgcn_cosf(fr); SIN[i] = __builtin_amdgcn_sinf(fr); }
        for (int i = gt; i < 8 * 132; i += NGT) { const int h = i / 132, dd0 = i - h * 132; const int dd = dd0 > 128 ? 128 : dd0; int bk;
            if (dd < 16) bk = dd; else { bk = 16 + (int)(logf((float)dd / 16.0f) / 2.0794415416798357f * 16.0f); bk = bk > 31 ? 31 : bk; }
            LUT[i] = 8.0f * ((const float*)KIN(ka, 6))[bk * 8 + h]; }
        for (int i = gt; i < NB * 64; i += NGT) { int mx = pos[i * 64];
            for (int k = 1; k < 64; ++k) mx = max(mx, pos[i * 64 + k]);
            TPMAX[i] = mx; }
        if (gt < NL) { const int l = gt; float s1 = 0.f, s2 = 0.f;
            for (int k = 0; k < 64; ++k) { s1 += ((const float*)KIN(ka, 7))[l * 64 + k] * ((const float*)KIN(ka, 8))[l * 64 + k]; s2 += ((const float*)KIN(ka, 9))[l * 64 + k] * ((const float*)KIN(ka, 10))[l * 64 + k]; }
            LAM[l] = expf(s1) - expf(s2) + KLAMI(ka, l); }
    }
    xcd_barrier(bar, wid0);

    for (int l = 0; l < NL; ++l) {
        { const kaptr_t ka = ka_fresh(); unsigned char* ws = KWS(ka); unsigned char* wl = ws + WS_W + (size_t)l * W_LAYER;
          { pg8::Gemm g{(const bf16*)(ws + WS_H), (const bf16*)(wl + W_IN), M, INP, DM}; pg8::StaticOrder S; S.init(M, INP, G, bx);
            pg8::EpiBf16<0, true> E{(bf16*)(ws + WS_PROJ), INP, (const float*)((gu32*)(ws + WS_CTL) + CW_SS) + (size_t)(3 * l) * M};
            pg8::gemm_phase<pg8::EpiBf16<0, true>, pg8::StaticOrder, true, true>(lds + RING_OFF, g, S, E, wid0); }
          { pg8::Gemm g{(const bf16*)(ws + WS_MEMN) + (size_t)l * 512 * DM, (const bf16*)(wl + W_MKV), 512, 1024, DM}; pg8::StaticOrder S; S.init(512, 1024, G, G - 1 - bx);
            pg8::EpiBf16<0, false> E{(bf16*)(ws + WS_KVMEM) + (size_t)l * 512 * 1024, 1024, nullptr};
            pg8::gemm_phase<pg8::EpiBf16<0, false>, pg8::StaticOrder, true, true>(lds + RING_OFF, g, S, E, wid0); }
          if (G == 256 && bx >= 160 && bx < 248) {
              const int lane = fresh_lane(); LAS float* scr = (LAS float*)(lds + RING_OFF + wid0 * 16640);
              const float* s_ = (const float*)KIN(ka, 24) + (size_t)(NL - 1) * DM * DFF; const float* gk_ = (const float*)KIN(ka, 23) + (size_t)(NL - 1) * DM;
              bf16* dst = (bf16*)(ws + WS_W + (size_t)(NL - 1) * W_LAYER + W_UP);
              for (int it = l * UPDEF + (bx - 160) * NWAVES + wid0; it < (l + 1) * UPDEF; it += 88 * NWAVES) tr_item(s_, DM, DFF, DFF / 64, dst, 0, scr, it, lane, gk_); } }
        xcd_barrier(bar, wid0);
        { const kaptr_t ka = ka_fresh(); unsigned char* ws = KWS(ka); FRESH_LANE(ln);
          for (int m = gw; m < M; m += NGW)
            prep_row((const bf16*)(ws + WS_PROJ), m, (const float*)KIN(ka, 12) + (size_t)l * QRANK, (const float*)KIN(ka, 13) + (size_t)l * KVRANK, (const float*)KIN(ka, 16) + l * 8,
                     (const float*)(ws + WS_COS), (const float*)(ws + WS_SIN), (bf16*)(ws + WS_CQN), (bf16*)(ws + WS_CKVN), (bf16*)(ws + WS_KPE), (float*)(ws + WS_LOGF), (unsigned*)((gu32*)(ws + WS_CTL) + CW_KN + l * 64), ln); }
        xcd_barrier(bar, wid0);
        { const kaptr_t ka = ka_fresh(); unsigned char* ws = KWS(ka); unsigned char* wl = ws + WS_W + (size_t)l * W_LAYER;
          if (gw < 16) { FRESH_LANE(ln); fox_scan((const float*)(ws + WS_LOGF) + (size_t)gw * SEQ, (float*)(ws + WS_NEGC) + (size_t)gw * SEQ, ln); }
          { pg8::Gemm g{(const bf16*)(ws + WS_CQN), (const bf16*)(wl + W_UQ), M, 1536, QRANK}; pg8::StaticOrder S; S.init(M, 1536, G, bx);
            pg8::EpiBf16<0, false> E{(bf16*)(ws + WS_QMLA), 1536, nullptr};
            pg8::gemm_phase<pg8::EpiBf16<0, false>, pg8::StaticOrder, true, true>(lds + RING_OFF, g, S, E, wid0); }
          { pg8::Gemm g{(const bf16*)(ws + WS_CKVN), (const bf16*)(wl + W_UKV), M, 2048, KVRANK}; pg8::StaticOrder S; S.init(M, 2048, G, G - 1 - bx);
            pg8::EpiBf16<0, false> E{(bf16*)(ws + WS_KVMLA), 2048, nullptr};
            pg8::gemm_phase<pg8::EpiBf16<0, false>, pg8::StaticOrder, true, true>(lds + RING_OFF, g, S, E, wid0); }
          if (G == 256 && bx >= 192) {
              const int lane = fresh_lane(); LAS float* scr = (LAS float*)(lds + RING_OFF + wid0 * 16640);
              const float* s_ = (const float*)KIN(ka, 24) + (size_t)(NL - 1) * DM * DFF; const float* gk_ = (const float*)KIN(ka, 23) + (size_t)(NL - 1) * DM;
              bf16* dst = (bf16*)(ws + WS_W + (size_t)(NL - 1) * W_LAYER + W_UP);
              for (int it = 2 * UPDEF + l * P4DEF + (bx - 192) * NWAVES + wid0; it < 2 * UPDEF + (l + 1) * P4DEF; it += 64 * NWAVES) tr_item(s_, DM, DFF, DFF / 64, dst, 0, scr, it, lane, gk_); } }
        xcd_barrier(bar, wid0);
        att::attn_phase<att::VA>(l, 0, lds, wid0);
        att::attn_phase<att::VB>(l, 1, lds, wid0);
        att::attn_phase<att::VD>(l, 2, lds, wid0);
        att::attn_phase<att::VC>(l, 3, lds, wid0);
        xcd_barrier(bar, wid0);
        { const kaptr_t ka = ka_fresh(); unsigned char* ws = KWS(ka); unsigned char* wl = ws + WS_W + (size_t)l * W_LAYER;
          pg8::Gemm g{(const bf16*)(ws + WS_MIX), (const bf16*)(wl + W_OUT), M, DM, DM}; pg8::StaticOrder S; S.init(M, DM, G, bx);
          pg8::EpiRes E{(bf16*)(ws + WS_H), (bf16*)(ws + WS_XL), DM, (float*)((gu32*)(ws + WS_CTL) + CW_SS) + (size_t)(3 * l + 1) * M};
          pg8::gemm_phase<pg8::EpiRes, pg8::StaticOrder, true, true>(lds + RING_OFF, g, S, E, wid0); }
        xcd_barrier(bar, wid0);
        { const kaptr_t ka = ka_fresh(); unsigned char* ws = KWS(ka); unsigned char* wl = ws + WS_W + (size_t)l * W_LAYER;
          pg8::Gemm g{(const bf16*)(ws + WS_H), (const bf16*)(wl + W_MQ), M, 512, DM}; pg8::StaticOrder S; S.init(M, 512, G, bx);
          pg8::EpiBf16<0, true> E{(bf16*)(ws + WS_QMEM), 512, (const float*)((gu32*)(ws + WS_CTL) + CW_SS) + (size_t)(3 * l + 1) * M};
          pg8::gemm_phase<pg8::EpiBf16<0, true>, pg8::StaticOrder, true, true>(lds + RING_OFF, g, S, E, wid0);
          if (G > 64 && bx >= 64) {
              const int lane = fresh_lane(); LAS float* scr = (LAS float*)(lds + RING_OFF + wid0 * 16640);
              const float* s_ = (const float*)KIN(ka, 25) + (size_t)(NL - 1) * DFF * DM; bf16* dst = (bf16*)(ws + WS_W + (size_t)(NL - 1) * W_LAYER + W_DN);
              constexpr int nblk = DM / 64, nit = (DFF / 64) * nblk, per = nit / NL;
              for (int it = l * per + (bx - 64) * NWAVES + wid0; it < (l + 1) * per; it += (G - 64) * NWAVES) tr_item(s_, DFF, DM, nblk, dst, 0, scr, it, lane, nullptr); } }
        xcd_barrier(bar, wid0);
        att::attn_phase<att::VE>(l, 4, lds, wid0);
        xcd_barrier(bar, wid0);
        { const kaptr_t ka = ka_fresh(); unsigned char* ws = KWS(ka); unsigned char* wl = ws + WS_W + (size_t)l * W_LAYER;
          pg8::Gemm g{(const bf16*)(ws + WS_OMEM), (const bf16*)(wl + W_MO), M, DM, 512}; pg8::StaticOrder S; S.init(M, DM, G, bx);
          pg8::EpiRes E{(bf16*)(ws + WS_H), (bf16*)(ws + WS_XL), DM, (float*)((gu32*)(ws + WS_CTL) + CW_SS) + (size_t)(3 * l + 2) * M};
          pg8::gemm_phase<pg8::EpiRes, pg8::StaticOrder, true, true>(lds + RING_OFF, g, S, E, wid0); }
        xcd_barrier(bar, wid0);
        { const kaptr_t ka = ka_fresh(); unsigned char* ws = KWS(ka); unsigned char* wl = ws + WS_W + (size_t)l * W_LAYER;
          pg8::Gemm g{(const bf16*)(ws + WS_H), (const bf16*)(wl + W_UP), M, DFF, DM}; pg8::StaticOrder S; S.init(M, DFF, G, bx);
          pg8::EpiBf16<1, true> E{(bf16*)(ws + WS_U), DFF, (const float*)((gu32*)(ws + WS_CTL) + CW_SS) + (size_t)(3 * l + 2) * M};
          pg8::gemm_phase<pg8::EpiBf16<1, true>, pg8::StaticOrder, true, true>(lds + RING_OFF, g, S, E, wid0); }
        xcd_barrier(bar, wid0);
        { const kaptr_t ka = ka_fresh(); unsigned char* ws = KWS(ka); unsigned char* wl = ws + WS_W + (size_t)l * W_LAYER;
          pg8::Gemm g{(const bf16*)(ws + WS_U), (const bf16*)(wl + W_DN), M, DM, DFF}; pg8::StaticOrder S; S.init(M, DM, G, bx);
          pg8::EpiRes E{(bf16*)(ws + WS_H), (bf16*)(ws + WS_XL), DM, (float*)((gu32*)(ws + WS_CTL) + CW_SS) + (size_t)(3 * l + 3) * M};
          pg8::gemm_phase<pg8::EpiRes, pg8::StaticOrder, true, true>(lds + RING_OFF, g, S, E, wid0); }
        xcd_barrier(bar, wid0);
    }
    { const kaptr_t ka = ka_fresh(); unsigned char* ws = KWS(ka); FRESH_LANE(ln); float* O = KOUT(ka);
      for (int m = gw; m < M; m += NGW) final_row((const bf16*)(ws + WS_H) + (size_t)m * DM, (const bf16*)(ws + WS_XL) + (size_t)m * DM, (const float*)KIN(ka, 26), O + (size_t)m * DM, ln); }
}

extern "C" void kernel_launch(void* const* d_in, const int* in_sizes, int n_in, void* d_out, int out_size, void* d_ws, size_t ws_size, hipStream_t stream) {
    static int grid = 0;
    if (grid == 0) {
        if (n_in != 27 || in_sizes[0] != M * DM || out_size != M * DM || ws_size < WS_END) {
            fprintf(stderr, "kernel_launch: built for 27 inputs, x/out of %d floats, >= %zu bytes of workspace; got n_in %d, in0 %d, out %d, ws %zu; nothing launched\n", M * DM, (size_t)WS_END, n_in, n_in > 0 ? in_sizes[0] : -1, out_size, ws_size);
            grid = -1; return; }
        int dev = 0, cus = 0, per_cu = 0;
        if (hipGetDevice(&dev) != hipSuccess || hipDeviceGetAttribute(&cus, hipDeviceAttributeMultiprocessorCount, dev) != hipSuccess) { fprintf(stderr, "kernel_launch: device query failed\n"); grid = -1; return; }
        if (hipFuncSetAttribute((const void*)mk_fwd, hipFuncAttributeMaxDynamicSharedMemorySize, LDS_BYTES) != hipSuccess) { fprintf(stderr, "kernel_launch: hipFuncSetAttribute failed\n"); grid = -1; return; }
        if (hipOccupancyMaxActiveBlocksPerMultiprocessor(&per_cu, (const void*)mk_fwd, NWAVES * 64, LDS_BYTES) != hipSuccess || per_cu < 1)
            fprintf(stderr, "kernel_launch: note: occupancy query reports %d workgroups per CU\n", per_cu);
        (void)hipGetLastError();
        grid = cus;
    }
    if (grid < 0) return;
    if (hipMemsetAsync((char*)d_ws + WS_CTL, 0, CTL_ZERO_BYTES, stream) != hipSuccess) { fprintf(stderr, "kernel_launch: memset failed\n"); return; }
    Args a; memset(&a, 0, sizeof(a));
    for (int i = 0; i < 27; ++i) a.in[i] = d_in[i];
    a.out = (float*)d_out; a.ws = (unsigned char*)d_ws;
    for (int i = 0; i < 32; ++i) a.inv_freq[i] = (float)pow(10000.0, -(double)i / 32.0);
    for (int l = 0; l < NL; ++l) a.lam_init[l] = (float)(0.8 - 0.6 * exp(-0.3 * (double)l));
    hipLaunchKernelGGL(mk_fwd, dim3(grid), dim3(NWAVES * 64), LDS_BYTES, stream, a);
    const hipError_t le = hipPeekAtLastError();
    if (le != hipSuccess) fprintf(stderr, "kernel_launch: launch failed: %s\n", hipGetErrorName(le));
}
```

```cpp
#include <hip/hip_runtime.h>
#include <cstdio>
#include <cstdint>
#include <cstring>
#include <cmath>
__device__ __forceinline__ int fresh_lane() { unsigned z = 0u; asm volatile("" : "+v"(z)); return (int)__builtin_amdgcn_mbcnt_hi(~0u, __builtin_amdgcn_mbcnt_lo(~0u, z)); }
namespace pg8 {
#define PG8_LAS __attribute__((address_space(3)))
typedef unsigned short bf16_t;
typedef short bf16x8 __attribute__((ext_vector_type(8)));
typedef float f32x4 __attribute__((ext_vector_type(4)));
typedef unsigned u32x4 __attribute__((ext_vector_type(4)));
constexpr int BM = 256, BK = 64, HALF = 128, HTB = HALF * BK * 2  , STAGE_BYTES = 8 * HTB, NXCD = 8, WGM = 8;

__host__ __device__ __forceinline__ int lds_byte(int r, int c) { const int st = (r >> 4) * 2 + (c >> 5), rr = r & 15, cc = c & 31, ob = rr * 64 + cc * 2; return st * 1024 + (ob ^ (((ob >> 9) & 1) << 5)); }
__host__ __device__ __forceinline__ void stage_rc(int b, int& R, int& C) { const int st = b / 1024, sb = b % 1024, swz = sb ^ (((sb >> 9) & 1) << 5); R = (st >> 1) * 16 + swz / 64; C = (st & 1) * 32 + (swz % 64) / 2; }
__host__ __device__ __forceinline__ int perm32(int rho) { const int n = rho >> 4, i = rho & 15; return 8 * (i >> 2) + 4 * n + (i & 3); }

struct Unit { int pm, pn; };
struct Gemm { const bf16_t* A; const bf16_t* Bt; int M, N, K; };

struct StaticOrder {
    int nM, nN, nwg, G, c;
    __host__ __device__ void init(int M, int N, int G_, int c_) { nM = M / BM; nN = N / BM; nwg = nM * nN; G = G_; c = c_; }
    __host__ __device__ bool next(int i, Unit& u) const {
        const long L = (long)i * G + c; if (L >= nwg) return false;
        int wgid = (int)L; { const int q = nwg / NXCD, r = nwg % NXCD, xcd = wgid % NXCD, off = wgid / NXCD; wgid = (xcd < r ? xcd * (q + 1) : r * (q + 1) + (xcd - r) * q) + off; }
        const int nig = WGM * nN, gid = wgid / nig, fm = gid * WGM, gsz = (nM - fm) < WGM ? (nM - fm) : WGM;
        u.pm = fm + ((wgid % nig) % gsz); u.pn = (wgid % nig) / gsz; return true;
    }
    __device__ __forceinline__ void a_ready(const Unit&) const {}
    __device__ __forceinline__ void done(const Unit&) const {}
};

__device__ __forceinline__ unsigned cvt_pk_bf16(float lo, float hi) { unsigned r; asm volatile("v_cvt_pk_bf16_f32 %0, %1, %2" : "=v"(r) : "v"(lo), "v"(hi)); return r; }
typedef float f32x2 __attribute__((ext_vector_type(2)));
template <int ACT, bool RS> struct EpiBf16 {
    static constexpr bool PERM = true, AFTER_DRAIN = false;
    bf16_t* O; int ldc; const unsigned long long* ss;
    __device__ __forceinline__ void operator()(const f32x4 (&acc)[2][2][4][2], const Unit& u, int wr, int wc, int fr, int fq) const {
        const int row0 = u.pm * BM + wr * 64 + fr, col0 = u.pn * BM + wc * 32 + 8 * fq;
#pragma unroll
        for (int ai = 0; ai < 2; ++ai)
#pragma unroll
            for (int m = 0; m < 4; ++m) { const int row = row0 + ai * HALF + m * 16; bf16_t* rowp = O + (size_t)row * ldc + col0;
                float rs = 1.f; if (RS) rs = 1.0f / sqrtf((float)ss[row] * (1.f / 1048576.f / 4096.f) + 1e-6f);
#pragma unroll
                for (int bj = 0; bj < 2; ++bj) { f32x4 v0 = acc[ai][bj][m][0], v1 = acc[ai][bj][m][1];
                    if (RS) { v0 = v0 * rs; v1 = v1 * rs; }
                    if (ACT == 1) {
#pragma unroll
                        for (int e = 0; e < 4; ++e) { const float a = fmaxf(v0[e], 0.f), b = fmaxf(v1[e], 0.f); v0[e] = a * a; v1[e] = b * b; } }
                    u32x4 w; w.x = cvt_pk_bf16(v0[0], v0[1]); w.y = cvt_pk_bf16(v0[2], v0[3]); w.z = cvt_pk_bf16(v1[0], v1[1]); w.w = cvt_pk_bf16(v1[2], v1[3]);
                    *(u32x4*)(rowp + bj * HALF) = w; } }
    }
};
struct EpiRes {
    static constexpr bool PERM = true, AFTER_DRAIN = false;
    bf16_t* xh; int ldc; unsigned long long* ss;
    __device__ __forceinline__ void operator()(const f32x4 (&acc)[2][2][4][2], const Unit& u, int wr, int wc, int fr, int fq) const {
        const int row0 = u.pm * BM + wr * 64 + fr, col0 = u.pn * BM + wc * 32 + 8 * fq;
#pragma unroll
        for (int ai = 0; ai < 2; ++ai)
#pragma unroll
            for (int m = 0; m < 4; ++m) { const int row = row0 + ai * HALF + m * 16; const size_t off = (size_t)row * ldc + col0; float sq = 0.f;
#pragma unroll
                for (int bj = 0; bj < 2; ++bj) { const u32x4 hv = *(const u32x4*)(xh + off + bj * HALF); u32x4 ho;
#pragma unroll
                    for (int e = 0; e < 4; ++e) { const f32x4& a = acc[ai][bj][m][e >> 1]; const int j = (e & 1) * 2;
                        const float v0 = __uint_as_float(hv[e] << 16) + a[j], v1 = __uint_as_float(hv[e] & 0xffff0000u) + a[j + 1];
                        ho[e] = cvt_pk_bf16(v0, v1); sq += v0 * v0 + v1 * v1; }
                    *(u32x4*)(xh + off + bj * HALF) = ho; }
                sq += __int_as_float(__builtin_amdgcn_ds_swizzle(__float_as_int(sq), 0x1f | (16 << 10)));
                { auto rr = __builtin_amdgcn_permlane32_swap(__float_as_uint(sq), __float_as_uint(sq), false, false); sq = __uint_as_float(rr[0]) + __uint_as_float(rr[1]); }
                if (fq == 0) __hip_atomic_fetch_add(ss + row, (unsigned long long)((double)sq * 1048576.0), __ATOMIC_RELAXED, __HIP_MEMORY_SCOPE_AGENT); }
    }
};
template <class Epi, class Sched, bool ALIGN_EPI = false, bool SP2 = false>
__device__ __forceinline__ void gemm_phase(PG8_LAS unsigned char* lds, const Gemm g, const Sched& S, const Epi& E, const int wid0) {
    const int wid = wid0, lane = fresh_lane(), tid = wid * 64 + lane, wr = wid >> 2, wc = wid & 3, fr = lane & 15, fq = lane >> 4;
    const int K = g.K, nt = K / BK;
    unsigned voffA[2], voffB[2];
#pragma unroll
    for (int i = 0; i < 2; ++i) { int R, C; stage_rc(tid * 16 + i * 8192, R, C); const int Rb = Epi::PERM ? ((R & ~31) + perm32(R & 31)) : R;
        voffA[i] = (unsigned)(R * K + C) * 2u; voffB[i] = (unsigned)(Rb * K + C) * 2u; }
    const size_t kstep = (size_t)(BK * 2);
    const size_t hstep = (size_t)HALF * K * 2;
    const size_t tstep = 2 * hstep;
    const unsigned ldsw = (unsigned)wid * 1024u;
    const int aoff = lds_byte(wr * 64 + fr, fq * 8), boff = lds_byte(wc * 32 + fr, fq * 8);
#define PG8_SA(b, h) (((b) * 2 + (h)) * HTB)
#define PG8_SB(b, h) ((4 + (b) * 2 + (h)) * HTB)
#define PG8_STAGE(bufoff, gbase, voff) do { _Pragma("unroll") for (int _i = 0; _i < 2; ++_i) \
        __builtin_amdgcn_global_load_lds((const unsigned*)((const char*)(gbase) + (voff)[_i]), (PG8_LAS unsigned*)(lds + (bufoff) + ldsw + _i * 8192), 16, 0, 0); } while (0)
#define PG8_LDA(dst, b, h) do { _Pragma("unroll") for (int m = 0; m < 4; ++m) _Pragma("unroll") for (int k = 0; k < 2; ++k) dst[m][k] = *(const PG8_LAS bf16x8*)(lds + PG8_SA(b, h) + aoff + m * 2048 + k * 1024); } while (0)
#define PG8_LDB(dst, b, h) do { _Pragma("unroll") for (int n = 0; n < 2; ++n) _Pragma("unroll") for (int k = 0; k < 2; ++k) dst[n][k] = *(const PG8_LAS bf16x8*)(lds + PG8_SB(b, h) + boff + n * 2048 + k * 1024); } while (0)
#define PG8_MMA(ai, bj, At, Bt) do { __builtin_amdgcn_s_setprio(1); _Pragma("unroll") for (int m = 0; m < 4; ++m) _Pragma("unroll") for (int n = 0; n < 2; ++n) _Pragma("unroll") for (int k = 0; k < 2; ++k) \
        acc[ai][bj][m][n] = __builtin_amdgcn_mfma_f32_16x16x32_bf16(Bt[n][k], At[m][k], acc[ai][bj][m][n], 0, 0, 0); __builtin_amdgcn_s_setprio(0); } while (0)
#define PG8_WAIT_V(n) asm volatile("s_waitcnt vmcnt(" #n ")" ::: "memory")
#define PG8_WAIT_L(n) asm volatile("s_waitcnt lgkmcnt(" #n ")" ::: "memory")
#define PG8_BAR __builtin_amdgcn_s_barrier()
#define PG8_SCHED __builtin_amdgcn_sched_barrier(0)
    Unit cur, nxt; int ui = 0;
    if (!S.next(0, cur)) return;
    f32x4 acc[2][2][4][2];
#pragma unroll
    for (int a = 0; a < 2; ++a)
#pragma unroll
        for (int b = 0; b < 2; ++b)
#pragma unroll
            for (int m = 0; m < 4; ++m)
#pragma unroll
                for (int n = 0; n < 2; ++n) acc[a][b][m][n] = (f32x4){0.f, 0.f, 0.f, 0.f};
    bf16x8 At[4][2], B0[2][2], B1[2][2];
    const char* cA = (const char*)g.A + (size_t)cur.pm * tstep; const char* cB = (const char*)g.Bt + (size_t)cur.pn * tstep;
    S.a_ready(cur);
    if constexpr (SP2) {
        PG8_STAGE(PG8_SB(0, 0), cB, voffB); PG8_STAGE(PG8_SB(0, 1), cB + hstep, voffB); PG8_STAGE(PG8_SA(0, 0), cA, voffA); PG8_STAGE(PG8_SA(0, 1), cA + hstep, voffA);
        if (wr == 1) PG8_BAR;
        PG8_WAIT_V(2); PG8_BAR;
        PG8_STAGE(PG8_SB(1, 0), cB + kstep, voffB); PG8_STAGE(PG8_SA(1, 0), cA + kstep, voffA); PG8_STAGE(PG8_SB(1, 1), cB + hstep + kstep, voffB);
        PG8_WAIT_V(6); PG8_BAR;
    } else {
        PG8_STAGE(PG8_SB(0, 0), cB, voffB); PG8_STAGE(PG8_SA(0, 0), cA, voffA); PG8_STAGE(PG8_SB(0, 1), cB + hstep, voffB); PG8_STAGE(PG8_SA(0, 1), cA + hstep, voffA);
        if (wr == 1) PG8_BAR;
        PG8_WAIT_V(4); PG8_BAR;
        PG8_STAGE(PG8_SB(1, 0), cB + kstep, voffB); PG8_STAGE(PG8_SA(1, 0), cA + kstep, voffA); PG8_STAGE(PG8_SB(1, 1), cB + hstep + kstep, voffB);
        PG8_WAIT_V(6); PG8_BAR;
    }
    for (;;) {
        const bool has_next = S.next(ui + 1, nxt);
        const char* nA = has_next ? (const char*)g.A + (size_t)nxt.pm * tstep : cA; const char* nB = has_next ? (const char*)g.Bt + (size_t)nxt.pn * tstep : cB;
        for (int t = 0; t < nt; t += 2) {
            const bool last = (t == nt - 2);
            const char* a1 = cA + (size_t)(t + 1) * kstep;
            const char* a2 = last ? nA : cA + (size_t)(t + 2) * kstep; const char* b2 = last ? nB : cB + (size_t)(t + 2) * kstep;
            const char* a3 = a2 + kstep; const char* b3 = b2 + kstep;
            if (last && has_next) S.a_ready(nxt);
            if constexpr (SP2) {
            PG8_LDB(B0, 0, 0); PG8_LDB(B1, 0, 1); PG8_SCHED; PG8_LDA(At, 0, 0); PG8_STAGE(PG8_SA(1, 1), a1 + hstep, voffA);
            PG8_WAIT_V(8); PG8_WAIT_L(0); PG8_BAR; PG8_MMA(0, 0, At, B0); PG8_MMA(0, 1, At, B1); PG8_BAR; PG8_SCHED;
            PG8_LDA(At, 0, 1); PG8_STAGE(PG8_SB(0, 0), b2, voffB); PG8_STAGE(PG8_SB(0, 1), b2 + hstep, voffB); PG8_STAGE(PG8_SA(0, 0), a2, voffA);
            PG8_WAIT_V(8); PG8_WAIT_L(0); PG8_BAR; PG8_MMA(1, 0, At, B0); PG8_MMA(1, 1, At, B1); PG8_BAR; PG8_SCHED;
            PG8_LDB(B0, 1, 0); PG8_LDB(B1, 1, 1); PG8_SCHED; PG8_LDA(At, 1, 0); PG8_STAGE(PG8_SA(0, 1), a2 + hstep, voffA);
            PG8_WAIT_V(8); PG8_WAIT_L(0); PG8_BAR; PG8_MMA(0, 0, At, B0); PG8_MMA(0, 1, At, B1); PG8_BAR; PG8_SCHED;
            PG8_LDA(At, 1, 1); PG8_STAGE(PG8_SB(1, 0), b3, voffB); PG8_STAGE(PG8_SB(1, 1), b3 + hstep, voffB); PG8_STAGE(PG8_SA(1, 0), a3, voffA);
            PG8_WAIT_V(8); PG8_WAIT_L(0); PG8_BAR; PG8_MMA(1, 0, At, B0); PG8_MMA(1, 1, At, B1); PG8_BAR; PG8_SCHED;
            } else {
            PG8_LDB(B0, 0, 0); PG8_SCHED; PG8_LDA(At, 0, 0); PG8_STAGE(PG8_SA(1, 1), a1 + hstep, voffA);
            PG8_WAIT_L(8); PG8_BAR; PG8_WAIT_L(0); PG8_MMA(0, 0, At, B0); PG8_BAR; PG8_SCHED;
            PG8_LDB(B1, 0, 1); PG8_STAGE(PG8_SB(0, 0), b2, voffB);
            PG8_BAR; PG8_WAIT_L(0); PG8_MMA(0, 1, At, B1); PG8_BAR;
            PG8_LDA(At, 0, 1); PG8_STAGE(PG8_SA(0, 0), a2, voffA);
            PG8_BAR; PG8_WAIT_L(0); PG8_MMA(1, 0, At, B0); PG8_BAR; PG8_SCHED;
            PG8_STAGE(PG8_SB(0, 1), b2 + hstep, voffB);
            PG8_WAIT_V(6); PG8_BAR; PG8_MMA(1, 1, At, B1); PG8_BAR;
            PG8_LDB(B0, 1, 0); PG8_SCHED; PG8_LDA(At, 1, 0); PG8_STAGE(PG8_SA(0, 1), a2 + hstep, voffA);
            PG8_WAIT_L(8); PG8_BAR; PG8_WAIT_L(0); PG8_MMA(0, 0, At, B0); PG8_BAR; PG8_SCHED;
            PG8_LDB(B1, 1, 1); PG8_STAGE(PG8_SB(1, 0), b3, voffB);
            PG8_BAR; PG8_WAIT_L(0); PG8_MMA(0, 1, At, B1); PG8_BAR;
            PG8_LDA(At, 1, 1); PG8_STAGE(PG8_SA(1, 0), a3, voffA);
            PG8_BAR; PG8_WAIT_L(0); PG8_MMA(1, 0, At, B0); PG8_BAR; PG8_SCHED;
            PG8_STAGE(PG8_SB(1, 1), b3 + hstep, voffB);
            PG8_WAIT_V(6); PG8_BAR; PG8_MMA(1, 1, At, B1); PG8_BAR;
            }
        }
        if constexpr (ALIGN_EPI) { if (wr == 0) PG8_BAR; }
        if constexpr (!Epi::AFTER_DRAIN) { E(acc, cur, wr, wc, fr, fq); S.done(cur); }
        if (!has_next) break;
#pragma unroll
        for (int a = 0; a < 2; ++a)
#pragma unroll
            for (int b = 0; b < 2; ++b)
#pragma unroll
                for (int m = 0; m < 4; ++m)
#pragma unroll
                    for (int n = 0; n < 2; ++n) acc[a][b][m][n] = (f32x4){0.f, 0.f, 0.f, 0.f};
        cur = nxt; cA = nA; cB = nB; ++ui;
        if constexpr (ALIGN_EPI) { if (wr == 1) PG8_BAR; }
    }
    PG8_WAIT_V(0);
    if constexpr (!ALIGN_EPI) { if (wr == 0) PG8_BAR; }
    PG8_BAR;
    if constexpr (Epi::AFTER_DRAIN) { E.fused(acc, cur, wr, wc, fr, fq, lds, wid, lane); S.done(cur); }
#undef PG8_SA
#undef PG8_SB
#undef PG8_STAGE
#undef PG8_LDA
#undef PG8_LDB
#undef PG8_MMA
#undef PG8_WAIT_V
#undef PG8_WAIT_L
#undef PG8_BAR
#undef PG8_SCHED
}
}
#define GAS __attribute__((address_space(1)))
#define LAS __attribute__((address_space(3)))
typedef unsigned short bf16;
typedef unsigned v4u __attribute__((ext_vector_type(4)));
typedef float f32x4 __attribute__((ext_vector_type(4)));
typedef short bf16x8 __attribute__((ext_vector_type(8)));
typedef GAS unsigned gu32;
typedef GAS unsigned long long gu64;
#define RLX_AGENT __ATOMIC_RELAXED, __HIP_MEMORY_SCOPE_AGENT
#define LDS_WAIT() asm volatile("s_waitcnt lgkmcnt(0)" ::: "memory")
#define VM_WAIT() asm volatile("s_waitcnt vmcnt(0)" ::: "memory")
__device__ __forceinline__ unsigned long long rt() { return __builtin_amdgcn_s_memrealtime(); }
__device__ __forceinline__ unsigned f2bf(float f) { unsigned u = __builtin_bit_cast(unsigned, f); return (u + 0x7fffu + ((u >> 16) & 1u)) >> 16; }
__device__ __forceinline__ unsigned pk2(float lo, float hi) { return f2bf(lo) | (f2bf(hi) << 16); }

#define XB_TMO      128
#define XB_XCNT(j)  (256  + 64 * (j))
#define XB_XSUB(j)  (1280 + 64 * (j))
#define XB_XGEN(j)  (2304 + 64 * (j))
#define XB_TOP      3328
#define XB_TOPGEN   3392
#define XCD_BAR_WORDS 3456
#define XB_SPIN_CAP (1u << 18)

__device__ __forceinline__ unsigned xb_ld(unsigned* p)              { return __hip_atomic_load(p, __ATOMIC_RELAXED, __HIP_MEMORY_SCOPE_AGENT); }
__device__ __forceinline__ unsigned xb_add(unsigned* p, unsigned v) { return __hip_atomic_fetch_add(p, v, __ATOMIC_RELAXED, __HIP_MEMORY_SCOPE_AGENT); }
__device__ __forceinline__ unsigned xb_xcc_id() { return (unsigned)__builtin_amdgcn_s_getreg((3 << 11) | 20) & 0xFu; }
#define XB_SPIN(cond, bar) do { unsigned _sp = 0; while (cond) { __builtin_amdgcn_s_sleep(1); \
    if ((++_sp & 255u) == 0u) { if (xb_ld(&(bar)[XB_TMO])) break; if (_sp > XB_SPIN_CAP) { atomicAdd(&(bar)[XB_TMO], 1u); break; } } } } while (0)

struct XcdBarrier {
    unsigned* bar; unsigned x;
    volatile LAS unsigned* st;
};

__device__ __forceinline__ XcdBarrier xcd_barrier_post(unsigned* bar, volatile LAS unsigned* st, const int wid0) {
    XcdBarrier b; b.bar = bar; b.x = xb_xcc_id(); b.st = st;
    if (wid0 == 0 && fresh_lane() == 0) (void)xb_add(&bar[XB_XCNT(b.x)], 1u);
    return b;
}
__device__ __forceinline__ void xcd_barrier_complete(unsigned* bar, unsigned x, unsigned& nloc, unsigned& nx) {
    const unsigned G = gridDim.x * gridDim.y * gridDim.z;
    unsigned sum, cnt, mine, sp = 0u;
    for (;;) {
        sum = 0u; cnt = 0u; mine = 0u;
#pragma unroll 1
        for (unsigned j = 0; j < 16; ++j) { const unsigned c = xb_ld(&bar[XB_XCNT(j)]); sum += c; cnt += (c > 0u) ? 1u : 0u; mine = (j == x) ? c : mine; }
        if (sum == G) break;
        __builtin_amdgcn_s_sleep(1);
        if ((++sp & 255u) == 0u) { if (xb_ld(&bar[XB_TMO])) break; if (sp > XB_SPIN_CAP) { atomicAdd(&bar[XB_TMO], 1u); break; } }
    }
    nloc = mine > 0u ? mine : 1u; nx = cnt > 0u ? cnt : 1u;
}

__device__ __forceinline__ void xcd_barrier(const XcdBarrier& b, const int wid0) {
    asm volatile("s_waitcnt vmcnt(0)" ::: "memory");
    __syncthreads();
    if (wid0 == 0 && fresh_lane() == 0) {
        unsigned* bar = b.bar;
        __builtin_amdgcn_s_waitcnt(0);
        unsigned nloc = b.st[0], nx = b.st[1];
        const unsigned bx_ = xb_xcc_id();
        if (nloc == 0u) { xcd_barrier_complete(bar, bx_, nloc, nx); b.st[0] = nloc; b.st[1] = nx; }
        const unsigned old = xb_add(&bar[XB_XSUB(bx_)], 1u);
        const unsigned gen = old / nloc;
        if (old + 1u == (gen + 1u) * nloc) {
            __builtin_amdgcn_fence(__ATOMIC_RELEASE, "agent");
            asm volatile("s_waitcnt vmcnt(0)" ::: "memory");
            const unsigned og = xb_add(&bar[XB_TOP], 1u);
            const unsigned tg = og / nx;
            if (og + 1u == (tg + 1u) * nx) xb_add(&bar[XB_TOPGEN], 1u);
            else XB_SPIN(xb_ld(&bar[XB_TOPGEN]) == tg, bar);
            __builtin_amdgcn_fence(__ATOMIC_ACQUIRE, "agent");
            xb_add(&bar[XB_XGEN(bx_)], 1u);
            asm volatile("s_waitcnt vmcnt(0)" ::: "memory");
        } else {
            XB_SPIN(xb_ld(&bar[XB_XGEN(bx_)]) == gen, bar);
            __builtin_amdgcn_fence(__ATOMIC_ACQUIRE, "agent");
            asm volatile("s_waitcnt vmcnt(0)" ::: "memory");
        }
    }
    __syncthreads();
}
constexpr int NWAVES = 8;
constexpr int NB = 2, SEQ = 4096, DM = 4096, NL = 2, M = NB * SEQ;
constexpr int INC = 11336, INP = 11520;
constexpr int A_Q = 0, B_CQ = 3072, B_CKV = 4608, B_KR = 5120, C_Q = 5184, D_Q = 8256, D_F = 11328;
constexpr int QRANK = 1536, KVRANK = 512, DFF = 16384, MEMT = 256;
constexpr int P4DEF = 64 * 8 * 4;
constexpr int UPDEF = 88 * 8 * 8;
constexpr float EPS = 1e-6f;

constexpr size_t MiB = 1u << 20;
constexpr size_t WS_CTL = 0, CTL_ZERO_BYTES = 1 * MiB;
constexpr size_t WS_COS = 1 * MiB, WS_SIN = 2 * MiB;
constexpr size_t WS_LUT = 3 * MiB;
constexpr size_t WS_TPMAX = 3 * MiB + 8192;
constexpr size_t WS_LAM = 3 * MiB + 12288;
constexpr size_t WS_LOGF = 4 * MiB, WS_NEGC = 4 * MiB + 512 * 1024;
constexpr size_t WS_W = 8 * MiB;
constexpr size_t SZ_IN = (size_t)INP * DM * 2, SZ_OUT = (size_t)DM * DM * 2, SZ_UQ = (size_t)1536 * 1536 * 2, SZ_UKV = (size_t)2048 * 512 * 2,
                 SZ_MQ = (size_t)512 * DM * 2, SZ_MKV = (size_t)1024 * DM * 2, SZ_MO = (size_t)DM * 512 * 2, SZ_UP = (size_t)DFF * DM * 2, SZ_DN = SZ_UP;
constexpr size_t W_IN = 0, W_OUT = W_IN + SZ_IN, W_UQ = W_OUT + SZ_OUT, W_UKV = W_UQ + SZ_UQ, W_MQ = W_UKV + SZ_UKV, W_MKV = W_MQ + SZ_MQ, W_MO = W_MKV + SZ_MKV,
                 W_UP = W_MO + SZ_MO, W_DN = W_UP + SZ_UP, W_LAYER = W_DN + SZ_DN;
static_assert(W_LAYER % 256 == 0, "weight block alignment");
constexpr size_t WS_MEMN = WS_W + NL * W_LAYER;
constexpr size_t WS_KVMEM = WS_MEMN + (size_t)NL * 512 * DM * 2;
constexpr size_t WS_H = WS_KVMEM + (size_t)NL * 512 * 1024 * 2;
constexpr size_t WS_CQN = WS_H + (size_t)M * DM * 2;
constexpr size_t WS_CKVN = WS_CQN + (size_t)M * 1536 * 2;
constexpr size_t WS_KPE = WS_CKVN + (size_t)M * 512 * 2;
constexpr size_t WS_QMLA = WS_KPE + (size_t)M * 64 * 2;
constexpr size_t WS_KVMLA = WS_QMLA + (size_t)M * 1536 * 2;
constexpr size_t WS_QMEM = WS_KVMLA + (size_t)M * 2048 * 2;
constexpr size_t WS_OMEM = WS_QMEM + (size_t)M * 512 * 2;
constexpr size_t WS_XL = WS_OMEM + (size_t)M * 512 * 2;
constexpr size_t WS_U = WS_XL + (size_t)M * DM * 2;
constexpr size_t WS_PROJ = WS_U;
constexpr size_t WS_MIX = WS_PROJ + (size_t)M * INP * 2;
static_assert(WS_MIX + (size_t)M * DM * 2 <= WS_U + (size_t)M * DFF * 2, "PROJ + MIX fit inside U");
constexpr size_t WS_END = WS_U + (size_t)M * DFF * 2;
constexpr int CW_BAR = 4096;
constexpr int CW_SS = 32768;
constexpr int CW_KN = 24576;
constexpr int CW_TKT = 16384;

constexpr int RING_OFF = 0, RING_BYTES = 137216;
constexpr int LDSCTL_OFF = RING_BYTES, MISC_OFF = LDSCTL_OFF + 320;
constexpr int LDS_BYTES = 147456;

typedef unsigned short bf16;
typedef short bf16x8 __attribute__((ext_vector_type(8)));
typedef short s16x4 __attribute__((ext_vector_type(4)));
typedef float f32x4 __attribute__((ext_vector_type(4)));
typedef float f32x16 __attribute__((ext_vector_type(16)));
typedef unsigned v4u __attribute__((ext_vector_type(4)));
typedef unsigned v2u __attribute__((ext_vector_type(2)));
typedef int i32x4 __attribute__((ext_vector_type(4)));

__device__ __forceinline__ unsigned cvtpk(float lo, float hi) { unsigned r; asm volatile("v_cvt_pk_bf16_f32 %0, %1, %2" : "=v"(r) : "v"(lo), "v"(hi)); return r; }
__device__ __forceinline__ float bf2f(short s) { return __uint_as_float(((unsigned)(unsigned short)s) << 16); }
template <int X> __device__ __forceinline__ float shx(float v) { return __int_as_float(__builtin_amdgcn_ds_swizzle(__float_as_int(v), 0x1f | (X << 10))); }
template <int X> __device__ __forceinline__ int shxi(int v) { return __builtin_amdgcn_ds_swizzle(v, 0x1f | (X << 10)); }
__device__ __forceinline__ float half_sum(float v) { v += shx<1>(v); v += shx<2>(v); v += shx<4>(v); v += shx<8>(v); v += shx<16>(v); return v; }
__device__ __forceinline__ float wave_sum(float v) { v = half_sum(v);
    auto rr = __builtin_amdgcn_permlane32_swap(__float_as_uint(v), __float_as_uint(v), false, false); return __uint_as_float(rr[0]) + __uint_as_float(rr[1]); }
#define FRESH_LANE(name) const int name = fresh_lane()
#define WAITBAR() asm volatile("s_waitcnt vmcnt(0) lgkmcnt(0)\n\ts_barrier" ::: "memory")

__device__ __forceinline__ void tr_item(const float* W, int K, int N, int nblk, bf16* WT, int row_off, LAS float* scr, int item, int lane, const float* gk) {
    const int kb = item / nblk, nb = item - kb * nblk, k0 = 64 * kb, n0 = 64 * nb;
    const int c4 = (lane & 15) * 4, rr = lane >> 4; const bool ok = n0 + c4 < N;
    const GAS f32x4* src = (const GAS f32x4*)(W + (size_t)(k0 + rr) * N + n0 + c4);
    f32x4 v[16];
#pragma unroll
    for (int i = 0; i < 16; ++i) v[i] = ok ? __builtin_nontemporal_load((const GAS f32x4*)((const GAS float*)src + (size_t)(4 * i) * N)) : (f32x4){0.f, 0.f, 0.f, 0.f};
    if (gk) {
#pragma unroll
        for (int i = 0; i < 16; ++i) v[i] = v[i] * gk[k0 + 4 * i + rr]; }
#pragma unroll
    for (int i = 0; i < 16; ++i) { LAS float* s = scr + (4 * i + rr) * 65 + c4; s[0] = v[i].x; s[1] = v[i].y; s[2] = v[i].z; s[3] = v[i].w; }
    LDS_WAIT(); asm volatile("" ::: "memory");
    const int c = lane & 7;
#pragma unroll
    for (int j = 0; j < 8; ++j) { const int nn = (lane >> 3) + 8 * j; const LAS float* s = scr + (8 * c) * 65 + nn;
        v4u o; o.x = cvtpk(s[0 * 65], s[1 * 65]); o.y = cvtpk(s[2 * 65], s[3 * 65]); o.z = cvtpk(s[4 * 65], s[5 * 65]); o.w = cvtpk(s[6 * 65], s[7 * 65]);
        *(GAS v4u*)(WT + (size_t)(row_off + n0 + nn) * K + k0 + 8 * c) = o; }
    LDS_WAIT(); asm volatile("" ::: "memory");
}
template <bool BF> __device__ __forceinline__ void rms_row(const float* xrow, const float* g, void* orow, int lane) {
    const GAS f32x4* xr = (const GAS f32x4*)xrow + lane; const GAS f32x4* gr = (const GAS f32x4*)g + lane;
    f32x4 v[16]; float s = 0.f;
#pragma unroll
    for (int j = 0; j < 16; ++j) { v[j] = xr[64 * j]; s += (v[j].x * v[j].x + v[j].y * v[j].y) + (v[j].z * v[j].z + v[j].w * v[j].w); }
    const float rstd = 1.0f / sqrtf(wave_sum(s) * (1.f / DM) + EPS);
#pragma unroll
    for (int j = 0; j < 16; ++j) { const f32x4 gg = gr[64 * j]; const f32x4 y = v[j] * rstd * gg;
        if (BF) { v2u w; w.x = cvtpk(y.x, y.y); w.y = cvtpk(y.z, y.w); ((GAS v2u*)orow)[64 * j + lane] = w; }
        else ((GAS f32x4*)orow)[64 * j + lane] = y; }
}
__device__ __forceinline__ void cast_row(const float* xrow, bf16* hrow, unsigned long long* ss, int lane) {
    const GAS f32x4* xr = (const GAS f32x4*)xrow + lane; float s = 0.f;
#pragma unroll
    for (int j = 0; j < 16; ++j) { const f32x4 v = xr[64 * j]; s += (v.x * v.x + v.y * v.y) + (v.z * v.z + v.w * v.w);
        v2u h; h.x = cvtpk(v.x, v.y); h.y = cvtpk(v.z, v.w); ((GAS v2u*)hrow)[64 * j + lane] = h; }
    s = wave_sum(s); if (lane == 0) *ss = (unsigned long long)((double)s * 1048576.0);
}
__device__ __forceinline__ void final_row(const bf16* hrow, const float* g, float* orow, int lane) {
    f32x4 v[16]; float s = 0.f;
#pragma unroll
    for (int j = 0; j < 16; ++j) { const v2u h = ((const GAS v2u*)hrow)[64 * j + lane];
        v[j].x = __uint_as_float(h.x << 16); v[j].y = __uint_as_float(h.x & 0xffff0000u); v[j].z = __uint_as_float(h.y << 16); v[j].w = __uint_as_float(h.y & 0xffff0000u);
        s += (v[j].x * v[j].x + v[j].y * v[j].y) + (v[j].z * v[j].z + v[j].w * v[j].w); }
    const float rstd = 1.0f / sqrtf(wave_sum(s) * (1.f / DM) + EPS);
#pragma unroll
    for (int j = 0; j < 16; ++j) { const f32x4 gg = ((const GAS f32x4*)g)[64 * j + lane]; ((GAS f32x4*)orow)[64 * j + lane] = v[j] * rstd * gg; }
}
__device__ __forceinline__ float logsigmoidf_(float x) {
    const float e = __expf(-fabsf(x)); return fminf(x, 0.f) - __logf(1.f + e);
}
__device__ __forceinline__ void prep_row(const bf16* proj, int m, const float* gq, const float* gkv, const float* bf, const float* COS, const float* SIN,
                                         bf16* CQN, bf16* CKVN, bf16* KPE, float* LOGF, unsigned* KN2, int lane) {
    const bf16* pr = proj + (size_t)m * INP;
    bf16x8 q[3]; float sq = 0.f;
#pragma unroll
    for (int j = 0; j < 3; ++j) { q[j] = *(const GAS bf16x8*)(pr + B_CQ + (j * 64 + lane) * 8);
#pragma unroll
        for (int e = 0; e < 8; ++e) { const float f = bf2f(q[j][e]); sq += f * f; } }
    const bf16x8 kv = *(const GAS bf16x8*)(pr + B_CKV + lane * 8); float skv = 0.f;
#pragma unroll
    for (int e = 0; e < 8; ++e) { const float f = bf2f(kv[e]); skv += f * f; }
    const float rq = 1.0f / sqrtf(wave_sum(sq) * (1.f / QRANK) + EPS), rkv = 1.0f / sqrtf(wave_sum(skv) * (1.f / KVRANK) + EPS);
#pragma unroll
    for (int j = 0; j < 3; ++j) { const int c0 = (j * 64 + lane) * 8; const f32x4 g0 = *(const GAS f32x4*)(gq + c0), g1 = *(const GAS f32x4*)(gq + c0 + 4);
        v4u w; w.x = cvtpk(bf2f(q[j][0]) * rq * g0.x, bf2f(q[j][1]) * rq * g0.y); w.y = cvtpk(bf2f(q[j][2]) * rq * g0.z, bf2f(q[j][3]) * rq * g0.w);
        w.z = cvtpk(bf2f(q[j][4]) * rq * g1.x, bf2f(q[j][5]) * rq * g1.y); w.w = cvtpk(bf2f(q[j][6]) * rq * g1.z, bf2f(q[j][7]) * rq * g1.w);
        *(GAS v4u*)(CQN + (size_t)m * QRANK + c0) = w; }
    { const int c0 = lane * 8; const f32x4 g0 = *(const GAS f32x4*)(gkv + c0), g1 = *(const GAS f32x4*)(gkv + c0 + 4);
        v4u w; w.x = cvtpk(bf2f(kv[0]) * rkv * g0.x, bf2f(kv[1]) * rkv * g0.y); w.y = cvtpk(bf2f(kv[2]) * rkv * g0.z, bf2f(kv[3]) * rkv * g0.w);
        w.z = cvtpk(bf2f(kv[4]) * rkv * g1.x, bf2f(kv[5]) * rkv * g1.y); w.w = cvtpk(bf2f(kv[6]) * rkv * g1.z, bf2f(kv[7]) * rkv * g1.w);
        *(GAS v4u*)(CKVN + (size_t)m * KVRANK + c0) = w; }
    { const float v = bf2f((short)pr[B_KR + lane]); float pv; { auto rr = __builtin_amdgcn_permlane32_swap(__float_as_uint(v), __float_as_uint(v), false, false); pv = __uint_as_float(lane >= 32 ? rr[0] : rr[1]); } const int i = lane & 31;
      const float c = COS[(size_t)m * 32 + i], s = SIN[(size_t)m * 32 + i];
      const float o = lane < 32 ? v * c - pv * s : pv * s + v * c;
      const float on = shx<1>(o);
      if ((lane & 1) == 0) *(GAS unsigned*)(KPE + (size_t)m * 64 + lane) = cvtpk(o, on); }
    if (lane < 8) { const float f = bf2f((short)pr[D_F + lane]) + bf[lane]; const int b = m / SEQ, s = m - b * SEQ; LOGF[(size_t)(b * 8 + lane) * SEQ + s] = logsigmoidf_(f); }
    { const bf16x8 k0 = *(const GAS bf16x8*)(pr + D_Q + 1024 + lane * 16), k1 = *(const GAS bf16x8*)(pr + D_Q + 1024 + lane * 16 + 8); float s = 0.f;
#pragma unroll
      for (int e = 0; e < 8; ++e) { const float a = bf2f(k0[e]), c = bf2f(k1[e]); s += a * a + c * c; }
      s += shx<1>(s); s += shx<2>(s); s += shx<4>(s);
      if ((lane & 7) == 0) { unsigned* p = KN2 + (m / SEQ) * 8 + (lane >> 3); const unsigned v = __float_as_uint(s);
          if (v > __hip_atomic_load(p, __ATOMIC_RELAXED, __HIP_MEMORY_SCOPE_AGENT)) __hip_atomic_fetch_max(p, v, __ATOMIC_RELAXED, __HIP_MEMORY_SCOPE_AGENT); } }
}
__device__ __forceinline__ void fox_scan(const float* logf, float* negc, int lane) {
    const GAS f32x4* src = (const GAS f32x4*)(logf + lane * 64); f32x4 v[16]; float tot = 0.f;
#pragma unroll
    for (int j = 0; j < 16; ++j) { v[j] = src[j]; tot += (v[j].x + v[j].y) + (v[j].z + v[j].w); }
    float inc = tot;
#pragma unroll
    for (int o = 1; o < 64; o <<= 1) { const float t = __int_as_float(__builtin_amdgcn_ds_bpermute((lane - o) << 2, __float_as_int(inc))); if (lane >= o) inc += t; }
    float run = inc - tot; const float k = -11.313708498984761f;
    GAS f32x4* dst = (GAS f32x4*)(negc + lane * 64);
#pragma unroll
    for (int j = 0; j < 16; ++j) { f32x4 o; run += v[j].x; o.x = run * k; run += v[j].y; o.y = run * k; run += v[j].z; o.z = run * k; run += v[j].w; o.w = run * k; dst[j] = o; }
}

namespace att {
constexpr int VA = 0, VB = 1, VC = 2, VD = 3, VE = 4;
constexpr int K_OFF = 0, V_OFF = 32768, B_OFF = 65536, WS_OFF = 67584, LUT_OFF = 69632, FLG_OFF = 70656, TKT_OFF = 70784, KPE_OFF = 71680, QF_OFF = 71680, ATT_END = QF_OFF + 65536;
constexpr float LOG2E = 1.4426950408889634f, LN2 = 0.6931471805599453f, THR = 8.f;
struct Ctx { const bf16* PROJ; const bf16* QMLA; const bf16* KVMLA; const bf16* KPE; bf16* MIX; const bf16* QMEM; const bf16* KVMEM; bf16* OMEM;
             const float* COS; const float* SIN; const float* LUT; const int* TPMAX; const int* pos; const float* NEGC; const float* sub_g; const unsigned* KN2; float lam, oml; };

__device__ __forceinline__ int crow(int r, int hi) { return (r & 3) + 8 * (r >> 2) + 4 * hi; }
__device__ __forceinline__ int swap23(int k) { return (k & ~0xC) | ((k & 4) << 1) | ((k & 8) >> 1); }
__device__ __forceinline__ float pmaxf(float v) { auto rr = __builtin_amdgcn_permlane32_swap(__float_as_uint(v), __float_as_uint(v), false, false); return fmaxf(__uint_as_float(rr[0]), __uint_as_float(rr[1])); }
__device__ __forceinline__ float psumf(float v) { auto rr = __builtin_amdgcn_permlane32_swap(__float_as_uint(v), __float_as_uint(v), false, false); return __uint_as_float(rr[0]) + __uint_as_float(rr[1]); }
__device__ __forceinline__ float partnerf(float v, int hi) { auto rr = __builtin_amdgcn_permlane32_swap(__float_as_uint(v), __float_as_uint(v), false, false); return __uint_as_float(hi ? rr[0] : rr[1]); }
__device__ __forceinline__ void dma16(const void* sbase, unsigned voff, unsigned ldsaddr) { unsigned keep;
    asm volatile("s_mov_b32 %0, m0\n\ts_mov_b32 m0, %3\n\ts_nop 0\n\tglobal_load_lds_dwordx4 %1, %2\n\ts_mov_b32 m0, %0" : "=&s"(keep) : "v"(voff), "s"(sbase), "s"(ldsaddr) : "memory"); }

template <int NK> __device__ __forceinline__ void qk(f32x16& p0, f32x16& p1, const LAS unsigned char* krow, int xr, int hx, const bf16x8* qf, int dstart) {
#pragma unroll
    for (int d0 = 0; d0 < NK; ++d0) { const int off = (((dstart + d0) * 32 + hx) ^ xr);
        const bf16x8 b0 = *(const LAS bf16x8*)(krow + off), b1 = *(const LAS bf16x8*)(krow + off + 8192);
        p0 = __builtin_amdgcn_mfma_f32_32x32x16_bf16(b0, qf[d0], p0, 0, 0, 0); p1 = __builtin_amdgcn_mfma_f32_32x32x16_bf16(b1, qf[d0], p1, 0, 0, 0); }
}
template <int NK> __device__ __forceinline__ void qk_l(f32x16& p0, f32x16& p1, const LAS unsigned char* krow, int xr, int hx, const LAS unsigned char* qlds, int dstart) {
#pragma unroll
    for (int d0 = 0; d0 < NK; ++d0) { const int off = (((dstart + d0) * 32 + hx) ^ xr);
        const bf16x8 b0 = *(const LAS bf16x8*)(krow + off), b1 = *(const LAS bf16x8*)(krow + off + 8192), q = *(const LAS bf16x8*)(qlds + (dstart + d0) * 1024);
        p0 = __builtin_amdgcn_mfma_f32_32x32x16_bf16(b0, q, p0, 0, 0, 0); p1 = __builtin_amdgcn_mfma_f32_32x32x16_bf16(b1, q, p1, 0, 0, 0); }
}
__device__ __forceinline__ void qk_pe(f32x16& p0, f32x16& p1, const LAS unsigned char* perow, int xpe, int hx, const bf16x8* qf) {
#pragma unroll
    for (int d0 = 0; d0 < 4; ++d0) { const int off = ((d0 * 32 + hx) ^ xpe);
        const bf16x8 b0 = *(const LAS bf16x8*)(perow + off), b1 = *(const LAS bf16x8*)(perow + off + 4096);
        p0 = __builtin_amdgcn_mfma_f32_32x32x16_bf16(b0, qf[d0], p0, 0, 0, 0); p1 = __builtin_amdgcn_mfma_f32_32x32x16_bf16(b1, qf[d0], p1, 0, 0, 0); }
}
__device__ __forceinline__ void pv(f32x16* o, unsigned vb, bf16x8 pa0, bf16x8 pa1, bf16x8 pa2, bf16x8 pa3) {
#define TRRD(dst, off) asm volatile("ds_read_b64_tr_b16 %0, %1 offset:%2" : "=&v"(dst) : "v"(vb), "i"(off) : "memory")
#define PV_D0(d0) do { s16x4 l0, l1, l2, l3, h0, h1, h2, h3; constexpr int b_ = (d0) * 512; \
        TRRD(l0, b_); TRRD(h0, b_ + 2048); TRRD(l1, b_ + 4096); TRRD(h1, b_ + 6144); TRRD(l2, b_ + 8192); TRRD(h2, b_ + 10240); TRRD(l3, b_ + 12288); TRRD(h3, b_ + 14336); \
        asm volatile("s_waitcnt lgkmcnt(0)" ::: "memory"); __builtin_amdgcn_sched_barrier(0); \
        o[d0] = __builtin_amdgcn_mfma_f32_32x32x16_bf16(pa0, (bf16x8){l0[0], l0[1], l0[2], l0[3], h0[0], h0[1], h0[2], h0[3]}, o[d0], 0, 0, 0); \
        o[d0] = __builtin_amdgcn_mfma_f32_32x32x16_bf16(pa1, (bf16x8){l1[0], l1[1], l1[2], l1[3], h1[0], h1[1], h1[2], h1[3]}, o[d0], 0, 0, 0); \
        o[d0] = __builtin_amdgcn_mfma_f32_32x32x16_bf16(pa2, (bf16x8){l2[0], l2[1], l2[2], l2[3], h2[0], h2[1], h2[2], h2[3]}, o[d0], 0, 0, 0); \
        o[d0] = __builtin_amdgcn_mfma_f32_32x32x16_bf16(pa3, (bf16x8){l3[0], l3[1], l3[2], l3[3], h3[0], h3[1], h3[2], h3[3]}, o[d0], 0, 0, 0); } while (0)
    PV_D0(0); PV_D0(1); PV_D0(2); PV_D0(3);
#undef PV_D0
#undef TRRD
}
__device__ __forceinline__ void pack_p(const f32x16& p0, const f32x16& p1, bf16x8& pa0, bf16x8& pa1, bf16x8& pa2, bf16x8& pa3) {
#define PK4(P, B_, OUT) do { unsigned a0 = cvtpk(P[B_ + 0], P[B_ + 1]), a1 = cvtpk(P[B_ + 2], P[B_ + 3]), b0 = cvtpk(P[B_ + 4], P[B_ + 5]), b1 = cvtpk(P[B_ + 6], P[B_ + 7]); \
        auto r0 = __builtin_amdgcn_permlane32_swap(a0, b0, false, false); auto r1 = __builtin_amdgcn_permlane32_swap(a1, b1, false, false); \
        v4u w = {r0[0], r1[0], r0[1], r1[1]}; OUT = __builtin_bit_cast(bf16x8, w); } while (0)
    PK4(p0, 0, pa0); PK4(p0, 8, pa1); PK4(p1, 0, pa2); PK4(p1, 8, pa3);
#undef PK4
}
__device__ __forceinline__ void softmax_pv(f32x16& p0, f32x16& p1, float& m, float& l, f32x16* o, LAS float* wsf, unsigned vb, int r32, int hi, const float SCALE, const float C2) {
    float mx0 = fmaxf(p0[0], p1[0]), mx1 = fmaxf(p0[1], p1[1]), mx2 = fmaxf(p0[2], p1[2]), mx3 = fmaxf(p0[3], p1[3]);
#pragma unroll
    for (int r = 4; r < 16; r += 4) { mx0 = fmaxf(fmaxf(mx0, p0[r]), p1[r]); mx1 = fmaxf(fmaxf(mx1, p0[r + 1]), p1[r + 1]); mx2 = fmaxf(fmaxf(mx2, p0[r + 2]), p1[r + 2]); mx3 = fmaxf(fmaxf(mx3, p0[r + 3]), p1[r + 3]); }
    float pmax = pmaxf(fmaxf(fmaxf(mx0, mx1), fmaxf(mx2, mx3)));
    float mn, alpha;
    if (__all((pmax - m) * SCALE <= THR)) { mn = m; alpha = 1.f; }
    else { mn = fmaxf(m, pmax); alpha = __builtin_amdgcn_exp2f((m - mn) * C2); m = mn; }
    const float mnL = -mn * C2;
#pragma unroll
    for (int r = 0; r < 16; ++r) { p0[r] = __builtin_amdgcn_exp2f(fmaf(p0[r], C2, mnL)); p1[r] = __builtin_amdgcn_exp2f(fmaf(p1[r], C2, mnL)); }
    float s0 = p0[0] + p1[0], s1 = p0[1] + p1[1], s2 = p0[2] + p1[2], s3 = p0[3] + p1[3];
#pragma unroll
    for (int r = 4; r < 16; r += 4) { s0 += p0[r] + p1[r]; s1 += p0[r + 1] + p1[r + 1]; s2 += p0[r + 2] + p1[r + 2]; s3 += p0[r + 3] + p1[r + 3]; }
    const float ps = psumf((s0 + s1) + (s2 + s3)); l = l * alpha + ps;
    bf16x8 pa0, pa1, pa2, pa3; pack_p(p0, p1, pa0, pa1, pa2, pa3);
    if (__any(alpha < 1.f)) { const int fl = fresh_lane(), fh = fl >> 5;
        if (fh == 0) wsf[fl] = alpha; asm volatile("s_waitcnt lgkmcnt(0)" ::: "memory");
#pragma unroll
        for (int r = 0; r < 16; ++r) { const float a = wsf[crow(r, fh)];
#pragma unroll
            for (int d = 0; d < 4; ++d) o[d][r] *= a; } }
    pv(o, vb, pa0, pa1, pa2, pa3);
}

template <int VAR>
__device__ __forceinline__ void attn_unit(const Ctx& C, int b, int h, int qb, LAS unsigned char* lds, int tid, int wid, int lane) {
    constexpr bool CAUSAL = VAR != VE, DESC = (VAR == VC || VAR == VD), MLA = (VAR == VB), DIFF = (VAR == VA), STICK = (VAR == VC), HASB = (VAR == VA || VAR == VD);
    constexpr int NQF = MLA ? 12 : 8;
    constexpr float SCALE = DIFF ? 0.125f : (MLA ? 0.07216878364870323f : 0.08838834764831845f);
    constexpr float C2 = SCALE * LOG2E;
    const int r32 = lane & 31, hi = lane >> 5;
    const int q0 = qb * 256, qw = q0 + wid * 32, trow = qw + r32;
    const size_t rb = (size_t)b * SEQ;
    const bf16 *Qp, *Kp, *Vp; bf16* Op; int qpitch, kpitch, opitch;
    if constexpr (VAR == VA || VAR == VC || VAR == VD) {
        constexpr int base = VAR == VA ? A_Q : (VAR == VC ? C_Q : D_Q);
        Qp = C.PROJ + rb * INP + base + h * 128; Kp = Qp + 1024; Vp = Qp + 2048; qpitch = INP; kpitch = INP;
        Op = C.MIX + rb * DM + VAR * 1024 + h * 128; opitch = DM;
    } else if constexpr (VAR == VB) {
        Qp = C.QMLA + rb * 1536 + h * 192; qpitch = 1536; Kp = C.KVMLA + rb * 2048 + h * 256; Vp = Kp + 128; kpitch = 2048;
        Op = C.MIX + rb * DM + 1024 + h * 128; opitch = DM;
    } else {
        Qp = C.QMEM + rb * 512 + h * 128; qpitch = 512; Kp = C.KVMEM + (size_t)b * MEMT * 1024 + h * 128; Vp = Kp + 512; kpitch = 1024;
        Op = C.OMEM + rb * 512 + h * 128; opitch = 512;
    }
    const char* Bp = nullptr;
    if constexpr (VAR == VA) Bp = (const char*)(C.pos + rb);
    if constexpr (VAR == VD) Bp = (const char*)(C.NEGC + (size_t)(b * 8 + h) * SEQ);
    const char* KPEp = nullptr;
    if constexpr (MLA) KPEp = (const char*)(C.KPE + rb * 64);
    bf16x8 qr[DIFF ? 1 : NQF];
    const LAS unsigned char* qlds = lds + QF_OFF + wid * 8192 + lane * 16;
    { const bf16* qrow = Qp + (size_t)trow * qpitch + hi * 8;
      if constexpr (DIFF) {
#pragma unroll
          for (int d0 = 0; d0 < 8; ++d0) { const bf16x8 q = *(const GAS bf16x8*)(qrow + d0 * 16); *(LAS bf16x8*)(lds + QF_OFF + wid * 8192 + lane * 16 + d0 * 1024) = q; }
      } else {
#pragma unroll
          for (int d0 = 0; d0 < NQF; ++d0) qr[d0] = *(const GAS bf16x8*)(qrow + d0 * 16); } }
    if constexpr (MLA) {
        const float* cs = C.COS + (rb + trow) * 32 + hi * 8; const float* sn = C.SIN + (rb + trow) * 32 + hi * 8;
#pragma unroll
        for (int j = 0; j < 2; ++j) {
            const f32x4 c0 = *(const GAS f32x4*)(cs + j * 16), c1 = *(const GAS f32x4*)(cs + j * 16 + 4), s0 = *(const GAS f32x4*)(sn + j * 16), s1 = *(const GAS f32x4*)(sn + j * 16 + 4);
            const bf16x8 a = qr[8 + j], bb = qr[10 + j]; float lo[8], hh[8];
#pragma unroll
            for (int e = 0; e < 8; ++e) { const float t1 = bf2f(a[e]), t2 = bf2f(bb[e]), c = e < 4 ? c0[e & 3] : c1[e & 3], s = e < 4 ? s0[e & 3] : s1[e & 3]; lo[e] = t1 * c - t2 * s; hh[e] = t1 * s + t2 * c; }
            v4u wl = {cvtpk(lo[0], lo[1]), cvtpk(lo[2], lo[3]), cvtpk(lo[4], lo[5]), cvtpk(lo[6], lo[7])}, wh = {cvtpk(hh[0], hh[1]), cvtpk(hh[2], hh[3]), cvtpk(hh[4], hh[5]), cvtpk(hh[6], hh[7])};
            qr[8 + j] = __builtin_bit_cast(bf16x8, wl); qr[10 + j] = __builtin_bit_cast(bf16x8, wh); }
    }
    unsigned koff[2], voff[2], peoff = 0;
#pragma unroll
    for (int i = 0; i < 2; ++i) { const int j = wid * 2 + i, row = 4 * j + (lane >> 4); koff[i] = (unsigned)(row * kpitch + (((lane & 15) ^ (row & 15)) << 3)) * 2u;
        const int st = 2 * j + (lane >> 5), kk = (st >> 2) * 8 + ((lane & 31) >> 2), c = (st & 3) * 32 + (lane & 3) * 8; voff[i] = (unsigned)(swap23(kk) * kpitch + c) * 2u; }
    if constexpr (MLA) { const int row = 8 * wid + (lane >> 3); peoff = (unsigned)(row * 64 + (((lane & 7) ^ ((row >> 1) & 7)) << 3)) * 2u; }
    const unsigned boff = (unsigned)(lane & 15) * 16u;
    const unsigned ldsbase = (unsigned)(unsigned long long)lds;
#define ISSUE(t_, buf_) do { const size_t tb_ = (size_t)(t_) * 64 * kpitch * 2; const char* kg_ = (const char*)Kp + tb_; const char* vg_ = (const char*)Vp + tb_; \
        _Pragma("unroll") for (int i_ = 0; i_ < 2; ++i_) dma16(kg_, koff[i_], ldsbase + K_OFF + (buf_) * 16384 + (wid * 2 + i_) * 1024); \
        _Pragma("unroll") for (int i_ = 0; i_ < 2; ++i_) dma16(vg_, voff[i_], ldsbase + V_OFF + (buf_) * 16384 + (wid * 2 + i_) * 1024); \
        if constexpr (MLA) dma16(KPEp + (size_t)(t_) * 64 * 64 * 2, peoff, ldsbase + KPE_OFF + (buf_) * 8192 + wid * 1024); \
        if constexpr (HASB) { if (wid == 0) dma16(Bp + (size_t)(t_) * 64 * 4, boff, ldsbase + B_OFF + (buf_) * 1024); } } while (0)
    const int NT = CAUSAL ? (q0 + 256) / 64 : MEMT / 64;
    LAS float* wsf = (LAS float*)(lds + WS_OFF) + wid * 64;
    LAS float* lut = (LAS float*)(lds + LUT_OFF);
    int pos_t = 0, wmin = 0; float lut_far = 0.f;
    if constexpr (DIFF) { if (tid < 132) lut[tid] = C.LUT[h * 132 + tid];
        pos_t = C.pos[rb + trow]; int mnp = pos_t;
        mnp = min(mnp, shxi<1>(mnp)); mnp = min(mnp, shxi<2>(mnp)); mnp = min(mnp, shxi<4>(mnp)); mnp = min(mnp, shxi<8>(mnp)); mnp = min(mnp, shxi<16>(mnp));
        wmin = __builtin_amdgcn_readfirstlane(mnp); lut_far = C.LUT[h * 132 + 128]; }
    const int xr = (r32 & 15) << 4, hx = hi << 4, xpe = ((r32 >> 1) & 7) << 4;
    const unsigned vrd = (unsigned)(((lane & 3) << 3) | (((lane >> 2) & 3) << 6) | (((lane >> 4) & 1) << 5) | (((lane >> 5) & 1) << 8));
    f32x16 o[4]; f32x16 o2[DIFF ? 4 : 1];
#pragma unroll
    for (int d = 0; d < 4; ++d) { o[d] = f32x16{}; if constexpr (DIFF) o2[d] = f32x16{}; }
    float m1 = -1e30f, l1 = 0.f, m2 = -1e30f, l2 = 0.f, R = 0.f;
    float qnkn = 0.f;
    if constexpr (VAR == VD) { float s = 0.f;
#pragma unroll
        for (int d0 = 0; d0 < 8; ++d0)
#pragma unroll
            for (int e = 0; e < 8; ++e) { const float a = bf2f(qr[d0][e]); s += a * a; }
        s = psumf(s); qnkn = sqrtf(s) * sqrtf(__uint_as_float(C.KN2[b * 8 + h])) * 1.001f + 1.f; }
    ISSUE(DESC ? NT - 1 : 0, 0);
    WAITBAR();
    int cur = 0;
    for (int i = 0; i < NT; ++i) {
        const int t = DESC ? NT - 1 - i : i, kb = t * 64;
        if (i + 1 < NT) ISSUE(DESC ? t - 1 : t + 1, cur ^ 1);
        const bool act = !CAUSAL || (STICK ? (kb < qw + 31) : (kb <= qw + 31));
        bool wdone = false;
        if constexpr (VAR == VD) {
            if (act) { const float nmax = ((const LAS float*)(lds + B_OFF + cur * 1024))[63]; wdone = __all((qnkn + nmax - m1) * SCALE < -40.f); } }
        if (act && !wdone) {
            const LAS unsigned char* krow = lds + K_OFF + cur * 16384 + r32 * 256;
            const unsigned vb = ldsbase + V_OFF + cur * 16384 + vrd;
            if constexpr (STICK) {
                f32x16 p0 = f32x16{}, p1 = f32x16{};
                qk<8>(p0, p1, krow, xr, hx, qr, 0);
                float L0[16], L1[16];
#pragma unroll
                for (int r = 0; r < 16; ++r) { const int key = kb + crow(r, hi);
                    { const float z = p0[r] * SCALE, e = __builtin_amdgcn_exp2f(-fabsf(z) * LOG2E), sp = fmaxf(z, 0.f) + __builtin_amdgcn_logf(1.f + e) * LN2; L0[r] = key < trow ? -sp : 0.f; p0[r] = z; }
                    { const float z = p1[r] * SCALE, e = __builtin_amdgcn_exp2f(-fabsf(z) * LOG2E), sp = fmaxf(z, 0.f) + __builtin_amdgcn_logf(1.f + e) * LN2; L1[r] = key + 32 < trow ? -sp : 0.f; p1[r] = z; } }
                float T[8], mb[8];
#pragma unroll
                for (int g = 0; g < 4; ++g) { T[g] = (L0[4 * g] + L0[4 * g + 1]) + (L0[4 * g + 2] + L0[4 * g + 3]); T[4 + g] = (L1[4 * g] + L1[4 * g + 1]) + (L1[4 * g + 2] + L1[4 * g + 3]); }
                float run = R;
#pragma unroll
                for (int k = 7; k >= 0; --k) { const float pt = partnerf(T[k], hi); const float T1 = hi ? T[k] : pt, T0 = hi ? pt : T[k];
                    const float b1 = run; run += T1; const float b0 = run; run += T0; mb[k] = hi ? b1 : b0; }
                R = run;
#pragma unroll
                for (int g = 0; g < 4; ++g) { float s0 = mb[g], s1 = mb[4 + g];
#pragma unroll
                    for (int e = 3; e >= 0; --e) { const int r = 4 * g + e, key = kb + crow(r, hi);
                        const float a0 = key < trow ? __builtin_amdgcn_exp2f((p0[r] + L0[r] + s0) * LOG2E) : 0.f; s0 += L0[r]; p0[r] = a0;
                        const float a1 = key + 32 < trow ? __builtin_amdgcn_exp2f((p1[r] + L1[r] + s1) * LOG2E) : 0.f; s1 += L1[r]; p1[r] = a1; } }
                bf16x8 pa0, pa1, pa2, pa3; pack_p(p0, p1, pa0, pa1, pa2, pa3);
                pv(o, vb, pa0, pa1, pa2, pa3);
            } else {
#pragma unroll
                for (int mp = 0; mp < (DIFF ? 2 : 1); ++mp) {
                    f32x16 p0, p1;
                    int xr_t = xr;
                    if constexpr (DIFF) { __builtin_amdgcn_sched_barrier(0); asm volatile("" : "+v"(pos_t), "+v"(xr_t)); }
                    if constexpr (VAR == VD) { const LAS float* nb = (const LAS float*)(lds + B_OFF + cur * 1024) + 4 * hi;
#pragma unroll
                        for (int g = 0; g < 4; ++g) { const f32x4 v0 = *(const LAS f32x4*)(nb + 8 * g), v1 = *(const LAS f32x4*)(nb + 32 + 8 * g);
#pragma unroll
                            for (int e = 0; e < 4; ++e) { p0[4 * g + e] = v0[e]; p1[4 * g + e] = v1[e]; } } }
                    else if constexpr (DIFF) {
                        if (wmin - C.TPMAX[b * 64 + t] >= 128) {
#pragma unroll
                            for (int r = 0; r < 16; ++r) { p0[r] = lut_far; p1[r] = lut_far; } }
                        else { const LAS int* pb = (const LAS int*)(lds + B_OFF + cur * 1024) + 4 * hi;
#pragma unroll
                            for (int g = 0; g < 4; ++g) { const i32x4 v0 = *(const LAS i32x4*)(pb + 8 * g), v1 = *(const LAS i32x4*)(pb + 32 + 8 * g);
#pragma unroll
                                for (int e = 0; e < 4; ++e) { p0[4 * g + e] = lut[min(max(pos_t - v0[e], 0), 128)]; p1[4 * g + e] = lut[min(max(pos_t - v1[e], 0), 128)]; }
                                __builtin_amdgcn_sched_barrier(0); } } }
                    else { p0 = f32x16{}; p1 = f32x16{}; }
                    if constexpr (DIFF) qk_l<4>(p0, p1, krow, xr_t, hx, qlds, 4 * mp);
                    else qk<8>(p0, p1, krow, xr, hx, qr, 0);
                    if constexpr (MLA) qk_pe(p0, p1, lds + KPE_OFF + cur * 8192 + r32 * 128, xpe, hx, qr + 8);
                    if (CAUSAL && kb + 63 > qw) { const float NEG = -__builtin_inff();
#pragma unroll
                        for (int r = 0; r < 16; ++r) { const int key = kb + crow(r, hi); if (key > trow) p0[r] = NEG; if (key + 32 > trow) p1[r] = NEG; } }
                    if (mp == 0) softmax_pv(p0, p1, m1, l1, o, wsf, vb, r32, hi, SCALE, C2);
                    else softmax_pv(p0, p1, m2, l2, o2, wsf, vb, r32, hi, SCALE, C2);
                }
            }
        }
        if constexpr (STICK) { const int dn_ = __all(R < -100.f) ? 1 : 0; if (lane == 0) ((LAS int*)(lds + FLG_OFF))[(i & 1) * 8 + wid] = dn_; }
        if constexpr (VAR == VD) { if (lane == 0) ((LAS int*)(lds + FLG_OFF))[(i & 1) * 8 + wid] = wdone ? 1 : 0; }
        WAITBAR(); cur ^= 1;
        if constexpr (STICK || VAR == VD) { const LAS i32x4* fl = (const LAS i32x4*)(lds + FLG_OFF + (i & 1) * 32); const i32x4 f0 = fl[0], f1 = fl[1];
            const int alld = (f0.x & f0.y & f0.z & f0.w) & (f1.x & f1.y & f1.z & f1.w); if (__builtin_amdgcn_readfirstlane(alld)) break; }
    }
#undef ISSUE
    const int lane_e = fresh_lane();
    const int r32e = lane_e & 31, hie = lane_e >> 5;
    bf16* Ob = Op + (size_t)(qw + 4 * hie) * opitch + r32e;
    if constexpr (DIFF) {
        if (hie == 0) { wsf[r32e] = l1; wsf[32 + r32e] = l2; } asm volatile("s_waitcnt lgkmcnt(0)" ::: "memory");
        const float lam = C.lam;
#pragma unroll
        for (int r = 0; r < 16; ++r) { const float i1 = __builtin_amdgcn_rcpf(wsf[crow(r, hie)]), i2 = lam * __builtin_amdgcn_rcpf(wsf[32 + crow(r, hie)]); float ss = 0.f;
#pragma unroll
            for (int d = 0; d < 4; ++d) { const float x = o[d][r] * i1 - o2[d][r] * i2; o[d][r] = x; ss += x * x; }
            ss = half_sum(ss);
            const float rstd = (1.0f / sqrtf(ss * (1.f / 128.f) + EPS)) * C.oml;
#pragma unroll
            for (int d = 0; d < 4; ++d) o[d][r] *= rstd; }
#pragma unroll
        for (int d = 0; d < 4; ++d) { const float g = C.sub_g[d * 32 + r32e];
#pragma unroll
            for (int r = 0; r < 16; ++r) o[d][r] *= g; }
    } else if constexpr (!STICK) {
        if (hie == 0) wsf[r32e] = l1; asm volatile("s_waitcnt lgkmcnt(0)" ::: "memory");
#pragma unroll
        for (int r = 0; r < 16; ++r) { const float i1 = __builtin_amdgcn_rcpf(wsf[crow(r, hie)]);
#pragma unroll
            for (int d = 0; d < 4; ++d) o[d][r] *= i1; }
    }
#pragma unroll
    for (int r = 0; r < 16; ++r) { const int orr = (r & 3) + 8 * (r >> 2);
#pragma unroll
        for (int d = 0; d < 4; ++d) { const float v = o[d][r], vn = shx<1>(v);
            if ((r32e & 1) == 0) *(GAS unsigned*)(Ob + (size_t)orr * opitch + d * 32) = cvtpk(v, vn); } }
}
template <int VAR> __device__ __forceinline__ void attn_queue(const Ctx& C, gu32* head, LAS unsigned char* lds, const int wid) {
    constexpr int NH = VAR == VE ? 4 : 8, NU = NB * NH * 16;
    const int lane = fresh_lane(), tid = wid * 64 + lane;
    volatile LAS int* tk = (volatile LAS int*)(lds + TKT_OFF);
    for (;;) {
        if (tid == 0) tk[0] = (int)__hip_atomic_fetch_add(head, 1u, RLX_AGENT);
        WAITBAR();
        const int n = __builtin_amdgcn_readfirstlane(tk[0]);
        if (n >= NU) break;
        const int qb = 15 - n / (NB * NH), bh = n % (NB * NH);
        attn_unit<VAR>(C, bh / NH, bh % NH, qb, lds, tid, wid, lane);
    }
}
}

struct Args { const void* in[27]; float* out; unsigned char* ws; float inv_freq[32]; float lam_init[2]; };
static_assert(sizeof(Args) == 27 * 8 + 16 + 128 + 8, "Args has no padding");
typedef const unsigned char __attribute__((address_space(4)))* kaptr_t;
__device__ __forceinline__ kaptr_t ka_fresh() { kaptr_t p = (kaptr_t)__builtin_amdgcn_kernarg_segment_ptr(); asm volatile("" : "+s"(p)); return p; }
#define KIN(ka, i) (*(const void* const __attribute__((address_space(4)))*)((ka) + 8 * (i)))
#define KOUT(ka) ((float*)KIN(ka, 27))
#define KWS(ka) ((unsigned char*)KIN(ka, 28))
#define KINVF(ka, i) (*(const float __attribute__((address_space(4)))*)((ka) + 232 + 4 * (i)))
#define KLAMI(ka, l) (*(const float __attribute__((address_space(4)))*)((ka) + 360 + 4 * (l)))

namespace att {
template <int VAR> __device__ __forceinline__ void attn_phase(int l, int q, LAS unsigned char* lds, const int wid0) {
    const kaptr_t ka = ka_fresh(); unsigned char* ws = KWS(ka);
    const Ctx C{(const bf16*)(ws + WS_PROJ), (const bf16*)(ws + WS_QMLA), (const bf16*)(ws + WS_KVMLA), (const bf16*)(ws + WS_KPE), (bf16*)(ws + WS_MIX), (const bf16*)(ws + WS_QMEM),
                (const bf16*)(ws + WS_KVMEM) + (size_t)l * 512 * 1024, (bf16*)(ws + WS_OMEM), (const float*)(ws + WS_COS), (const float*)(ws + WS_SIN), (const float*)(ws + WS_LUT),
                (const int*)(ws + WS_TPMAX), (const int*)KIN(ka, 2), (const float*)(ws + WS_NEGC), (const float*)KIN(ka, 11) + l * 128, (const unsigned*)((gu32*)(ws + WS_CTL) + CW_KN + l * 64), ((const float*)(ws + WS_LAM))[l], 1.0f - KLAMI(ka, l)};
    attn_queue<VAR>(C, (gu32*)(ws + WS_CTL) + CW_TKT + (l * 16 + q) * 64, lds, wid0);
}
}

__global__ void __launch_bounds__(NWAVES * 64, 2) mk_fwd(Args args) {
    extern __shared__ __attribute__((aligned(16))) unsigned char lds_raw[];
    LAS unsigned char* lds = (LAS unsigned char*)lds_raw;
    const int G = gridDim.x, bx = blockIdx.x;
    const int vcu = (G % 8 == 0) ? (bx % 8) * (G / 8) + bx / 8 : bx;
    const int wid0 = __builtin_amdgcn_readfirstlane((int)threadIdx.x >> 6);
    const int gw = vcu * NWAVES + wid0, NGW = G * NWAVES;
    { const int tid = wid0 * 64 + fresh_lane();
      for (int u = tid; u < (LDS_BYTES - LDSCTL_OFF) / 4; u += NWAVES * 64) ((LAS unsigned*)(lds + LDSCTL_OFF))[u] = 0u; }
    __syncthreads();
    volatile LAS unsigned* MISC = (volatile LAS unsigned*)(lds + MISC_OFF);
    XcdBarrier bar = xcd_barrier_post((unsigned*)(args.ws + WS_CTL) + CW_BAR, MISC + 8, wid0);

    {
        const kaptr_t ka = ka_fresh(); unsigned char* ws = KWS(ka);
        const int lane = fresh_lane(), wid = wid0, tid = wid * 64 + lane;
        LAS float* scr = (LAS float*)(lds + RING_OFF + wid * 16640);
        for (int l = 0; l < NL; ++l) {
            unsigned char* wl = ws + WS_W + (size_t)l * W_LAYER;
#define TR_MAT(idx_, K_, N_, NP_, dst_, roff_, gain_) do { const float* s_ = (const float*)KIN(ka, idx_) + (size_t)l * (K_) * (N_); const int nblk_ = (NP_) / 64, nit_ = ((K_) / 64) * nblk_; \
            const float* gk_ = (gain_) >= 0 ? (const float*)KIN(ka, (gain_) >= 0 ? (gain_) : 0) + (size_t)l * (K_) : nullptr; \
            for (int it = gw; it < nit_; it += NGW) tr_item(s_, (K_), (N_), nblk_, (bf16*)(dst_), (roff_), scr, it, lane, gk_); } while (0)
            TR_MAT(4, DM, INC, INP, wl + W_IN, 0, 3);
            TR_MAT(5, DM, DM, DM, wl + W_OUT, 0, -1);
            TR_MAT(14, QRANK, 1536, 1536, wl + W_UQ, 0, -1);
            TR_MAT(15, KVRANK, 2048, 2048, wl + W_UKV, 0, -1);
            TR_MAT(19, DM, 512, 512, wl + W_MQ, 0, 17);
            TR_MAT(20, DM, 512, 512, wl + W_MKV, 0, -1);
            TR_MAT(21, DM, 512, 512, wl + W_MKV, 512, -1);
            TR_MAT(22, 512, DM, DM, wl + W_MO, 0, -1);
            if (l == NL - 1 && G == 256) {
                const float* s_ = (const float*)KIN(ka, 24) + (size_t)l * DM * DFF; const float* gk_ = (const float*)KIN(ka, 23) + (size_t)l * DM;
                for (int it = 2 * UPDEF + 2 * P4DEF + gw; it < (DM / 64) * (DFF / 64); it += NGW) tr_item(s_, DM, DFF, DFF / 64, (bf16*)(wl + W_UP), 0, scr, it, lane, gk_);
            } else TR_MAT(24, DM, DFF, DFF, wl + W_UP, 0, 23);
            if (l == 0 || G <= 64) TR_MAT(25, DFF, DM, DM, wl + W_DN, 0, -1);
#undef TR_MAT
        }
        { const float* x0 = (const float*)KIN(ka, 0); bf16* H = (bf16*)(ws + WS_H); unsigned long long* SS = (unsigned long long*)((gu32*)(ws + WS_CTL) + CW_SS);
          for (int m = gw; m < M; m += NGW) cast_row(x0 + (size_t)m * DM, H + (size_t)m * DM, SS + m, lane); }
        { const float* mem = (const float*)KIN(ka, 1); bf16* MEMN = (bf16*)(ws + WS_MEMN);
          for (int r = gw; r < NL * NB * MEMT; r += NGW) { const int l = r / (NB * MEMT), mr = r - l * (NB * MEMT);
            rms_row<true>(mem + (size_t)mr * DM, (const float*)KIN(ka, 18) + (size_t)l * DM, MEMN + (size_t)r * DM, lane); } }
        const int* pos = (const int*)KIN(ka, 2);
        float* COS = (float*)(ws + WS_COS); float* SIN = (float*)(ws + WS_SIN); float* LUT = (float*)(ws + WS_LUT); int* TPMAX = (int*)(ws + WS_TPMAX); float* LAM = (float*)(ws + WS_LAM);
        const int gt = vcu * (NWAVES * 64) + tid, NGT = G * NWAVES * 64;
        for (int i = gt; i < M * 32; i += NGT) { const int row = i >> 5, f = i & 31; const float ang = (float)pos[row] * KINVF(ka, f);
            double rv = (double)ang * 0.15915494309189535; rv -= floor(rv); const float fr = (float)rv;
            COS[i] = __builtin_amdgcn_cosf(fr); SIN[i] = __builtin_amdgcn_sinf(fr); }
        for (int i = gt; i < 8 * 132; i += NGT) { const int h = i / 132, dd0 = i - h * 132; const int dd = dd0 > 128 ? 128 : dd0; int bk;
            if (dd < 16) bk = dd; else { bk = 16 + (int)(logf((float)dd / 16.0f) / 2.0794415416798357f * 16.0f); bk = bk > 31 ? 31 : bk; }
            LUT[i] = 8.0f * ((const float*)KIN(ka, 6))[bk * 8 + h]; }
        for (int i = gt; i < NB * 64; i += NGT) { int mx = pos[i * 64];
            for (int k = 1; k < 64; ++k) mx = max(mx, pos[i * 64 + k]);
            TPMAX[i] = mx; }
        if (gt < NL) { const int l = gt; float s1 = 0.f, s2 = 0.f;
            for (int k = 0; k < 64; ++k) { s1 += ((const float*)KIN(ka, 7))[l * 64 + k] * ((const float*)KIN(ka, 8))[l * 64 + k]; s2 += ((const float*)KIN(ka, 9))[l * 64 + k] * ((const float*)KIN(ka, 10))[l * 64 + k]; }
            LAM[l] = expf(s1) - expf(s2) + KLAMI(ka, l); }
    }
    xcd_barrier(bar, wid0);

    for (int l = 0; l < NL; ++l) {
        { const kaptr_t ka = ka_fresh(); unsigned char* ws = KWS(ka); unsigned char* wl = ws + WS_W + (size_t)l * W_LAYER;
          { pg8::Gemm g{(const bf16*)(ws + WS_H), (const bf16*)(wl + W_IN), M, INP, DM}; pg8::StaticOrder S; S.init(M, INP, G, bx);
            pg8::EpiBf16<0, true> E{(bf16*)(ws + WS_PROJ), INP, (const unsigned long long*)((gu32*)(ws + WS_CTL) + CW_SS) + (size_t)(3 * l) * M};
            pg8::gemm_phase<pg8::EpiBf16<0, true>, pg8::StaticOrder, true, true>(lds + RING_OFF, g, S, E, wid0); }
          { pg8::Gemm g{(const bf16*)(ws + WS_MEMN) + (size_t)l * 512 * DM, (const bf16*)(wl + W_MKV), 512, 1024, DM}; pg8::StaticOrder S; S.init(512, 1024, G, G - 1 - bx);
            pg8::EpiBf16<0, false> E{(bf16*)(ws + WS_KVMEM) + (size_t)l * 512 * 1024, 1024, nullptr};
            pg8::gemm_phase<pg8::EpiBf16<0, false>, pg8::StaticOrder, true, true>(lds + RING_OFF, g, S, E, wid0); }
          if (G == 256 && bx >= 160 && bx < 248) {
              const int lane = fresh_lane(); LAS float* scr = (LAS float*)(lds + RING_OFF + wid0 * 16640);
              const float* s_ = (const float*)KIN(ka, 24) + (size_t)(NL - 1) * DM * DFF; const float* gk_ = (const float*)KIN(ka, 23) + (size_t)(NL - 1) * DM;
              bf16* dst = (bf16*)(ws + WS_W + (size_t)(NL - 1) * W_LAYER + W_UP);
              for (int it = l * UPDEF + (bx - 160) * NWAVES + wid0; it < (l + 1) * UPDEF; it += 88 * NWAVES) tr_item(s_, DM, DFF, DFF / 64, dst, 0, scr, it, lane, gk_); } }
        xcd_barrier(bar, wid0);
        { const kaptr_t ka = ka_fresh(); unsigned char* ws = KWS(ka); FRESH_LANE(ln);
          for (int m = gw; m < M; m += NGW)
            prep_row((const bf16*)(ws + WS_PROJ), m, (const float*)KIN(ka, 12) + (size_t)l * QRANK, (const float*)KIN(ka, 13) + (size_t)l * KVRANK, (const float*)KIN(ka, 16) + l * 8,
                     (const float*)(ws + WS_COS), (const float*)(ws + WS_SIN), (bf16*)(ws + WS_CQN), (bf16*)(ws + WS_CKVN), (bf16*)(ws + WS_KPE), (float*)(ws + WS_LOGF), (unsigned*)((gu32*)(ws + WS_CTL) + CW_KN + l * 64), ln); }
        xcd_barrier(bar, wid0);
        { const kaptr_t ka = ka_fresh(); unsigned char* ws = KWS(ka); unsigned char* wl = ws + WS_W + (size_t)l * W_LAYER;
          if (gw < 16) { FRESH_LANE(ln); fox_scan((const float*)(ws + WS_LOGF) + (size_t)gw * SEQ, (float*)(ws + WS_NEGC) + (size_t)gw * SEQ, ln); }
          { pg8::Gemm g{(const bf16*)(ws + WS_CQN), (const bf16*)(wl + W_UQ), M, 1536, QRANK}; pg8::StaticOrder S; S.init(M, 1536, G, bx);
            pg8::EpiBf16<0, false> E{(bf16*)(ws + WS_QMLA), 1536, nullptr};
            pg8::gemm_phase<pg8::EpiBf16<0, false>, pg8::StaticOrder, true, true>(lds + RING_OFF, g, S, E, wid0); }
          { pg8::Gemm g{(const bf16*)(ws + WS_CKVN), (const bf16*)(wl + W_UKV), M, 2048, KVRANK}; pg8::StaticOrder S; S.init(M, 2048, G, G - 1 - bx);
            pg8::EpiBf16<0, false> E{(bf16*)(ws + WS_KVMLA), 2048, nullptr};
            pg8::gemm_phase<pg8::EpiBf16<0, false>, pg8::StaticOrder, true, true>(lds + RING_OFF, g, S, E, wid0); }
          if (G == 256 && bx >= 192) {
              const int lane = fresh_lane(); LAS float* scr = (LAS float*)(lds + RING_OFF + wid0 * 16640);
              const float* s_ = (const float*)KIN(ka, 24) + (size_t)(NL - 1) * DM * DFF; const float* gk_ = (const float*)KIN(ka, 23) + (size_t)(NL - 1) * DM;
              bf16* dst = (bf16*)(ws + WS_W + (size_t)(NL - 1) * W_LAYER + W_UP);
              for (int it = 2 * UPDEF + l * P4DEF + (bx - 192) * NWAVES + wid0; it < 2 * UPDEF + (l + 1) * P4DEF; it += 64 * NWAVES) tr_item(s_, DM, DFF, DFF / 64, dst, 0, scr, it, lane, gk_); } }
        xcd_barrier(bar, wid0);
        att::attn_phase<att::VA>(l, 0, lds, wid0);
        att::attn_phase<att::VB>(l, 1, lds, wid0);
        att::attn_phase<att::VD>(l, 2, lds, wid0);
        att::attn_phase<att::VC>(l, 3, lds, wid0);
        xcd_barrier(bar, wid0);
        { const kaptr_t ka = ka_fresh(); unsigned char* ws = KWS(ka); unsigned char* wl = ws + WS_W + (size_t)l * W_LAYER;
          pg8::Gemm g{(const bf16*)(ws + WS_MIX), (const bf16*)(wl + W_OUT), M, DM, DM}; pg8::StaticOrder S; S.init(M, DM, G, bx);
          pg8::EpiRes E{(bf16*)(ws + WS_H), DM, (unsigned long long*)((gu32*)(ws + WS_CTL) + CW_SS) + (size_t)(3 * l + 1) * M};
          pg8::gemm_phase<pg8::EpiRes, pg8::StaticOrder, true, true>(lds + RING_OFF, g, S, E, wid0); }
        xcd_barrier(bar, wid0);
        { const kaptr_t ka = ka_fresh(); unsigned char* ws = KWS(ka); unsigned char* wl = ws + WS_W + (size_t)l * W_LAYER;
          pg8::Gemm g{(const bf16*)(ws + WS_H), (const bf16*)(wl + W_MQ), M, 512, DM}; pg8::StaticOrder S; S.init(M, 512, G, bx);
          pg8::EpiBf16<0, true> E{(bf16*)(ws + WS_QMEM), 512, (const unsigned long long*)((gu32*)(ws + WS_CTL) + CW_SS) + (size_t)(3 * l + 1) * M};
          pg8::gemm_phase<pg8::EpiBf16<0, true>, pg8::StaticOrder, true, true>(lds + RING_OFF, g, S, E, wid0);
          if (G > 64 && bx >= 64) {
              const int lane = fresh_lane(); LAS float* scr = (LAS float*)(lds + RING_OFF + wid0 * 16640);
              const float* s_ = (const float*)KIN(ka, 25) + (size_t)(NL - 1) * DFF * DM; bf16* dst = (bf16*)(ws + WS_W + (size_t)(NL - 1) * W_LAYER + W_DN);
              constexpr int nblk = DM / 64, nit = (DFF / 64) * nblk, per = nit / NL;
              for (int it = l * per + (bx - 64) * NWAVES + wid0; it < (l + 1) * per; it += (G - 64) * NWAVES) tr_item(s_, DFF, DM, nblk, dst, 0, scr, it, lane, nullptr); } }
        xcd_barrier(bar, wid0);
        att::attn_phase<att::VE>(l, 4, lds, wid0);
        xcd_barrier(bar, wid0);
        { const kaptr_t ka = ka_fresh(); unsigned char* ws = KWS(ka); unsigned char* wl = ws + WS_W + (size_t)l * W_LAYER;
          pg8::Gemm g{(const bf16*)(ws + WS_OMEM), (const bf16*)(wl + W_MO), M, DM, 512}; pg8::StaticOrder S; S.init(M, DM, G, bx);
          pg8::EpiRes E{(bf16*)(ws + WS_H), DM, (unsigned long long*)((gu32*)(ws + WS_CTL) + CW_SS) + (size_t)(3 * l + 2) * M};
          pg8::gemm_phase<pg8::EpiRes, pg8::StaticOrder, true, true>(lds + RING_OFF, g, S, E, wid0); }
        xcd_barrier(bar, wid0);
        { const kaptr_t ka = ka_fresh(); unsigned char* ws = KWS(ka); unsigned char* wl = ws + WS_W + (size_t)l * W_LAYER;
          pg8::Gemm g{(const bf16*)(ws + WS_H), (const bf16*)(wl + W_UP), M, DFF, DM}; pg8::StaticOrder S; S.init(M, DFF, G, bx);
          pg8::EpiBf16<1, true> E{(bf16*)(ws + WS_U), DFF, (const unsigned long long*)((gu32*)(ws + WS_CTL) + CW_SS) + (size_t)(3 * l + 2) * M};
          pg8::gemm_phase<pg8::EpiBf16<1, true>, pg8::StaticOrder, true, true>(lds + RING_OFF, g, S, E, wid0); }
        xcd_barrier(bar, wid0);
        { const kaptr_t ka = ka_fresh(); unsigned char* ws = KWS(ka); unsigned char* wl = ws + WS_W + (size_t)l * W_LAYER;
          pg8::Gemm g{(const bf16*)(ws + WS_U), (const bf16*)(wl + W_DN), M, DM, DFF}; pg8::StaticOrder S; S.init(M, DM, G, bx);
          pg8::EpiRes E{(bf16*)(ws + WS_H), DM, (unsigned long long*)((gu32*)(ws + WS_CTL) + CW_SS) + (size_t)(3 * l + 3) * M};
          pg8::gemm_phase<pg8::EpiRes, pg8::StaticOrder, true, true>(lds + RING_OFF, g, S, E, wid0); }
        xcd_barrier(bar, wid0);
    }
    { const kaptr_t ka = ka_fresh(); unsigned char* ws = KWS(ka); FRESH_LANE(ln); float* O = KOUT(ka);
      for (int m = gw; m < M; m += NGW) final_row((const bf16*)(ws + WS_H) + (size_t)m * DM, (const float*)KIN(ka, 26), O + (size_t)m * DM, ln); }
}

extern "C" void kernel_launch(void* const* d_in, const int* in_sizes, int n_in, void* d_out, int out_size, void* d_ws, size_t ws_size, hipStream_t stream) {
    static int grid = 0;
    if (grid == 0) {
        if (n_in != 27 || in_sizes[0] != M * DM || out_size != M * DM || ws_size < WS_END) {
            fprintf(stderr, "kernel_launch: built for 27 inputs, x/out of %d floats, >= %zu bytes of workspace; got n_in %d, in0 %d, out %d, ws %zu; nothing launched\n", M * DM, (size_t)WS_END, n_in, n_in > 0 ? in_sizes[0] : -1, out_size, ws_size);
            grid = -1; return; }
        int dev = 0, cus = 0, per_cu = 0;
        if (hipGetDevice(&dev) != hipSuccess || hipDeviceGetAttribute(&cus, hipDeviceAttributeMultiprocessorCount, dev) != hipSuccess) { fprintf(stderr, "kernel_launch: device query failed\n"); grid = -1; return; }
        if (hipFuncSetAttribute((const void*)mk_fwd, hipFuncAttributeMaxDynamicSharedMemorySize, LDS_BYTES) != hipSuccess) { fprintf(stderr, "kernel_launch: hipFuncSetAttribute failed\n"); grid = -1; return; }
        if (hipOccupancyMaxActiveBlocksPerMultiprocessor(&per_cu, (const void*)mk_fwd, NWAVES * 64, LDS_BYTES) != hipSuccess || per_cu < 1)
            fprintf(stderr, "kernel_launch: note: occupancy query reports %d workgroups per CU\n", per_cu);
        (void)hipGetLastError();
        grid = cus;
    }
    if (grid < 0) return;
    if (hipMemsetAsync((char*)d_ws + WS_CTL, 0, CTL_ZERO_BYTES, stream) != hipSuccess) { fprintf(stderr, "kernel_launch: memset failed\n"); return; }
    Args a; memset(&a, 0, sizeof(a));
    for (int i = 0; i < 27; ++i) a.in[i] = d_in[i];
    a.out = (float*)d_out; a.ws = (unsigned char*)d_ws;
    for (int i = 0; i < 32; ++i) a.inv_freq[i] = (float)pow(10000.0, -(double)i / 32.0);
    for (int l = 0; l < NL; ++l) a.lam_init[l] = (float)(0.8 - 0.6 * exp(-0.3 * (double)l));
    hipLaunchKernelGGL(mk_fwd, dim3(grid), dim3(NWAVES * 64), LDS_BYTES, stream, a);
    const hipError_t le = hipPeekAtLastError();
    if (le != hipSuccess) fprintf(stderr, "kernel_launch: launch failed: %s\n", hipGetErrorName(le));
}
```

```cpp
#include <hip/hip_runtime.h>
#include <cstdio>
#include <cstdint>
#include <cstring>
#include <cmath>
__device__ __forceinline__ int fresh_lane() { unsigned z = 0u; asm volatile("" : "+v"(z)); return (int)__builtin_amdgcn_mbcnt_hi(~0u, __builtin_amdgcn_mbcnt_lo(~0u, z)); }
namespace pg8 {
#define PG8_LAS __attribute__((address_space(3)))
typedef unsigned short bf16_t;
typedef short bf16x8 __attribute__((ext_vector_type(8)));
typedef float f32x4 __attribute__((ext_vector_type(4)));
typedef unsigned u32x4 __attribute__((ext_vector_type(4)));
constexpr int BM = 256, BK = 64, HALF = 128, HTB = HALF * BK * 2  , STAGE_BYTES = 8 * HTB, NXCD = 8, WGM = 8;

__host__ __device__ __forceinline__ int lds_byte(int r, int c) { const int st = (r >> 4) * 2 + (c >> 5), rr = r & 15, cc = c & 31, ob = rr * 64 + cc * 2; return st * 1024 + (ob ^ (((ob >> 9) & 1) << 5)); }
__host__ __device__ __forceinline__ void stage_rc(int b, int& R, int& C) { const int st = b / 1024, sb = b % 1024, swz = sb ^ (((sb >> 9) & 1) << 5); R = (st >> 1) * 16 + swz / 64; C = (st & 1) * 32 + (swz % 64) / 2; }
__host__ __device__ __forceinline__ int perm32(int rho) { const int n = rho >> 4, i = rho & 15; return 8 * (i >> 2) + 4 * n + (i & 3); }

struct Unit { int pm, pn; };
struct Gemm { const bf16_t* A; const bf16_t* Bt; int M, N, K; };

struct StaticOrder {
    int nM, nN, nwg, G, c;
    __host__ __device__ void init(int M, int N, int G_, int c_) { nM = M / BM; nN = N / BM; nwg = nM * nN; G = G_; c = c_; }
    __host__ __device__ bool next(int i, Unit& u) const {
        const long L = (long)i * G + c; if (L >= nwg) return false;
        int wgid = (int)L; { const int q = nwg / NXCD, r = nwg % NXCD, xcd = wgid % NXCD, off = wgid / NXCD; wgid = (xcd < r ? xcd * (q + 1) : r * (q + 1) + (xcd - r) * q) + off; }
        const int nig = WGM * nN, gid = wgid / nig, fm = gid * WGM, gsz = (nM - fm) < WGM ? (nM - fm) : WGM;
        u.pm = fm + ((wgid % nig) % gsz); u.pn = (wgid % nig) / gsz; return true;
    }
    __device__ __forceinline__ void a_ready(const Unit&) const {}
    __device__ __forceinline__ void done(const Unit&) const {}
};

__device__ __forceinline__ unsigned cvt_pk_bf16(float lo, float hi) { unsigned r; asm volatile("v_cvt_pk_bf16_f32 %0, %1, %2" : "=v"(r) : "v"(lo), "v"(hi)); return r; }
typedef float f32x2 __attribute__((ext_vector_type(2)));
template <int ACT, bool RS> struct EpiBf16 {
    static constexpr bool PERM = true, AFTER_DRAIN = false;
    bf16_t* O; int ldc; const unsigned long long* ss;
    __device__ __forceinline__ void operator()(const f32x4 (&acc)[2][2][4][2], const Unit& u, int wr, int wc, int fr, int fq) const {
        const int row0 = u.pm * BM + wr * 64 + fr, col0 = u.pn * BM + wc * 32 + 8 * fq;
#pragma unroll
        for (int ai = 0; ai < 2; ++ai)
#pragma unroll
            for (int m = 0; m < 4; ++m) { const int row = row0 + ai * HALF + m * 16; bf16_t* rowp = O + (size_t)row * ldc + col0;
                float rs = 1.f; if (RS) rs = 1.0f / sqrtf((float)ss[row] * (1.f / 1048576.f / 4096.f) + 1e-6f);
#pragma unroll
                for (int bj = 0; bj < 2; ++bj) { f32x4 v0 = acc[ai][bj][m][0], v1 = acc[ai][bj][m][1];
                    if (RS) { v0 = v0 * rs; v1 = v1 * rs; }
                    if (ACT == 1) {
#pragma unroll
                        for (int e = 0; e < 4; ++e) { const float a = fmaxf(v0[e], 0.f), b = fmaxf(v1[e], 0.f); v0[e] = a * a; v1[e] = b * b; } }
                    u32x4 w; w.x = cvt_pk_bf16(v0[0], v0[1]); w.y = cvt_pk_bf16(v0[2], v0[3]); w.z = cvt_pk_bf16(v1[0], v1[1]); w.w = cvt_pk_bf16(v1[2], v1[3]);
                    *(u32x4*)(rowp + bj * HALF) = w; } }
    }
};
struct EpiRes {
    static constexpr bool PERM = true, AFTER_DRAIN = false;
    bf16_t* xh; int ldc; unsigned long long* ss;
    __device__ __forceinline__ void operator()(const f32x4 (&acc)[2][2][4][2], const Unit& u, int wr, int wc, int fr, int fq) const {
        const int row0 = u.pm * BM + wr * 64 + fr, col0 = u.pn * BM + wc * 32 + 8 * fq;
#pragma unroll
        for (int ai = 0; ai < 2; ++ai)
#pragma unroll
            for (int m = 0; m < 4; ++m) { const int row = row0 + ai * HALF + m * 16; const size_t off = (size_t)row * ldc + col0; float sq = 0.f;
#pragma unroll
                for (int bj = 0; bj < 2; ++bj) { const u32x4 hv = *(const u32x4*)(xh + off + bj * HALF); u32x4 ho;
#pragma unroll
                    for (int e = 0; e < 4; ++e) { const f32x4& a = acc[ai][bj][m][e >> 1]; const int j = (e & 1) * 2;
                        const float v0 = __uint_as_float(hv[e] << 16) + a[j], v1 = __uint_as_float(hv[e] & 0xffff0000u) + a[j + 1];
                        ho[e] = cvt_pk_bf16(v0, v1); sq += v0 * v0 + v1 * v1; }
                    *(u32x4*)(xh + off + bj * HALF) = ho; }
                sq += __int_as_float(__builtin_amdgcn_ds_swizzle(__float_as_int(sq), 0x1f | (16 << 10)));
                { auto rr = __builtin_amdgcn_permlane32_swap(__float_as_uint(sq), __float_as_uint(sq), false, false); sq = __uint_as_float(rr[0]) + __uint_as_float(rr[1]); }
                if (fq == 0) __hip_atomic_fetch_add(ss + row, (unsigned long long)((double)sq * 1048576.0), __ATOMIC_RELAXED, __HIP_MEMORY_SCOPE_AGENT); }
    }
};
template <class Epi, class Sched, bool ALIGN_EPI = false, bool SP2 = false>
__device__ __forceinline__ void gemm_phase(PG8_LAS unsigned char* lds, const Gemm g, const Sched& S, const Epi& E, const int wid0) {
    const int wid = wid0, lane = fresh_lane(), tid = wid * 64 + lane, wr = wid >> 2, wc = wid & 3, fr = lane & 15, fq = lane >> 4;
    const int K = g.K, nt = K / BK;
    unsigned voffA[2], voffB[2];
#pragma unroll
    for (int i = 0; i < 2; ++i) { int R, C; stage_rc(tid * 16 + i * 8192, R, C); const int Rb = Epi::PERM ? ((R & ~31) + perm32(R & 31)) : R;
        voffA[i] = (unsigned)(R * K + C) * 2u; voffB[i] = (unsigned)(Rb * K + C) * 2u; }
    const size_t kstep = (size_t)(BK * 2);
    const size_t hstep = (size_t)HALF * K * 2;
    const size_t tstep = 2 * hstep;
    const unsigned ldsw = (unsigned)wid * 1024u;
    const int aoff = lds_byte(wr * 64 + fr, fq * 8), boff = lds_byte(wc * 32 + fr, fq * 8);
#define PG8_SA(b, h) (((b) * 2 + (h)) * HTB)
#define PG8_SB(b, h) ((4 + (b) * 2 + (h)) * HTB)
#define PG8_STAGE(bufoff, gbase, voff) do { _Pragma("unroll") for (int _i = 0; _i < 2; ++_i) \
        __builtin_amdgcn_global_load_lds((const unsigned*)((const char*)(gbase) + (voff)[_i]), (PG8_LAS unsigned*)(lds + (bufoff) + ldsw + _i * 8192), 16, 0, 0); } while (0)
#define PG8_LDA(dst, b, h) do { _Pragma("unroll") for (int m = 0; m < 4; ++m) _Pragma("unroll") for (int k = 0; k < 2; ++k) dst[m][k] = *(const PG8_LAS bf16x8*)(lds + PG8_SA(b, h) + aoff + m * 2048 + k * 1024); } while (0)
#define PG8_LDB(dst, b, h) do { _Pragma("unroll") for (int n = 0; n < 2; ++n) _Pragma("unroll") for (int k = 0; k < 2; ++k) dst[n][k] = *(const PG8_LAS bf16x8*)(lds + PG8_SB(b, h) + boff + n * 2048 + k * 1024); } while (0)
#define PG8_MMA(ai, bj, At, Bt) do { __builtin_amdgcn_s_setprio(1); _Pragma("unroll") for (int m = 0; m < 4; ++m) _Pragma("unroll") for (int n = 0; n < 2; ++n) _Pragma("unroll") for (int k = 0; k < 2; ++k) \
        acc[ai][bj][m][n] = __builtin_amdgcn_mfma_f32_16x16x32_bf16(Bt[n][k], At[m][k], acc[ai][bj][m][n], 0, 0, 0); __builtin_amdgcn_s_setprio(0); } while (0)
#define PG8_WAIT_V(n) asm volatile("s_waitcnt vmcnt(" #n ")" ::: "memory")
#define PG8_WAIT_L(n) asm volatile("s_waitcnt lgkmcnt(" #n ")" ::: "memory")
#define PG8_BAR __builtin_amdgcn_s_barrier()
#define PG8_SCHED __builtin_amdgcn_sched_barrier(0)
    Unit cur, nxt; int ui = 0;
    if (!S.next(0, cur)) return;
    f32x4 acc[2][2][4][2];
#pragma unroll
    for (int a = 0; a < 2; ++a)
#pragma unroll
        for (int b = 0; b < 2; ++b)
#pragma unroll
            for (int m = 0; m < 4; ++m)
#pragma unroll
                for (int n = 0; n < 2; ++n) acc[a][b][m][n] = (f32x4){0.f, 0.f, 0.f, 0.f};
    bf16x8 At[4][2], B0[2][2], B1[2][2];
    const char* cA = (const char*)g.A + (size_t)cur.pm * tstep; const char* cB = (const char*)g.Bt + (size_t)cur.pn * tstep;
    S.a_ready(cur);
    if constexpr (SP2) {
        PG8_STAGE(PG8_SB(0, 0), cB, voffB); PG8_STAGE(PG8_SB(0, 1), cB + hstep, voffB); PG8_STAGE(PG8_SA(0, 0), cA, voffA); PG8_STAGE(PG8_SA(0, 1), cA + hstep, voffA);
        if (wr == 1) PG8_BAR;
        PG8_WAIT_V(2); PG8_BAR;
        PG8_STAGE(PG8_SB(1, 0), cB + kstep, voffB); PG8_STAGE(PG8_SA(1, 0), cA + kstep, voffA); PG8_STAGE(PG8_SB(1, 1), cB + hstep + kstep, voffB);
        PG8_WAIT_V(6); PG8_BAR;
    } else {
        PG8_STAGE(PG8_SB(0, 0), cB, voffB); PG8_STAGE(PG8_SA(0, 0), cA, voffA); PG8_STAGE(PG8_SB(0, 1), cB + hstep, voffB); PG8_STAGE(PG8_SA(0, 1), cA + hstep, voffA);
        if (wr == 1) PG8_BAR;
        PG8_WAIT_V(4); PG8_BAR;
        PG8_STAGE(PG8_SB(1, 0), cB + kstep, voffB); PG8_STAGE(PG8_SA(1, 0), cA + kstep, voffA); PG8_STAGE(PG8_SB(1, 1), cB + hstep + kstep, voffB);
        PG8_WAIT_V(6); PG8_BAR;
    }
    for (;;) {
        const bool has_next = S.next(ui + 1, nxt);
        const char* nA = has_next ? (const char*)g.A + (size_t)nxt.pm * tstep : cA; const char* nB = has_next ? (const char*)g.Bt + (size_t)nxt.pn * tstep : cB;
        for (int t = 0; t < nt; t += 2) {
            const bool last = (t == nt - 2);
            const char* a1 = cA + (size_t)(t + 1) * kstep;
            const char* a2 = last ? nA : cA + (size_t)(t + 2) * kstep; const char* b2 = last ? nB : cB + (size_t)(t + 2) * kstep;
            const char* a3 = a2 + kstep; const char* b3 = b2 + kstep;
            if (last && has_next) S.a_ready(nxt);
            if constexpr (SP2) {
            PG8_LDB(B0, 0, 0); PG8_LDB(B1, 0, 1); PG8_SCHED; PG8_LDA(At, 0, 0); PG8_STAGE(PG8_SA(1, 1), a1 + hstep, voffA);
            PG8_WAIT_V(8); PG8_WAIT_L(0); PG8_BAR; PG8_MMA(0, 0, At, B0); PG8_MMA(0, 1, At, B1); PG8_BAR; PG8_SCHED;
            PG8_LDA(At, 0, 1); PG8_STAGE(PG8_SB(0, 0), b2, voffB); PG8_STAGE(PG8_SB(0, 1), b2 + hstep, voffB); PG8_STAGE(PG8_SA(0, 0), a2, voffA);
            PG8_WAIT_V(8); PG8_WAIT_L(0); PG8_BAR; PG8_MMA(1, 0, At, B0); PG8_MMA(1, 1, At, B1); PG8_BAR; PG8_SCHED;
            PG8_LDB(B0, 1, 0); PG8_LDB(B1, 1, 1); PG8_SCHED; PG8_LDA(At, 1, 0); PG8_STAGE(PG8_SA(0, 1), a2 + hstep, voffA);
            PG8_WAIT_V(8); PG8_WAIT_L(0); PG8_BAR; PG8_MMA(0, 0, At, B0); PG8_MMA(0, 1, At, B1); PG8_BAR; PG8_SCHED;
            PG8_LDA(At, 1, 1); PG8_STAGE(PG8_SB(1, 0), b3, voffB); PG8_STAGE(PG8_SB(1, 1), b3 + hstep, voffB); PG8_STAGE(PG8_SA(1, 0), a3, voffA);
            PG8_WAIT_V(8); PG8_WAIT_L(0); PG8_BAR; PG8_MMA(1, 0, At, B0); PG8_MMA(1, 1, At, B1); PG8_BAR; PG8_SCHED;
            } else {
            PG8_LDB(B0, 0, 0); PG8_SCHED; PG8_LDA(At, 0, 0); PG8_STAGE(PG8_SA(1, 1), a1 + hstep, voffA);
            PG8_WAIT_L(8); PG8_BAR; PG8_WAIT_L(0); PG8_MMA(0, 0, At, B0); PG8_BAR; PG8_SCHED;
            PG8_LDB(B1, 0, 1); PG8_STAGE(PG8_SB(0, 0), b2, voffB);
            PG8_BAR; PG8_WAIT_L(0); PG8_MMA(0, 1, At, B1); PG8_BAR;
            PG8_LDA(At, 0, 1); PG8_STAGE(PG8_SA(0, 0), a2, voffA);
            PG8_BAR; PG8_WAIT_L(0); PG8_MMA(1, 0, At, B0); PG8_BAR; PG8_SCHED;
            PG8_STAGE(PG8_SB(0, 1), b2 + hstep, voffB);
            PG8_WAIT_V(6); PG8_BAR; PG8_MMA(1, 1, At, B1); PG8_BAR;
            PG8_LDB(B0, 1, 0); PG8_SCHED; PG8_LDA(At, 1, 0); PG8_STAGE(PG8_SA(0, 1), a2 + hstep, voffA);
            PG8_WAIT_L(8); PG8_BAR; PG8_WAIT_L(0); PG8_MMA(0, 0, At, B0); PG8_BAR; PG8_SCHED;
            PG8_LDB(B1, 1, 1); PG8_STAGE(PG8_SB(1, 0), b3, voffB);
            PG8_BAR; PG8_WAIT_L(0); PG8_MMA(0, 1, At, B1); PG8_BAR;
            PG8_LDA(At, 1, 1); PG8_STAGE(PG8_SA(1, 0), a3, voffA);
            PG8_BAR; PG8_WAIT_L(0); PG8_MMA(1, 0, At, B0); PG8_BAR; PG8_SCHED;
            PG8_STAGE(PG8_SB(1, 1), b3 + hstep, voffB);
            PG8_WAIT_V(6); PG8_BAR; PG8_MMA(1, 1, At, B1); PG8_BAR;
            }
        }
        if constexpr (ALIGN_EPI) { if (wr == 0) PG8_BAR; }
        if constexpr (!Epi::AFTER_DRAIN) { E(acc, cur, wr, wc, fr, fq); S.done(cur); }
        if (!has_next) break;
#pragma unroll
        for (int a = 0; a < 2; ++a)
#pragma unroll
            for (int b = 0; b < 2; ++b)
#pragma unroll
                for (int m = 0; m < 4; ++m)
#pragma unroll
                    for (int n = 0; n < 2; ++n) acc[a][b][m][n] = (f32x4){0.f, 0.f, 0.f, 0.f};
        cur = nxt; cA = nA; cB = nB; ++ui;
        if constexpr (ALIGN_EPI) { if (wr == 1) PG8_BAR; }
    }
    PG8_WAIT_V(0);
    if constexpr (!ALIGN_EPI) { if (wr == 0) PG8_BAR; }
    PG8_BAR;
    if constexpr (Epi::AFTER_DRAIN) { E.fused(acc, cur, wr, wc, fr, fq, lds, wid, lane); S.done(cur); }
#undef PG8_SA
#undef PG8_SB
#undef PG8_STAGE
#undef PG8_LDA
#undef PG8_LDB
#undef PG8_MMA
#undef PG8_WAIT_V
#undef PG8_WAIT_L
#undef PG8_BAR
#undef PG8_SCHED
}
}
#define GAS __attribute__((address_space(1)))
#define LAS __attribute__((address_space(3)))
typedef unsigned short bf16;
typedef unsigned v4u __attribute__((ext_vector_type(4)));
typedef float f32x4 __attribute__((ext_vector_type(4)));
typedef short bf16x8 __attribute__((ext_vector_type(8)));
typedef GAS unsigned gu32;
typedef GAS unsigned long long gu64;
#define RLX_AGENT __ATOMIC_RELAXED, __HIP_MEMORY_SCOPE_AGENT
#define LDS_WAIT() asm volatile("s_waitcnt lgkmcnt(0)" ::: "memory")
#define VM_WAIT() asm volatile("s_waitcnt vmcnt(0)" ::: "memory")
__device__ __forceinline__ unsigned long long rt() { return __builtin_amdgcn_s_memrealtime(); }
__device__ __forceinline__ unsigned f2bf(float f) { unsigned u = __builtin_bit_cast(unsigned, f); return (u + 0x7fffu + ((u >> 16) & 1u)) >> 16; }
__device__ __forceinline__ unsigned pk2(float lo, float hi) { return f2bf(lo) | (f2bf(hi) << 16); }

#define XB_TMO      128
#define XB_XCNT(j)  (256  + 64 * (j))
#define XB_XSUB(j)  (1280 + 64 * (j))
#define XB_XGEN(j)  (2304 + 64 * (j))
#define XB_TOP      3328
#define XB_TOPGEN   3392
#define XCD_BAR_WORDS 3456
#define XB_SPIN_CAP (1u << 18)

__device__ __forceinline__ unsigned xb_ld(unsigned* p)              { return __hip_atomic_load(p, __ATOMIC_RELAXED, __HIP_MEMORY_SCOPE_AGENT); }
__device__ __forceinline__ unsigned xb_add(unsigned* p, unsigned v) { return __hip_atomic_fetch_add(p, v, __ATOMIC_RELAXED, __HIP_MEMORY_SCOPE_AGENT); }
__device__ __forceinline__ unsigned xb_xcc_id() { return (unsigned)__builtin_amdgcn_s_getreg((3 << 11) | 20) & 0xFu; }
#define XB_SPIN(cond, bar) do { unsigned _sp = 0; while (cond) { __builtin_amdgcn_s_sleep(1); \
    if ((++_sp & 255u) == 0u) { if (xb_ld(&(bar)[XB_TMO])) break; if (_sp > XB_SPIN_CAP) { atomicAdd(&(bar)[XB_TMO], 1u); break; } } } } while (0)

struct XcdBarrier {
    unsigned* bar; unsigned x;
    volatile LAS unsigned* st;
};

__device__ __forceinline__ XcdBarrier xcd_barrier_post(unsigned* bar, volatile LAS unsigned* st, const int wid0) {
    XcdBarrier b; b.bar = bar; b.x = xb_xcc_id(); b.st = st;
    if (wid0 == 0 && fresh_lane() == 0) (void)xb_add(&bar[XB_XCNT(b.x)], 1u);
    return b;
}
__device__ __forceinline__ void xcd_barrier_complete(unsigned* bar, unsigned x, unsigned& nloc, unsigned& nx) {
    const unsigned G = gridDim.x * gridDim.y * gridDim.z;
    unsigned sum, cnt, mine, sp = 0u;
    for (;;) {
        sum = 0u; cnt = 0u; mine = 0u;
#pragma unroll 1
        for (unsigned j = 0; j < 16; ++j) { const unsigned c = xb_ld(&bar[XB_XCNT(j)]); sum += c; cnt += (c > 0u) ? 1u : 0u; mine = (j == x) ? c : mine; }
        if (sum == G) break;
        __builtin_amdgcn_s_sleep(1);
        if ((++sp & 255u) == 0u) { if (xb_ld(&bar[XB_TMO])) break; if (sp > XB_SPIN_CAP) { atomicAdd(&bar[XB_TMO], 1u); break; } }
    }
    nloc = mine > 0u ? mine : 1u; nx = cnt > 0u ? cnt : 1u;
}

__device__ __forceinline__ void xcd_barrier(const XcdBarrier& b, const int wid0) {
    asm volatile("s_waitcnt vmcnt(0)" ::: "memory");
    __syncthreads();
    if (wid0 == 0 && fresh_lane() == 0) {
        unsigned* bar = b.bar;
        __builtin_amdgcn_s_waitcnt(0);
        unsigned nloc = b.st[0], nx = b.st[1];
        const unsigned bx_ = xb_xcc_id();
        if (nloc == 0u) { xcd_barrier_complete(bar, bx_, nloc, nx); b.st[0] = nloc; b.st[1] = nx; }
        const unsigned old = xb_add(&bar[XB_XSUB(bx_)], 1u);
        const unsigned gen = old / nloc;
        if (old + 1u == (gen + 1u) * nloc) {
            __builtin_amdgcn_fence(__ATOMIC_RELEASE, "agent");
            asm volatile("s_waitcnt vmcnt(0)" ::: "memory");
            const unsigned og = xb_add(&bar[XB_TOP], 1u);
            const unsigned tg = og / nx;
            if (og + 1u == (tg + 1u) * nx) xb_add(&bar[XB_TOPGEN], 1u);
            else XB_SPIN(xb_ld(&bar[XB_TOPGEN]) == tg, bar);
            __builtin_amdgcn_fence(__ATOMIC_ACQUIRE, "agent");
            xb_add(&bar[XB_XGEN(bx_)], 1u);
            asm volatile("s_waitcnt vmcnt(0)" ::: "memory");
        } else {
            XB_SPIN(xb_ld(&bar[XB_XGEN(bx_)]) == gen, bar);
            __builtin_amdgcn_fence(__ATOMIC_ACQUIRE, "agent");
            asm volatile("s_waitcnt vmcnt(0)" ::: "memory");
        }
    }
    __syncthreads();
}
constexpr int NWAVES = 8;
constexpr int NB = 2, SEQ = 4096, DM = 4096, NL = 2, M = NB * SEQ;
constexpr int INC = 11336, INP = 11520;
constexpr int A_Q = 0, B_CQ = 3072, B_CKV = 4608, B_KR = 5120, C_Q = 5184, D_Q = 8256, D_F = 11328;
constexpr int QRANK = 1536, KVRANK = 512, DFF = 16384, MEMT = 256;
constexpr int P4DEF = 64 * 8 * 4;
constexpr int UPDEF = 88 * 8 * 8;
constexpr float EPS = 1e-6f;

constexpr size_t MiB = 1u << 20;
constexpr size_t WS_CTL = 0, CTL_ZERO_BYTES = 1 * MiB;
constexpr size_t WS_COS = 1 * MiB, WS_SIN = 2 * MiB;
constexpr size_t WS_LUT = 3 * MiB;
constexpr size_t WS_TPMAX = 3 * MiB + 8192;
constexpr size_t WS_LAM = 3 * MiB + 12288;
constexpr size_t WS_LOGF = 4 * MiB, WS_NEGC = 4 * MiB + 512 * 1024;
constexpr size_t WS_W = 8 * MiB;
constexpr size_t SZ_IN = (size_t)INP * DM * 2, SZ_OUT = (size_t)DM * DM * 2, SZ_UQ = (size_t)1536 * 1536 * 2, SZ_UKV = (size_t)2048 * 512 * 2,
                 SZ_MQ = (size_t)512 * DM * 2, SZ_MKV = (size_t)1024 * DM * 2, SZ_MO = (size_t)DM * 512 * 2, SZ_UP = (size_t)DFF * DM * 2, SZ_DN = SZ_UP;
constexpr size_t W_IN = 0, W_OUT = W_IN + SZ_IN, W_UQ = W_OUT + SZ_OUT, W_UKV = W_UQ + SZ_UQ, W_MQ = W_UKV + SZ_UKV, W_MKV = W_MQ + SZ_MQ, W_MO = W_MKV + SZ_MKV,
                 W_UP = W_MO + SZ_MO, W_DN = W_UP + SZ_UP, W_LAYER = W_DN + SZ_DN;
static_assert(W_LAYER % 256 == 0, "weight block alignment");
constexpr size_t WS_MEMN = WS_W + NL * W_LAYER;
constexpr size_t WS_KVMEM = WS_MEMN + (size_t)NL * 512 * DM * 2;
constexpr size_t WS_H = WS_KVMEM + (size_t)NL * 512 * 1024 * 2;
constexpr size_t WS_CQN = WS_H + (size_t)M * DM * 2;
constexpr size_t WS_CKVN = WS_CQN + (size_t)M * 1536 * 2;
constexpr size_t WS_KPE = WS_CKVN + (size_t)M * 512 * 2;
constexpr size_t WS_QMLA = WS_KPE + (size_t)M * 64 * 2;
constexpr size_t WS_KVMLA = WS_QMLA + (size_t)M * 1536 * 2;
constexpr size_t WS_QMEM = WS_KVMLA + (size_t)M * 2048 * 2;
constexpr size_t WS_OMEM = WS_QMEM + (size_t)M * 512 * 2;
constexpr size_t WS_XL = WS_OMEM + (size_t)M * 512 * 2;
constexpr size_t WS_U = WS_XL + (size_t)M * DM * 2;
constexpr size_t WS_PROJ = WS_U;
constexpr size_t WS_MIX = WS_PROJ + (size_t)M * INP * 2;
static_assert(WS_MIX + (size_t)M * DM * 2 <= WS_U + (size_t)M * DFF * 2, "PROJ + MIX fit inside U");
constexpr size_t WS_END = WS_U + (size_t)M * DFF * 2;
constexpr int CW_BAR = 4096;
constexpr int CW_SS = 32768;
constexpr int CW_KN = 24576;
constexpr int CW_TKT = 16384;

constexpr int RING_OFF = 0, RING_BYTES = 137216;
constexpr int LDSCTL_OFF = RING_BYTES, MISC_OFF = LDSCTL_OFF + 320;
constexpr int LDS_BYTES = 147456;

typedef unsigned short bf16;
typedef short bf16x8 __attribute__((ext_vector_type(8)));
typedef short s16x4 __attribute__((ext_vector_type(4)));
typedef float f32x4 __attribute__((ext_vector_type(4)));
typedef float f32x16 __attribute__((ext_vector_type(16)));
typedef unsigned v4u __attribute__((ext_vector_type(4)));
typedef unsigned v2u __attribute__((ext_vector_type(2)));
typedef int i32x4 __attribute__((ext_vector_type(4)));

__device__ __forceinline__ unsigned cvtpk(float lo, float hi) { unsigned r; asm volatile("v_cvt_pk_bf16_f32 %0, %1, %2" : "=v"(r) : "v"(lo), "v"(hi)); return r; }
__device__ __forceinline__ float bf2f(short s) { return __uint_as_float(((unsigned)(unsigned short)s) << 16); }
template <int X> __device__ __forceinline__ float shx(float v) { return __int_as_float(__builtin_amdgcn_ds_swizzle(__float_as_int(v), 0x1f | (X << 10))); }
template <int X> __device__ __forceinline__ int shxi(int v) { return __builtin_amdgcn_ds_swizzle(v, 0x1f | (X << 10)); }
__device__ __forceinline__ float half_sum(float v) { v += shx<1>(v); v += shx<2>(v); v += shx<4>(v); v += shx<8>(v); v += shx<16>(v); return v; }
__device__ __forceinline__ float wave_sum(float v) { v = half_sum(v);
    auto rr = __builtin_amdgcn_permlane32_swap(__float_as_uint(v), __float_as_uint(v), false, false); return __uint_as_float(rr[0]) + __uint_as_float(rr[1]); }
#define FRESH_LANE(name) const int name = fresh_lane()
#define WAITBAR() asm volatile("s_waitcnt vmcnt(0) lgkmcnt(0)\n\ts_barrier" ::: "memory")

__device__ __forceinline__ void tr_item(const float* W, int K, int N, int nblk, bf16* WT, int row_off, LAS float* scr, int item, int lane, const float* gk) {
    const int kb = item / nblk, nb = item - kb * nblk, k0 = 64 * kb, n0 = 64 * nb;
    const int c4 = (lane & 15) * 4, rr = lane >> 4; const bool ok = n0 + c4 < N;
    const GAS f32x4* src = (const GAS f32x4*)(W + (size_t)(k0 + rr) * N + n0 + c4);
    f32x4 v[16];
#pragma unroll
    for (int i = 0; i < 16; ++i) v[i] = ok ? __builtin_nontemporal_load((const GAS f32x4*)((const GAS float*)src + (size_t)(4 * i) * N)) : (f32x4){0.f, 0.f, 0.f, 0.f};
    if (gk) {
#pragma unroll
        for (int i = 0; i < 16; ++i) v[i] = v[i] * gk[k0 + 4 * i + rr]; }
#pragma unroll
    for (int i = 0; i < 16; ++i) { LAS float* s = scr + (4 * i + rr) * 65 + c4; s[0] = v[i].x; s[1] = v[i].y; s[2] = v[i].z; s[3] = v[i].w; }
    LDS_WAIT(); asm volatile("" ::: "memory");
    const int c = lane & 7;
#pragma unroll
    for (int j = 0; j < 8; ++j) { const int nn = (lane >> 3) + 8 * j; const LAS float* s = scr + (8 * c) * 65 + nn;
        v4u o; o.x = cvtpk(s[0 * 65], s[1 * 65]); o.y = cvtpk(s[2 * 65], s[3 * 65]); o.z = cvtpk(s[4 * 65], s[5 * 65]); o.w = cvtpk(s[6 * 65], s[7 * 65]);
        *(GAS v4u*)(WT + (size_t)(row_off + n0 + nn) * K + k0 + 8 * c) = o; }
    LDS_WAIT(); asm volatile("" ::: "memory");
}
template <bool BF> __device__ __forceinline__ void rms_row(const float* xrow, const float* g, void* orow, int lane) {
    const GAS f32x4* xr = (const GAS f32x4*)xrow + lane; const GAS f32x4* gr = (const GAS f32x4*)g + lane;
    f32x4 v[16]; float s = 0.f;
#pragma unroll
    for (int j = 0; j < 16; ++j) { v[j] = xr[64 * j]; s += (v[j].x * v[j].x + v[j].y * v[j].y) + (v[j].z * v[j].z + v[j].w * v[j].w); }
    const float rstd = 1.0f / sqrtf(wave_sum(s) * (1.f / DM) + EPS);
#pragma unroll
    for (int j = 0; j < 16; ++j) { const f32x4 gg = gr[64 * j]; const f32x4 y = v[j] * rstd * gg;
        if (BF) { v2u w; w.x = cvtpk(y.x, y.y); w.y = cvtpk(y.z, y.w); ((GAS v2u*)orow)[64 * j + lane] = w; }
        else ((GAS f32x4*)orow)[64 * j + lane] = y; }
}
__device__ __forceinline__ void cast_row(const float* xrow, bf16* hrow, unsigned long long* ss, int lane) {
    const GAS f32x4* xr = (const GAS f32x4*)xrow + lane; float s = 0.f;
#pragma unroll
    for (int j = 0; j < 16; ++j) { const f32x4 v = xr[64 * j]; s += (v.x * v.x + v.y * v.y) + (v.z * v.z + v.w * v.w);
        v2u h; h.x = cvtpk(v.x, v.y); h.y = cvtpk(v.z, v.w); ((GAS v2u*)hrow)[64 * j + lane] = h; }
    s = wave_sum(s); if (lane == 0) *ss = (unsigned long long)((double)s * 1048576.0);
}
__device__ __forceinline__ void final_row(const bf16* hrow, const float* g, float* orow, int lane) {
    f32x4 v[16]; float s = 0.f;
#pragma unroll
    for (int j = 0; j < 16; ++j) { const v2u h = ((const GAS v2u*)hrow)[64 * j + lane];
        v[j].x = __uint_as_float(h.x << 16); v[j].y = __uint_as_float(h.x & 0xffff0000u); v[j].z = __uint_as_float(h.y << 16); v[j].w = __uint_as_float(h.y & 0xffff0000u);
        s += (v[j].x * v[j].x + v[j].y * v[j].y) + (v[j].z * v[j].z + v[j].w * v[j].w); }
    const float rstd = 1.0f / sqrtf(wave_sum(s) * (1.f / DM) + EPS);
#pragma unroll
    for (int j = 0; j < 16; ++j) { const f32x4 gg = ((const GAS f32x4*)g)[64 * j + lane]; ((GAS f32x4*)orow)[64 * j + lane] = v[j] * rstd * gg; }
}
__device__ __forceinline__ float logsigmoidf_(float x) {
    const float e = __expf(-fabsf(x)); return fminf(x, 0.f) - __logf(1.f + e);
}
__device__ __forceinline__ void prep_row(const bf16* proj, int m, const float* gq, const float* gkv, const float* bf, const float* COS, const float* SIN,
                                         bf16* CQN, bf16* CKVN, bf16* KPE, float* LOGF, unsigned* KN2, int lane) {
    const bf16* pr = proj + (size_t)m * INP;
    bf16x8 q[3]; float sq = 0.f;
#pragma unroll
    for (int j = 0; j < 3; ++j) { q[j] = *(const GAS bf16x8*)(pr + B_CQ + (j * 64 + lane) * 8);
#pragma unroll
        for (int e = 0; e < 8; ++e) { const float f = bf2f(q[j][e]); sq += f * f; } }
    const bf16x8 kv = *(const GAS bf16x8*)(pr + B_CKV + lane * 8); float skv = 0.f;
#pragma unroll
    for (int e = 0; e < 8; ++e) { const float f = bf2f(kv[e]); skv += f * f; }
    const float rq = 1.0f / sqrtf(wave_sum(sq) * (1.f / QRANK) + EPS), rkv = 1.0f / sqrtf(wave_sum(skv) * (1.f / KVRANK) + EPS);
#pragma unroll
    for (int j = 0; j < 3; ++j) { const int c0 = (j * 64 + lane) * 8; const f32x4 g0 = *(const GAS f32x4*)(gq + c0), g1 = *(const GAS f32x4*)(gq + c0 + 4);
        v4u w; w.x = cvtpk(bf2f(q[j][0]) * rq * g0.x, bf2f(q[j][1]) * rq * g0.y); w.y = cvtpk(bf2f(q[j][2]) * rq * g0.z, bf2f(q[j][3]) * rq * g0.w);
        w.z = cvtpk(bf2f(q[j][4]) * rq * g1.x, bf2f(q[j][5]) * rq * g1.y); w.w = cvtpk(bf2f(q[j][6]) * rq * g1.z, bf2f(q[j][7]) * rq * g1.w);
        *(GAS v4u*)(CQN + (size_t)m * QRANK + c0) = w; }
    { const int c0 = lane * 8; const f32x4 g0 = *(const GAS f32x4*)(gkv + c0), g1 = *(const GAS f32x4*)(gkv + c0 + 4);
        v4u w; w.x = cvtpk(bf2f(kv[0]) * rkv * g0.x, bf2f(kv[1]) * rkv * g0.y); w.y = cvtpk(bf2f(kv[2]) * rkv * g0.z, bf2f(kv[3]) * rkv * g0.w);
        w.z = cvtpk(bf2f(kv[4]) * rkv * g1.x, bf2f(kv[5]) * rkv * g1.y); w.w = cvtpk(bf2f(kv[6]) * rkv * g1.z, bf2f(kv[7]) * rkv * g1.w);
        *(GAS v4u*)(CKVN + (size_t)m * KVRANK + c0) = w; }
    { const float v = bf2f((short)pr[B_KR + lane]); float pv; { auto rr = __builtin_amdgcn_permlane32_swap(__float_as_uint(v), __float_as_uint(v), false, false); pv = __uint_as_float(lane >= 32 ? rr[0] : rr[1]); } const int i = lane & 31;
      const float c = COS[(size_t)m * 32 + i], s = SIN[(size_t)m * 32 + i];
      const float o = lane < 32 ? v * c - pv * s : pv * s + v * c;
      const float on = shx<1>(o);
      if ((lane & 1) == 0) *(GAS unsigned*)(KPE + (size_t)m * 64 + lane) = cvtpk(o, on); }
    if (lane < 8) { const float f = bf2f((short)pr[D_F + lane]) + bf[lane]; const int b = m / SEQ, s = m - b * SEQ; LOGF[(size_t)(b * 8 + lane) * SEQ + s] = logsigmoidf_(f); }
    { const bf16x8 k0 = *(const GAS bf16x8*)(pr + D_Q + 1024 + lane * 16), k1 = *(const GAS bf16x8*)(pr + D_Q + 1024 + lane * 16 + 8); float s = 0.f;
#pragma unroll
      for (int e = 0; e < 8; ++e) { const float a = bf2f(k0[e]), c = bf2f(k1[e]); s += a * a + c * c; }
      s += shx<1>(s); s += shx<2>(s); s += shx<4>(s);
      if ((lane & 7) == 0) { unsigned* p = KN2 + (m / SEQ) * 8 + (lane >> 3); const unsigned v = __float_as_uint(s);
          if (v > __hip_atomic_load(p, __ATOMIC_RELAXED, __HIP_MEMORY_SCOPE_AGENT)) __hip_atomic_fetch_max(p, v, __ATOMIC_RELAXED, __HIP_MEMORY_SCOPE_AGENT); } }
}
__device__ __forceinline__ void fox_scan(const float* logf, float* negc, int lane) {
    const GAS f32x4* src = (const GAS f32x4*)(logf + lane * 64); f32x4 v[16]; float tot = 0.f;
#pragma unroll
    for (int j = 0; j < 16; ++j) { v[j] = src[j]; tot += (v[j].x + v[j].y) + (v[j].z + v[j].w); }
    float inc = tot;
#pragma unroll
    for (int o = 1; o < 64; o <<= 1) { const float t = __int_as_float(__builtin_amdgcn_ds_bpermute((lane - o) << 2, __float_as_int(inc))); if (lane >= o) inc += t; }
    float run = inc - tot; const float k = -11.313708498984761f;
    GAS f32x4* dst = (GAS f32x4*)(negc + lane * 64);
#pragma unroll
    for (int j = 0; j < 16; ++j) { f32x4 o; run += v[j].x; o.x = run * k; run += v[j].y; o.y = run * k; run += v[j].z; o.z = run * k; run += v[j].w; o.w = run * k; dst[j] = o; }
}

struct Cv { int idx, K, N, NP; long long dst; int roff, gain, lay, first, cnt, pad; };
constexpr int NCV = 12;
struct Args { const void* in[27]; float* out; unsigned char* ws; float inv_freq[32]; float lam_init[2]; Cv cv[NL][NCV]; int ncv[NL]; int nchunk[NL]; };
static_assert(sizeof(Cv) == 48 && sizeof(Args) == 27 * 8 + 16 + 128 + 8 + NL * NCV * 48 + 8 * NL, "Args has no padding");
typedef const unsigned char __attribute__((address_space(4)))* kaptr_t;
__device__ __forceinline__ kaptr_t ka_fresh() { kaptr_t p = (kaptr_t)__builtin_amdgcn_kernarg_segment_ptr(); asm volatile("" : "+s"(p)); return p; }
#define KIN(ka, i) (*(const void* const __attribute__((address_space(4)))*)((ka) + 8 * (i)))
#define KOUT(ka) ((float*)KIN(ka, 27))
#define KWS(ka) ((unsigned char*)KIN(ka, 28))
#define KINVF(ka, i) (*(const float __attribute__((address_space(4)))*)((ka) + 232 + 4 * (i)))
#define KLAMI(ka, l) (*(const float __attribute__((address_space(4)))*)((ka) + 360 + 4 * (l)))
#define KCVI(ka, l, j, f) (*(const int __attribute__((address_space(4)))*)((ka) + 368 + ((l) * NCV + (j)) * 48 + 4 * (f)))
#define KCVD(ka, l, j) (*(const long long __attribute__((address_space(4)))*)((ka) + 368 + ((l) * NCV + (j)) * 48 + 16))
#define KNCV(ka, l) (*(const int __attribute__((address_space(4)))*)((ka) + 368 + NL * NCV * 48 + 4 * (l)))
#define KNCH(ka, l) (*(const int __attribute__((address_space(4)))*)((ka) + 368 + NL * NCV * 48 + 4 * NL + 4 * (l)))
__device__ __forceinline__ void conv_chunk(const kaptr_t ka, unsigned char* ws, int l, int c, LAS float* scr, int wid, int lane) {
    const int n = KNCV(ka, l);
    for (int k = 0; k < 8; ++k) {
        int rem = c * 64 + wid * 8 + k, j = 0;
        for (; j < n; ++j) { const int cnt = KCVI(ka, l, j, 10); if (rem < cnt) break; rem -= cnt; }
        if (j >= n) break;
        const int idx = KCVI(ka, l, j, 0), K = KCVI(ka, l, j, 1), N = KCVI(ka, l, j, 2), NP = KCVI(ka, l, j, 3), roff = KCVI(ka, l, j, 6), gain = KCVI(ka, l, j, 7), lay = KCVI(ka, l, j, 8), first = KCVI(ka, l, j, 9);
        const float* gk = nullptr; if (gain >= 0) gk = (const float*)KIN(ka, gain) + (size_t)lay * K;
        tr_item((const float*)KIN(ka, idx) + (size_t)lay * K * N, K, N, NP / 64, (bf16*)(ws + KCVD(ka, l, j)), roff, scr, first + rem, lane, gk);
    }
}

namespace att {
constexpr int VA = 0, VB = 1, VC = 2, VD = 3, VE = 4;
constexpr int K_OFF = 0, V_OFF = 32768, B_OFF = 65536, WS_OFF = 67584, LUT_OFF = 69632, FLG_OFF = 70656, TKT_OFF = 70784, KPE_OFF = 71680, QF_OFF = 71680, ATT_END = QF_OFF + 65536;
constexpr float LOG2E = 1.4426950408889634f, LN2 = 0.6931471805599453f, THR = 8.f;
struct Ctx { const bf16* PROJ; const bf16* QMLA; const bf16* KVMLA; const bf16* KPE; bf16* MIX; const bf16* QMEM; const bf16* KVMEM; bf16* OMEM;
             const float* COS; const float* SIN; const float* LUT; const int* TPMAX; const int* pos; const float* NEGC; const float* sub_g; const unsigned* KN2; float lam, oml; };

__device__ __forceinline__ int crow(int r, int hi) { return (r & 3) + 8 * (r >> 2) + 4 * hi; }
__device__ __forceinline__ int swap23(int k) { return (k & ~0xC) | ((k & 4) << 1) | ((k & 8) >> 1); }
__device__ __forceinline__ float pmaxf(float v) { auto rr = __builtin_amdgcn_permlane32_swap(__float_as_uint(v), __float_as_uint(v), false, false); return fmaxf(__uint_as_float(rr[0]), __uint_as_float(rr[1])); }
__device__ __forceinline__ float psumf(float v) { auto rr = __builtin_amdgcn_permlane32_swap(__float_as_uint(v), __float_as_uint(v), false, false); return __uint_as_float(rr[0]) + __uint_as_float(rr[1]); }
__device__ __forceinline__ float partnerf(float v, int hi) { auto rr = __builtin_amdgcn_permlane32_swap(__float_as_uint(v), __float_as_uint(v), false, false); return __uint_as_float(hi ? rr[0] : rr[1]); }
__device__ __forceinline__ void dma16(const void* sbase, unsigned voff, unsigned ldsaddr) { unsigned keep;
    asm volatile("s_mov_b32 %0, m0\n\ts_mov_b32 m0, %3\n\ts_nop 0\n\tglobal_load_lds_dwordx4 %1, %2\n\ts_mov_b32 m0, %0" : "=&s"(keep) : "v"(voff), "s"(sbase), "s"(ldsaddr) : "memory"); }

template <int NK> __device__ __forceinline__ void qk(f32x16& p0, f32x16& p1, const LAS unsigned char* krow, int xr, int hx, const bf16x8* qf, int dstart) {
#pragma unroll
    for (int d0 = 0; d0 < NK; ++d0) { const int off = (((dstart + d0) * 32 + hx) ^ xr);
        const bf16x8 b0 = *(const LAS bf16x8*)(krow + off), b1 = *(const LAS bf16x8*)(krow + off + 8192);
        p0 = __builtin_amdgcn_mfma_f32_32x32x16_bf16(b0, qf[d0], p0, 0, 0, 0); p1 = __builtin_amdgcn_mfma_f32_32x32x16_bf16(b1, qf[d0], p1, 0, 0, 0); }
}
template <int NK> __device__ __forceinline__ void qk_l(f32x16& p0, f32x16& p1, const LAS unsigned char* krow, int xr, int hx, const LAS unsigned char* qlds, int dstart) {
#pragma unroll
    for (int d0 = 0; d0 < NK; ++d0) { const int off = (((dstart + d0) * 32 + hx) ^ xr);
        const bf16x8 b0 = *(const LAS bf16x8*)(krow + off), b1 = *(const LAS bf16x8*)(krow + off + 8192), q = *(const LAS bf16x8*)(qlds + (dstart + d0) * 1024);
        p0 = __builtin_amdgcn_mfma_f32_32x32x16_bf16(b0, q, p0, 0, 0, 0); p1 = __builtin_amdgcn_mfma_f32_32x32x16_bf16(b1, q, p1, 0, 0, 0); }
}
__device__ __forceinline__ void qk_pe(f32x16& p0, f32x16& p1, const LAS unsigned char* perow, int xpe, int hx, const bf16x8* qf) {
#pragma unroll
    for (int d0 = 0; d0 < 4; ++d0) { const int off = ((d0 * 32 + hx) ^ xpe);
        const bf16x8 b0 = *(const LAS bf16x8*)(perow + off), b1 = *(const LAS bf16x8*)(perow + off + 4096);
        p0 = __builtin_amdgcn_mfma_f32_32x32x16_bf16(b0, qf[d0], p0, 0, 0, 0); p1 = __builtin_amdgcn_mfma_f32_32x32x16_bf16(b1, qf[d0], p1, 0, 0, 0); }
}
__device__ __forceinline__ void pv(f32x16* o, unsigned vb, bf16x8 pa0, bf16x8 pa1, bf16x8 pa2, bf16x8 pa3) {
#define TRRD(dst, off) asm volatile("ds_read_b64_tr_b16 %0, %1 offset:%2" : "=&v"(dst) : "v"(vb), "i"(off) : "memory")
#define PV_D0(d0) do { s16x4 l0, l1, l2, l3, h0, h1, h2, h3; constexpr int b_ = (d0) * 512; \
        TRRD(l0, b_); TRRD(h0, b_ + 2048); TRRD(l1, b_ + 4096); TRRD(h1, b_ + 6144); TRRD(l2, b_ + 8192); TRRD(h2, b_ + 10240); TRRD(l3, b_ + 12288); TRRD(h3, b_ + 14336); \
        asm volatile("s_waitcnt lgkmcnt(0)" ::: "memory"); __builtin_amdgcn_sched_barrier(0); \
        o[d0] = __builtin_amdgcn_mfma_f32_32x32x16_bf16(pa0, (bf16x8){l0[0], l0[1], l0[2], l0[3], h0[0], h0[1], h0[2], h0[3]}, o[d0], 0, 0, 0); \
        o[d0] = __builtin_amdgcn_mfma_f32_32x32x16_bf16(pa1, (bf16x8){l1[0], l1[1], l1[2], l1[3], h1[0], h1[1], h1[2], h1[3]}, o[d0], 0, 0, 0); \
        o[d0] = __builtin_amdgcn_mfma_f32_32x32x16_bf16(pa2, (bf16x8){l2[0], l2[1], l2[2], l2[3], h2[0], h2[1], h2[2], h2[3]}, o[d0], 0, 0, 0); \
        o[d0] = __builtin_amdgcn_mfma_f32_32x32x16_bf16(pa3, (bf16x8){l3[0], l3[1], l3[2], l3[3], h3[0], h3[1], h3[2], h3[3]}, o[d0], 0, 0, 0); } while (0)
    PV_D0(0); PV_D0(1); PV_D0(2); PV_D0(3);
#undef PV_D0
#undef TRRD
}
__device__ __forceinline__ void pack_p(const f32x16& p0, const f32x16& p1, bf16x8& pa0, bf16x8& pa1, bf16x8& pa2, bf16x8& pa3) {
#define PK4(P, B_, OUT) do { unsigned a0 = cvtpk(P[B_ + 0], P[B_ + 1]), a1 = cvtpk(P[B_ + 2], P[B_ + 3]), b0 = cvtpk(P[B_ + 4], P[B_ + 5]), b1 = cvtpk(P[B_ + 6], P[B_ + 7]); \
        auto r0 = __builtin_amdgcn_permlane32_swap(a0, b0, false, false); auto r1 = __builtin_amdgcn_permlane32_swap(a1, b1, false, false); \
        v4u w = {r0[0], r1[0], r0[1], r1[1]}; OUT = __builtin_bit_cast(bf16x8, w); } while (0)
    PK4(p0, 0, pa0); PK4(p0, 8, pa1); PK4(p1, 0, pa2); PK4(p1, 8, pa3);
#undef PK4
}
__device__ __forceinline__ void softmax_pv(f32x16& p0, f32x16& p1, float& m, float& l, f32x16* o, LAS float* wsf, unsigned vb, int r32, int hi, const float SCALE, const float C2) {
    float mx0 = fmaxf(p0[0], p1[0]), mx1 = fmaxf(p0[1], p1[1]), mx2 = fmaxf(p0[2], p1[2]), mx3 = fmaxf(p0[3], p1[3]);
#pragma unroll
    for (int r = 4; r < 16; r += 4) { mx0 = fmaxf(fmaxf(mx0, p0[r]), p1[r]); mx1 = fmaxf(fmaxf(mx1, p0[r + 1]), p1[r + 1]); mx2 = fmaxf(fmaxf(mx2, p0[r + 2]), p1[r + 2]); mx3 = fmaxf(fmaxf(mx3, p0[r + 3]), p1[r + 3]); }
    float pmax = pmaxf(fmaxf(fmaxf(mx0, mx1), fmaxf(mx2, mx3)));
    float mn, alpha;
    if (__all((pmax - m) * SCALE <= THR)) { mn = m; alpha = 1.f; }
    else { mn = fmaxf(m, pmax); alpha = __builtin_amdgcn_exp2f((m - mn) * C2); m = mn; }
    const float mnL = -mn * C2;
#pragma unroll
    for (int r = 0; r < 16; ++r) { p0[r] = __builtin_amdgcn_exp2f(fmaf(p0[r], C2, mnL)); p1[r] = __builtin_amdgcn_exp2f(fmaf(p1[r], C2, mnL)); }
    float s0 = p0[0] + p1[0], s1 = p0[1] + p1[1], s2 = p0[2] + p1[2], s3 = p0[3] + p1[3];
#pragma unroll
    for (int r = 4; r < 16; r += 4) { s0 += p0[r] + p1[r]; s1 += p0[r + 1] + p1[r + 1]; s2 += p0[r + 2] + p1[r + 2]; s3 += p0[r + 3] + p1[r + 3]; }
    const float ps = psumf((s0 + s1) + (s2 + s3)); l = l * alpha + ps;
    bf16x8 pa0, pa1, pa2, pa3; pack_p(p0, p1, pa0, pa1, pa2, pa3);
    if (__any(alpha < 1.f)) { const int fl = fresh_lane(), fh = fl >> 5;
        if (fh == 0) wsf[fl] = alpha; asm volatile("s_waitcnt lgkmcnt(0)" ::: "memory");
#pragma unroll
        for (int r = 0; r < 16; ++r) { const float a = wsf[crow(r, fh)];
#pragma unroll
            for (int d = 0; d < 4; ++d) o[d][r] *= a; } }
    pv(o, vb, pa0, pa1, pa2, pa3);
}

template <int VAR>
__device__ __forceinline__ void attn_unit(const Ctx& C, int b, int h, int qb, LAS unsigned char* lds, int tid, int wid, int lane) {
    constexpr bool CAUSAL = VAR != VE, DESC = (VAR == VC || VAR == VD), MLA = (VAR == VB), DIFF = (VAR == VA), STICK = (VAR == VC), HASB = (VAR == VA || VAR == VD);
    constexpr int NQF = MLA ? 12 : 8;
    constexpr float SCALE = DIFF ? 0.125f : (MLA ? 0.07216878364870323f : 0.08838834764831845f);
    constexpr float C2 = SCALE * LOG2E;
    const int r32 = lane & 31, hi = lane >> 5;
    const int q0 = qb * 256, qw = q0 + wid * 32, trow = qw + r32;
    const size_t rb = (size_t)b * SEQ;
    const bf16 *Qp, *Kp, *Vp; bf16* Op; int qpitch, kpitch, opitch;
    if constexpr (VAR == VA || VAR == VC || VAR == VD) {
        constexpr int base = VAR == VA ? A_Q : (VAR == VC ? C_Q : D_Q);
        Qp = C.PROJ + rb * INP + base + h * 128; Kp = Qp + 1024; Vp = Qp + 2048; qpitch = INP; kpitch = INP;
        Op = C.MIX + rb * DM + VAR * 1024 + h * 128; opitch = DM;
    } else if constexpr (VAR == VB) {
        Qp = C.QMLA + rb * 1536 + h * 192; qpitch = 1536; Kp = C.KVMLA + rb * 2048 + h * 256; Vp = Kp + 128; kpitch = 2048;
        Op = C.MIX + rb * DM + 1024 + h * 128; opitch = DM;
    } else {
        Qp = C.QMEM + rb * 512 + h * 128; qpitch = 512; Kp = C.KVMEM + (size_t)b * MEMT * 1024 + h * 128; Vp = Kp + 512; kpitch = 1024;
        Op = C.OMEM + rb * 512 + h * 128; opitch = 512;
    }
    const char* Bp = nullptr;
    if constexpr (VAR == VA) Bp = (const char*)(C.pos + rb);
    if constexpr (VAR == VD) Bp = (const char*)(C.NEGC + (size_t)(b * 8 + h) * SEQ);
    const char* KPEp = nullptr;
    if constexpr (MLA) KPEp = (const char*)(C.KPE + rb * 64);
    bf16x8 qr[DIFF ? 1 : NQF];
    const LAS unsigned char* qlds = lds + QF_OFF + wid * 8192 + lane * 16;
    { const bf16* qrow = Qp + (size_t)trow * qpitch + hi * 8;
      if constexpr (DIFF) {
#pragma unroll
          for (int d0 = 0; d0 < 8; ++d0) { const bf16x8 q = *(const GAS bf16x8*)(qrow + d0 * 16); *(LAS bf16x8*)(lds + QF_OFF + wid * 8192 + lane * 16 + d0 * 1024) = q; }
      } else {
#pragma unroll
          for (int d0 = 0; d0 < NQF; ++d0) qr[d0] = *(const GAS bf16x8*)(qrow + d0 * 16); } }
    if constexpr (MLA) {
        const float* cs = C.COS + (rb + trow) * 32 + hi * 8; const float* sn = C.SIN + (rb + trow) * 32 + hi * 8;
#pragma unroll
        for (int j = 0; j < 2; ++j) {
            const f32x4 c0 = *(const GAS f32x4*)(cs + j * 16), c1 = *(const GAS f32x4*)(cs + j * 16 + 4), s0 = *(const GAS f32x4*)(sn + j * 16), s1 = *(const GAS f32x4*)(sn + j * 16 + 4);
            const bf16x8 a = qr[8 + j], bb = qr[10 + j]; float lo[8], hh[8];
#pragma unroll
            for (int e = 0; e < 8; ++e) { const float t1 = bf2f(a[e]), t2 = bf2f(bb[e]), c = e < 4 ? c0[e & 3] : c1[e & 3], s = e < 4 ? s0[e & 3] : s1[e & 3]; lo[e] = t1 * c - t2 * s; hh[e] = t1 * s + t2 * c; }
            v4u wl = {cvtpk(lo[0], lo[1]), cvtpk(lo[2], lo[3]), cvtpk(lo[4], lo[5]), cvtpk(lo[6], lo[7])}, wh = {cvtpk(hh[0], hh[1]), cvtpk(hh[2], hh[3]), cvtpk(hh[4], hh[5]), cvtpk(hh[6], hh[7])};
            qr[8 + j] = __builtin_bit_cast(bf16x8, wl); qr[10 + j] = __builtin_bit_cast(bf16x8, wh); }
    }
    unsigned koff[2], voff[2], peoff = 0;
#pragma unroll
    for (int i = 0; i < 2; ++i) { const int j = wid * 2 + i, row = 4 * j + (lane >> 4); koff[i] = (unsigned)(row * kpitch + (((lane & 15) ^ (row & 15)) << 3)) * 2u;
        const int st = 2 * j + (lane >> 5), kk = (st >> 2) * 8 + ((lane & 31) >> 2), c = (st & 3) * 32 + (lane & 3) * 8; voff[i] = (unsigned)(swap23(kk) * kpitch + c) * 2u; }
    if constexpr (MLA) { const int row = 8 * wid + (lane >> 3); peoff = (unsigned)(row * 64 + (((lane & 7) ^ ((row >> 1) & 7)) << 3)) * 2u; }
    const unsigned boff = (unsigned)(lane & 15) * 16u;
    const unsigned ldsbase = (unsigned)(unsigned long long)lds;
#define ISSUE(t_, buf_) do { const size_t tb_ = (size_t)(t_) * 64 * kpitch * 2; const char* kg_ = (const char*)Kp + tb_; const char* vg_ = (const char*)Vp + tb_; \
        _Pragma("unroll") for (int i_ = 0; i_ < 2; ++i_) dma16(kg_, koff[i_], ldsbase + K_OFF + (buf_) * 16384 + (wid * 2 + i_) * 1024); \
        _Pragma("unroll") for (int i_ = 0; i_ < 2; ++i_) dma16(vg_, voff[i_], ldsbase + V_OFF + (buf_) * 16384 + (wid * 2 + i_) * 1024); \
        if constexpr (MLA) dma16(KPEp + (size_t)(t_) * 64 * 64 * 2, peoff, ldsbase + KPE_OFF + (buf_) * 8192 + wid * 1024); \
        if constexpr (HASB) { if (wid == 0) dma16(Bp + (size_t)(t_) * 64 * 4, boff, ldsbase + B_OFF + (buf_) * 1024); } } while (0)
    const int NT = CAUSAL ? (q0 + 256) / 64 : MEMT / 64;
    LAS float* wsf = (LAS float*)(lds + WS_OFF) + wid * 64;
    LAS float* lut = (LAS float*)(lds + LUT_OFF);
    int pos_t = 0, wmin = 0; float lut_far = 0.f;
    if constexpr (DIFF) { if (tid < 132) lut[tid] = C.LUT[h * 132 + tid];
        pos_t = C.pos[rb + trow]; int mnp = pos_t;
        mnp = min(mnp, shxi<1>(mnp)); mnp = min(mnp, shxi<2>(mnp)); mnp = min(mnp, shxi<4>(mnp)); mnp = min(mnp, shxi<8>(mnp)); mnp = min(mnp, shxi<16>(mnp));
        wmin = __builtin_amdgcn_readfirstlane(mnp); lut_far = C.LUT[h * 132 + 128]; }
    const int xr = (r32 & 15) << 4, hx = hi << 4, xpe = ((r32 >> 1) & 7) << 4;
    const unsigned vrd = (unsigned)(((lane & 3) << 3) | (((lane >> 2) & 3) << 6) | (((lane >> 4) & 1) << 5) | (((lane >> 5) & 1) << 8));
    f32x16 o[4]; f32x16 o2[DIFF ? 4 : 1];
#pragma unroll
    for (int d = 0; d < 4; ++d) { o[d] = f32x16{}; if constexpr (DIFF) o2[d] = f32x16{}; }
    float m1 = -1e30f, l1 = 0.f, m2 = -1e30f, l2 = 0.f, R = 0.f;
    float qnkn = 0.f;
    if constexpr (VAR == VD) { float s = 0.f;
#pragma unroll
        for (int d0 = 0; d0 < 8; ++d0)
#pragma unroll
            for (int e = 0; e < 8; ++e) { const float a = bf2f(qr[d0][e]); s += a * a; }
        s = psumf(s); qnkn = sqrtf(s) * sqrtf(__uint_as_float(C.KN2[b * 8 + h])) * 1.001f + 1.f; }
    ISSUE(DESC ? NT - 1 : 0, 0);
    WAITBAR();
    int cur = 0;
    for (int i = 0; i < NT; ++i) {
        const int t = DESC ? NT - 1 - i : i, kb = t * 64;
        if (i + 1 < NT) ISSUE(DESC ? t - 1 : t + 1, cur ^ 1);
        const bool act = !CAUSAL || (STICK ? (kb < qw + 31) : (kb <= qw + 31));
        bool wdone = false;
        if constexpr (VAR == VD) {
            if (act) { const float nmax = ((const LAS float*)(lds + B_OFF + cur * 1024))[63]; wdone = __all((qnkn + nmax - m1) * SCALE < -40.f); } }
        if (act && !wdone) {
            const LAS unsigned char* krow = lds + K_OFF + cur * 16384 + r32 * 256;
            const unsigned vb = ldsbase + V_OFF + cur * 16384 + vrd;
            if constexpr (STICK) {
                f32x16 p0 = f32x16{}, p1 = f32x16{};
                qk<8>(p0, p1, krow, xr, hx, qr, 0);
                float L0[16], L1[16];
#pragma unroll
                for (int r = 0; r < 16; ++r) { const int key = kb + crow(r, hi);
                    { const float z = p0[r] * SCALE, e = __builtin_amdgcn_exp2f(-fabsf(z) * LOG2E), sp = fmaxf(z, 0.f) + __builtin_amdgcn_logf(1.f + e) * LN2; L0[r] = key < trow ? -sp : 0.f; p0[r] = z; }
                    { const float z = p1[r] * SCALE, e = __builtin_amdgcn_exp2f(-fabsf(z) * LOG2E), sp = fmaxf(z, 0.f) + __builtin_amdgcn_logf(1.f + e) * LN2; L1[r] = key + 32 < trow ? -sp : 0.f; p1[r] = z; } }
                float T[8], mb[8];
#pragma unroll
                for (int g = 0; g < 4; ++g) { T[g] = (L0[4 * g] + L0[4 * g + 1]) + (L0[4 * g + 2] + L0[4 * g + 3]); T[4 + g] = (L1[4 * g] + L1[4 * g + 1]) + (L1[4 * g + 2] + L1[4 * g + 3]); }
                float run = R;
#pragma unroll
                for (int k = 7; k >= 0; --k) { const float pt = partnerf(T[k], hi); const float T1 = hi ? T[k] : pt, T0 = hi ? pt : T[k];
                    const float b1 = run; run += T1; const float b0 = run; run += T0; mb[k] = hi ? b1 : b0; }
                R = run;
#pragma unroll
                for (int g = 0; g < 4; ++g) { float s0 = mb[g], s1 = mb[4 + g];
#pragma unroll
                    for (int e = 3; e >= 0; --e) { const int r = 4 * g + e, key = kb + crow(r, hi);
                        const float a0 = key < trow ? __builtin_amdgcn_exp2f((p0[r] + L0[r] + s0) * LOG2E) : 0.f; s0 += L0[r]; p0[r] = a0;
                        const float a1 = key + 32 < trow ? __builtin_amdgcn_exp2f((p1[r] + L1[r] + s1) * LOG2E) : 0.f; s1 += L1[r]; p1[r] = a1; } }
                bf16x8 pa0, pa1, pa2, pa3; pack_p(p0, p1, pa0, pa1, pa2, pa3);
                pv(o, vb, pa0, pa1, pa2, pa3);
            } else {
#pragma unroll
                for (int mp = 0; mp < (DIFF ? 2 : 1); ++mp) {
                    f32x16 p0, p1;
                    int xr_t = xr;
                    if constexpr (DIFF) { __builtin_amdgcn_sched_barrier(0); asm volatile("" : "+v"(pos_t), "+v"(xr_t)); }
                    if constexpr (VAR == VD) { const LAS float* nb = (const LAS float*)(lds + B_OFF + cur * 1024) + 4 * hi;
#pragma unroll
                        for (int g = 0; g < 4; ++g) { const f32x4 v0 = *(const LAS f32x4*)(nb + 8 * g), v1 = *(const LAS f32x4*)(nb + 32 + 8 * g);
#pragma unroll
                            for (int e = 0; e < 4; ++e) { p0[4 * g + e] = v0[e]; p1[4 * g + e] = v1[e]; } } }
                    else if constexpr (DIFF) {
                        if (wmin - C.TPMAX[b * 64 + t] >= 128) {
#pragma unroll
                            for (int r = 0; r < 16; ++r) { p0[r] = lut_far; p1[r] = lut_far; } }
                        else { const LAS int* pb = (const LAS int*)(lds + B_OFF + cur * 1024) + 4 * hi;
#pragma unroll
                            for (int g = 0; g < 4; ++g) { const i32x4 v0 = *(const LAS i32x4*)(pb + 8 * g), v1 = *(const LAS i32x4*)(pb + 32 + 8 * g);
#pragma unroll
                                for (int e = 0; e < 4; ++e) { p0[4 * g + e] = lut[min(max(pos_t - v0[e], 0), 128)]; p1[4 * g + e] = lut[min(max(pos_t - v1[e], 0), 128)]; }
                                __builtin_amdgcn_sched_barrier(0); } } }
                    else { p0 = f32x16{}; p1 = f32x16{}; }
                    if constexpr (DIFF) qk_l<4>(p0, p1, krow, xr_t, hx, qlds, 4 * mp);
                    else qk<8>(p0, p1, krow, xr, hx, qr, 0);
                    if constexpr (MLA) qk_pe(p0, p1, lds + KPE_OFF + cur * 8192 + r32 * 128, xpe, hx, qr + 8);
                    if (CAUSAL && kb + 63 > qw) { const float NEG = -__builtin_inff();
#pragma unroll
                        for (int r = 0; r < 16; ++r) { const int key = kb + crow(r, hi); if (key > trow) p0[r] = NEG; if (key + 32 > trow) p1[r] = NEG; } }
                    if (mp == 0) softmax_pv(p0, p1, m1, l1, o, wsf, vb, r32, hi, SCALE, C2);
                    else softmax_pv(p0, p1, m2, l2, o2, wsf, vb, r32, hi, SCALE, C2);
                }
            }
        }
        if constexpr (STICK) { const int dn_ = __all(R < -100.f) ? 1 : 0; if (lane == 0) ((LAS int*)(lds + FLG_OFF))[(i & 1) * 8 + wid] = dn_; }
        if constexpr (VAR == VD) { if (lane == 0) ((LAS int*)(lds + FLG_OFF))[(i & 1) * 8 + wid] = wdone ? 1 : 0; }
        WAITBAR(); cur ^= 1;
        if constexpr (STICK || VAR == VD) { const LAS i32x4* fl = (const LAS i32x4*)(lds + FLG_OFF + (i & 1) * 32); const i32x4 f0 = fl[0], f1 = fl[1];
            const int alld = (f0.x & f0.y & f0.z & f0.w) & (f1.x & f1.y & f1.z & f1.w); if (__builtin_amdgcn_readfirstlane(alld)) break; }
    }
#undef ISSUE
    const int lane_e = fresh_lane();
    const int r32e = lane_e & 31, hie = lane_e >> 5;
    bf16* Ob = Op + (size_t)(qw + 4 * hie) * opitch + r32e;
    if constexpr (DIFF) {
        if (hie == 0) { wsf[r32e] = l1; wsf[32 + r32e] = l2; } asm volatile("s_waitcnt lgkmcnt(0)" ::: "memory");
        const float lam = C.lam;
#pragma unroll
        for (int r = 0; r < 16; ++r) { const float i1 = __builtin_amdgcn_rcpf(wsf[crow(r, hie)]), i2 = lam * __builtin_amdgcn_rcpf(wsf[32 + crow(r, hie)]); float ss = 0.f;
#pragma unroll
            for (int d = 0; d < 4; ++d) { const float x = o[d][r] * i1 - o2[d][r] * i2; o[d][r] = x; ss += x * x; }
            ss = half_sum(ss);
            const float rstd = (1.0f / sqrtf(ss * (1.f / 128.f) + EPS)) * C.oml;
#pragma unroll
            for (int d = 0; d < 4; ++d) o[d][r] *= rstd; }
#pragma unroll
        for (int d = 0; d < 4; ++d) { const float g = C.sub_g[d * 32 + r32e];
#pragma unroll
            for (int r = 0; r < 16; ++r) o[d][r] *= g; }
    } else if constexpr (!STICK) {
        if (hie == 0) wsf[r32e] = l1; asm volatile("s_waitcnt lgkmcnt(0)" ::: "memory");
#pragma unroll
        for (int r = 0; r < 16; ++r) { const float i1 = __builtin_amdgcn_rcpf(wsf[crow(r, hie)]);
#pragma unroll
            for (int d = 0; d < 4; ++d) o[d][r] *= i1; }
    }
#pragma unroll
    for (int r = 0; r < 16; ++r) { const int orr = (r & 3) + 8 * (r >> 2);
#pragma unroll
        for (int d = 0; d < 4; ++d) { const float v = o[d][r], vn = shx<1>(v);
            if ((r32e & 1) == 0) *(GAS unsigned*)(Ob + (size_t)orr * opitch + d * 32) = cvtpk(v, vn); } }
}
template <int VAR> __device__ __forceinline__ void attn_queue(const Ctx& C, gu32* head, LAS unsigned char* lds, const int wid, const kaptr_t ka, unsigned char* ws, const int cvl) {
    constexpr int NH = VAR == VE ? 4 : 8, NU = NB * NH * 16;
    const int lane = fresh_lane(), tid = wid * 64 + lane;
    volatile LAS int* tk = (volatile LAS int*)(lds + LDSCTL_OFF);
    for (;;) {
        if (tid == 0) tk[0] = (int)__hip_atomic_fetch_add(head, 1u, RLX_AGENT);
        WAITBAR();
        const int n = __builtin_amdgcn_readfirstlane(tk[0]);
        if (n >= NU) break;
        const int qb = 15 - n / (NB * NH), bh = n % (NB * NH);
        attn_unit<VAR>(C, bh / NH, bh % NH, qb, lds, tid, wid, lane);
        if (cvl >= 0) {
            if (tid == 0) tk[1] = (int)__hip_atomic_fetch_add((gu32*)(ws + WS_CTL) + CW_TKT + (cvl * 16 + 10) * 64, 1u, RLX_AGENT);
            WAITBAR();
            const int c = __builtin_amdgcn_readfirstlane(tk[1]);
            if (c < KNCH(ka, cvl)) conv_chunk(ka, ws, cvl, c, (LAS float*)(lds + RING_OFF + wid * 16640), wid, lane);
        }
    }
}
}


namespace att {
template <int VAR> __device__ __forceinline__ void attn_phase(int l, int q, LAS unsigned char* lds, const int wid0) {
    const kaptr_t ka = ka_fresh(); unsigned char* ws = KWS(ka);
    const Ctx C{(const bf16*)(ws + WS_PROJ), (const bf16*)(ws + WS_QMLA), (const bf16*)(ws + WS_KVMLA), (const bf16*)(ws + WS_KPE), (bf16*)(ws + WS_MIX), (const bf16*)(ws + WS_QMEM),
                (const bf16*)(ws + WS_KVMEM) + (size_t)l * 512 * 1024, (bf16*)(ws + WS_OMEM), (const float*)(ws + WS_COS), (const float*)(ws + WS_SIN), (const float*)(ws + WS_LUT),
                (const int*)(ws + WS_TPMAX), (const int*)KIN(ka, 2), (const float*)(ws + WS_NEGC), (const float*)KIN(ka, 11) + l * 128, (const unsigned*)((gu32*)(ws + WS_CTL) + CW_KN + l * 64), ((const float*)(ws + WS_LAM))[l], 1.0f - KLAMI(ka, l)};
    attn_queue<VAR>(C, (gu32*)(ws + WS_CTL) + CW_TKT + (l * 16 + q) * 64, lds, wid0, ka, ws, VAR == VE ? -1 : l);
}
}

__global__ void __launch_bounds__(NWAVES * 64, 2) mk_fwd(Args args) {
    extern __shared__ __attribute__((aligned(16))) unsigned char lds_raw[];
    LAS unsigned char* lds = (LAS unsigned char*)lds_raw;
    const int G = gridDim.x, bx = blockIdx.x;
    const int vcu = (G % 8 == 0) ? (bx % 8) * (G / 8) + bx / 8 : bx;
    const int wid0 = __builtin_amdgcn_readfirstlane((int)threadIdx.x >> 6);
    const int gw = vcu * NWAVES + wid0, NGW = G * NWAVES;
    { const int tid = wid0 * 64 + fresh_lane();
      for (int u = tid; u < (LDS_BYTES - LDSCTL_OFF) / 4; u += NWAVES * 64) ((LAS unsigned*)(lds + LDSCTL_OFF))[u] = 0u; }
    __syncthreads();
    volatile LAS unsigned* MISC = (volatile LAS unsigned*)(lds + MISC_OFF);
    XcdBarrier bar = xcd_barrier_post((unsigned*)(args.ws + WS_CTL) + CW_BAR, MISC + 8, wid0);

    {
        const kaptr_t ka = ka_fresh(); unsigned char* ws = KWS(ka);
        const int lane = fresh_lane(), wid = wid0, tid = wid * 64 + lane;
        LAS float* scr = (LAS float*)(lds + RING_OFF + wid * 16640);
        {
            const int l = 0; unsigned char* wl = ws + WS_W;
#define TR_MAT(idx_, K_, N_, NP_, dst_, roff_, gain_) do { const float* s_ = (const float*)KIN(ka, idx_) + (size_t)l * (K_) * (N_); const int nblk_ = (NP_) / 64, nit_ = ((K_) / 64) * nblk_; \
            const float* gk_ = (gain_) >= 0 ? (const float*)KIN(ka, (gain_) >= 0 ? (gain_) : 0) + (size_t)l * (K_) : nullptr; \
            for (int it = gw; it < nit_; it += NGW) tr_item(s_, (K_), (N_), nblk_, (bf16*)(dst_), (roff_), scr, it, lane, gk_); } while (0)
            TR_MAT(4, DM, INC, INP, wl + W_IN, 0, 3);
            TR_MAT(14, QRANK, 1536, 1536, wl + W_UQ, 0, -1);
            TR_MAT(15, KVRANK, 2048, 2048, wl + W_UKV, 0, -1);
            TR_MAT(20, DM, 512, 512, wl + W_MKV, 0, -1);
            TR_MAT(21, DM, 512, 512, wl + W_MKV, 512, -1);
#undef TR_MAT
        }
        { const float* x0 = (const float*)KIN(ka, 0); bf16* H = (bf16*)(ws + WS_H); unsigned long long* SS = (unsigned long long*)((gu32*)(ws + WS_CTL) + CW_SS);
          for (int m = gw; m < M; m += NGW) cast_row(x0 + (size_t)m * DM, H + (size_t)m * DM, SS + m, lane); }
        { const float* mem = (const float*)KIN(ka, 1); bf16* MEMN = (bf16*)(ws + WS_MEMN);
          for (int r = gw; r < NL * NB * MEMT; r += NGW) { const int l = r / (NB * MEMT), mr = r - l * (NB * MEMT);
            rms_row<true>(mem + (size_t)mr * DM, (const float*)KIN(ka, 18) + (size_t)l * DM, MEMN + (size_t)r * DM, lane); } }
        const int* pos = (const int*)KIN(ka, 2);
        float* COS = (float*)(ws + WS_COS); float* SIN = (float*)(ws + WS_SIN); float* LUT = (float*)(ws + WS_LUT); int* TPMAX = (int*)(ws + WS_TPMAX); float* LAM = (float*)(ws + WS_LAM);
        const int gt = vcu * (NWAVES * 64) + tid, NGT = G * NWAVES * 64;
        for (int i = gt; i < M * 32; i += NGT) { const int row = i >> 5, f = i & 31; const float ang = (float)pos[row] * KINVF(ka, f);
            double rv = (double)ang * 0.15915494309189535; rv -= floor(rv); const float fr = (float)rv;
            COS[i] = __builtin_amdgcn_cosf(fr); SIN[i] = __builtin_amdgcn_sinf(fr); }
        for (int i = gt; i < 8 * 132; i += NGT) { const int h = i / 132, dd0 = i - h * 132; const int dd = dd0 > 128 ? 128 : dd0; int bk;
            if (dd < 16) bk = dd; else { bk = 16 + (int)(logf((float)dd / 16.0f) / 2.0794415416798357f * 16.0f); bk = bk > 31 ? 31 : bk; }
            LUT[i] = 8.0f * ((const float*)KIN(ka, 6))[bk * 8 + h]; }
        for (int i = gt; i < NB * 64; i += NGT) { int mx = pos[i * 64];
            for (int k = 1; k < 64; ++k) mx = max(mx, pos[i * 64 + k]);
            TPMAX[i] = mx; }
        if (gt < NL) { const int l = gt; float s1 = 0.f, s2 = 0.f;
            for (int k = 0; k < 64; ++k) { s1 += ((const float*)KIN(ka, 7))[l * 64 + k] * ((const float*)KIN(ka, 8))[l * 64 + k]; s2 += ((const float*)KIN(ka, 9))[l * 64 + k] * ((const float*)KIN(ka, 10))[l * 64 + k]; }
            LAM[l] = expf(s1) - expf(s2) + KLAMI(ka, l); }
    }
    xcd_barrier(bar, wid0);

    for (int l = 0; l < NL; ++l) {
        { const kaptr_t ka = ka_fresh(); unsigned char* ws = KWS(ka); unsigned char* wl = ws + WS_W + (size_t)l * W_LAYER;
          { pg8::Gemm g{(const bf16*)(ws + WS_H), (const bf16*)(wl + W_IN), M, INP, DM}; pg8::StaticOrder S; S.init(M, INP, G, bx);
            pg8::EpiBf16<0, true> E{(bf16*)(ws + WS_PROJ), INP, (const unsigned long long*)((gu32*)(ws + WS_CTL) + CW_SS) + (size_t)(3 * l) * M};
            pg8::gemm_phase<pg8::EpiBf16<0, true>, pg8::StaticOrder, true, true>(lds + RING_OFF, g, S, E, wid0); }
          { pg8::Gemm g{(const bf16*)(ws + WS_MEMN) + (size_t)l * 512 * DM, (const bf16*)(wl + W_MKV), 512, 1024, DM}; pg8::StaticOrder S; S.init(512, 1024, G, G - 1 - bx);
            pg8::EpiBf16<0, false> E{(bf16*)(ws + WS_KVMEM) + (size_t)l * 512 * 1024, 1024, nullptr};
            pg8::gemm_phase<pg8::EpiBf16<0, false>, pg8::StaticOrder, true, true>(lds + RING_OFF, g, S, E, wid0); }
          if (G == 256 && bx >= 160 && bx < 248) {
              const int lane = fresh_lane(); LAS float* scr = (LAS float*)(lds + RING_OFF + wid0 * 16640);
              const float* s_ = (const float*)KIN(ka, 24) + (size_t)(NL - 1) * DM * DFF; const float* gk_ = (const float*)KIN(ka, 23) + (size_t)(NL - 1) * DM;
              bf16* dst = (bf16*)(ws + WS_W + (size_t)(NL - 1) * W_LAYER + W_UP);
              for (int it = l * UPDEF + (bx - 160) * NWAVES + wid0; it < (l + 1) * UPDEF; it += 88 * NWAVES) tr_item(s_, DM, DFF, DFF / 64, dst, 0, scr, it, lane, gk_); } }
        xcd_barrier(bar, wid0);
        { const kaptr_t ka = ka_fresh(); unsigned char* ws = KWS(ka); FRESH_LANE(ln);
          for (int m = gw; m < M; m += NGW)
            prep_row((const bf16*)(ws + WS_PROJ), m, (const float*)KIN(ka, 12) + (size_t)l * QRANK, (const float*)KIN(ka, 13) + (size_t)l * KVRANK, (const float*)KIN(ka, 16) + l * 8,
                     (const float*)(ws + WS_COS), (const float*)(ws + WS_SIN), (bf16*)(ws + WS_CQN), (bf16*)(ws + WS_CKVN), (bf16*)(ws + WS_KPE), (float*)(ws + WS_LOGF), (unsigned*)((gu32*)(ws + WS_CTL) + CW_KN + l * 64), ln); }
        xcd_barrier(bar, wid0);
        { const kaptr_t ka = ka_fresh(); unsigned char* ws = KWS(ka); unsigned char* wl = ws + WS_W + (size_t)l * W_LAYER;
          if (gw < 16) { FRESH_LANE(ln); fox_scan((const float*)(ws + WS_LOGF) + (size_t)gw * SEQ, (float*)(ws + WS_NEGC) + (size_t)gw * SEQ, ln); }
          { pg8::Gemm g{(const bf16*)(ws + WS_CQN), (const bf16*)(wl + W_UQ), M, 1536, QRANK}; pg8::StaticOrder S; S.init(M, 1536, G, bx);
            pg8::EpiBf16<0, false> E{(bf16*)(ws + WS_QMLA), 1536, nullptr};
            pg8::gemm_phase<pg8::EpiBf16<0, false>, pg8::StaticOrder, true, true>(lds + RING_OFF, g, S, E, wid0); }
          { pg8::Gemm g{(const bf16*)(ws + WS_CKVN), (const bf16*)(wl + W_UKV), M, 2048, KVRANK}; pg8::StaticOrder S; S.init(M, 2048, G, G - 1 - bx);
            pg8::EpiBf16<0, false> E{(bf16*)(ws + WS_KVMLA), 2048, nullptr};
            pg8::gemm_phase<pg8::EpiBf16<0, false>, pg8::StaticOrder, true, true>(lds + RING_OFF, g, S, E, wid0); }
          if (G == 256 && bx >= 192) {
              const int lane = fresh_lane(); LAS float* scr = (LAS float*)(lds + RING_OFF + wid0 * 16640);
              const float* s_ = (const float*)KIN(ka, 24) + (size_t)(NL - 1) * DM * DFF; const float* gk_ = (const float*)KIN(ka, 23) + (size_t)(NL - 1) * DM;
              bf16* dst = (bf16*)(ws + WS_W + (size_t)(NL - 1) * W_LAYER + W_UP);
              for (int it = 2 * UPDEF + l * P4DEF + (bx - 192) * NWAVES + wid0; it < 2 * UPDEF + (l + 1) * P4DEF; it += 64 * NWAVES) tr_item(s_, DM, DFF, DFF / 64, dst, 0, scr, it, lane, gk_); } }
        xcd_barrier(bar, wid0);
        att::attn_phase<att::VA>(l, 0, lds, wid0);
        att::attn_phase<att::VB>(l, 1, lds, wid0);
        att::attn_phase<att::VD>(l, 2, lds, wid0);
        att::attn_phase<att::VC>(l, 3, lds, wid0);
        { const kaptr_t ka = ka_fresh(); unsigned char* ws = KWS(ka); const int lane = fresh_lane(); volatile LAS int* tk = (volatile LAS int*)(lds + LDSCTL_OFF + 16);
          for (;;) { if (wid0 == 0 && lane == 0) tk[0] = (int)__hip_atomic_fetch_add((gu32*)(ws + WS_CTL) + CW_TKT + (l * 16 + 10) * 64, 1u, RLX_AGENT);
              WAITBAR(); const int c = __builtin_amdgcn_readfirstlane(tk[0]); WAITBAR();
              if (c >= KNCH(ka, l)) break;
              conv_chunk(ka, ws, l, c, (LAS float*)(lds + RING_OFF + wid0 * 16640), wid0, lane); } }
        xcd_barrier(bar, wid0);
        { const kaptr_t ka = ka_fresh(); unsigned char* ws = KWS(ka); unsigned char* wl = ws + WS_W + (size_t)l * W_LAYER;
          pg8::Gemm g{(const bf16*)(ws + WS_MIX), (const bf16*)(wl + W_OUT), M, DM, DM}; pg8::StaticOrder S; S.init(M, DM, G, bx);
          pg8::EpiRes E{(bf16*)(ws + WS_H), DM, (unsigned long long*)((gu32*)(ws + WS_CTL) + CW_SS) + (size_t)(3 * l + 1) * M};
          pg8::gemm_phase<pg8::EpiRes, pg8::StaticOrder, true, true>(lds + RING_OFF, g, S, E, wid0); }
        xcd_barrier(bar, wid0);
        { const kaptr_t ka = ka_fresh(); unsigned char* ws = KWS(ka); unsigned char* wl = ws + WS_W + (size_t)l * W_LAYER;
          pg8::Gemm g{(const bf16*)(ws + WS_H), (const bf16*)(wl + W_MQ), M, 512, DM}; pg8::StaticOrder S; S.init(M, 512, G, bx);
          pg8::EpiBf16<0, true> E{(bf16*)(ws + WS_QMEM), 512, (const unsigned long long*)((gu32*)(ws + WS_CTL) + CW_SS) + (size_t)(3 * l + 1) * M};
          pg8::gemm_phase<pg8::EpiBf16<0, true>, pg8::StaticOrder, true, true>(lds + RING_OFF, g, S, E, wid0);
          if (G > 64 && bx >= 64) {
              const int lane = fresh_lane(); LAS float* scr = (LAS float*)(lds + RING_OFF + wid0 * 16640);
              const float* s_ = (const float*)KIN(ka, 25) + (size_t)(NL - 1) * DFF * DM; bf16* dst = (bf16*)(ws + WS_W + (size_t)(NL - 1) * W_LAYER + W_DN);
              constexpr int nblk = DM / 64, nit = (DFF / 64) * nblk, per = nit / NL;
              for (int it = l * per + (bx - 64) * NWAVES + wid0; it < (l + 1) * per; it += (G - 64) * NWAVES) tr_item(s_, DFF, DM, nblk, dst, 0, scr, it, lane, nullptr); } }
        xcd_barrier(bar, wid0);
        att::attn_phase<att::VE>(l, 4, lds, wid0);
        xcd_barrier(bar, wid0);
        { const kaptr_t ka = ka_fresh(); unsigned char* ws = KWS(ka); unsigned char* wl = ws + WS_W + (size_t)l * W_LAYER;
          pg8::Gemm g{(const bf16*)(ws + WS_OMEM), (const bf16*)(wl + W_MO), M, DM, 512}; pg8::StaticOrder S; S.init(M, DM, G, bx);
          pg8::EpiRes E{(bf16*)(ws + WS_H), DM, (unsigned long long*)((gu32*)(ws + WS_CTL) + CW_SS) + (size_t)(3 * l + 2) * M};
          pg8::gemm_phase<pg8::EpiRes, pg8::StaticOrder, true, true>(lds + RING_OFF, g, S, E, wid0); }
        xcd_barrier(bar, wid0);
        { const kaptr_t ka = ka_fresh(); unsigned char* ws = KWS(ka); unsigned char* wl = ws + WS_W + (size_t)l * W_LAYER;
          pg8::Gemm g{(const bf16*)(ws + WS_H), (const bf16*)(wl + W_UP), M, DFF, DM}; pg8::StaticOrder S; S.init(M, DFF, G, bx);
          pg8::EpiBf16<1, true> E{(bf16*)(ws + WS_U), DFF, (const unsigned long long*)((gu32*)(ws + WS_CTL) + CW_SS) + (size_t)(3 * l + 2) * M};
          pg8::gemm_phase<pg8::EpiBf16<1, true>, pg8::StaticOrder, true, true>(lds + RING_OFF, g, S, E, wid0); }
        xcd_barrier(bar, wid0);
        { const kaptr_t ka = ka_fresh(); unsigned char* ws = KWS(ka); unsigned char* wl = ws + WS_W + (size_t)l * W_LAYER;
          pg8::Gemm g{(const bf16*)(ws + WS_U), (const bf16*)(wl + W_DN), M, DM, DFF}; pg8::StaticOrder S; S.init(M, DM, G, bx);
          pg8::EpiRes E{(bf16*)(ws + WS_H), DM, (unsigned long long*)((gu32*)(ws + WS_CTL) + CW_SS) + (size_t)(3 * l + 3) * M};
          pg8::gemm_phase<pg8::EpiRes, pg8::StaticOrder, true, true>(lds + RING_OFF, g, S, E, wid0); }
        xcd_barrier(bar, wid0);
    }
    { const kaptr_t ka = ka_fresh(); unsigned char* ws = KWS(ka); FRESH_LANE(ln); float* O = KOUT(ka);
      for (int m = gw; m < M; m += NGW) final_row((const bf16*)(ws + WS_H) + (size_t)m * DM, (const float*)KIN(ka, 26), O + (size_t)m * DM, ln); }
}

extern "C" void kernel_launch(void* const* d_in, const int* in_sizes, int n_in, void* d_out, int out_size, void* d_ws, size_t ws_size, hipStream_t stream) {
    static int grid = 0;
    if (grid == 0) {
        if (n_in != 27 || in_sizes[0] != M * DM || out_size != M * DM || ws_size < WS_END) {
            fprintf(stderr, "kernel_launch: built for 27 inputs, x/out of %d floats, >= %zu bytes of workspace; got n_in %d, in0 %d, out %d, ws %zu; nothing launched\n", M * DM, (size_t)WS_END, n_in, n_in > 0 ? in_sizes[0] : -1, out_size, ws_size);
            grid = -1; return; }
        int dev = 0, cus = 0, per_cu = 0;
        if (hipGetDevice(&dev) != hipSuccess || hipDeviceGetAttribute(&cus, hipDeviceAttributeMultiprocessorCount, dev) != hipSuccess) { fprintf(stderr, "kernel_launch: device query failed\n"); grid = -1; return; }
        if (hipFuncSetAttribute((const void*)mk_fwd, hipFuncAttributeMaxDynamicSharedMemorySize, LDS_BYTES) != hipSuccess) { fprintf(stderr, "kernel_launch: hipFuncSetAttribute failed\n"); grid = -1; return; }
        if (hipOccupancyMaxActiveBlocksPerMultiprocessor(&per_cu, (const void*)mk_fwd, NWAVES * 64, LDS_BYTES) != hipSuccess || per_cu < 1)
            fprintf(stderr, "kernel_launch: note: occupancy query reports %d workgroups per CU\n", per_cu);
        (void)hipGetLastError();
        grid = cus;
    }
    if (grid < 0) return;
    if (hipMemsetAsync((char*)d_ws + WS_CTL, 0, CTL_ZERO_BYTES, stream) != hipSuccess) { fprintf(stderr, "kernel_launch: memset failed\n"); return; }
    Args a; memset(&a, 0, sizeof(a));
    for (int i = 0; i < 27; ++i) a.in[i] = d_in[i];
    a.out = (float*)d_out; a.ws = (unsigned char*)d_ws;
    for (int i = 0; i < 32; ++i) a.inv_freq[i] = (float)pow(10000.0, -(double)i / 32.0);
    for (int l = 0; l < NL; ++l) a.lam_init[l] = (float)(0.8 - 0.6 * exp(-0.3 * (double)l));
    {
        auto put = [&](int t, int idx, int K, int N, int NP, size_t off, int roff, int gain, int lay, int first, int cnt) {
            Cv& c = a.cv[t][a.ncv[t]++]; c.idx = idx; c.K = K; c.N = N; c.NP = NP; c.dst = (long long)(WS_W + (size_t)lay * W_LAYER + off); c.roff = roff; c.gain = gain; c.lay = lay;
            c.first = first; c.cnt = cnt < 0 ? (K / 64) * (NP / 64) - first : cnt; };
        put(0, 5, DM, DM, DM, W_OUT, 0, -1, 0, 0, -1); put(0, 19, DM, 512, 512, W_MQ, 0, 17, 0, 0, -1); put(0, 22, 512, DM, DM, W_MO, 0, -1, 0, 0, -1);
        put(0, 24, DM, DFF, DFF, W_UP, 0, 23, 0, 0, -1); put(0, 25, DFF, DM, DM, W_DN, 0, -1, 0, 0, -1);
        put(0, 4, DM, INC, INP, W_IN, 0, 3, 1, 0, -1); put(0, 14, QRANK, 1536, 1536, W_UQ, 0, -1, 1, 0, -1); put(0, 15, KVRANK, 2048, 2048, W_UKV, 0, -1, 1, 0, -1);
        put(0, 20, DM, 512, 512, W_MKV, 0, -1, 1, 0, -1); put(0, 21, DM, 512, 512, W_MKV, 512, -1, 1, 0, -1);
        put(1, 5, DM, DM, DM, W_OUT, 0, -1, 1, 0, -1); put(1, 19, DM, 512, 512, W_MQ, 0, 17, 1, 0, -1); put(1, 22, 512, DM, DM, W_MO, 0, -1, 1, 0, -1);
        put(1, 24, DM, DFF, DFF, W_UP, 0, 23, 1, grid == 256 ? 2 * UPDEF + 2 * P4DEF : 0, -1);
        if (grid <= 64) put(1, 25, DFF, DM, DM, W_DN, 0, -1, 1, 0, -1);
        for (int t = 0; t < NL; ++t) { long tot = 0; for (int j = 0; j < a.ncv[t]; ++j) tot += a.cv[t][j].cnt; a.nchunk[t] = (int)((tot + 63) / 64); }
    }
    hipLaunchKernelGGL(mk_fwd, dim3(grid), dim3(NWAVES * 64), LDS_BYTES, stream, a);
    const hipError_t le = hipPeekAtLastError();
    if (le != hipSuccess) fprintf(stderr, "kernel_launch: launch failed: %s\n", hipGetErrorName(le));
}
```

```cpp
#include <hip/hip_runtime.h>
#include <cstdio>
#include <cstdint>
#include <cstring>
#include <cmath>
__device__ __forceinline__ int fresh_lane() { unsigned z = 0u; asm volatile("" : "+v"(z)); return (int)__builtin_amdgcn_mbcnt_hi(~0u, __builtin_amdgcn_mbcnt_lo(~0u, z)); }
namespace pg8 {
#define PG8_LAS __attribute__((address_space(3)))
typedef unsigned short bf16_t;
typedef short bf16x8 __attribute__((ext_vector_type(8)));
typedef float f32x4 __attribute__((ext_vector_type(4)));
typedef unsigned u32x4 __attribute__((ext_vector_type(4)));
constexpr int BM = 256, BK = 64, HALF = 128, HTB = HALF * BK * 2  , STAGE_BYTES = 8 * HTB, NXCD = 8, WGM = 8;

__host__ __device__ __forceinline__ int lds_byte(int r, int c) { const int st = (r >> 4) * 2 + (c >> 5), rr = r & 15, cc = c & 31, ob = rr * 64 + cc * 2; return st * 1024 + (ob ^ (((ob >> 9) & 1) << 5)); }
__host__ __device__ __forceinline__ void stage_rc(int b, int& R, int& C) { const int st = b / 1024, sb = b % 1024, swz = sb ^ (((sb >> 9) & 1) << 5); R = (st >> 1) * 16 + swz / 64; C = (st & 1) * 32 + (swz % 64) / 2; }
__host__ __device__ __forceinline__ int perm32(int rho) { const int n = rho >> 4, i = rho & 15; return 8 * (i >> 2) + 4 * n + (i & 3); }

struct Unit { int pm, pn; };
struct Gemm { const bf16_t* A; const bf16_t* Bt; int M, N, K; };

struct StaticOrder {
    int nM, nN, nwg, G, c;
    __host__ __device__ void init(int M, int N, int G_, int c_) { nM = M / BM; nN = N / BM; nwg = nM * nN; G = G_; c = c_; }
    __host__ __device__ bool next(int i, Unit& u) const {
        const long L = (long)i * G + c; if (L >= nwg) return false;
        int wgid = (int)L; { const int q = nwg / NXCD, r = nwg % NXCD, xcd = wgid % NXCD, off = wgid / NXCD; wgid = (xcd < r ? xcd * (q + 1) : r * (q + 1) + (xcd - r) * q) + off; }
        const int nig = WGM * nN, gid = wgid / nig, fm = gid * WGM, gsz = (nM - fm) < WGM ? (nM - fm) : WGM;
        u.pm = fm + ((wgid % nig) % gsz); u.pn = (wgid % nig) / gsz; return true;
    }
    __device__ __forceinline__ void a_ready(const Unit&) const {}
    __device__ __forceinline__ void done(const Unit&) const {}
};

__device__ __forceinline__ unsigned cvt_pk_bf16(float lo, float hi) { unsigned r; asm volatile("v_cvt_pk_bf16_f32 %0, %1, %2" : "=v"(r) : "v"(lo), "v"(hi)); return r; }
typedef float f32x2 __attribute__((ext_vector_type(2)));
template <int ACT, bool RS> struct EpiBf16 {
    static constexpr bool PERM = true, AFTER_DRAIN = false;
    bf16_t* O; int ldc; const unsigned long long* ss;
    __device__ __forceinline__ void operator()(const f32x4 (&acc)[2][2][4][2], const Unit& u, int wr, int wc, int fr, int fq) const {
        const int row0 = u.pm * BM + wr * 64 + fr, col0 = u.pn * BM + wc * 32 + 8 * fq;
#pragma unroll
        for (int ai = 0; ai < 2; ++ai)
#pragma unroll
            for (int m = 0; m < 4; ++m) { const int row = row0 + ai * HALF + m * 16; bf16_t* rowp = O + (size_t)row * ldc + col0;
                float rs = 1.f; if (RS) rs = 1.0f / sqrtf((float)ss[row] * (1.f / 1048576.f / 4096.f) + 1e-6f);
#pragma unroll
                for (int bj = 0; bj < 2; ++bj) { f32x4 v0 = acc[ai][bj][m][0], v1 = acc[ai][bj][m][1];
                    if (RS) { v0 = v0 * rs; v1 = v1 * rs; }
                    if (ACT == 1) {
#pragma unroll
                        for (int e = 0; e < 4; ++e) { const float a = fmaxf(v0[e], 0.f), b = fmaxf(v1[e], 0.f); v0[e] = a * a; v1[e] = b * b; } }
                    u32x4 w; w.x = cvt_pk_bf16(v0[0], v0[1]); w.y = cvt_pk_bf16(v0[2], v0[3]); w.z = cvt_pk_bf16(v1[0], v1[1]); w.w = cvt_pk_bf16(v1[2], v1[3]);
                    *(u32x4*)(rowp + bj * HALF) = w; } }
    }
};
struct EpiRes {
    static constexpr bool PERM = true, AFTER_DRAIN = false;
    bf16_t* xh; int ldc; unsigned long long* ss;
    __device__ __forceinline__ void operator()(const f32x4 (&acc)[2][2][4][2], const Unit& u, int wr, int wc, int fr, int fq) const {
        const int row0 = u.pm * BM + wr * 64 + fr, col0 = u.pn * BM + wc * 32 + 8 * fq;
#pragma unroll
        for (int ai = 0; ai < 2; ++ai)
#pragma unroll
            for (int m = 0; m < 4; ++m) { const int row = row0 + ai * HALF + m * 16; const size_t off = (size_t)row * ldc + col0; float sq = 0.f;
#pragma unroll
                for (int bj = 0; bj < 2; ++bj) { const u32x4 hv = *(const u32x4*)(xh + off + bj * HALF); u32x4 ho;
#pragma unroll
                    for (int e = 0; e < 4; ++e) { const f32x4& a = acc[ai][bj][m][e >> 1]; const int j = (e & 1) * 2;
                        const float v0 = __uint_as_float(hv[e] << 16) + a[j], v1 = __uint_as_float(hv[e] & 0xffff0000u) + a[j + 1];
                        ho[e] = cvt_pk_bf16(v0, v1); sq += v0 * v0 + v1 * v1; }
                    *(u32x4*)(xh + off + bj * HALF) = ho; }
                sq += __int_as_float(__builtin_amdgcn_ds_swizzle(__float_as_int(sq), 0x1f | (16 << 10)));
                { auto rr = __builtin_amdgcn_permlane32_swap(__float_as_uint(sq), __float_as_uint(sq), false, false); sq = __uint_as_float(rr[0]) + __uint_as_float(rr[1]); }
                if (fq == 0) __hip_atomic_fetch_add(ss + row, (unsigned long long)((double)sq * 1048576.0), __ATOMIC_RELAXED, __HIP_MEMORY_SCOPE_AGENT); }
    }
};
template <class Epi, class Sched, bool ALIGN_EPI = false, bool SP2 = false>
__device__ __forceinline__ void gemm_phase(PG8_LAS unsigned char* lds, const Gemm g, const Sched& S, const Epi& E, const int wid0) {
    const int wid = wid0, lane = fresh_lane(), tid = wid * 64 + lane, wr = wid >> 2, wc = wid & 3, fr = lane & 15, fq = lane >> 4;
    const int K = g.K, nt = K / BK;
    unsigned voffA[2], voffB[2];
#pragma unroll
    for (int i = 0; i < 2; ++i) { int R, C; stage_rc(tid * 16 + i * 8192, R, C); const int Rb = Epi::PERM ? ((R & ~31) + perm32(R & 31)) : R;
        voffA[i] = (unsigned)(R * K + C) * 2u; voffB[i] = (unsigned)(Rb * K + C) * 2u; }
    const size_t kstep = (size_t)(BK * 2);
    const size_t hstep = (size_t)HALF * K * 2;
    const size_t tstep = 2 * hstep;
    const unsigned ldsw = (unsigned)wid * 1024u;
    const int aoff = lds_byte(wr * 64 + fr, fq * 8), boff = lds_byte(wc * 32 + fr, fq * 8);
#define PG8_SA(b, h) (((b) * 2 + (h)) * HTB)
#define PG8_SB(b, h) ((4 + (b) * 2 + (h)) * HTB)
#define PG8_STAGE(bufoff, gbase, voff) do { _Pragma("unroll") for (int _i = 0; _i < 2; ++_i) \
        __builtin_amdgcn_global_load_lds((const unsigned*)((const char*)(gbase) + (voff)[_i]), (PG8_LAS unsigned*)(lds + (bufoff) + ldsw + _i * 8192), 16, 0, 0); } while (0)
#define PG8_LDA(dst, b, h) do { _Pragma("unroll") for (int m = 0; m < 4; ++m) _Pragma("unroll") for (int k = 0; k < 2; ++k) dst[m][k] = *(const PG8_LAS bf16x8*)(lds + PG8_SA(b, h) + aoff + m * 2048 + k * 1024); } while (0)
#define PG8_LDB(dst, b, h) do { _Pragma("unroll") for (int n = 0; n < 2; ++n) _Pragma("unroll") for (int k = 0; k < 2; ++k) dst[n][k] = *(const PG8_LAS bf16x8*)(lds + PG8_SB(b, h) + boff + n * 2048 + k * 1024); } while (0)
#define PG8_MMA(ai, bj, At, Bt) do { __builtin_amdgcn_s_setprio(1); _Pragma("unroll") for (int m = 0; m < 4; ++m) _Pragma("unroll") for (int n = 0; n < 2; ++n) _Pragma("unroll") for (int k = 0; k < 2; ++k) \
        acc[ai][bj][m][n] = __builtin_amdgcn_mfma_f32_16x16x32_bf16(Bt[n][k], At[m][k], acc[ai][bj][m][n], 0, 0, 0); __builtin_amdgcn_s_setprio(0); } while (0)
#define PG8_WAIT_V(n) asm volatile("s_waitcnt vmcnt(" #n ")" ::: "memory")
#define PG8_WAIT_L(n) asm volatile("s_waitcnt lgkmcnt(" #n ")" ::: "memory")
#define PG8_BAR __builtin_amdgcn_s_barrier()
#define PG8_SCHED __builtin_amdgcn_sched_barrier(0)
    Unit cur, nxt; int ui = 0;
    if (!S.next(0, cur)) return;
    f32x4 acc[2][2][4][2];
#pragma unroll
    for (int a = 0; a < 2; ++a)
#pragma unroll
        for (int b = 0; b < 2; ++b)
#pragma unroll
            for (int m = 0; m < 4; ++m)
#pragma unroll
                for (int n = 0; n < 2; ++n) acc[a][b][m][n] = (f32x4){0.f, 0.f, 0.f, 0.f};
    bf16x8 At[4][2], B0[2][2], B1[2][2];
    const char* cA = (const char*)g.A + (size_t)cur.pm * tstep; const char* cB = (const char*)g.Bt + (size_t)cur.pn * tstep;
    S.a_ready(cur);
    if constexpr (SP2) {
        PG8_STAGE(PG8_SB(0, 0), cB, voffB); PG8_STAGE(PG8_SB(0, 1), cB + hstep, voffB); PG8_STAGE(PG8_SA(0, 0), cA, voffA); PG8_STAGE(PG8_SA(0, 1), cA + hstep, voffA);
        if (wr == 1) PG8_BAR;
        PG8_WAIT_V(2); PG8_BAR;
        PG8_STAGE(PG8_SB(1, 0), cB + kstep, voffB); PG8_STAGE(PG8_SA(1, 0), cA + kstep, voffA); PG8_STAGE(PG8_SB(1, 1), cB + hstep + kstep, voffB);
        PG8_WAIT_V(6); PG8_BAR;
    } else {
        PG8_STAGE(PG8_SB(0, 0), cB, voffB); PG8_STAGE(PG8_SA(0, 0), cA, voffA); PG8_STAGE(PG8_SB(0, 1), cB + hstep, voffB); PG8_STAGE(PG8_SA(0, 1), cA + hstep, voffA);
        if (wr == 1) PG8_BAR;
        PG8_WAIT_V(4); PG8_BAR;
        PG8_STAGE(PG8_SB(1, 0), cB + kstep, voffB); PG8_STAGE(PG8_SA(1, 0), cA + kstep, voffA); PG8_STAGE(PG8_SB(1, 1), cB + hstep + kstep, voffB);
        PG8_WAIT_V(6); PG8_BAR;
    }
    for (;;) {
        const bool has_next = S.next(ui + 1, nxt);
        const char* nA = has_next ? (const char*)g.A + (size_t)nxt.pm * tstep : cA; const char* nB = has_next ? (const char*)g.Bt + (size_t)nxt.pn * tstep : cB;
        for (int t = 0; t < nt; t += 2) {
            const bool last = (t == nt - 2);
            const char* a1 = cA + (size_t)(t + 1) * kstep;
            const char* a2 = last ? nA : cA + (size_t)(t + 2) * kstep; const char* b2 = last ? nB : cB + (size_t)(t + 2) * kstep;
            const char* a3 = a2 + kstep; const char* b3 = b2 + kstep;
            if (last && has_next) S.a_ready(nxt);
            if constexpr (SP2) {
            PG8_LDB(B0, 0, 0); PG8_LDB(B1, 0, 1); PG8_SCHED; PG8_LDA(At, 0, 0); PG8_STAGE(PG8_SA(1, 1), a1 + hstep, voffA);
            PG8_WAIT_V(8); PG8_WAIT_L(0); PG8_BAR; PG8_MMA(0, 0, At, B0); PG8_MMA(0, 1, At, B1); PG8_BAR; PG8_SCHED;
            PG8_LDA(At, 0, 1); PG8_STAGE(PG8_SB(0, 0), b2, voffB); PG8_STAGE(PG8_SB(0, 1), b2 + hstep, voffB); PG8_STAGE(PG8_SA(0, 0), a2, voffA);
            PG8_WAIT_V(8); PG8_WAIT_L(0); PG8_BAR; PG8_MMA(1, 0, At, B0); PG8_MMA(1, 1, At, B1); PG8_BAR; PG8_SCHED;
            PG8_LDB(B0, 1, 0); PG8_LDB(B1, 1, 1); PG8_SCHED; PG8_LDA(At, 1, 0); PG8_STAGE(PG8_SA(0, 1), a2 + hstep, voffA);
            PG8_WAIT_V(8); PG8_WAIT_L(0); PG8_BAR; PG8_MMA(0, 0, At, B0); PG8_MMA(0, 1, At, B1); PG8_BAR; PG8_SCHED;
            PG8_LDA(At, 1, 1); PG8_STAGE(PG8_SB(1, 0), b3, voffB); PG8_STAGE(PG8_SB(1, 1), b3 + hstep, voffB); PG8_STAGE(PG8_SA(1, 0), a3, voffA);
            PG8_WAIT_V(8); PG8_WAIT_L(0); PG8_BAR; PG8_MMA(1, 0, At, B0); PG8_MMA(1, 1, At, B1); PG8_BAR; PG8_SCHED;
            } else {
            PG8_LDB(B0, 0, 0); PG8_SCHED; PG8_LDA(At, 0, 0); PG8_STAGE(PG8_SA(1, 1), a1 + hstep, voffA);
            PG8_WAIT_L(8); PG8_BAR; PG8_WAIT_L(0); PG8_MMA(0, 0, At, B0); PG8_BAR; PG8_SCHED;
            PG8_LDB(B1, 0, 1); PG8_STAGE(PG8_SB(0, 0), b2, voffB);
            PG8_BAR; PG8_WAIT_L(0); PG8_MMA(0, 1, At, B1); PG8_BAR;
            PG8_LDA(At, 0, 1); PG8_STAGE(PG8_SA(0, 0), a2, voffA);
            PG8_BAR; PG8_WAIT_L(0); PG8_MMA(1, 0, At, B0); PG8_BAR; PG8_SCHED;
            PG8_STAGE(PG8_SB(0, 1), b2 + hstep, voffB);
            PG8_WAIT_V(6); PG8_BAR; PG8_MMA(1, 1, At, B1); PG8_BAR;
            PG8_LDB(B0, 1, 0); PG8_SCHED; PG8_LDA(At, 1, 0); PG8_STAGE(PG8_SA(0, 1), a2 + hstep, voffA);
            PG8_WAIT_L(8); PG8_BAR; PG8_WAIT_L(0); PG8_MMA(0, 0, At, B0); PG8_BAR; PG8_SCHED;
            PG8_LDB(B1, 1, 1); PG8_STAGE(PG8_SB(1, 0), b3, voffB);
            PG8_BAR; PG8_WAIT_L(0); PG8_MMA(0, 1, At, B1); PG8_BAR;
            PG8_LDA(At, 1, 1); PG8_STAGE(PG8_SA(1, 0), a3, voffA);
            PG8_BAR; PG8_WAIT_L(0); PG8_MMA(1, 0, At, B0); PG8_BAR; PG8_SCHED;
            PG8_STAGE(PG8_SB(1, 1), b3 + hstep, voffB);
            PG8_WAIT_V(6); PG8_BAR; PG8_MMA(1, 1, At, B1); PG8_BAR;
            }
        }
        if constexpr (ALIGN_EPI) { if (wr == 0) PG8_BAR; }
        if constexpr (!Epi::AFTER_DRAIN) { E(acc, cur, wr, wc, fr, fq); S.done(cur); }
        if (!has_next) break;
#pragma unroll
        for (int a = 0; a < 2; ++a)
#pragma unroll
            for (int b = 0; b < 2; ++b)
#pragma unroll
                for (int m = 0; m < 4; ++m)
#pragma unroll
                    for (int n = 0; n < 2; ++n) acc[a][b][m][n] = (f32x4){0.f, 0.f, 0.f, 0.f};
        cur = nxt; cA = nA; cB = nB; ++ui;
        if constexpr (ALIGN_EPI) { if (wr == 1) PG8_BAR; }
    }
    PG8_WAIT_V(0);
    if constexpr (!ALIGN_EPI) { if (wr == 0) PG8_BAR; }
    PG8_BAR;
    if constexpr (Epi::AFTER_DRAIN) { E.fused(acc, cur, wr, wc, fr, fq, lds, wid, lane); S.done(cur); }
#undef PG8_SA
#undef PG8_SB
#undef PG8_STAGE
#undef PG8_LDA
#undef PG8_LDB
#undef PG8_MMA
#undef PG8_WAIT_V
#undef PG8_WAIT_L
#undef PG8_BAR
#undef PG8_SCHED
}
}
#define GAS __attribute__((address_space(1)))
#define LAS __attribute__((address_space(3)))
typedef unsigned short bf16;
typedef unsigned v4u __attribute__((ext_vector_type(4)));
typedef float f32x4 __attribute__((ext_vector_type(4)));
typedef short bf16x8 __attribute__((ext_vector_type(8)));
typedef GAS unsigned gu32;
typedef GAS unsigned long long gu64;
#define RLX_AGENT __ATOMIC_RELAXED, __HIP_MEMORY_SCOPE_AGENT
#define LDS_WAIT() asm volatile("s_waitcnt lgkmcnt(0)" ::: "memory")
#define VM_WAIT() asm volatile("s_waitcnt vmcnt(0)" ::: "memory")
__device__ __forceinline__ unsigned long long rt() { return __builtin_amdgcn_s_memrealtime(); }
__device__ __forceinline__ unsigned f2bf(float f) { unsigned u = __builtin_bit_cast(unsigned, f); return (u + 0x7fffu + ((u >> 16) & 1u)) >> 16; }
__device__ __forceinline__ unsigned pk2(float lo, float hi) { return f2bf(lo) | (f2bf(hi) << 16); }

#define XB_TMO      128
#define XB_XCNT(j)  (256  + 64 * (j))
#define XB_XSUB(j)  (1280 + 64 * (j))
#define XB_XGEN(j)  (2304 + 64 * (j))
#define XB_TOP      3328
#define XB_TOPGEN   3392
#define XCD_BAR_WORDS 3456
#define XB_SPIN_CAP (1u << 18)

__device__ __forceinline__ unsigned xb_ld(unsigned* p)              { return __hip_atomic_load(p, __ATOMIC_RELAXED, __HIP_MEMORY_SCOPE_AGENT); }
__device__ __forceinline__ unsigned xb_add(unsigned* p, unsigned v) { return __hip_atomic_fetch_add(p, v, __ATOMIC_RELAXED, __HIP_MEMORY_SCOPE_AGENT); }
__device__ __forceinline__ unsigned xb_xcc_id() { return (unsigned)__builtin_amdgcn_s_getreg((3 << 11) | 20) & 0xFu; }
#define XB_SPIN(cond, bar) do { unsigned _sp = 0; while (cond) { __builtin_amdgcn_s_sleep(1); \
    if ((++_sp & 255u) == 0u) { if (xb_ld(&(bar)[XB_TMO])) break; if (_sp > XB_SPIN_CAP) { atomicAdd(&(bar)[XB_TMO], 1u); break; } } } } while (0)

struct XcdBarrier {
    unsigned* bar; unsigned x;
    volatile LAS unsigned* st;
};

__device__ __forceinline__ XcdBarrier xcd_barrier_post(unsigned* bar, volatile LAS unsigned* st, const int wid0) {
    XcdBarrier b; b.bar = bar; b.x = xb_xcc_id(); b.st = st;
    if (wid0 == 0 && fresh_lane() == 0) (void)xb_add(&bar[XB_XCNT(b.x)], 1u);
    return b;
}
__device__ __forceinline__ void xcd_barrier_complete(unsigned* bar, unsigned x, unsigned& nloc, unsigned& nx) {
    const unsigned G = gridDim.x * gridDim.y * gridDim.z;
    unsigned sum, cnt, mine, sp = 0u;
    for (;;) {
        sum = 0u; cnt = 0u; mine = 0u;
#pragma unroll 1
        for (unsigned j = 0; j < 16; ++j) { const unsigned c = xb_ld(&bar[XB_XCNT(j)]); sum += c; cnt += (c > 0u) ? 1u : 0u; mine = (j == x) ? c : mine; }
        if (sum == G) break;
        __builtin_amdgcn_s_sleep(1);
        if ((++sp & 255u) == 0u) { if (xb_ld(&bar[XB_TMO])) break; if (sp > XB_SPIN_CAP) { atomicAdd(&bar[XB_TMO], 1u); break; } }
    }
    nloc = mine > 0u ? mine : 1u; nx = cnt > 0u ? cnt : 1u;
}

__device__ __forceinline__ void xcd_barrier(const XcdBarrier& b, const int wid0) {
    asm volatile("s_waitcnt vmcnt(0)" ::: "memory");
    __syncthreads();
    if (wid0 == 0 && fresh_lane() == 0) {
        unsigned* bar = b.bar;
        __builtin_amdgcn_s_waitcnt(0);
        unsigned nloc = b.st[0], nx = b.st[1];
        const unsigned bx_ = xb_xcc_id();
        if (nloc == 0u) { xcd_barrier_complete(bar, bx_, nloc, nx); b.st[0] = nloc; b.st[1] = nx; }
        const unsigned old = xb_add(&bar[XB_XSUB(bx_)], 1u);
        const unsigned gen = old / nloc;
        if (old + 1u == (gen + 1u) * nloc) {
            __builtin_amdgcn_fence(__ATOMIC_RELEASE, "agent");
            asm volatile("s_waitcnt vmcnt(0)" ::: "memory");
            const unsigned og = xb_add(&bar[XB_TOP], 1u);
            const unsigned tg = og / nx;
            if (og + 1u == (tg + 1u) * nx) xb_add(&bar[XB_TOPGEN], 1u);
            else XB_SPIN(xb_ld(&bar[XB_TOPGEN]) == tg, bar);
            __builtin_amdgcn_fence(__ATOMIC_ACQUIRE, "agent");
            xb_add(&bar[XB_XGEN(bx_)], 1u);
            asm volatile("s_waitcnt vmcnt(0)" ::: "memory");
        } else {
            XB_SPIN(xb_ld(&bar[XB_XGEN(bx_)]) == gen, bar);
            __builtin_amdgcn_fence(__ATOMIC_ACQUIRE, "agent");
            asm volatile("s_waitcnt vmcnt(0)" ::: "memory");
        }
    }
    __syncthreads();
}
constexpr int NWAVES = 8;
constexpr int NB = 2, SEQ = 4096, DM = 4096, NL = 2, M = NB * SEQ;
constexpr int INC = 11336, INP = 11520;
constexpr int A_Q = 0, B_CQ = 3072, B_CKV = 4608, B_KR = 5120, C_Q = 5184, D_Q = 8256, D_F = 11328;
constexpr int QRANK = 1536, KVRANK = 512, DFF = 16384, MEMT = 256;
constexpr int P4DEF = 64 * 8 * 4;
constexpr int P8DEF = 8192;
constexpr int UPDEF = 88 * 8 * 8;
constexpr float EPS = 1e-6f;

constexpr size_t MiB = 1u << 20;
constexpr size_t WS_CTL = 0, CTL_ZERO_BYTES = 1 * MiB;
constexpr size_t WS_COS = 1 * MiB, WS_SIN = 2 * MiB;
constexpr size_t WS_LUT = 3 * MiB;
constexpr size_t WS_TPMAX = 3 * MiB + 8192;
constexpr size_t WS_LAM = 3 * MiB + 12288;
constexpr size_t WS_LOGF = 4 * MiB, WS_NEGC = 4 * MiB + 512 * 1024;
constexpr size_t WS_W = 8 * MiB;
constexpr size_t SZ_IN = (size_t)INP * DM * 2, SZ_OUT = (size_t)DM * DM * 2, SZ_UQ = (size_t)1536 * 1536 * 2, SZ_UKV = (size_t)2048 * 512 * 2,
                 SZ_MQ = (size_t)512 * DM * 2, SZ_MKV = (size_t)1024 * DM * 2, SZ_MO = (size_t)DM * 512 * 2, SZ_UP = (size_t)DFF * DM * 2, SZ_DN = SZ_UP;
constexpr size_t W_IN = 0, W_OUT = W_IN + SZ_IN, W_UQ = W_OUT + SZ_OUT, W_UKV = W_UQ + SZ_UQ, W_MQ = W_UKV + SZ_UKV, W_MKV = W_MQ + SZ_MQ, W_MO = W_MKV + SZ_MKV,
                 W_UP = W_MO + SZ_MO, W_DN = W_UP + SZ_UP, W_LAYER = W_DN + SZ_DN;
static_assert(W_LAYER % 256 == 0, "weight block alignment");
constexpr size_t WS_MEMN = WS_W + NL * W_LAYER;
constexpr size_t WS_KVMEM = WS_MEMN + (size_t)NL * 512 * DM * 2;
constexpr size_t WS_H = WS_KVMEM + (size_t)NL * 512 * 1024 * 2;
constexpr size_t WS_CQN = WS_H + (size_t)M * DM * 2;
constexpr size_t WS_CKVN = WS_CQN + (size_t)M * 1536 * 2;
constexpr size_t WS_KPE = WS_CKVN + (size_t)M * 512 * 2;
constexpr size_t WS_QMLA = WS_KPE + (size_t)M * 64 * 2;
constexpr size_t WS_KVMLA = WS_QMLA + (size_t)M * 1536 * 2;
constexpr size_t WS_QMEM = WS_KVMLA + (size_t)M * 2048 * 2;
constexpr size_t WS_OMEM = WS_QMEM + (size_t)M * 512 * 2;
constexpr size_t WS_XL = WS_OMEM + (size_t)M * 512 * 2;
constexpr size_t WS_U = WS_XL + (size_t)M * DM * 2;
constexpr size_t WS_PROJ = WS_U;
constexpr size_t WS_MIX = WS_PROJ + (size_t)M * INP * 2;
static_assert(WS_MIX + (size_t)M * DM * 2 <= WS_U + (size_t)M * DFF * 2, "PROJ + MIX fit inside U");
constexpr size_t WS_END = WS_U + (size_t)M * DFF * 2;
constexpr int CW_BAR = 4096;
constexpr int CW_SS = 32768;
constexpr int CW_KN = 24576;
constexpr int CW_TKT = 16384;

constexpr int RING_OFF = 0, RING_BYTES = 137216;
constexpr int LDSCTL_OFF = RING_BYTES, MISC_OFF = LDSCTL_OFF + 320;
constexpr int LDS_BYTES = 147456;

typedef unsigned short bf16;
typedef short bf16x8 __attribute__((ext_vector_type(8)));
typedef short s16x4 __attribute__((ext_vector_type(4)));
typedef float f32x4 __attribute__((ext_vector_type(4)));
typedef float f32x16 __attribute__((ext_vector_type(16)));
typedef unsigned v4u __attribute__((ext_vector_type(4)));
typedef unsigned v2u __attribute__((ext_vector_type(2)));
typedef int i32x4 __attribute__((ext_vector_type(4)));

__device__ __forceinline__ unsigned cvtpk(float lo, float hi) { unsigned r; asm volatile("v_cvt_pk_bf16_f32 %0, %1, %2" : "=v"(r) : "v"(lo), "v"(hi)); return r; }
__device__ __forceinline__ float bf2f(short s) { return __uint_as_float(((unsigned)(unsigned short)s) << 16); }
template <int X> __device__ __forceinline__ float shx(float v) { return __int_as_float(__builtin_amdgcn_ds_swizzle(__float_as_int(v), 0x1f | (X << 10))); }
template <int X> __device__ __forceinline__ int shxi(int v) { return __builtin_amdgcn_ds_swizzle(v, 0x1f | (X << 10)); }
__device__ __forceinline__ float half_sum(float v) { v += shx<1>(v); v += shx<2>(v); v += shx<4>(v); v += shx<8>(v); v += shx<16>(v); return v; }
__device__ __forceinline__ float wave_sum(float v) { v = half_sum(v);
    auto rr = __builtin_amdgcn_permlane32_swap(__float_as_uint(v), __float_as_uint(v), false, false); return __uint_as_float(rr[0]) + __uint_as_float(rr[1]); }
#define FRESH_LANE(name) const int name = fresh_lane()
#define WAITBAR() asm volatile("s_waitcnt vmcnt(0) lgkmcnt(0)\n\ts_barrier" ::: "memory")

__device__ __forceinline__ void tr_item(const float* W, int K, int N, int nblk, bf16* WT, int row_off, LAS float* scr, int item, int lane, const float* gk) {
    const int kb = item / nblk, nb = item - kb * nblk, k0 = 64 * kb, n0 = 64 * nb;
    const int c4 = (lane & 15) * 4, rr = lane >> 4; const bool ok = n0 + c4 < N;
    const GAS f32x4* src = (const GAS f32x4*)(W + (size_t)(k0 + rr) * N + n0 + c4);
    f32x4 v[16];
#pragma unroll
    for (int i = 0; i < 16; ++i) v[i] = ok ? __builtin_nontemporal_load((const GAS f32x4*)((const GAS float*)src + (size_t)(4 * i) * N)) : (f32x4){0.f, 0.f, 0.f, 0.f};
    if (gk) {
#pragma unroll
        for (int i = 0; i < 16; ++i) v[i] = v[i] * gk[k0 + 4 * i + rr]; }
#pragma unroll
    for (int i = 0; i < 16; ++i) { LAS float* s = scr + (4 * i + rr) * 65 + c4; s[0] = v[i].x; s[1] = v[i].y; s[2] = v[i].z; s[3] = v[i].w; }
    LDS_WAIT(); asm volatile("" ::: "memory");
    const int c = lane & 7;
#pragma unroll
    for (int j = 0; j < 8; ++j) { const int nn = (lane >> 3) + 8 * j; const LAS float* s = scr + (8 * c) * 65 + nn;
        v4u o; o.x = cvtpk(s[0 * 65], s[1 * 65]); o.y = cvtpk(s[2 * 65], s[3 * 65]); o.z = cvtpk(s[4 * 65], s[5 * 65]); o.w = cvtpk(s[6 * 65], s[7 * 65]);
        *(GAS v4u*)(WT + (size_t)(row_off + n0 + nn) * K + k0 + 8 * c) = o; }
    LDS_WAIT(); asm volatile("" ::: "memory");
}
template <bool BF> __device__ __forceinline__ void rms_row(const float* xrow, const float* g, void* orow, int lane) {
    const GAS f32x4* xr = (const GAS f32x4*)xrow + lane; const GAS f32x4* gr = (const GAS f32x4*)g + lane;
    f32x4 v[16]; float s = 0.f;
#pragma unroll
    for (int j = 0; j < 16; ++j) { v[j] = xr[64 * j]; s += (v[j].x * v[j].x + v[j].y * v[j].y) + (v[j].z * v[j].z + v[j].w * v[j].w); }
    const float rstd = 1.0f / sqrtf(wave_sum(s) * (1.f / DM) + EPS);
#pragma unroll
    for (int j = 0; j < 16; ++j) { const f32x4 gg = gr[64 * j]; const f32x4 y = v[j] * rstd * gg;
        if (BF) { v2u w; w.x = cvtpk(y.x, y.y); w.y = cvtpk(y.z, y.w); ((GAS v2u*)orow)[64 * j + lane] = w; }
        else ((GAS f32x4*)orow)[64 * j + lane] = y; }
}
__device__ __forceinline__ void cast_row(const float* xrow, bf16* hrow, unsigned long long* ss, int lane) {
    const GAS f32x4* xr = (const GAS f32x4*)xrow + lane; float s = 0.f;
#pragma unroll
    for (int j = 0; j < 16; ++j) { const f32x4 v = xr[64 * j]; s += (v.x * v.x + v.y * v.y) + (v.z * v.z + v.w * v.w);
        v2u h; h.x = cvtpk(v.x, v.y); h.y = cvtpk(v.z, v.w); ((GAS v2u*)hrow)[64 * j + lane] = h; }
    s = wave_sum(s); if (lane == 0) *ss = (unsigned long long)((double)s * 1048576.0);
}
__device__ __forceinline__ void final_row(const bf16* hrow, const float* g, float* orow, int lane) {
    f32x4 v[16]; float s = 0.f;
#pragma unroll
    for (int j = 0; j < 16; ++j) { const v2u h = ((const GAS v2u*)hrow)[64 * j + lane];
        v[j].x = __uint_as_float(h.x << 16); v[j].y = __uint_as_float(h.x & 0xffff0000u); v[j].z = __uint_as_float(h.y << 16); v[j].w = __uint_as_float(h.y & 0xffff0000u);
        s += (v[j].x * v[j].x + v[j].y * v[j].y) + (v[j].z * v[j].z + v[j].w * v[j].w); }
    const float rstd = 1.0f / sqrtf(wave_sum(s) * (1.f / DM) + EPS);
#pragma unroll
    for (int j = 0; j < 16; ++j) { const f32x4 gg = ((const GAS f32x4*)g)[64 * j + lane]; ((GAS f32x4*)orow)[64 * j + lane] = v[j] * rstd * gg; }
}
__device__ __forceinline__ float logsigmoidf_(float x) {
    const float e = __expf(-fabsf(x)); return fminf(x, 0.f) - __logf(1.f + e);
}
__device__ __forceinline__ void prep_row(const bf16* proj, int m, const float* gq, const float* gkv, const float* bf, const float* COS, const float* SIN,
                                         bf16* CQN, bf16* CKVN, bf16* KPE, float* LOGF, unsigned* KN2, int lane) {
    const bf16* pr = proj + (size_t)m * INP;
    bf16x8 q[3]; float sq = 0.f;
#pragma unroll
    for (int j = 0; j < 3; ++j) { q[j] = *(const GAS bf16x8*)(pr + B_CQ + (j * 64 + lane) * 8);
#pragma unroll
        for (int e = 0; e < 8; ++e) { const float f = bf2f(q[j][e]); sq += f * f; } }
    const bf16x8 kv = *(const GAS bf16x8*)(pr + B_CKV + lane * 8); float skv = 0.f;
#pragma unroll
    for (int e = 0; e < 8; ++e) { const float f = bf2f(kv[e]); skv += f * f; }
    const float rq = 1.0f / sqrtf(wave_sum(sq) * (1.f / QRANK) + EPS), rkv = 1.0f / sqrtf(wave_sum(skv) * (1.f / KVRANK) + EPS);
#pragma unroll
    for (int j = 0; j < 3; ++j) { const int c0 = (j * 64 + lane) * 8; const f32x4 g0 = *(const GAS f32x4*)(gq + c0), g1 = *(const GAS f32x4*)(gq + c0 + 4);
        v4u w; w.x = cvtpk(bf2f(q[j][0]) * rq * g0.x, bf2f(q[j][1]) * rq * g0.y); w.y = cvtpk(bf2f(q[j][2]) * rq * g0.z, bf2f(q[j][3]) * rq * g0.w);
        w.z = cvtpk(bf2f(q[j][4]) * rq * g1.x, bf2f(q[j][5]) * rq * g1.y); w.w = cvtpk(bf2f(q[j][6]) * rq * g1.z, bf2f(q[j][7]) * rq * g1.w);
        *(GAS v4u*)(CQN + (size_t)m * QRANK + c0) = w; }
    { const int c0 = lane * 8; const f32x4 g0 = *(const GAS f32x4*)(gkv + c0), g1 = *(const GAS f32x4*)(gkv + c0 + 4);
        v4u w; w.x = cvtpk(bf2f(kv[0]) * rkv * g0.x, bf2f(kv[1]) * rkv * g0.y); w.y = cvtpk(bf2f(kv[2]) * rkv * g0.z, bf2f(kv[3]) * rkv * g0.w);
        w.z = cvtpk(bf2f(kv[4]) * rkv * g1.x, bf2f(kv[5]) * rkv * g1.y); w.w = cvtpk(bf2f(kv[6]) * rkv * g1.z, bf2f(kv[7]) * rkv * g1.w);
        *(GAS v4u*)(CKVN + (size_t)m * KVRANK + c0) = w; }
    { const float v = bf2f((short)pr[B_KR + lane]); float pv; { auto rr = __builtin_amdgcn_permlane32_swap(__float_as_uint(v), __float_as_uint(v), false, false); pv = __uint_as_float(lane >= 32 ? rr[0] : rr[1]); } const int i = lane & 31;
      const float c = COS[(size_t)m * 32 + i], s = SIN[(size_t)m * 32 + i];
      const float o = lane < 32 ? v * c - pv * s : pv * s + v * c;
      const float on = shx<1>(o);
      if ((lane & 1) == 0) *(GAS unsigned*)(KPE + (size_t)m * 64 + lane) = cvtpk(o, on); }
    if (lane < 8) { const float f = bf2f((short)pr[D_F + lane]) + bf[lane]; const int b = m / SEQ, s = m - b * SEQ; LOGF[(size_t)(b * 8 + lane) * SEQ + s] = logsigmoidf_(f); }
    { const bf16x8 k0 = *(const GAS bf16x8*)(pr + D_Q + 1024 + lane * 16), k1 = *(const GAS bf16x8*)(pr + D_Q + 1024 + lane * 16 + 8); float s = 0.f;
#pragma unroll
      for (int e = 0; e < 8; ++e) { const float a = bf2f(k0[e]), c = bf2f(k1[e]); s += a * a + c * c; }
      s += shx<1>(s); s += shx<2>(s); s += shx<4>(s);
      if ((lane & 7) == 0) { unsigned* p = KN2 + (m / SEQ) * 8 + (lane >> 3); const unsigned v = __float_as_uint(s);
          if (v > __hip_atomic_load(p, __ATOMIC_RELAXED, __HIP_MEMORY_SCOPE_AGENT)) __hip_atomic_fetch_max(p, v, __ATOMIC_RELAXED, __HIP_MEMORY_SCOPE_AGENT); } }
}
__device__ __forceinline__ void fox_scan(const float* logf, float* negc, int lane) {
    const GAS f32x4* src = (const GAS f32x4*)(logf + lane * 64); f32x4 v[16]; float tot = 0.f;
#pragma unroll
    for (int j = 0; j < 16; ++j) { v[j] = src[j]; tot += (v[j].x + v[j].y) + (v[j].z + v[j].w); }
    float inc = tot;
#pragma unroll
    for (int o = 1; o < 64; o <<= 1) { const float t = __int_as_float(__builtin_amdgcn_ds_bpermute((lane - o) << 2, __float_as_int(inc))); if (lane >= o) inc += t; }
    float run = inc - tot; const float k = -11.313708498984761f;
    GAS f32x4* dst = (GAS f32x4*)(negc + lane * 64);
#pragma unroll
    for (int j = 0; j < 16; ++j) { f32x4 o; run += v[j].x; o.x = run * k; run += v[j].y; o.y = run * k; run += v[j].z; o.z = run * k; run += v[j].w; o.w = run * k; dst[j] = o; }
}

struct Cv { int idx, K, N, NP; long long dst; int roff, gain, lay, first, cnt, pad; };
constexpr int NCV = 12;
constexpr int NTB = 4;
struct Args { const void* in[27]; float* out; unsigned char* ws; float inv_freq[32]; float lam_init[2]; Cv cv[NTB][NCV]; int ncv[NTB]; int nchunk[NTB]; };
static_assert(sizeof(Cv) == 48 && sizeof(Args) == 27 * 8 + 16 + 128 + 8 + NTB * NCV * 48 + 8 * NTB, "Args has no padding");
typedef const unsigned char __attribute__((address_space(4)))* kaptr_t;
__device__ __forceinline__ kaptr_t ka_fresh() { kaptr_t p = (kaptr_t)__builtin_amdgcn_kernarg_segment_ptr(); asm volatile("" : "+s"(p)); return p; }
#define KIN(ka, i) (*(const void* const __attribute__((address_space(4)))*)((ka) + 8 * (i)))
#define KOUT(ka) ((float*)KIN(ka, 27))
#define KWS(ka) ((unsigned char*)KIN(ka, 28))
#define KINVF(ka, i) (*(const float __attribute__((address_space(4)))*)((ka) + 232 + 4 * (i)))
#define KLAMI(ka, l) (*(const float __attribute__((address_space(4)))*)((ka) + 360 + 4 * (l)))
#define KCVI(ka, l, j, f) (*(const int __attribute__((address_space(4)))*)((ka) + 368 + ((l) * NCV + (j)) * 48 + 4 * (f)))
#define KCVD(ka, l, j) (*(const long long __attribute__((address_space(4)))*)((ka) + 368 + ((l) * NCV + (j)) * 48 + 16))
#define KNCV(ka, l) (*(const int __attribute__((address_space(4)))*)((ka) + 368 + NTB * NCV * 48 + 4 * (l)))
#define KNCH(ka, l) (*(const int __attribute__((address_space(4)))*)((ka) + 368 + NTB * NCV * 48 + 4 * NTB + 4 * (l)))
__device__ __forceinline__ void conv_item(const kaptr_t ka, unsigned char* ws, int t, int it, LAS float* scr, int lane) {
    const int n = KNCV(ka, t); int rem = it, j = 0;
    for (; j < n; ++j) { const int cnt = KCVI(ka, t, j, 10); if (rem < cnt) break; rem -= cnt; }
    if (j >= n) return;
    const int idx = KCVI(ka, t, j, 0), K = KCVI(ka, t, j, 1), N = KCVI(ka, t, j, 2), NP = KCVI(ka, t, j, 3), roff = KCVI(ka, t, j, 6), gain = KCVI(ka, t, j, 7), lay = KCVI(ka, t, j, 8), first = KCVI(ka, t, j, 9);
    const float* gk = nullptr; if (gain >= 0) gk = (const float*)KIN(ka, gain) + (size_t)lay * K;
    tr_item((const float*)KIN(ka, idx) + (size_t)lay * K * N, K, N, NP / 64, (bf16*)(ws + KCVD(ka, t, j)), roff, scr, first + rem, lane, gk);
}
__device__ __forceinline__ void conv_chunk(const kaptr_t ka, unsigned char* ws, int l, int c, LAS float* scr, int wid, int lane) {
    for (int k = 0; k < 8; ++k) conv_item(ka, ws, l, c * 64 + wid * 8 + k, scr, lane);
}

namespace att {
constexpr int VA = 0, VB = 1, VC = 2, VD = 3, VE = 4;
constexpr int K_OFF = 0, V_OFF = 32768, B_OFF = 65536, WS_OFF = 67584, LUT_OFF = 69632, FLG_OFF = 70656, TKT_OFF = 70784, KPE_OFF = 71680, QF_OFF = 71680, ATT_END = QF_OFF + 65536;
constexpr float LOG2E = 1.4426950408889634f, LN2 = 0.6931471805599453f, THR = 8.f;
struct Ctx { const bf16* PROJ; const bf16* QMLA; const bf16* KVMLA; const bf16* KPE; bf16* MIX; const bf16* QMEM; const bf16* KVMEM; bf16* OMEM;
             const float* COS; const float* SIN; const float* LUT; const int* TPMAX; const int* pos; const float* NEGC; const float* sub_g; const unsigned* KN2; float lam, oml; };

__device__ __forceinline__ int crow(int r, int hi) { return (r & 3) + 8 * (r >> 2) + 4 * hi; }
__device__ __forceinline__ int swap23(int k) { return (k & ~0xC) | ((k & 4) << 1) | ((k & 8) >> 1); }
__device__ __forceinline__ float pmaxf(float v) { auto rr = __builtin_amdgcn_permlane32_swap(__float_as_uint(v), __float_as_uint(v), false, false); return fmaxf(__uint_as_float(rr[0]), __uint_as_float(rr[1])); }
__device__ __forceinline__ float psumf(float v) { auto rr = __builtin_amdgcn_permlane32_swap(__float_as_uint(v), __float_as_uint(v), false, false); return __uint_as_float(rr[0]) + __uint_as_float(rr[1]); }
__device__ __forceinline__ float partnerf(float v, int hi) { auto rr = __builtin_amdgcn_permlane32_swap(__float_as_uint(v), __float_as_uint(v), false, false); return __uint_as_float(hi ? rr[0] : rr[1]); }
__device__ __forceinline__ void dma16(const void* sbase, unsigned voff, unsigned ldsaddr) { unsigned keep;
    asm volatile("s_mov_b32 %0, m0\n\ts_mov_b32 m0, %3\n\ts_nop 0\n\tglobal_load_lds_dwordx4 %1, %2\n\ts_mov_b32 m0, %0" : "=&s"(keep) : "v"(voff), "s"(sbase), "s"(ldsaddr) : "memory"); }

template <int NK> __device__ __forceinline__ void qk(f32x16& p0, f32x16& p1, const LAS unsigned char* krow, int xr, int hx, const bf16x8* qf, int dstart) {
#pragma unroll
    for (int d0 = 0; d0 < NK; ++d0) { const int off = (((dstart + d0) * 32 + hx) ^ xr);
        const bf16x8 b0 = *(const LAS bf16x8*)(krow + off), b1 = *(const LAS bf16x8*)(krow + off + 8192);
        p0 = __builtin_amdgcn_mfma_f32_32x32x16_bf16(b0, qf[d0], p0, 0, 0, 0); p1 = __builtin_amdgcn_mfma_f32_32x32x16_bf16(b1, qf[d0], p1, 0, 0, 0); }
}
template <int NK> __device__ __forceinline__ void qk_l(f32x16& p0, f32x16& p1, const LAS unsigned char* krow, int xr, int hx, const LAS unsigned char* qlds, int dstart) {
#pragma unroll
    for (int d0 = 0; d0 < NK; ++d0) { const int off = (((dstart + d0) * 32 + hx) ^ xr);
        const bf16x8 b0 = *(const LAS bf16x8*)(krow + off), b1 = *(const LAS bf16x8*)(krow + off + 8192), q = *(const LAS bf16x8*)(qlds + (dstart + d0) * 1024);
        p0 = __builtin_amdgcn_mfma_f32_32x32x16_bf16(b0, q, p0, 0, 0, 0); p1 = __builtin_amdgcn_mfma_f32_32x32x16_bf16(b1, q, p1, 0, 0, 0); }
}
__device__ __forceinline__ void qk_pe(f32x16& p0, f32x16& p1, const LAS unsigned char* perow, int xpe, int hx, const bf16x8* qf) {
#pragma unroll
    for (int d0 = 0; d0 < 4; ++d0) { const int off = ((d0 * 32 + hx) ^ xpe);
        const bf16x8 b0 = *(const LAS bf16x8*)(perow + off), b1 = *(const LAS bf16x8*)(perow + off + 4096);
        p0 = __builtin_amdgcn_mfma_f32_32x32x16_bf16(b0, qf[d0], p0, 0, 0, 0); p1 = __builtin_amdgcn_mfma_f32_32x32x16_bf16(b1, qf[d0], p1, 0, 0, 0); }
}
__device__ __forceinline__ void pv(f32x16* o, unsigned vb, bf16x8 pa0, bf16x8 pa1, bf16x8 pa2, bf16x8 pa3) {
#define TRRD(dst, off) asm volatile("ds_read_b64_tr_b16 %0, %1 offset:%2" : "=&v"(dst) : "v"(vb), "i"(off) : "memory")
#define PV_D0(d0) do { s16x4 l0, l1, l2, l3, h0, h1, h2, h3; constexpr int b_ = (d0) * 512; \
        TRRD(l0, b_); TRRD(h0, b_ + 2048); TRRD(l1, b_ + 4096); TRRD(h1, b_ + 6144); TRRD(l2, b_ + 8192); TRRD(h2, b_ + 10240); TRRD(l3, b_ + 12288); TRRD(h3, b_ + 14336); \
        asm volatile("s_waitcnt lgkmcnt(0)" ::: "memory"); __builtin_amdgcn_sched_barrier(0); \
        o[d0] = __builtin_amdgcn_mfma_f32_32x32x16_bf16(pa0, (bf16x8){l0[0], l0[1], l0[2], l0[3], h0[0], h0[1], h0[2], h0[3]}, o[d0], 0, 0, 0); \
        o[d0] = __builtin_amdgcn_mfma_f32_32x32x16_bf16(pa1, (bf16x8){l1[0], l1[1], l1[2], l1[3], h1[0], h1[1], h1[2], h1[3]}, o[d0], 0, 0, 0); \
        o[d0] = __builtin_amdgcn_mfma_f32_32x32x16_bf16(pa2, (bf16x8){l2[0], l2[1], l2[2], l2[3], h2[0], h2[1], h2[2], h2[3]}, o[d0], 0, 0, 0); \
        o[d0] = __builtin_amdgcn_mfma_f32_32x32x16_bf16(pa3, (bf16x8){l3[0], l3[1], l3[2], l3[3], h3[0], h3[1], h3[2], h3[3]}, o[d0], 0, 0, 0); } while (0)
    PV_D0(0); PV_D0(1); PV_D0(2); PV_D0(3);
#undef PV_D0
#undef TRRD
}
__device__ __forceinline__ void pack_p(const f32x16& p0, const f32x16& p1, bf16x8& pa0, bf16x8& pa1, bf16x8& pa2, bf16x8& pa3) {
#define PK4(P, B_, OUT) do { unsigned a0 = cvtpk(P[B_ + 0], P[B_ + 1]), a1 = cvtpk(P[B_ + 2], P[B_ + 3]), b0 = cvtpk(P[B_ + 4], P[B_ + 5]), b1 = cvtpk(P[B_ + 6], P[B_ + 7]); \
        auto r0 = __builtin_amdgcn_permlane32_swap(a0, b0, false, false); auto r1 = __builtin_amdgcn_permlane32_swap(a1, b1, false, false); \
        v4u w = {r0[0], r1[0], r0[1], r1[1]}; OUT = __builtin_bit_cast(bf16x8, w); } while (0)
    PK4(p0, 0, pa0); PK4(p0, 8, pa1); PK4(p1, 0, pa2); PK4(p1, 8, pa3);
#undef PK4
}
__device__ __forceinline__ void softmax_pv(f32x16& p0, f32x16& p1, float& m, float& l, f32x16* o, LAS float* wsf, unsigned vb, int r32, int hi, const float SCALE, const float C2) {
    float mx0 = fmaxf(p0[0], p1[0]), mx1 = fmaxf(p0[1], p1[1]), mx2 = fmaxf(p0[2], p1[2]), mx3 = fmaxf(p0[3], p1[3]);
#pragma unroll
    for (int r = 4; r < 16; r += 4) { mx0 = fmaxf(fmaxf(mx0, p0[r]), p1[r]); mx1 = fmaxf(fmaxf(mx1, p0[r + 1]), p1[r + 1]); mx2 = fmaxf(fmaxf(mx2, p0[r + 2]), p1[r + 2]); mx3 = fmaxf(fmaxf(mx3, p0[r + 3]), p1[r + 3]); }
    float pmax = pmaxf(fmaxf(fmaxf(mx0, mx1), fmaxf(mx2, mx3)));
    float mn, alpha;
    if (__all((pmax - m) * SCALE <= THR)) { mn = m; alpha = 1.f; }
    else { mn = fmaxf(m, pmax); alpha = __builtin_amdgcn_exp2f((m - mn) * C2); m = mn; }
    const float mnL = -mn * C2;
#pragma unroll
    for (int r = 0; r < 16; ++r) { p0[r] = __builtin_amdgcn_exp2f(fmaf(p0[r], C2, mnL)); p1[r] = __builtin_amdgcn_exp2f(fmaf(p1[r], C2, mnL)); }
    float s0 = p0[0] + p1[0], s1 = p0[1] + p1[1], s2 = p0[2] + p1[2], s3 = p0[3] + p1[3];
#pragma unroll
    for (int r = 4; r < 16; r += 4) { s0 += p0[r] + p1[r]; s1 += p0[r + 1] + p1[r + 1]; s2 += p0[r + 2] + p1[r + 2]; s3 += p0[r + 3] + p1[r + 3]; }
    const float ps = psumf((s0 + s1) + (s2 + s3)); l = l * alpha + ps;
    bf16x8 pa0, pa1, pa2, pa3; pack_p(p0, p1, pa0, pa1, pa2, pa3);
    if (__any(alpha < 1.f)) { const int fl = fresh_lane(), fh = fl >> 5;
        if (fh == 0) wsf[fl] = alpha; asm volatile("s_waitcnt lgkmcnt(0)" ::: "memory");
#pragma unroll
        for (int r = 0; r < 16; ++r) { const float a = wsf[crow(r, fh)];
#pragma unroll
            for (int d = 0; d < 4; ++d) o[d][r] *= a; } }
    pv(o, vb, pa0, pa1, pa2, pa3);
}

template <int VAR>
__device__ __forceinline__ void attn_unit(const Ctx& C, int b, int h, int qb, LAS unsigned char* lds, int tid, int wid, int lane) {
    constexpr bool CAUSAL = VAR != VE, DESC = (VAR == VC || VAR == VD), MLA = (VAR == VB), DIFF = (VAR == VA), STICK = (VAR == VC), HASB = (VAR == VA || VAR == VD);
    constexpr int NQF = MLA ? 12 : 8;
    constexpr float SCALE = DIFF ? 0.125f : (MLA ? 0.07216878364870323f : 0.08838834764831845f);
    constexpr float C2 = SCALE * LOG2E;
    const int r32 = lane & 31, hi = lane >> 5;
    const int q0 = qb * 256, qw = q0 + wid * 32, trow = qw + r32;
    const size_t rb = (size_t)b * SEQ;
    const bf16 *Qp, *Kp, *Vp; bf16* Op; int qpitch, kpitch, opitch;
    if constexpr (VAR == VA || VAR == VC || VAR == VD) {
        constexpr int base = VAR == VA ? A_Q : (VAR == VC ? C_Q : D_Q);
        Qp = C.PROJ + rb * INP + base + h * 128; Kp = Qp + 1024; Vp = Qp + 2048; qpitch = INP; kpitch = INP;
        Op = C.MIX + rb * DM + VAR * 1024 + h * 128; opitch = DM;
    } else if constexpr (VAR == VB) {
        Qp = C.QMLA + rb * 1536 + h * 192; qpitch = 1536; Kp = C.KVMLA + rb * 2048 + h * 256; Vp = Kp + 128; kpitch = 2048;
        Op = C.MIX + rb * DM + 1024 + h * 128; opitch = DM;
    } else {
        Qp = C.QMEM + rb * 512 + h * 128; qpitch = 512; Kp = C.KVMEM + (size_t)b * MEMT * 1024 + h * 128; Vp = Kp + 512; kpitch = 1024;
        Op = C.OMEM + rb * 512 + h * 128; opitch = 512;
    }
    const char* Bp = nullptr;
    if constexpr (VAR == VA) Bp = (const char*)(C.pos + rb);
    if constexpr (VAR == VD) Bp = (const char*)(C.NEGC + (size_t)(b * 8 + h) * SEQ);
    const char* KPEp = nullptr;
    if constexpr (MLA) KPEp = (const char*)(C.KPE + rb * 64);
    bf16x8 qr[DIFF ? 1 : NQF];
    const LAS unsigned char* qlds = lds + QF_OFF + wid * 8192 + lane * 16;
    { const bf16* qrow = Qp + (size_t)trow * qpitch + hi * 8;
      if constexpr (DIFF) {
#pragma unroll
          for (int d0 = 0; d0 < 8; ++d0) { const bf16x8 q = *(const GAS bf16x8*)(qrow + d0 * 16); *(LAS bf16x8*)(lds + QF_OFF + wid * 8192 + lane * 16 + d0 * 1024) = q; }
      } else {
#pragma unroll
          for (int d0 = 0; d0 < NQF; ++d0) qr[d0] = *(const GAS bf16x8*)(qrow + d0 * 16); } }
    if constexpr (MLA) {
        const float* cs = C.COS + (rb + trow) * 32 + hi * 8; const float* sn = C.SIN + (rb + trow) * 32 + hi * 8;
#pragma unroll
        for (int j = 0; j < 2; ++j) {
            const f32x4 c0 = *(const GAS f32x4*)(cs + j * 16), c1 = *(const GAS f32x4*)(cs + j * 16 + 4), s0 = *(const GAS f32x4*)(sn + j * 16), s1 = *(const GAS f32x4*)(sn + j * 16 + 4);
            const bf16x8 a = qr[8 + j], bb = qr[10 + j]; float lo[8], hh[8];
#pragma unroll
            for (int e = 0; e < 8; ++e) { const float t1 = bf2f(a[e]), t2 = bf2f(bb[e]), c = e < 4 ? c0[e & 3] : c1[e & 3], s = e < 4 ? s0[e & 3] : s1[e & 3]; lo[e] = t1 * c - t2 * s; hh[e] = t1 * s + t2 * c; }
            v4u wl = {cvtpk(lo[0], lo[1]), cvtpk(lo[2], lo[3]), cvtpk(lo[4], lo[5]), cvtpk(lo[6], lo[7])}, wh = {cvtpk(hh[0], hh[1]), cvtpk(hh[2], hh[3]), cvtpk(hh[4], hh[5]), cvtpk(hh[6], hh[7])};
            qr[8 + j] = __builtin_bit_cast(bf16x8, wl); qr[10 + j] = __builtin_bit_cast(bf16x8, wh); }
    }
    unsigned koff[2], voff[2], peoff = 0;
#pragma unroll
    for (int i = 0; i < 2; ++i) { const int j = wid * 2 + i, row = 4 * j + (lane >> 4); koff[i] = (unsigned)(row * kpitch + (((lane & 15) ^ (row & 15)) << 3)) * 2u;
        const int st = 2 * j + (lane >> 5), kk = (st >> 2) * 8 + ((lane & 31) >> 2), c = (st & 3) * 32 + (lane & 3) * 8; voff[i] = (unsigned)(swap23(kk) * kpitch + c) * 2u; }
    if constexpr (MLA) { const int row = 8 * wid + (lane >> 3); peoff = (unsigned)(row * 64 + (((lane & 7) ^ ((row >> 1) & 7)) << 3)) * 2u; }
    const unsigned boff = (unsigned)(lane & 15) * 16u;
    const unsigned ldsbase = (unsigned)(unsigned long long)lds;
#define ISSUE(t_, buf_) do { const size_t tb_ = (size_t)(t_) * 64 * kpitch * 2; const char* kg_ = (const char*)Kp + tb_; const char* vg_ = (const char*)Vp + tb_; \
        _Pragma("unroll") for (int i_ = 0; i_ < 2; ++i_) dma16(kg_, koff[i_], ldsbase + K_OFF + (buf_) * 16384 + (wid * 2 + i_) * 1024); \
        _Pragma("unroll") for (int i_ = 0; i_ < 2; ++i_) dma16(vg_, voff[i_], ldsbase + V_OFF + (buf_) * 16384 + (wid * 2 + i_) * 1024); \
        if constexpr (MLA) dma16(KPEp + (size_t)(t_) * 64 * 64 * 2, peoff, ldsbase + KPE_OFF + (buf_) * 8192 + wid * 1024); \
        if constexpr (HASB) { if (wid == 0) dma16(Bp + (size_t)(t_) * 64 * 4, boff, ldsbase + B_OFF + (buf_) * 1024); } } while (0)
    const int NT = CAUSAL ? (q0 + 256) / 64 : MEMT / 64;
    LAS float* wsf = (LAS float*)(lds + WS_OFF) + wid * 64;
    LAS float* lut = (LAS float*)(lds + LUT_OFF);
    int pos_t = 0, wmin = 0; float lut_far = 0.f;
    if constexpr (DIFF) { if (tid < 132) lut[tid] = C.LUT[h * 132 + tid];
        pos_t = C.pos[rb + trow]; int mnp = pos_t;
        mnp = min(mnp, shxi<1>(mnp)); mnp = min(mnp, shxi<2>(mnp)); mnp = min(mnp, shxi<4>(mnp)); mnp = min(mnp, shxi<8>(mnp)); mnp = min(mnp, shxi<16>(mnp));
        wmin = __builtin_amdgcn_readfirstlane(mnp); lut_far = C.LUT[h * 132 + 128]; }
    const int xr = (r32 & 15) << 4, hx = hi << 4, xpe = ((r32 >> 1) & 7) << 4;
    const unsigned vrd = (unsigned)(((lane & 3) << 3) | (((lane >> 2) & 3) << 6) | (((lane >> 4) & 1) << 5) | (((lane >> 5) & 1) << 8));
    f32x16 o[4]; f32x16 o2[DIFF ? 4 : 1];
#pragma unroll
    for (int d = 0; d < 4; ++d) { o[d] = f32x16{}; if constexpr (DIFF) o2[d] = f32x16{}; }
    float m1 = -1e30f, l1 = 0.f, m2 = -1e30f, l2 = 0.f, R = 0.f;
    float qnkn = 0.f;
    if constexpr (VAR == VD) { float s = 0.f;
#pragma unroll
        for (int d0 = 0; d0 < 8; ++d0)
#pragma unroll
            for (int e = 0; e < 8; ++e) { const float a = bf2f(qr[d0][e]); s += a * a; }
        s = psumf(s); qnkn = sqrtf(s) * sqrtf(__uint_as_float(C.KN2[b * 8 + h])) * 1.001f + 1.f; }
    ISSUE(DESC ? NT - 1 : 0, 0);
    WAITBAR();
    int cur = 0;
    for (int i = 0; i < NT; ++i) {
        const int t = DESC ? NT - 1 - i : i, kb = t * 64;
        if (i + 1 < NT) ISSUE(DESC ? t - 1 : t + 1, cur ^ 1);
        const bool act = !CAUSAL || (STICK ? (kb < qw + 31) : (kb <= qw + 31));
        bool wdone = false;
        if constexpr (VAR == VD) {
            if (act) { const float nmax = ((const LAS float*)(lds + B_OFF + cur * 1024))[63]; wdone = __all((qnkn + nmax - m1) * SCALE < -40.f); } }
        if (act && !wdone) {
            const LAS unsigned char* krow = lds + K_OFF + cur * 16384 + r32 * 256;
            const unsigned vb = ldsbase + V_OFF + cur * 16384 + vrd;
            if constexpr (STICK) {
                f32x16 p0 = f32x16{}, p1 = f32x16{};
                qk<8>(p0, p1, krow, xr, hx, qr, 0);
                float L0[16], L1[16];
#pragma unroll
                for (int r = 0; r < 16; ++r) { const int key = kb + crow(r, hi);
                    { const float z = p0[r] * SCALE, e = __builtin_amdgcn_exp2f(-fabsf(z) * LOG2E), sp = fmaxf(z, 0.f) + __builtin_amdgcn_logf(1.f + e) * LN2; L0[r] = key < trow ? -sp : 0.f; p0[r] = z; }
                    { const float z = p1[r] * SCALE, e = __builtin_amdgcn_exp2f(-fabsf(z) * LOG2E), sp = fmaxf(z, 0.f) + __builtin_amdgcn_logf(1.f + e) * LN2; L1[r] = key + 32 < trow ? -sp : 0.f; p1[r] = z; } }
                float T[8], mb[8];
#pragma unroll
                for (int g = 0; g < 4; ++g) { T[g] = (L0[4 * g] + L0[4 * g + 1]) + (L0[4 * g + 2] + L0[4 * g + 3]); T[4 + g] = (L1[4 * g] + L1[4 * g + 1]) + (L1[4 * g + 2] + L1[4 * g + 3]); }
                float run = R;
#pragma unroll
                for (int k = 7; k >= 0; --k) { const float pt = partnerf(T[k], hi); const float T1 = hi ? T[k] : pt, T0 = hi ? pt : T[k];
                    const float b1 = run; run += T1; const float b0 = run; run += T0; mb[k] = hi ? b1 : b0; }
                R = run;
#pragma unroll
                for (int g = 0; g < 4; ++g) { float s0 = mb[g], s1 = mb[4 + g];
#pragma unroll
                    for (int e = 3; e >= 0; --e) { const int r = 4 * g + e, key = kb + crow(r, hi);
                        const float a0 = key < trow ? __builtin_amdgcn_exp2f((p0[r] + L0[r] + s0) * LOG2E) : 0.f; s0 += L0[r]; p0[r] = a0;
                        const float a1 = key + 32 < trow ? __builtin_amdgcn_exp2f((p1[r] + L1[r] + s1) * LOG2E) : 0.f; s1 += L1[r]; p1[r] = a1; } }
                bf16x8 pa0, pa1, pa2, pa3; pack_p(p0, p1, pa0, pa1, pa2, pa3);
                pv(o, vb, pa0, pa1, pa2, pa3);
            } else {
#pragma unroll
                for (int mp = 0; mp < (DIFF ? 2 : 1); ++mp) {
                    f32x16 p0, p1;
                    int xr_t = xr;
                    if constexpr (DIFF) { __builtin_amdgcn_sched_barrier(0); asm volatile("" : "+v"(pos_t), "+v"(xr_t)); }
                    if constexpr (VAR == VD) { const LAS float* nb = (const LAS float*)(lds + B_OFF + cur * 1024) + 4 * hi;
#pragma unroll
                        for (int g = 0; g < 4; ++g) { const f32x4 v0 = *(const LAS f32x4*)(nb + 8 * g), v1 = *(const LAS f32x4*)(nb + 32 + 8 * g);
#pragma unroll
                            for (int e = 0; e < 4; ++e) { p0[4 * g + e] = v0[e]; p1[4 * g + e] = v1[e]; } } }
                    else if constexpr (DIFF) {
                        if (wmin - C.TPMAX[b * 64 + t] >= 128) {
#pragma unroll
                            for (int r = 0; r < 16; ++r) { p0[r] = lut_far; p1[r] = lut_far; } }
                        else { const LAS int* pb = (const LAS int*)(lds + B_OFF + cur * 1024) + 4 * hi;
#pragma unroll
                            for (int g = 0; g < 4; ++g) { const i32x4 v0 = *(const LAS i32x4*)(pb + 8 * g), v1 = *(const LAS i32x4*)(pb + 32 + 8 * g);
#pragma unroll
                                for (int e = 0; e < 4; ++e) { p0[4 * g + e] = lut[min(max(pos_t - v0[e], 0), 128)]; p1[4 * g + e] = lut[min(max(pos_t - v1[e], 0), 128)]; }
                                __builtin_amdgcn_sched_barrier(0); } } }
                    else { p0 = f32x16{}; p1 = f32x16{}; }
                    if constexpr (DIFF) qk_l<4>(p0, p1, krow, xr_t, hx, qlds, 4 * mp);
                    else qk<8>(p0, p1, krow, xr, hx, qr, 0);
                    if constexpr (MLA) qk_pe(p0, p1, lds + KPE_OFF + cur * 8192 + r32 * 128, xpe, hx, qr + 8);
                    if (CAUSAL && kb + 63 > qw) { const float NEG = -__builtin_inff();
#pragma unroll
                        for (int r = 0; r < 16; ++r) { const int key = kb + crow(r, hi); if (key > trow) p0[r] = NEG; if (key + 32 > trow) p1[r] = NEG; } }
                    if (mp == 0) softmax_pv(p0, p1, m1, l1, o, wsf, vb, r32, hi, SCALE, C2);
                    else softmax_pv(p0, p1, m2, l2, o2, wsf, vb, r32, hi, SCALE, C2);
                }
            }
        }
        if constexpr (STICK) { const int dn_ = __all(R < -100.f) ? 1 : 0; if (lane == 0) ((LAS int*)(lds + FLG_OFF))[(i & 1) * 8 + wid] = dn_; }
        if constexpr (VAR == VD) { if (lane == 0) ((LAS int*)(lds + FLG_OFF))[(i & 1) * 8 + wid] = wdone ? 1 : 0; }
        WAITBAR(); cur ^= 1;
        if constexpr (STICK || VAR == VD) { const LAS i32x4* fl = (const LAS i32x4*)(lds + FLG_OFF + (i & 1) * 32); const i32x4 f0 = fl[0], f1 = fl[1];
            const int alld = (f0.x & f0.y & f0.z & f0.w) & (f1.x & f1.y & f1.z & f1.w); if (__builtin_amdgcn_readfirstlane(alld)) break; }
    }
#undef ISSUE
    const int lane_e = fresh_lane();
    const int r32e = lane_e & 31, hie = lane_e >> 5;
    bf16* Ob = Op + (size_t)(qw + 4 * hie) * opitch + r32e;
    if constexpr (DIFF) {
        if (hie == 0) { wsf[r32e] = l1; wsf[32 + r32e] = l2; } asm volatile("s_waitcnt lgkmcnt(0)" ::: "memory");
        const float lam = C.lam;
#pragma unroll
        for (int r = 0; r < 16; ++r) { const float i1 = __builtin_amdgcn_rcpf(wsf[crow(r, hie)]), i2 = lam * __builtin_amdgcn_rcpf(wsf[32 + crow(r, hie)]); float ss = 0.f;
#pragma unroll
            for (int d = 0; d < 4; ++d) { const float x = o[d][r] * i1 - o2[d][r] * i2; o[d][r] = x; ss += x * x; }
            ss = half_sum(ss);
            const float rstd = (1.0f / sqrtf(ss * (1.f / 128.f) + EPS)) * C.oml;
#pragma unroll
            for (int d = 0; d < 4; ++d) o[d][r] *= rstd; }
#pragma unroll
        for (int d = 0; d < 4; ++d) { const float g = C.sub_g[d * 32 + r32e];
#pragma unroll
            for (int r = 0; r < 16; ++r) o[d][r] *= g; }
    } else if constexpr (!STICK) {
        if (hie == 0) wsf[r32e] = l1; asm volatile("s_waitcnt lgkmcnt(0)" ::: "memory");
#pragma unroll
        for (int r = 0; r < 16; ++r) { const float i1 = __builtin_amdgcn_rcpf(wsf[crow(r, hie)]);
#pragma unroll
            for (int d = 0; d < 4; ++d) o[d][r] *= i1; }
    }
#pragma unroll
    for (int r = 0; r < 16; ++r) { const int orr = (r & 3) + 8 * (r >> 2);
#pragma unroll
        for (int d = 0; d < 4; ++d) { const float v = o[d][r], vn = shx<1>(v);
            if ((r32e & 1) == 0) *(GAS unsigned*)(Ob + (size_t)orr * opitch + d * 32) = cvtpk(v, vn); } }
}
template <int VAR> __device__ __forceinline__ void attn_queue(const Ctx& C, gu32* head, LAS unsigned char* lds, const int wid, const kaptr_t ka, unsigned char* ws, const int cvl) {
    constexpr int NH = VAR == VE ? 4 : 8, NU = NB * NH * 16;
    const int lane = fresh_lane(), tid = wid * 64 + lane;
    volatile LAS int* tk = (volatile LAS int*)(lds + LDSCTL_OFF);
    for (;;) {
        if (tid == 0) tk[0] = (int)__hip_atomic_fetch_add(head, 1u, RLX_AGENT);
        WAITBAR();
        const int n = __builtin_amdgcn_readfirstlane(tk[0]);
        if (n >= NU) break;
        const int qb = 15 - n / (NB * NH), bh = n % (NB * NH);
        attn_unit<VAR>(C, bh / NH, bh % NH, qb, lds, tid, wid, lane);
        if (cvl >= 0) {
            if (tid == 0) tk[1] = (int)__hip_atomic_fetch_add((gu32*)(ws + WS_CTL) + CW_TKT + (cvl * 16 + 10) * 64, 1u, RLX_AGENT);
            WAITBAR();
            const int c = __builtin_amdgcn_readfirstlane(tk[1]);
            if (c < KNCH(ka, cvl)) conv_chunk(ka, ws, cvl, c, (LAS float*)(lds + RING_OFF + wid * 16640), wid, lane);
        }
    }
}
}


namespace att {
template <int VAR> __device__ __forceinline__ void attn_phase(int l, int q, LAS unsigned char* lds, const int wid0) {
    const kaptr_t ka = ka_fresh(); unsigned char* ws = KWS(ka);
    const Ctx C{(const bf16*)(ws + WS_PROJ), (const bf16*)(ws + WS_QMLA), (const bf16*)(ws + WS_KVMLA), (const bf16*)(ws + WS_KPE), (bf16*)(ws + WS_MIX), (const bf16*)(ws + WS_QMEM),
                (const bf16*)(ws + WS_KVMEM) + (size_t)l * 512 * 1024, (bf16*)(ws + WS_OMEM), (const float*)(ws + WS_COS), (const float*)(ws + WS_SIN), (const float*)(ws + WS_LUT),
                (const int*)(ws + WS_TPMAX), (const int*)KIN(ka, 2), (const float*)(ws + WS_NEGC), (const float*)KIN(ka, 11) + l * 128, (const unsigned*)((gu32*)(ws + WS_CTL) + CW_KN + l * 64), ((const float*)(ws + WS_LAM))[l], 1.0f - KLAMI(ka, l)};
    attn_queue<VAR>(C, (gu32*)(ws + WS_CTL) + CW_TKT + (l * 16 + q) * 64, lds, wid0, ka, ws, VAR == VE ? -1 : l);
}
}

__global__ void __launch_bounds__(NWAVES * 64, 2) mk_fwd(Args args) {
    extern __shared__ __attribute__((aligned(16))) unsigned char lds_raw[];
    LAS unsigned char* lds = (LAS unsigned char*)lds_raw;
    const int G = gridDim.x, bx = blockIdx.x;
    const int vcu = (G % 8 == 0) ? (bx % 8) * (G / 8) + bx / 8 : bx;
    const int wid0 = __builtin_amdgcn_readfirstlane((int)threadIdx.x >> 6);
    const int gw = vcu * NWAVES + wid0, NGW = G * NWAVES;
    { const int tid = wid0 * 64 + fresh_lane();
      for (int u = tid; u < (LDS_BYTES - LDSCTL_OFF) / 4; u += NWAVES * 64) ((LAS unsigned*)(lds + LDSCTL_OFF))[u] = 0u; }
    __syncthreads();
    volatile LAS unsigned* MISC = (volatile LAS unsigned*)(lds + MISC_OFF);
    XcdBarrier bar = xcd_barrier_post((unsigned*)(args.ws + WS_CTL) + CW_BAR, MISC + 8, wid0);

    {
        const kaptr_t ka = ka_fresh(); unsigned char* ws = KWS(ka);
        const int lane = fresh_lane(), wid = wid0, tid = wid * 64 + lane;
        LAS float* scr = (LAS float*)(lds + RING_OFF + wid * 16640);
        {
            const int l = 0; unsigned char* wl = ws + WS_W;
#define TR_MAT(idx_, K_, N_, NP_, dst_, roff_, gain_) do { const float* s_ = (const float*)KIN(ka, idx_) + (size_t)l * (K_) * (N_); const int nblk_ = (NP_) / 64, nit_ = ((K_) / 64) * nblk_; \
            const float* gk_ = (gain_) >= 0 ? (const float*)KIN(ka, (gain_) >= 0 ? (gain_) : 0) + (size_t)l * (K_) : nullptr; \
            for (int it = gw; it < nit_; it += NGW) tr_item(s_, (K_), (N_), nblk_, (bf16*)(dst_), (roff_), scr, it, lane, gk_); } while (0)
            TR_MAT(4, DM, INC, INP, wl + W_IN, 0, 3);
            TR_MAT(14, QRANK, 1536, 1536, wl + W_UQ, 0, -1);
            TR_MAT(15, KVRANK, 2048, 2048, wl + W_UKV, 0, -1);
            TR_MAT(20, DM, 512, 512, wl + W_MKV, 0, -1);
            TR_MAT(21, DM, 512, 512, wl + W_MKV, 512, -1);
#undef TR_MAT
        }
        { const float* x0 = (const float*)KIN(ka, 0); bf16* H = (bf16*)(ws + WS_H); unsigned long long* SS = (unsigned long long*)((gu32*)(ws + WS_CTL) + CW_SS);
          for (int m = gw; m < M; m += NGW) cast_row(x0 + (size_t)m * DM, H + (size_t)m * DM, SS + m, lane); }
        { const float* mem = (const float*)KIN(ka, 1); bf16* MEMN = (bf16*)(ws + WS_MEMN);
          for (int r = gw; r < NL * NB * MEMT; r += NGW) { const int l = r / (NB * MEMT), mr = r - l * (NB * MEMT);
            rms_row<true>(mem + (size_t)mr * DM, (const float*)KIN(ka, 18) + (size_t)l * DM, MEMN + (size_t)r * DM, lane); } }
        const int* pos = (const int*)KIN(ka, 2);
        float* COS = (float*)(ws + WS_COS); float* SIN = (float*)(ws + WS_SIN); float* LUT = (float*)(ws + WS_LUT); int* TPMAX = (int*)(ws + WS_TPMAX); float* LAM = (float*)(ws + WS_LAM);
        const int gt = vcu * (NWAVES * 64) + tid, NGT = G * NWAVES * 64;
        for (int i = gt; i < M * 32; i += NGT) { const int row = i >> 5, f = i & 31; const float ang = (float)pos[row] * KINVF(ka, f);
            double rv = (double)ang * 0.15915494309189535; rv -= floor(rv); const float fr = (float)rv;
            COS[i] = __builtin_amdgcn_cosf(fr); SIN[i] = __builtin_amdgcn_sinf(fr); }
        for (int i = gt; i < 8 * 132; i += NGT) { const int h = i / 132, dd0 = i - h * 132; const int dd = dd0 > 128 ? 128 : dd0; int bk;
            if (dd < 16) bk = dd; else { bk = 16 + (int)(logf((float)dd / 16.0f) / 2.0794415416798357f * 16.0f); bk = bk > 31 ? 31 : bk; }
            LUT[i] = 8.0f * ((const float*)KIN(ka, 6))[bk * 8 + h]; }
        for (int i = gt; i < NB * 64; i += NGT) { int mx = pos[i * 64];
            for (int k = 1; k < 64; ++k) mx = max(mx, pos[i * 64 + k]);
            TPMAX[i] = mx; }
        if (gt < NL) { const int l = gt; float s1 = 0.f, s2 = 0.f;
            for (int k = 0; k < 64; ++k) { s1 += ((const float*)KIN(ka, 7))[l * 64 + k] * ((const float*)KIN(ka, 8))[l * 64 + k]; s2 += ((const float*)KIN(ka, 9))[l * 64 + k] * ((const float*)KIN(ka, 10))[l * 64 + k]; }
            LAM[l] = expf(s1) - expf(s2) + KLAMI(ka, l); }
    }
    xcd_barrier(bar, wid0);

    for (int l = 0; l < NL; ++l) {
        { const kaptr_t ka = ka_fresh(); unsigned char* ws = KWS(ka); unsigned char* wl = ws + WS_W + (size_t)l * W_LAYER;
          { pg8::Gemm g{(const bf16*)(ws + WS_H), (const bf16*)(wl + W_IN), M, INP, DM}; pg8::StaticOrder S; S.init(M, INP, G, bx);
            pg8::EpiBf16<0, true> E{(bf16*)(ws + WS_PROJ), INP, (const unsigned long long*)((gu32*)(ws + WS_CTL) + CW_SS) + (size_t)(3 * l) * M};
            pg8::gemm_phase<pg8::EpiBf16<0, true>, pg8::StaticOrder, true, true>(lds + RING_OFF, g, S, E, wid0); }
          { pg8::Gemm g{(const bf16*)(ws + WS_MEMN) + (size_t)l * 512 * DM, (const bf16*)(wl + W_MKV), 512, 1024, DM}; pg8::StaticOrder S; S.init(512, 1024, G, G - 1 - bx);
            pg8::EpiBf16<0, false> E{(bf16*)(ws + WS_KVMEM) + (size_t)l * 512 * 1024, 1024, nullptr};
            pg8::gemm_phase<pg8::EpiBf16<0, false>, pg8::StaticOrder, true, true>(lds + RING_OFF, g, S, E, wid0); }
          if (G == 256 && bx >= 160 && bx < 248) {
              const int lane = fresh_lane(); LAS float* scr = (LAS float*)(lds + RING_OFF + wid0 * 16640);
              for (int it = (bx - 160) * NWAVES + wid0; it < UPDEF; it += 88 * NWAVES) conv_item(ka, ws, 2 + l, it, scr, lane); } }
        xcd_barrier(bar, wid0);
        { const kaptr_t ka = ka_fresh(); unsigned char* ws = KWS(ka); FRESH_LANE(ln);
          for (int m = gw; m < M; m += NGW)
            prep_row((const bf16*)(ws + WS_PROJ), m, (const float*)KIN(ka, 12) + (size_t)l * QRANK, (const float*)KIN(ka, 13) + (size_t)l * KVRANK, (const float*)KIN(ka, 16) + l * 8,
                     (const float*)(ws + WS_COS), (const float*)(ws + WS_SIN), (bf16*)(ws + WS_CQN), (bf16*)(ws + WS_CKVN), (bf16*)(ws + WS_KPE), (float*)(ws + WS_LOGF), (unsigned*)((gu32*)(ws + WS_CTL) + CW_KN + l * 64), ln); }
        xcd_barrier(bar, wid0);
        { const kaptr_t ka = ka_fresh(); unsigned char* ws = KWS(ka); unsigned char* wl = ws + WS_W + (size_t)l * W_LAYER;
          if (gw < 16) { FRESH_LANE(ln); fox_scan((const float*)(ws + WS_LOGF) + (size_t)gw * SEQ, (float*)(ws + WS_NEGC) + (size_t)gw * SEQ, ln); }
          { pg8::Gemm g{(const bf16*)(ws + WS_CQN), (const bf16*)(wl + W_UQ), M, 1536, QRANK}; pg8::StaticOrder S; S.init(M, 1536, G, bx);
            pg8::EpiBf16<0, false> E{(bf16*)(ws + WS_QMLA), 1536, nullptr};
            pg8::gemm_phase<pg8::EpiBf16<0, false>, pg8::StaticOrder, true, true>(lds + RING_OFF, g, S, E, wid0); }
          { pg8::Gemm g{(const bf16*)(ws + WS_CKVN), (const bf16*)(wl + W_UKV), M, 2048, KVRANK}; pg8::StaticOrder S; S.init(M, 2048, G, G - 1 - bx);
            pg8::EpiBf16<0, false> E{(bf16*)(ws + WS_KVMLA), 2048, nullptr};
            pg8::gemm_phase<pg8::EpiBf16<0, false>, pg8::StaticOrder, true, true>(lds + RING_OFF, g, S, E, wid0); }
          if (G == 256 && bx >= 192) {
              const int lane = fresh_lane(); LAS float* scr = (LAS float*)(lds + RING_OFF + wid0 * 16640);
              for (int it = UPDEF + (bx - 192) * NWAVES + wid0; it < UPDEF + P4DEF; it += 64 * NWAVES) conv_item(ka, ws, 2 + l, it, scr, lane); } }
        xcd_barrier(bar, wid0);
        att::attn_phase<att::VA>(l, 0, lds, wid0);
        att::attn_phase<att::VB>(l, 1, lds, wid0);
        att::attn_phase<att::VD>(l, 2, lds, wid0);
        att::attn_phase<att::VC>(l, 3, lds, wid0);
        { const kaptr_t ka = ka_fresh(); unsigned char* ws = KWS(ka); const int lane = fresh_lane(); volatile LAS int* tk = (volatile LAS int*)(lds + LDSCTL_OFF + 16);
          for (;;) { if (wid0 == 0 && lane == 0) tk[0] = (int)__hip_atomic_fetch_add((gu32*)(ws + WS_CTL) + CW_TKT + (l * 16 + 10) * 64, 1u, RLX_AGENT);
              WAITBAR(); const int c = __builtin_amdgcn_readfirstlane(tk[0]); WAITBAR();
              if (c >= KNCH(ka, l)) break;
              conv_chunk(ka, ws, l, c, (LAS float*)(lds + RING_OFF + wid0 * 16640), wid0, lane); } }
        xcd_barrier(bar, wid0);
        { const kaptr_t ka = ka_fresh(); unsigned char* ws = KWS(ka); unsigned char* wl = ws + WS_W + (size_t)l * W_LAYER;
          pg8::Gemm g{(const bf16*)(ws + WS_MIX), (const bf16*)(wl + W_OUT), M, DM, DM}; pg8::StaticOrder S; S.init(M, DM, G, bx);
          pg8::EpiRes E{(bf16*)(ws + WS_H), DM, (unsigned long long*)((gu32*)(ws + WS_CTL) + CW_SS) + (size_t)(3 * l + 1) * M};
          pg8::gemm_phase<pg8::EpiRes, pg8::StaticOrder, true, true>(lds + RING_OFF, g, S, E, wid0); }
        xcd_barrier(bar, wid0);
        { const kaptr_t ka = ka_fresh(); unsigned char* ws = KWS(ka); unsigned char* wl = ws + WS_W + (size_t)l * W_LAYER;
          pg8::Gemm g{(const bf16*)(ws + WS_H), (const bf16*)(wl + W_MQ), M, 512, DM}; pg8::StaticOrder S; S.init(M, 512, G, bx);
          pg8::EpiBf16<0, true> E{(bf16*)(ws + WS_QMEM), 512, (const unsigned long long*)((gu32*)(ws + WS_CTL) + CW_SS) + (size_t)(3 * l + 1) * M};
          pg8::gemm_phase<pg8::EpiBf16<0, true>, pg8::StaticOrder, true, true>(lds + RING_OFF, g, S, E, wid0);
          if (G == 256 && bx >= 64) {
              const int lane = fresh_lane(); LAS float* scr = (LAS float*)(lds + RING_OFF + wid0 * 16640);
              for (int it = UPDEF + P4DEF + (bx - 64) * NWAVES + wid0; it < UPDEF + P4DEF + P8DEF; it += 192 * NWAVES) conv_item(ka, ws, 2 + l, it, scr, lane); } }
        xcd_barrier(bar, wid0);
        att::attn_phase<att::VE>(l, 4, lds, wid0);
        xcd_barrier(bar, wid0);
        { const kaptr_t ka = ka_fresh(); unsigned char* ws = KWS(ka); unsigned char* wl = ws + WS_W + (size_t)l * W_LAYER;
          pg8::Gemm g{(const bf16*)(ws + WS_OMEM), (const bf16*)(wl + W_MO), M, DM, 512}; pg8::StaticOrder S; S.init(M, DM, G, bx);
          pg8::EpiRes E{(bf16*)(ws + WS_H), DM, (unsigned long long*)((gu32*)(ws + WS_CTL) + CW_SS) + (size_t)(3 * l + 2) * M};
          pg8::gemm_phase<pg8::EpiRes, pg8::StaticOrder, true, true>(lds + RING_OFF, g, S, E, wid0); }
        xcd_barrier(bar, wid0);
        { const kaptr_t ka = ka_fresh(); unsigned char* ws = KWS(ka); unsigned char* wl = ws + WS_W + (size_t)l * W_LAYER;
          pg8::Gemm g{(const bf16*)(ws + WS_H), (const bf16*)(wl + W_UP), M, DFF, DM}; pg8::StaticOrder S; S.init(M, DFF, G, bx);
          pg8::EpiBf16<1, true> E{(bf16*)(ws + WS_U), DFF, (const unsigned long long*)((gu32*)(ws + WS_CTL) + CW_SS) + (size_t)(3 * l + 2) * M};
          pg8::gemm_phase<pg8::EpiBf16<1, true>, pg8::StaticOrder, true, true>(lds + RING_OFF, g, S, E, wid0); }
        xcd_barrier(bar, wid0);
        { const kaptr_t ka = ka_fresh(); unsigned char* ws = KWS(ka); unsigned char* wl = ws + WS_W + (size_t)l * W_LAYER;
          pg8::Gemm g{(const bf16*)(ws + WS_U), (const bf16*)(wl + W_DN), M, DM, DFF}; pg8::StaticOrder S; S.init(M, DM, G, bx);
          pg8::EpiRes E{(bf16*)(ws + WS_H), DM, (unsigned long long*)((gu32*)(ws + WS_CTL) + CW_SS) + (size_t)(3 * l + 3) * M};
          pg8::gemm_phase<pg8::EpiRes, pg8::StaticOrder, true, true>(lds + RING_OFF, g, S, E, wid0); }
        xcd_barrier(bar, wid0);
    }
    { const kaptr_t ka = ka_fresh(); unsigned char* ws = KWS(ka); FRESH_LANE(ln); float* O = KOUT(ka);
      for (int m = gw; m < M; m += NGW) final_row((const bf16*)(ws + WS_H) + (size_t)m * DM, (const float*)KIN(ka, 26), O + (size_t)m * DM, ln); }
}

extern "C" void kernel_launch(void* const* d_in, const int* in_sizes, int n_in, void* d_out, int out_size, void* d_ws, size_t ws_size, hipStream_t stream) {
    static int grid = 0;
    if (grid == 0) {
        if (n_in != 27 || in_sizes[0] != M * DM || out_size != M * DM || ws_size < WS_END) {
            fprintf(stderr, "kernel_launch: built for 27 inputs, x/out of %d floats, >= %zu bytes of workspace; got n_in %d, in0 %d, out %d, ws %zu; nothing launched\n", M * DM, (size_t)WS_END, n_in, n_in > 0 ? in_sizes[0] : -1, out_size, ws_size);
            grid = -1; return; }
        int dev = 0, cus = 0, per_cu = 0;
        if (hipGetDevice(&dev) != hipSuccess || hipDeviceGetAttribute(&cus, hipDeviceAttributeMultiprocessorCount, dev) != hipSuccess) { fprintf(stderr, "kernel_launch: device query failed\n"); grid = -1; return; }
        if (hipFuncSetAttribute((const void*)mk_fwd, hipFuncAttributeMaxDynamicSharedMemorySize, LDS_BYTES) != hipSuccess) { fprintf(stderr, "kernel_launch: hipFuncSetAttribute failed\n"); grid = -1; return; }
        if (hipOccupancyMaxActiveBlocksPerMultiprocessor(&per_cu, (const void*)mk_fwd, NWAVES * 64, LDS_BYTES) != hipSuccess || per_cu < 1)
            fprintf(stderr, "kernel_launch: note: occupancy query reports %d workgroups per CU\n", per_cu);
        (void)hipGetLastError();
        grid = cus;
    }
    if (grid < 0) return;
    if (hipMemsetAsync((char*)d_ws + WS_CTL, 0, CTL_ZERO_BYTES, stream) != hipSuccess) { fprintf(stderr, "kernel_launch: memset failed\n"); return; }
    Args a; memset(&a, 0, sizeof(a));
    for (int i = 0; i < 27; ++i) a.in[i] = d_in[i];
    a.out = (float*)d_out; a.ws = (unsigned char*)d_ws;
    for (int i = 0; i < 32; ++i) a.inv_freq[i] = (float)pow(10000.0, -(double)i / 32.0);
    for (int l = 0; l < NL; ++l) a.lam_init[l] = (float)(0.8 - 0.6 * exp(-0.3 * (double)l));
    {
        auto put = [&](int t, int idx, int K, int N, int NP, size_t off, int roff, int gain, int lay, int first, int cnt) {
            Cv& c = a.cv[t][a.ncv[t]++]; c.idx = idx; c.K = K; c.N = N; c.NP = NP; c.dst = (long long)(WS_W + (size_t)lay * W_LAYER + off); c.roff = roff; c.gain = gain; c.lay = lay;
            c.first = first; c.cnt = cnt < 0 ? (K / 64) * (NP / 64) - first : cnt; };
        put(0, 5, DM, DM, DM, W_OUT, 0, -1, 0, 0, -1); put(0, 19, DM, 512, 512, W_MQ, 0, 17, 0, 0, -1); put(0, 22, 512, DM, DM, W_MO, 0, -1, 0, 0, -1);
        put(0, 24, DM, DFF, DFF, W_UP, 0, 23, 0, 0, -1); put(0, 25, DFF, DM, DM, W_DN, 0, -1, 0, 0, -1);
        const bool idle = (grid == 256);
        const int te = idle ? 2 : 0, tl = idle ? 3 : 1;
        constexpr int UP2 = UPDEF + P4DEF + P8DEF - (11520 + 576 + 256 + 512 + 512);
        constexpr int DN3 = UPDEF + P4DEF + P8DEF - (16384 - UP2);
        static_assert(UP2 > 0 && UP2 < 16384 && DN3 > 0 && DN3 < 16384, "idle-window split");
        put(te, 4, DM, INC, INP, W_IN, 0, 3, 1, 0, -1); put(te, 14, QRANK, 1536, 1536, W_UQ, 0, -1, 1, 0, -1); put(te, 15, KVRANK, 2048, 2048, W_UKV, 0, -1, 1, 0, -1);
        put(te, 20, DM, 512, 512, W_MKV, 0, -1, 1, 0, -1); put(te, 21, DM, 512, 512, W_MKV, 512, -1, 1, 0, -1);
        put(1, 5, DM, DM, DM, W_OUT, 0, -1, 1, 0, -1); put(1, 19, DM, 512, 512, W_MQ, 0, 17, 1, 0, -1); put(1, 22, 512, DM, DM, W_MO, 0, -1, 1, 0, -1);
        if (idle) { put(2, 24, DM, DFF, DFF, W_UP, 0, 23, 1, 0, UP2); put(3, 24, DM, DFF, DFF, W_UP, 0, 23, 1, UP2, -1); put(3, 25, DFF, DM, DM, W_DN, 0, -1, 1, 0, DN3); put(1, 25, DFF, DM, DM, W_DN, 0, -1, 1, DN3, -1); }
        else { put(1, 24, DM, DFF, DFF, W_UP, 0, 23, 1, 0, -1); put(1, 25, DFF, DM, DM, W_DN, 0, -1, 1, 0, -1); }
        (void)tl;
        for (int t = 0; t < NTB; ++t) { long tot = 0; for (int j = 0; j < a.ncv[t]; ++j) tot += a.cv[t][j].cnt; a.nchunk[t] = (int)((tot + 63) / 64); }
    }
    hipLaunchKernelGGL(mk_fwd, dim3(grid), dim3(NWAVES * 64), LDS_BYTES, stream, a);
    const hipError_t le = hipPeekAtLastError();
    if (le != hipSuccess) fprintf(stderr, "kernel_launch: launch failed: %s\n", hipGetErrorName(le));
}
```

```cpp
#include <hip/hip_runtime.h>
#include <cstdio>
#include <cstdint>
#include <cstring>
#include <cmath>
__device__ __forceinline__ int fresh_lane() { unsigned z = 0u; asm volatile("" : "+v"(z)); return (int)__builtin_amdgcn_mbcnt_hi(~0u, __builtin_amdgcn_mbcnt_lo(~0u, z)); }
namespace pg8 {
#define PG8_LAS __attribute__((address_space(3)))
typedef unsigned short bf16_t;
typedef short bf16x8 __attribute__((ext_vector_type(8)));
typedef float f32x4 __attribute__((ext_vector_type(4)));
typedef unsigned u32x4 __attribute__((ext_vector_type(4)));
constexpr int BM = 256, BK = 64, HALF = 128, HTB = HALF * BK * 2  , STAGE_BYTES = 8 * HTB, NXCD = 8, WGM = 8;

__host__ __device__ __forceinline__ int lds_byte(int r, int c) { const int st = (r >> 4) * 2 + (c >> 5), rr = r & 15, cc = c & 31, ob = rr * 64 + cc * 2; return st * 1024 + (ob ^ (((ob >> 9) & 1) << 5)); }
__host__ __device__ __forceinline__ void stage_rc(int b, int& R, int& C) { const int st = b / 1024, sb = b % 1024, swz = sb ^ (((sb >> 9) & 1) << 5); R = (st >> 1) * 16 + swz / 64; C = (st & 1) * 32 + (swz % 64) / 2; }
__host__ __device__ __forceinline__ int perm32(int rho) { const int n = rho >> 4, i = rho & 15; return 8 * (i >> 2) + 4 * n + (i & 3); }

struct Unit { int pm, pn; };
struct Gemm { const bf16_t* A; const bf16_t* Bt; int M, N, K; };

struct StaticOrder {
    int nM, nN, nwg, G, c;
    __host__ __device__ void init(int M, int N, int G_, int c_) { nM = M / BM; nN = N / BM; nwg = nM * nN; G = G_; c = c_; }
    __host__ __device__ bool next(int i, Unit& u) const {
        const long L = (long)i * G + c; if (L >= nwg) return false;
        int wgid = (int)L; { const int q = nwg / NXCD, r = nwg % NXCD, xcd = wgid % NXCD, off = wgid / NXCD; wgid = (xcd < r ? xcd * (q + 1) : r * (q + 1) + (xcd - r) * q) + off; }
        const int nig = WGM * nN, gid = wgid / nig, fm = gid * WGM, gsz = (nM - fm) < WGM ? (nM - fm) : WGM;
        u.pm = fm + ((wgid % nig) % gsz); u.pn = (wgid % nig) / gsz; return true;
    }
    __device__ __forceinline__ void a_ready(const Unit&) const {}
    __device__ __forceinline__ void done(const Unit&) const {}
};

__device__ __forceinline__ unsigned cvt_pk_bf16(float lo, float hi) { unsigned r; asm volatile("v_cvt_pk_bf16_f32 %0, %1, %2" : "=v"(r) : "v"(lo), "v"(hi)); return r; }
typedef float f32x2 __attribute__((ext_vector_type(2)));
template <int ACT, bool RS> struct EpiBf16 {
    static constexpr bool PERM = true, AFTER_DRAIN = false;
    bf16_t* O; int ldc; const unsigned long long* ss;
    __device__ __forceinline__ void operator()(const f32x4 (&acc)[2][2][4][2], const Unit& u, int wr, int wc, int fr, int fq) const {
        const int row0 = u.pm * BM + wr * 64 + fr, col0 = u.pn * BM + wc * 32 + 8 * fq;
#pragma unroll
        for (int ai = 0; ai < 2; ++ai)
#pragma unroll
            for (int m = 0; m < 4; ++m) { const int row = row0 + ai * HALF + m * 16; bf16_t* rowp = O + (size_t)row * ldc + col0;
                float rs = 1.f; if (RS) rs = 1.0f / sqrtf((float)ss[row] * (1.f / 1048576.f / 4096.f) + 1e-6f);
#pragma unroll
                for (int bj = 0; bj < 2; ++bj) { f32x4 v0 = acc[ai][bj][m][0], v1 = acc[ai][bj][m][1];
                    if (RS) { v0 = v0 * rs; v1 = v1 * rs; }
                    if (ACT == 1) {
#pragma unroll
                        for (int e = 0; e < 4; ++e) { const float a = fmaxf(v0[e], 0.f), b = fmaxf(v1[e], 0.f); v0[e] = a * a; v1[e] = b * b; } }
                    u32x4 w; w.x = cvt_pk_bf16(v0[0], v0[1]); w.y = cvt_pk_bf16(v0[2], v0[3]); w.z = cvt_pk_bf16(v1[0], v1[1]); w.w = cvt_pk_bf16(v1[2], v1[3]);
                    *(u32x4*)(rowp + bj * HALF) = w; } }
    }
};
struct EpiRes {
    static constexpr bool PERM = true, AFTER_DRAIN = false;
    bf16_t* xh; int ldc; unsigned long long* ss;
    __device__ __forceinline__ void operator()(const f32x4 (&acc)[2][2][4][2], const Unit& u, int wr, int wc, int fr, int fq) const {
        const int row0 = u.pm * BM + wr * 64 + fr, col0 = u.pn * BM + wc * 32 + 8 * fq;
#pragma unroll
        for (int ai = 0; ai < 2; ++ai)
#pragma unroll
            for (int m = 0; m < 4; ++m) { const int row = row0 + ai * HALF + m * 16; const size_t off = (size_t)row * ldc + col0; float sq = 0.f;
#pragma unroll
                for (int bj = 0; bj < 2; ++bj) { const u32x4 hv = *(const u32x4*)(xh + off + bj * HALF); u32x4 ho;
#pragma unroll
                    for (int e = 0; e < 4; ++e) { const f32x4& a = acc[ai][bj][m][e >> 1]; const int j = (e & 1) * 2;
                        const float v0 = __uint_as_float(hv[e] << 16) + a[j], v1 = __uint_as_float(hv[e] & 0xffff0000u) + a[j + 1];
                        ho[e] = cvt_pk_bf16(v0, v1); sq += v0 * v0 + v1 * v1; }
                    *(u32x4*)(xh + off + bj * HALF) = ho; }
                sq += __int_as_float(__builtin_amdgcn_ds_swizzle(__float_as_int(sq), 0x1f | (16 << 10)));
                { auto rr = __builtin_amdgcn_permlane32_swap(__float_as_uint(sq), __float_as_uint(sq), false, false); sq = __uint_as_float(rr[0]) + __uint_as_float(rr[1]); }
                if (fq == 0) __hip_atomic_fetch_add(ss + row, (unsigned long long)((double)sq * 1048576.0), __ATOMIC_RELAXED, __HIP_MEMORY_SCOPE_AGENT); }
    }
};
template <class Epi, class Sched, bool ALIGN_EPI = false, bool SP2 = false>
__device__ __forceinline__ void gemm_phase(PG8_LAS unsigned char* lds, const Gemm g, const Sched& S, const Epi& E, const int wid0) {
    const int wid = wid0, lane = fresh_lane(), tid = wid * 64 + lane, wr = wid >> 2, wc = wid & 3, fr = lane & 15, fq = lane >> 4;
    const int K = g.K, nt = K / BK;
    unsigned voffA[2], voffB[2];
#pragma unroll
    for (int i = 0; i < 2; ++i) { int R, C; stage_rc(tid * 16 + i * 8192, R, C); const int Rb = Epi::PERM ? ((R & ~31) + perm32(R & 31)) : R;
        voffA[i] = (unsigned)(R * K + C) * 2u; voffB[i] = (unsigned)(Rb * K + C) * 2u; }
    const size_t kstep = (size_t)(BK * 2);
    const size_t hstep = (size_t)HALF * K * 2;
    const size_t tstep = 2 * hstep;
    const unsigned ldsw = (unsigned)wid * 1024u;
    const int aoff = lds_byte(wr * 64 + fr, fq * 8), boff = lds_byte(wc * 32 + fr, fq * 8);
#define PG8_SA(b, h) (((b) * 2 + (h)) * HTB)
#define PG8_SB(b, h) ((4 + (b) * 2 + (h)) * HTB)
#define PG8_STAGE(bufoff, gbase, voff) do { _Pragma("unroll") for (int _i = 0; _i < 2; ++_i) \
        __builtin_amdgcn_global_load_lds((const unsigned*)((const char*)(gbase) + (voff)[_i]), (PG8_LAS unsigned*)(lds + (bufoff) + ldsw + _i * 8192), 16, 0, 0); } while (0)
#define PG8_LDA(dst, b, h) do { _Pragma("unroll") for (int m = 0; m < 4; ++m) _Pragma("unroll") for (int k = 0; k < 2; ++k) dst[m][k] = *(const PG8_LAS bf16x8*)(lds + PG8_SA(b, h) + aoff + m * 2048 + k * 1024); } while (0)
#define PG8_LDB(dst, b, h) do { _Pragma("unroll") for (int n = 0; n < 2; ++n) _Pragma("unroll") for (int k = 0; k < 2; ++k) dst[n][k] = *(const PG8_LAS bf16x8*)(lds + PG8_SB(b, h) + boff + n * 2048 + k * 1024); } while (0)
#define PG8_MMA(ai, bj, At, Bt) do { __builtin_amdgcn_s_setprio(1); _Pragma("unroll") for (int m = 0; m < 4; ++m) _Pragma("unroll") for (int n = 0; n < 2; ++n) _Pragma("unroll") for (int k = 0; k < 2; ++k) \
        acc[ai][bj][m][n] = __builtin_amdgcn_mfma_f32_16x16x32_bf16(Bt[n][k], At[m][k], acc[ai][bj][m][n], 0, 0, 0); __builtin_amdgcn_s_setprio(0); } while (0)
#define PG8_WAIT_V(n) asm volatile("s_waitcnt vmcnt(" #n ")" ::: "memory")
#define PG8_WAIT_L(n) asm volatile("s_waitcnt lgkmcnt(" #n ")" ::: "memory")
#define PG8_BAR __builtin_amdgcn_s_barrier()
#define PG8_SCHED __builtin_amdgcn_sched_barrier(0)
    Unit cur, nxt; int ui = 0;
    if (!S.next(0, cur)) return;
    f32x4 acc[2][2][4][2];
#pragma unroll
    for (int a = 0; a < 2; ++a)
#pragma unroll
        for (int b = 0; b < 2; ++b)
#pragma unroll
            for (int m = 0; m < 4; ++m)
#pragma unroll
                for (int n = 0; n < 2; ++n) acc[a][b][m][n] = (f32x4){0.f, 0.f, 0.f, 0.f};
    bf16x8 At[4][2], B0[2][2], B1[2][2];
    const char* cA = (const char*)g.A + (size_t)cur.pm * tstep; const char* cB = (const char*)g.Bt + (size_t)cur.pn * tstep;
    S.a_ready(cur);
    if constexpr (SP2) {
        PG8_STAGE(PG8_SB(0, 0), cB, voffB); PG8_STAGE(PG8_SB(0, 1), cB + hstep, voffB); PG8_STAGE(PG8_SA(0, 0), cA, voffA); PG8_STAGE(PG8_SA(0, 1), cA + hstep, voffA);
        if (wr == 1) PG8_BAR;
        PG8_WAIT_V(2); PG8_BAR;
        PG8_STAGE(PG8_SB(1, 0), cB + kstep, voffB); PG8_STAGE(PG8_SA(1, 0), cA + kstep, voffA); PG8_STAGE(PG8_SB(1, 1), cB + hstep + kstep, voffB);
        PG8_WAIT_V(6); PG8_BAR;
    } else {
        PG8_STAGE(PG8_SB(0, 0), cB, voffB); PG8_STAGE(PG8_SA(0, 0), cA, voffA); PG8_STAGE(PG8_SB(0, 1), cB + hstep, voffB); PG8_STAGE(PG8_SA(0, 1), cA + hstep, voffA);
        if (wr == 1) PG8_BAR;
        PG8_WAIT_V(4); PG8_BAR;
        PG8_STAGE(PG8_SB(1, 0), cB + kstep, voffB); PG8_STAGE(PG8_SA(1, 0), cA + kstep, voffA); PG8_STAGE(PG8_SB(1, 1), cB + hstep + kstep, voffB);
        PG8_WAIT_V(6); PG8_BAR;
    }
    for (;;) {
        const bool has_next = S.next(ui + 1, nxt);
        const char* nA = has_next ? (const char*)g.A + (size_t)nxt.pm * tstep : cA; const char* nB = has_next ? (const char*)g.Bt + (size_t)nxt.pn * tstep : cB;
        for (int t = 0; t < nt; t += 2) {
            const bool last = (t == nt - 2);
            const char* a1 = cA + (size_t)(t + 1) * kstep;
            const char* a2 = last ? nA : cA + (size_t)(t + 2) * kstep; const char* b2 = last ? nB : cB + (size_t)(t + 2) * kstep;
            const char* a3 = a2 + kstep; const char* b3 = b2 + kstep;
            if (last && has_next) S.a_ready(nxt);
            if constexpr (SP2) {
            PG8_LDB(B0, 0, 0); PG8_LDB(B1, 0, 1); PG8_SCHED; PG8_LDA(At, 0, 0); PG8_STAGE(PG8_SA(1, 1), a1 + hstep, voffA);
            PG8_WAIT_V(8); PG8_WAIT_L(0); PG8_BAR; PG8_MMA(0, 0, At, B0); PG8_MMA(0, 1, At, B1); PG8_BAR; PG8_SCHED;
            PG8_LDA(At, 0, 1); PG8_STAGE(PG8_SB(0, 0), b2, voffB); PG8_STAGE(PG8_SB(0, 1), b2 + hstep, voffB); PG8_STAGE(PG8_SA(0, 0), a2, voffA);
            PG8_WAIT_V(8); PG8_WAIT_L(0); PG8_BAR; PG8_MMA(1, 0, At, B0); PG8_MMA(1, 1, At, B1); PG8_BAR; PG8_SCHED;
            PG8_LDB(B0, 1, 0); PG8_LDB(B1, 1, 1); PG8_SCHED; PG8_LDA(At, 1, 0); PG8_STAGE(PG8_SA(0, 1), a2 + hstep, voffA);
            PG8_WAIT_V(8); PG8_WAIT_L(0); PG8_BAR; PG8_MMA(0, 0, At, B0); PG8_MMA(0, 1, At, B1); PG8_BAR; PG8_SCHED;
            PG8_LDA(At, 1, 1); PG8_STAGE(PG8_SB(1, 0), b3, voffB); PG8_STAGE(PG8_SB(1, 1), b3 + hstep, voffB); PG8_STAGE(PG8_SA(1, 0), a3, voffA);
            PG8_WAIT_V(8); PG8_WAIT_L(0); PG8_BAR; PG8_MMA(1, 0, At, B0); PG8_MMA(1, 1, At, B1); PG8_BAR; PG8_SCHED;
            } else {
            PG8_LDB(B0, 0, 0); PG8_SCHED; PG8_LDA(At, 0, 0); PG8_STAGE(PG8_SA(1, 1), a1 + hstep, voffA);
            PG8_WAIT_L(8); PG8_BAR; PG8_WAIT_L(0); PG8_MMA(0, 0, At, B0); PG8_BAR; PG8_SCHED;
            PG8_LDB(B1, 0, 1); PG8_STAGE(PG8_SB(0, 0), b2, voffB);
            PG8_BAR; PG8_WAIT_L(0); PG8_MMA(0, 1, At, B1); PG8_BAR;
            PG8_LDA(At, 0, 1); PG8_STAGE(PG8_SA(0, 0), a2, voffA);
            PG8_BAR; PG8_WAIT_L(0); PG8_MMA(1, 0, At, B0); PG8_BAR; PG8_SCHED;
            PG8_STAGE(PG8_SB(0, 1), b2 + hstep, voffB);
            PG8_WAIT_V(6); PG8_BAR; PG8_MMA(1, 1, At, B1); PG8_BAR;
            PG8_LDB(B0, 1, 0); PG8_SCHED; PG8_LDA(At, 1, 0); PG8_STAGE(PG8_SA(0, 1), a2 + hstep, voffA);
            PG8_WAIT_L(8); PG8_BAR; PG8_WAIT_L(0); PG8_MMA(0, 0, At, B0); PG8_BAR; PG8_SCHED;
            PG8_LDB(B1, 1, 1); PG8_STAGE(PG8_SB(1, 0), b3, voffB);
            PG8_BAR; PG8_WAIT_L(0); PG8_MMA(0, 1, At, B1); PG8_BAR;
            PG8_LDA(At, 1, 1); PG8_STAGE(PG8_SA(1, 0), a3, voffA);
            PG8_BAR; PG8_WAIT_L(0); PG8_MMA(1, 0, At, B0); PG8_BAR; PG8_SCHED;
            PG8_STAGE(PG8_SB(1, 1), b3 + hstep, voffB);
            PG8_WAIT_V(6); PG8_BAR; PG8_MMA(1, 1, At, B1); PG8_BAR;
            }
        }
        if constexpr (ALIGN_EPI) { if (wr == 0) PG8_BAR; }
        if constexpr (!Epi::AFTER_DRAIN) { E(acc, cur, wr, wc, fr, fq); S.done(cur); }
        if (!has_next) break;
#pragma unroll
        for (int a = 0; a < 2; ++a)
#pragma unroll
            for (int b = 0; b < 2; ++b)
#pragma unroll
                for (int m = 0; m < 4; ++m)
#pragma unroll
                    for (int n = 0; n < 2; ++n) acc[a][b][m][n] = (f32x4){0.f, 0.f, 0.f, 0.f};
        cur = nxt; cA = nA; cB = nB; ++ui;
        if constexpr (ALIGN_EPI) { if (wr == 1) PG8_BAR; }
    }
    PG8_WAIT_V(0);
    if constexpr (!ALIGN_EPI) { if (wr == 0) PG8_BAR; }
    PG8_BAR;
    if constexpr (Epi::AFTER_DRAIN) { E.fused(acc, cur, wr, wc, fr, fq, lds, wid, lane); S.done(cur); }
#undef PG8_SA
#undef PG8_SB
#undef PG8_STAGE
#undef PG8_LDA
#undef PG8_LDB
#undef PG8_MMA
#undef PG8_WAIT_V
#undef PG8_WAIT_L
#undef PG8_BAR
#undef PG8_SCHED
}
}
#define GAS __attribute__((address_space(1)))
#define LAS __attribute__((address_space(3)))
typedef unsigned short bf16;
typedef unsigned v4u __attribute__((ext_vector_type(4)));
typedef float f32x4 __attribute__((ext_vector_type(4)));
typedef short bf16x8 __attribute__((ext_vector_type(8)));
typedef GAS unsigned gu32;
typedef GAS unsigned long long gu64;
#define RLX_AGENT __ATOMIC_RELAXED, __HIP_MEMORY_SCOPE_AGENT
#define LDS_WAIT() asm volatile("s_waitcnt lgkmcnt(0)" ::: "memory")
#define VM_WAIT() asm volatile("s_waitcnt vmcnt(0)" ::: "memory")
__device__ __forceinline__ unsigned long long rt() { return __builtin_amdgcn_s_memrealtime(); }
__device__ __forceinline__ unsigned f2bf(float f) { unsigned u = __builtin_bit_cast(unsigned, f); return (u + 0x7fffu + ((u >> 16) & 1u)) >> 16; }
__device__ __forceinline__ unsigned pk2(float lo, float hi) { return f2bf(lo) | (f2bf(hi) << 16); }

#define XB_TMO      128
#define XB_XCNT(j)  (256  + 64 * (j))
#define XB_XSUB(j)  (1280 + 64 * (j))
#define XB_XGEN(j)  (2304 + 64 * (j))
#define XB_TOP      3328
#define XB_TOPGEN   3392
#define XCD_BAR_WORDS 3456
#define XB_SPIN_CAP (1u << 18)

__device__ __forceinline__ unsigned xb_ld(unsigned* p)              { return __hip_atomic_load(p, __ATOMIC_RELAXED, __HIP_MEMORY_SCOPE_AGENT); }
__device__ __forceinline__ unsigned xb_add(unsigned* p, unsigned v) { return __hip_atomic_fetch_add(p, v, __ATOMIC_RELAXED, __HIP_MEMORY_SCOPE_AGENT); }
__device__ __forceinline__ unsigned xb_xcc_id() { return (unsigned)__builtin_amdgcn_s_getreg((3 << 11) | 20) & 0xFu; }
#define XB_SPIN(cond, bar) do { unsigned _sp = 0; while (cond) { __builtin_amdgcn_s_sleep(1); \
    if ((++_sp & 255u) == 0u) { if (xb_ld(&(bar)[XB_TMO])) break; if (_sp > XB_SPIN_CAP) { atomicAdd(&(bar)[XB_TMO], 1u); break; } } } } while (0)

struct XcdBarrier {
    unsigned* bar; unsigned x;
    volatile LAS unsigned* st;
};

__device__ __forceinline__ XcdBarrier xcd_barrier_post(unsigned* bar, volatile LAS unsigned* st, const int wid0) {
    XcdBarrier b; b.bar = bar; b.x = xb_xcc_id(); b.st = st;
    if (wid0 == 0 && fresh_lane() == 0) (void)xb_add(&bar[XB_XCNT(b.x)], 1u);
    return b;
}
__device__ __forceinline__ void xcd_barrier_complete(unsigned* bar, unsigned x, unsigned& nloc, unsigned& nx) {
    const unsigned G = gridDim.x * gridDim.y * gridDim.z;
    unsigned sum, cnt, mine, sp = 0u;
    for (;;) {
        sum = 0u; cnt = 0u; mine = 0u;
#pragma unroll 1
        for (unsigned j = 0; j < 16; ++j) { const unsigned c = xb_ld(&bar[XB_XCNT(j)]); sum += c; cnt += (c > 0u) ? 1u : 0u; mine = (j == x) ? c : mine; }
        if (sum == G) break;
        __builtin_amdgcn_s_sleep(1);
        if ((++sp & 255u) == 0u) { if (xb_ld(&bar[XB_TMO])) break; if (sp > XB_SPIN_CAP) { atomicAdd(&bar[XB_TMO], 1u); break; } }
    }
    nloc = mine > 0u ? mine : 1u; nx = cnt > 0u ? cnt : 1u;
}

__device__ __forceinline__ void xcd_barrier(const XcdBarrier& b, const int wid0) {
    asm volatile("s_waitcnt vmcnt(0)" ::: "memory");
    __syncthreads();
    if (wid0 == 0 && fresh_lane() == 0) {
        unsigned* bar = b.bar;
        __builtin_amdgcn_s_waitcnt(0);
        unsigned nloc = b.st[0], nx = b.st[1];
        const unsigned bx_ = xb_xcc_id();
        if (nloc == 0u) { xcd_barrier_complete(bar, bx_, nloc, nx); b.st[0] = nloc; b.st[1] = nx; }
        const unsigned old = xb_add(&bar[XB_XSUB(bx_)], 1u);
        const unsigned gen = old / nloc;
        if (old + 1u == (gen + 1u) * nloc) {
            __builtin_amdgcn_fence(__ATOMIC_RELEASE, "agent");
            asm volatile("s_waitcnt vmcnt(0)" ::: "memory");
            const unsigned og = xb_add(&bar[XB_TOP], 1u);
            const unsigned tg = og / nx;
            if (og + 1u == (tg + 1u) * nx) xb_add(&bar[XB_TOPGEN], 1u);
            else XB_SPIN(xb_ld(&bar[XB_TOPGEN]) == tg, bar);
            __builtin_amdgcn_fence(__ATOMIC_ACQUIRE, "agent");
            xb_add(&bar[XB_XGEN(bx_)], 1u);
            asm volatile("s_waitcnt vmcnt(0)" ::: "memory");
        } else {
            XB_SPIN(xb_ld(&bar[XB_XGEN(bx_)]) == gen, bar);
            __builtin_amdgcn_fence(__ATOMIC_ACQUIRE, "agent");
            asm volatile("s_waitcnt vmcnt(0)" ::: "memory");
        }
    }
    __syncthreads();
}
constexpr int NWAVES = 8;
constexpr int NB = 2, SEQ = 4096, DM = 4096, NL = 2, M = NB * SEQ;
constexpr int INC = 11336, INP = 11520;
constexpr int A_Q = 0, B_CQ = 3072, B_CKV = 4608, B_KR = 5120, C_Q = 5184, D_Q = 8256, D_F = 11328;
constexpr int QRANK = 1536, KVRANK = 512, DFF = 16384, MEMT = 256;
constexpr int P4DEF = 64 * 8 * 4;
constexpr int P8DEF = 8192;
constexpr int UPDEF = 88 * 8 * 8;
constexpr float EPS = 1e-6f;

constexpr size_t MiB = 1u << 20;
constexpr size_t WS_CTL = 0, CTL_ZERO_BYTES = 1 * MiB;
constexpr size_t WS_COS = 1 * MiB, WS_SIN = 2 * MiB;
constexpr size_t WS_LUT = 3 * MiB;
constexpr size_t WS_TPMAX = 3 * MiB + 8192;
constexpr size_t WS_LAM = 3 * MiB + 12288;
constexpr size_t WS_LOGF = 4 * MiB, WS_NEGC = 4 * MiB + 512 * 1024;
constexpr size_t WS_W = 8 * MiB;
constexpr size_t SZ_IN = (size_t)INP * DM * 2, SZ_OUT = (size_t)DM * DM * 2, SZ_UQ = (size_t)1536 * 1536 * 2, SZ_UKV = (size_t)2048 * 512 * 2,
                 SZ_MQ = (size_t)512 * DM * 2, SZ_MKV = (size_t)1024 * DM * 2, SZ_MO = (size_t)DM * 512 * 2, SZ_UP = (size_t)DFF * DM * 2, SZ_DN = SZ_UP;
constexpr size_t W_IN = 0, W_OUT = W_IN + SZ_IN, W_UQ = W_OUT + SZ_OUT, W_UKV = W_UQ + SZ_UQ, W_MQ = W_UKV + SZ_UKV, W_MKV = W_MQ + SZ_MQ, W_MO = W_MKV + SZ_MKV,
                 W_UP = W_MO + SZ_MO, W_DN = W_UP + SZ_UP, W_LAYER = W_DN + SZ_DN;
static_assert(W_LAYER % 256 == 0, "weight block alignment");
constexpr size_t WS_MEMN = WS_W + NL * W_LAYER;
constexpr size_t WS_KVMEM = WS_MEMN + (size_t)NL * 512 * DM * 2;
constexpr size_t WS_H = WS_KVMEM + (size_t)NL * 512 * 1024 * 2;
constexpr size_t WS_CQN = WS_H + (size_t)M * DM * 2;
constexpr size_t WS_CKVN = WS_CQN + (size_t)M * 1536 * 2;
constexpr size_t WS_KPE = WS_CKVN + (size_t)M * 512 * 2;
constexpr size_t WS_QMLA = WS_KPE + (size_t)M * 64 * 2;
constexpr size_t WS_KVMLA = WS_QMLA + (size_t)M * 1536 * 2;
constexpr size_t WS_QMEM = WS_KVMLA + (size_t)M * 2048 * 2;
constexpr size_t WS_OMEM = WS_QMEM + (size_t)M * 512 * 2;
constexpr size_t WS_XL = WS_OMEM + (size_t)M * 512 * 2;
constexpr size_t WS_U = WS_XL + (size_t)M * DM * 2;
constexpr size_t WS_PROJ = WS_U;
constexpr size_t WS_MIX = WS_PROJ + (size_t)M * INP * 2;
static_assert(WS_MIX + (size_t)M * DM * 2 <= WS_U + (size_t)M * DFF * 2, "PROJ + MIX fit inside U");
constexpr size_t WS_END = WS_U + (size_t)M * DFF * 2;
constexpr int CW_BAR = 4096;
constexpr int CW_SS = 32768;
constexpr int CW_KN = 24576;
constexpr int CW_TKT = 16384;

constexpr int RING_OFF = 0, RING_BYTES = 137216;
constexpr int LDSCTL_OFF = RING_BYTES, MISC_OFF = LDSCTL_OFF + 320;
constexpr int LDS_BYTES = 147456;

typedef unsigned short bf16;
typedef short bf16x8 __attribute__((ext_vector_type(8)));
typedef short s16x4 __attribute__((ext_vector_type(4)));
typedef float f32x4 __attribute__((ext_vector_type(4)));
typedef float f32x16 __attribute__((ext_vector_type(16)));
typedef unsigned v4u __attribute__((ext_vector_type(4)));
typedef unsigned v2u __attribute__((ext_vector_type(2)));
typedef int i32x4 __attribute__((ext_vector_type(4)));

__device__ __forceinline__ unsigned cvtpk(float lo, float hi) { unsigned r; asm volatile("v_cvt_pk_bf16_f32 %0, %1, %2" : "=v"(r) : "v"(lo), "v"(hi)); return r; }
__device__ __forceinline__ float bf2f(short s) { return __uint_as_float(((unsigned)(unsigned short)s) << 16); }
template <int X> __device__ __forceinline__ float shx(float v) { return __int_as_float(__builtin_amdgcn_ds_swizzle(__float_as_int(v), 0x1f | (X << 10))); }
template <int X> __device__ __forceinline__ int shxi(int v) { return __builtin_amdgcn_ds_swizzle(v, 0x1f | (X << 10)); }
__device__ __forceinline__ float half_sum(float v) { v += shx<1>(v); v += shx<2>(v); v += shx<4>(v); v += shx<8>(v); v += shx<16>(v); return v; }
__device__ __forceinline__ float wave_sum(float v) { v = half_sum(v);
    auto rr = __builtin_amdgcn_permlane32_swap(__float_as_uint(v), __float_as_uint(v), false, false); return __uint_as_float(rr[0]) + __uint_as_float(rr[1]); }
#define FRESH_LANE(name) const int name = fresh_lane()
#define WAITBAR() asm volatile("s_waitcnt vmcnt(0) lgkmcnt(0)\n\ts_barrier" ::: "memory")

__device__ __forceinline__ void tr_item(const float* W, int K, int N, int nblk, bf16* WT, int row_off, LAS float* scr, int item, int lane, const float* gk) {
    const int kb = item / nblk, nb = item - kb * nblk, k0 = 64 * kb, n0 = 64 * nb;
    const int c4 = (lane & 15) * 4, rr = lane >> 4; const bool ok = n0 + c4 < N;
    const GAS f32x4* src = (const GAS f32x4*)(W + (size_t)(k0 + rr) * N + n0 + c4);
    f32x4 v[16];
#pragma unroll
    for (int i = 0; i < 16; ++i) v[i] = ok ? __builtin_nontemporal_load((const GAS f32x4*)((const GAS float*)src + (size_t)(4 * i) * N)) : (f32x4){0.f, 0.f, 0.f, 0.f};
    if (gk) {
#pragma unroll
        for (int i = 0; i < 16; ++i) v[i] = v[i] * gk[k0 + 4 * i + rr]; }
#pragma unroll
    for (int i = 0; i < 16; ++i) { LAS float* s = scr + (4 * i + rr) * 65 + c4; s[0] = v[i].x; s[1] = v[i].y; s[2] = v[i].z; s[3] = v[i].w; }
    LDS_WAIT(); asm volatile("" ::: "memory");
    const int c = lane & 7;
#pragma unroll
    for (int j = 0; j < 8; ++j) { const int nn = (lane >> 3) + 8 * j; const LAS float* s = scr + (8 * c) * 65 + nn;
        v4u o; o.x = cvtpk(s[0 * 65], s[1 * 65]); o.y = cvtpk(s[2 * 65], s[3 * 65]); o.z = cvtpk(s[4 * 65], s[5 * 65]); o.w = cvtpk(s[6 * 65], s[7 * 65]);
        *(GAS v4u*)(WT + (size_t)(row_off + n0 + nn) * K + k0 + 8 * c) = o; }
    LDS_WAIT(); asm volatile("" ::: "memory");
}
template <bool BF> __device__ __forceinline__ void rms_row(const float* xrow, const float* g, void* orow, int lane) {
    const GAS f32x4* xr = (const GAS f32x4*)xrow + lane; const GAS f32x4* gr = (const GAS f32x4*)g + lane;
    f32x4 v[16]; float s = 0.f;
#pragma unroll
    for (int j = 0; j < 16; ++j) { v[j] = xr[64 * j]; s += (v[j].x * v[j].x + v[j].y * v[j].y) + (v[j].z * v[j].z + v[j].w * v[j].w); }
    const float rstd = 1.0f / sqrtf(wave_sum(s) * (1.f / DM) + EPS);
#pragma unroll
    for (int j = 0; j < 16; ++j) { const f32x4 gg = gr[64 * j]; const f32x4 y = v[j] * rstd * gg;
        if (BF) { v2u w; w.x = cvtpk(y.x, y.y); w.y = cvtpk(y.z, y.w); ((GAS v2u*)orow)[64 * j + lane] = w; }
        else ((GAS f32x4*)orow)[64 * j + lane] = y; }
}
__device__ __forceinline__ void cast_row(const float* xrow, bf16* hrow, unsigned long long* ss, int lane) {
    const GAS f32x4* xr = (const GAS f32x4*)xrow + lane; float s = 0.f;
#pragma unroll
    for (int j = 0; j < 16; ++j) { const f32x4 v = xr[64 * j]; s += (v.x * v.x + v.y * v.y) + (v.z * v.z + v.w * v.w);
        v2u h; h.x = cvtpk(v.x, v.y); h.y = cvtpk(v.z, v.w); ((GAS v2u*)hrow)[64 * j + lane] = h; }
    s = wave_sum(s); if (lane == 0) *ss = (unsigned long long)((double)s * 1048576.0);
}
__device__ __forceinline__ void final_row(const bf16* hrow, const float* g, float* orow, int lane) {
    f32x4 v[16]; float s = 0.f;
#pragma unroll
    for (int j = 0; j < 16; ++j) { const v2u h = ((const GAS v2u*)hrow)[64 * j + lane];
        v[j].x = __uint_as_float(h.x << 16); v[j].y = __uint_as_float(h.x & 0xffff0000u); v[j].z = __uint_as_float(h.y << 16); v[j].w = __uint_as_float(h.y & 0xffff0000u);
        s += (v[j].x * v[j].x + v[j].y * v[j].y) + (v[j].z * v[j].z + v[j].w * v[j].w); }
    const float rstd = 1.0f / sqrtf(wave_sum(s) * (1.f / DM) + EPS);
#pragma unroll
    for (int j = 0; j < 16; ++j) { const f32x4 gg = ((const GAS f32x4*)g)[64 * j + lane]; ((GAS f32x4*)orow)[64 * j + lane] = v[j] * rstd * gg; }
}
__device__ __forceinline__ float logsigmoidf_(float x) {
    const float e = __expf(-fabsf(x)); return fminf(x, 0.f) - __logf(1.f + e);
}
__device__ __forceinline__ void prep_row(const bf16* proj, int m, const float* gq, const float* gkv, const float* bf, const float* COS, const float* SIN,
                                         bf16* CQN, bf16* CKVN, bf16* KPE, float* LOGF, unsigned* KN2, int lane) {
    const bf16* pr = proj + (size_t)m * INP;
    bf16x8 q[3]; float sq = 0.f;
#pragma unroll
    for (int j = 0; j < 3; ++j) { q[j] = *(const GAS bf16x8*)(pr + B_CQ + (j * 64 + lane) * 8);
#pragma unroll
        for (int e = 0; e < 8; ++e) { const float f = bf2f(q[j][e]); sq += f * f; } }
    const bf16x8 kv = *(const GAS bf16x8*)(pr + B_CKV + lane * 8); float skv = 0.f;
#pragma unroll
    for (int e = 0; e < 8; ++e) { const float f = bf2f(kv[e]); skv += f * f; }
    const float rq = 1.0f / sqrtf(wave_sum(sq) * (1.f / QRANK) + EPS), rkv = 1.0f / sqrtf(wave_sum(skv) * (1.f / KVRANK) + EPS);
#pragma unroll
    for (int j = 0; j < 3; ++j) { const int c0 = (j * 64 + lane) * 8; const f32x4 g0 = *(const GAS f32x4*)(gq + c0), g1 = *(const GAS f32x4*)(gq + c0 + 4);
        v4u w; w.x = cvtpk(bf2f(q[j][0]) * rq * g0.x, bf2f(q[j][1]) * rq * g0.y); w.y = cvtpk(bf2f(q[j][2]) * rq * g0.z, bf2f(q[j][3]) * rq * g0.w);
        w.z = cvtpk(bf2f(q[j][4]) * rq * g1.x, bf2f(q[j][5]) * rq * g1.y); w.w = cvtpk(bf2f(q[j][6]) * rq * g1.z, bf2f(q[j][7]) * rq * g1.w);
        *(GAS v4u*)(CQN + (size_t)m * QRANK + c0) = w; }
    { const int c0 = lane * 8; const f32x4 g0 = *(const GAS f32x4*)(gkv + c0), g1 = *(const GAS f32x4*)(gkv + c0 + 4);
        v4u w; w.x = cvtpk(bf2f(kv[0]) * rkv * g0.x, bf2f(kv[1]) * rkv * g0.y); w.y = cvtpk(bf2f(kv[2]) * rkv * g0.z, bf2f(kv[3]) * rkv * g0.w);
        w.z = cvtpk(bf2f(kv[4]) * rkv * g1.x, bf2f(kv[5]) * rkv * g1.y); w.w = cvtpk(bf2f(kv[6]) * rkv * g1.z, bf2f(kv[7]) * rkv * g1.w);
        *(GAS v4u*)(CKVN + (size_t)m * KVRANK + c0) = w; }
    { const float v = bf2f((short)pr[B_KR + lane]); float pv; { auto rr = __builtin_amdgcn_permlane32_swap(__float_as_uint(v), __float_as_uint(v), false, false); pv = __uint_as_float(lane >= 32 ? rr[0] : rr[1]); } const int i = lane & 31;
      const float c = COS[(size_t)m * 32 + i], s = SIN[(size_t)m * 32 + i];
      const float o = lane < 32 ? v * c - pv * s : pv * s + v * c;
      const float on = shx<1>(o);
      if ((lane & 1) == 0) *(GAS unsigned*)(KPE + (size_t)m * 64 + lane) = cvtpk(o, on); }
    if (lane < 8) { const float f = bf2f((short)pr[D_F + lane]) + bf[lane]; const int b = m / SEQ, s = m - b * SEQ; LOGF[(size_t)(b * 8 + lane) * SEQ + s] = logsigmoidf_(f); }
    { const bf16x8 k0 = *(const GAS bf16x8*)(pr + D_Q + 1024 + lane * 16), k1 = *(const GAS bf16x8*)(pr + D_Q + 1024 + lane * 16 + 8); float s = 0.f;
#pragma unroll
      for (int e = 0; e < 8; ++e) { const float a = bf2f(k0[e]), c = bf2f(k1[e]); s += a * a + c * c; }
      s += shx<1>(s); s += shx<2>(s); s += shx<4>(s);
      if ((lane & 7) == 0) { unsigned* p = KN2 + (m / SEQ) * 8 + (lane >> 3); const unsigned v = __float_as_uint(s);
          if (v > __hip_atomic_load(p, __ATOMIC_RELAXED, __HIP_MEMORY_SCOPE_AGENT)) __hip_atomic_fetch_max(p, v, __ATOMIC_RELAXED, __HIP_MEMORY_SCOPE_AGENT); } }
}
__device__ __forceinline__ void fox_scan(const float* logf, float* negc, int lane) {
    const GAS f32x4* src = (const GAS f32x4*)(logf + lane * 64); f32x4 v[16]; float tot = 0.f;
#pragma unroll
    for (int j = 0; j < 16; ++j) { v[j] = src[j]; tot += (v[j].x + v[j].y) + (v[j].z + v[j].w); }
    float inc = tot;
#pragma unroll
    for (int o = 1; o < 64; o <<= 1) { const float t = __int_as_float(__builtin_amdgcn_ds_bpermute((lane - o) << 2, __float_as_int(inc))); if (lane >= o) inc += t; }
    float run = inc - tot; const float k = -11.313708498984761f;
    GAS f32x4* dst = (GAS f32x4*)(negc + lane * 64);
#pragma unroll
    for (int j = 0; j < 16; ++j) { f32x4 o; run += v[j].x; o.x = run * k; run += v[j].y; o.y = run * k; run += v[j].z; o.z = run * k; run += v[j].w; o.w = run * k; dst[j] = o; }
}

struct Cv { int idx, K, N, NP; long long dst; int roff, gain, lay, first, cnt, pad; };
constexpr int NCV = 12;
constexpr int NTB = 4;
struct Args { const void* in[27]; float* out; unsigned char* ws; float inv_freq[32]; float lam_init[2]; Cv cv[NTB][NCV]; int ncv[NTB]; int nchunk[NTB]; };
static_assert(sizeof(Cv) == 48 && sizeof(Args) == 27 * 8 + 16 + 128 + 8 + NTB * NCV * 48 + 8 * NTB, "Args has no padding");
typedef const unsigned char __attribute__((address_space(4)))* kaptr_t;
__device__ __forceinline__ kaptr_t ka_fresh() { kaptr_t p = (kaptr_t)__builtin_amdgcn_kernarg_segment_ptr(); asm volatile("" : "+s"(p)); return p; }
#define KIN(ka, i) (*(const void* const __attribute__((address_space(4)))*)((ka) + 8 * (i)))
#define KOUT(ka) ((float*)KIN(ka, 27))
#define KWS(ka) ((unsigned char*)KIN(ka, 28))
#define KINVF(ka, i) (*(const float __attribute__((address_space(4)))*)((ka) + 232 + 4 * (i)))
#define KLAMI(ka, l) (*(const float __attribute__((address_space(4)))*)((ka) + 360 + 4 * (l)))
#define KCVI(ka, l, j, f) (*(const int __attribute__((address_space(4)))*)((ka) + 368 + ((l) * NCV + (j)) * 48 + 4 * (f)))
#define KCVD(ka, l, j) (*(const long long __attribute__((address_space(4)))*)((ka) + 368 + ((l) * NCV + (j)) * 48 + 16))
#define KNCV(ka, l) (*(const int __attribute__((address_space(4)))*)((ka) + 368 + NTB * NCV * 48 + 4 * (l)))
#define KNCH(ka, l) (*(const int __attribute__((address_space(4)))*)((ka) + 368 + NTB * NCV * 48 + 4 * NTB + 4 * (l)))
__device__ __forceinline__ void conv_item(const kaptr_t ka, unsigned char* ws, int t, int it, LAS float* scr, int lane) {
    const int n = KNCV(ka, t); int rem = it, j = 0;
    for (; j < n; ++j) { const int cnt = KCVI(ka, t, j, 10); if (rem < cnt) break; rem -= cnt; }
    if (j >= n) return;
    const int idx = KCVI(ka, t, j, 0), K = KCVI(ka, t, j, 1), N = KCVI(ka, t, j, 2), NP = KCVI(ka, t, j, 3), roff = KCVI(ka, t, j, 6), gain = KCVI(ka, t, j, 7), lay = KCVI(ka, t, j, 8), first = KCVI(ka, t, j, 9);
    const float* gk = nullptr; if (gain >= 0) gk = (const float*)KIN(ka, gain) + (size_t)lay * K;
    tr_item((const float*)KIN(ka, idx) + (size_t)lay * K * N, K, N, NP / 64, (bf16*)(ws + KCVD(ka, t, j)), roff, scr, first + rem, lane, gk);
}
__device__ __forceinline__ void conv_chunk(const kaptr_t ka, unsigned char* ws, int l, int c, LAS float* scr, int wid, int lane) {
    for (int k = 0; k < 8; ++k) conv_item(ka, ws, l, c * 64 + wid * 8 + k, scr, lane);
}

namespace att {
constexpr int VA = 0, VB = 1, VC = 2, VD = 3, VE = 4;
constexpr int K_OFF = 0, V_OFF = 32768, B_OFF = 65536, WS_OFF = 67584, LUT_OFF = 69632, FLG_OFF = 70656, TKT_OFF = 70784, KPE_OFF = 71680, QF_OFF = 71680, ATT_END = QF_OFF + 65536;
constexpr float LOG2E = 1.4426950408889634f, LN2 = 0.6931471805599453f, THR = 8.f;
struct Ctx { const bf16* PROJ; const bf16* QMLA; const bf16* KVMLA; const bf16* KPE; bf16* MIX; const bf16* QMEM; const bf16* KVMEM; bf16* OMEM;
             const float* COS; const float* SIN; const float* LUT; const int* TPMAX; const int* pos; const float* NEGC; const float* sub_g; const unsigned* KN2; float lam, oml; };

__device__ __forceinline__ int crow(int r, int hi) { return (r & 3) + 8 * (r >> 2) + 4 * hi; }
__device__ __forceinline__ int swap23(int k) { return (k & ~0xC) | ((k & 4) << 1) | ((k & 8) >> 1); }
__device__ __forceinline__ float pmaxf(float v) { auto rr = __builtin_amdgcn_permlane32_swap(__float_as_uint(v), __float_as_uint(v), false, false); return fmaxf(__uint_as_float(rr[0]), __uint_as_float(rr[1])); }
__device__ __forceinline__ float psumf(float v) { auto rr = __builtin_amdgcn_permlane32_swap(__float_as_uint(v), __float_as_uint(v), false, false); return __uint_as_float(rr[0]) + __uint_as_float(rr[1]); }
__device__ __forceinline__ float partnerf(float v, int hi) { auto rr = __builtin_amdgcn_permlane32_swap(__float_as_uint(v), __float_as_uint(v), false, false); return __uint_as_float(hi ? rr[0] : rr[1]); }
__device__ __forceinline__ void dma16(const void* sbase, unsigned voff, unsigned ldsaddr) { unsigned keep;
    asm volatile("s_mov_b32 %0, m0\n\ts_mov_b32 m0, %3\n\ts_nop 0\n\tglobal_load_lds_dwordx4 %1, %2\n\ts_mov_b32 m0, %0" : "=&s"(keep) : "v"(voff), "s"(sbase), "s"(ldsaddr) : "memory"); }

template <int NK> __device__ __forceinline__ void qk(f32x16& p0, f32x16& p1, const LAS unsigned char* krow, int xr, int hx, const bf16x8* qf, int dstart) {
#pragma unroll
    for (int d0 = 0; d0 < NK; ++d0) { const int off = (((dstart + d0) * 32 + hx) ^ xr);
        const bf16x8 b0 = *(const LAS bf16x8*)(krow + off), b1 = *(const LAS bf16x8*)(krow + off + 8192);
        p0 = __builtin_amdgcn_mfma_f32_32x32x16_bf16(b0, qf[d0], p0, 0, 0, 0); p1 = __builtin_amdgcn_mfma_f32_32x32x16_bf16(b1, qf[d0], p1, 0, 0, 0); }
}
template <int NK> __device__ __forceinline__ void qk_l(f32x16& p0, f32x16& p1, const LAS unsigned char* krow, int xr, int hx, const LAS unsigned char* qlds, int dstart) {
#pragma unroll
    for (int d0 = 0; d0 < NK; ++d0) { const int off = (((dstart + d0) * 32 + hx) ^ xr);
        const bf16x8 b0 = *(const LAS bf16x8*)(krow + off), b1 = *(const LAS bf16x8*)(krow + off + 8192), q = *(const LAS bf16x8*)(qlds + (dstart + d0) * 1024);
        p0 = __builtin_amdgcn_mfma_f32_32x32x16_bf16(b0, q, p0, 0, 0, 0); p1 = __builtin_amdgcn_mfma_f32_32x32x16_bf16(b1, q, p1, 0, 0, 0); }
}
__device__ __forceinline__ void qk_pe(f32x16& p0, f32x16& p1, const LAS unsigned char* perow, int xpe, int hx, const bf16x8* qf) {
#pragma unroll
    for (int d0 = 0; d0 < 4; ++d0) { const int off = ((d0 * 32 + hx) ^ xpe);
        const bf16x8 b0 = *(const LAS bf16x8*)(perow + off), b1 = *(const LAS bf16x8*)(perow + off + 4096);
        p0 = __builtin_amdgcn_mfma_f32_32x32x16_bf16(b0, qf[d0], p0, 0, 0, 0); p1 = __builtin_amdgcn_mfma_f32_32x32x16_bf16(b1, qf[d0], p1, 0, 0, 0); }
}
__device__ __forceinline__ void pv(f32x16* o, unsigned vb, bf16x8 pa0, bf16x8 pa1, bf16x8 pa2, bf16x8 pa3) {
#define TRRD(dst, off) asm volatile("ds_read_b64_tr_b16 %0, %1 offset:%2" : "=&v"(dst) : "v"(vb), "i"(off) : "memory")
#define PV_D0(d0) do { s16x4 l0, l1, l2, l3, h0, h1, h2, h3; constexpr int b_ = (d0) * 512; \
        TRRD(l0, b_); TRRD(h0, b_ + 2048); TRRD(l1, b_ + 4096); TRRD(h1, b_ + 6144); TRRD(l2, b_ + 8192); TRRD(h2, b_ + 10240); TRRD(l3, b_ + 12288); TRRD(h3, b_ + 14336); \
        asm volatile("s_waitcnt lgkmcnt(0)" ::: "memory"); __builtin_amdgcn_sched_barrier(0); \
        o[d0] = __builtin_amdgcn_mfma_f32_32x32x16_bf16(pa0, (bf16x8){l0[0], l0[1], l0[2], l0[3], h0[0], h0[1], h0[2], h0[3]}, o[d0], 0, 0, 0); \
        o[d0] = __builtin_amdgcn_mfma_f32_32x32x16_bf16(pa1, (bf16x8){l1[0], l1[1], l1[2], l1[3], h1[0], h1[1], h1[2], h1[3]}, o[d0], 0, 0, 0); \
        o[d0] = __builtin_amdgcn_mfma_f32_32x32x16_bf16(pa2, (bf16x8){l2[0], l2[1], l2[2], l2[3], h2[0], h2[1], h2[2], h2[3]}, o[d0], 0, 0, 0); \
        o[d0] = __builtin_amdgcn_mfma_f32_32x32x16_bf16(pa3, (bf16x8){l3[0], l3[1], l3[2], l3[3], h3[0], h3[1], h3[2], h3[3]}, o[d0], 0, 0, 0); } while (0)
    PV_D0(0); PV_D0(1); PV_D0(2); PV_D0(3);
#undef PV_D0
#undef TRRD
}
__device__ __forceinline__ void pack_p(const f32x16& p0, const f32x16& p1, bf16x8& pa0, bf16x8& pa1, bf16x8& pa2, bf16x8& pa3) {
#define PK4(P, B_, OUT) do { unsigned a0 = cvtpk(P[B_ + 0], P[B_ + 1]), a1 = cvtpk(P[B_ + 2], P[B_ + 3]), b0 = cvtpk(P[B_ + 4], P[B_ + 5]), b1 = cvtpk(P[B_ + 6], P[B_ + 7]); \
        auto r0 = __builtin_amdgcn_permlane32_swap(a0, b0, false, false); auto r1 = __builtin_amdgcn_permlane32_swap(a1, b1, false, false); \
        v4u w = {r0[0], r1[0], r0[1], r1[1]}; OUT = __builtin_bit_cast(bf16x8, w); } while (0)
    PK4(p0, 0, pa0); PK4(p0, 8, pa1); PK4(p1, 0, pa2); PK4(p1, 8, pa3);
#undef PK4
}
__device__ __forceinline__ void softmax_pv(f32x16& p0, f32x16& p1, float& m, float& l, f32x16* o, LAS float* wsf, unsigned vb, int r32, int hi, const float SCALE, const float C2) {
    float mx0 = fmaxf(p0[0], p1[0]), mx1 = fmaxf(p0[1], p1[1]), mx2 = fmaxf(p0[2], p1[2]), mx3 = fmaxf(p0[3], p1[3]);
#pragma unroll
    for (int r = 4; r < 16; r += 4) { mx0 = fmaxf(fmaxf(mx0, p0[r]), p1[r]); mx1 = fmaxf(fmaxf(mx1, p0[r + 1]), p1[r + 1]); mx2 = fmaxf(fmaxf(mx2, p0[r + 2]), p1[r + 2]); mx3 = fmaxf(fmaxf(mx3, p0[r + 3]), p1[r + 3]); }
    float pmax = pmaxf(fmaxf(fmaxf(mx0, mx1), fmaxf(mx2, mx3)));
    float mn, alpha;
    if (__all((pmax - m) * SCALE <= THR)) { mn = m; alpha = 1.f; }
    else { mn = fmaxf(m, pmax); alpha = __builtin_amdgcn_exp2f((m - mn) * C2); m = mn; }
    const float mnL = -mn * C2;
#pragma unroll
    for (int r = 0; r < 16; ++r) { p0[r] = __builtin_amdgcn_exp2f(fmaf(p0[r], C2, mnL)); p1[r] = __builtin_amdgcn_exp2f(fmaf(p1[r], C2, mnL)); }
    float s0 = p0[0] + p1[0], s1 = p0[1] + p1[1], s2 = p0[2] + p1[2], s3 = p0[3] + p1[3];
#pragma unroll
    for (int r = 4; r < 16; r += 4) { s0 += p0[r] + p1[r]; s1 += p0[r + 1] + p1[r + 1]; s2 += p0[r + 2] + p1[r + 2]; s3 += p0[r + 3] + p1[r + 3]; }
    const float ps = psumf((s0 + s1) + (s2 + s3)); l = l * alpha + ps;
    bf16x8 pa0, pa1, pa2, pa3; pack_p(p0, p1, pa0, pa1, pa2, pa3);
    if (__any(alpha < 1.f)) { const int fl = fresh_lane(), fh = fl >> 5;
        if (fh == 0) wsf[fl] = alpha; asm volatile("s_waitcnt lgkmcnt(0)" ::: "memory");
#pragma unroll
        for (int r = 0; r < 16; ++r) { const float a = wsf[crow(r, fh)];
#pragma unroll
            for (int d = 0; d < 4; ++d) o[d][r] *= a; } }
    pv(o, vb, pa0, pa1, pa2, pa3);
}

template <int VAR>
__device__ __forceinline__ void attn_unit(const Ctx& C, int b, int h, int qb, LAS unsigned char* lds, int tid, int wid, int lane) {
    constexpr bool CAUSAL = VAR != VE, DESC = (VAR == VC || VAR == VD), MLA = (VAR == VB), DIFF = (VAR == VA), STICK = (VAR == VC), HASB = (VAR == VA || VAR == VD);
    constexpr int NQF = MLA ? 12 : 8;
    constexpr float SCALE = DIFF ? 0.125f : (MLA ? 0.07216878364870323f : 0.08838834764831845f);
    constexpr float C2 = SCALE * LOG2E;
    const int r32 = lane & 31, hi = lane >> 5;
    const int q0 = qb * 256, qw = q0 + wid * 32, trow = qw + r32;
    const size_t rb = (size_t)b * SEQ;
    const bf16 *Qp, *Kp, *Vp; bf16* Op; int qpitch, kpitch, opitch;
    if constexpr (VAR == VA || VAR == VC || VAR == VD) {
        constexpr int base = VAR == VA ? A_Q : (VAR == VC ? C_Q : D_Q);
        Qp = C.PROJ + rb * INP + base + h * 128; Kp = Qp + 1024; Vp = Qp + 2048; qpitch = INP; kpitch = INP;
        Op = C.MIX + rb * DM + VAR * 1024 + h * 128; opitch = DM;
    } else if constexpr (VAR == VB) {
        Qp = C.QMLA + rb * 1536 + h * 192; qpitch = 1536; Kp = C.KVMLA + rb * 2048 + h * 256; Vp = Kp + 128; kpitch = 2048;
        Op = C.MIX + rb * DM + 1024 + h * 128; opitch = DM;
    } else {
        Qp = C.QMEM + rb * 512 + h * 128; qpitch = 512; Kp = C.KVMEM + (size_t)b * MEMT * 1024 + h * 128; Vp = Kp + 512; kpitch = 1024;
        Op = C.OMEM + rb * 512 + h * 128; opitch = 512;
    }
    const char* Bp = nullptr;
    if constexpr (VAR == VA) Bp = (const char*)(C.pos + rb);
    if constexpr (VAR == VD) Bp = (const char*)(C.NEGC + (size_t)(b * 8 + h) * SEQ);
    const char* KPEp = nullptr;
    if constexpr (MLA) KPEp = (const char*)(C.KPE + rb * 64);
    bf16x8 qr[DIFF ? 1 : NQF];
    const LAS unsigned char* qlds = lds + QF_OFF + wid * 8192 + lane * 16;
    { const bf16* qrow = Qp + (size_t)trow * qpitch + hi * 8;
      if constexpr (DIFF) {
#pragma unroll
          for (int d0 = 0; d0 < 8; ++d0) { const bf16x8 q = *(const GAS bf16x8*)(qrow + d0 * 16); *(LAS bf16x8*)(lds + QF_OFF + wid * 8192 + lane * 16 + d0 * 1024) = q; }
      } else {
#pragma unroll
          for (int d0 = 0; d0 < NQF; ++d0) qr[d0] = *(const GAS bf16x8*)(qrow + d0 * 16); } }
    if constexpr (MLA) {
        const float* cs = C.COS + (rb + trow) * 32 + hi * 8; const float* sn = C.SIN + (rb + trow) * 32 + hi * 8;
#pragma unroll
        for (int j = 0; j < 2; ++j) {
            const f32x4 c0 = *(const GAS f32x4*)(cs + j * 16), c1 = *(const GAS f32x4*)(cs + j * 16 + 4), s0 = *(const GAS f32x4*)(sn + j * 16), s1 = *(const GAS f32x4*)(sn + j * 16 + 4);
            const bf16x8 a = qr[8 + j], bb = qr[10 + j]; float lo[8], hh[8];
#pragma unroll
            for (int e = 0; e < 8; ++e) { const float t1 = bf2f(a[e]), t2 = bf2f(bb[e]), c = e < 4 ? c0[e & 3] : c1[e & 3], s = e < 4 ? s0[e & 3] : s1[e & 3]; lo[e] = t1 * c - t2 * s; hh[e] = t1 * s + t2 * c; }
            v4u wl = {cvtpk(lo[0], lo[1]), cvtpk(lo[2], lo[3]), cvtpk(lo[4], lo[5]), cvtpk(lo[6], lo[7])}, wh = {cvtpk(hh[0], hh[1]), cvtpk(hh[2], hh[3]), cvtpk(hh[4], hh[5]), cvtpk(hh[6], hh[7])};
            qr[8 + j] = __builtin_bit_cast(bf16x8, wl); qr[10 + j] = __builtin_bit_cast(bf16x8, wh); }
    }
    unsigned koff[2], voff[2], peoff = 0;
#pragma unroll
    for (int i = 0; i < 2; ++i) { const int j = wid * 2 + i, row = 4 * j + (lane >> 4); koff[i] = (unsigned)(row * kpitch + (((lane & 15) ^ (row & 15)) << 3)) * 2u;
        const int st = 2 * j + (lane >> 5), kk = (st >> 2) * 8 + ((lane & 31) >> 2), c = (st & 3) * 32 + (lane & 3) * 8; voff[i] = (unsigned)(swap23(kk) * kpitch + c) * 2u; }
    if constexpr (MLA) { const int row = 8 * wid + (lane >> 3); peoff = (unsigned)(row * 64 + (((lane & 7) ^ ((row >> 1) & 7)) << 3)) * 2u; }
    const unsigned boff = (unsigned)(lane & 15) * 16u;
    const unsigned ldsbase = (unsigned)(unsigned long long)lds;
#define ISSUE(t_, buf_) do { const size_t tb_ = (size_t)(t_) * 64 * kpitch * 2; const char* kg_ = (const char*)Kp + tb_; const char* vg_ = (const char*)Vp + tb_; \
        _Pragma("unroll") for (int i_ = 0; i_ < 2; ++i_) dma16(kg_, koff[i_], ldsbase + K_OFF + (buf_) * 16384 + (wid * 2 + i_) * 1024); \
        _Pragma("unroll") for (int i_ = 0; i_ < 2; ++i_) dma16(vg_, voff[i_], ldsbase + V_OFF + (buf_) * 16384 + (wid * 2 + i_) * 1024); \
        if constexpr (MLA) dma16(KPEp + (size_t)(t_) * 64 * 64 * 2, peoff, ldsbase + KPE_OFF + (buf_) * 8192 + wid * 1024); \
        if constexpr (HASB) { if (wid == 0) dma16(Bp + (size_t)(t_) * 64 * 4, boff, ldsbase + B_OFF + (buf_) * 1024); } } while (0)
    const int NT = CAUSAL ? (q0 + 256) / 64 : MEMT / 64;
    LAS float* wsf = (LAS float*)(lds + WS_OFF) + wid * 64;
    LAS float* lut = (LAS float*)(lds + LUT_OFF);
    int pos_t = 0, wmin = 0; float lut_far = 0.f;
    if constexpr (DIFF) { if (tid < 132) lut[tid] = C.LUT[h * 132 + tid];
        pos_t = C.pos[rb + trow]; int mnp = pos_t;
        mnp = min(mnp, shxi<1>(mnp)); mnp = min(mnp, shxi<2>(mnp)); mnp = min(mnp, shxi<4>(mnp)); mnp = min(mnp, shxi<8>(mnp)); mnp = min(mnp, shxi<16>(mnp));
        wmin = __builtin_amdgcn_readfirstlane(mnp); lut_far = C.LUT[h * 132 + 128]; }
    const int xr = (r32 & 15) << 4, hx = hi << 4, xpe = ((r32 >> 1) & 7) << 4;
    const unsigned vrd = (unsigned)(((lane & 3) << 3) | (((lane >> 2) & 3) << 6) | (((lane >> 4) & 1) << 5) | (((lane >> 5) & 1) << 8));
    f32x16 o[4]; f32x16 o2[DIFF ? 4 : 1];
#pragma unroll
    for (int d = 0; d < 4; ++d) { o[d] = f32x16{}; if constexpr (DIFF) o2[d] = f32x16{}; }
    float m1 = -1e30f, l1 = 0.f, m2 = -1e30f, l2 = 0.f, R = 0.f;
    float qnkn = 0.f;
    if constexpr (VAR == VD) { float s = 0.f;
#pragma unroll
        for (int d0 = 0; d0 < 8; ++d0)
#pragma unroll
            for (int e = 0; e < 8; ++e) { const float a = bf2f(qr[d0][e]); s += a * a; }
        s = psumf(s); qnkn = sqrtf(s) * sqrtf(__uint_as_float(C.KN2[b * 8 + h])) * 1.001f + 1.f; }
    ISSUE(DESC ? NT - 1 : 0, 0);
    WAITBAR();
    int cur = 0;
    for (int i = 0; i < NT; ++i) {
        const int t = DESC ? NT - 1 - i : i, kb = t * 64;
        if (i + 1 < NT) ISSUE(DESC ? t - 1 : t + 1, cur ^ 1);
        const bool act = !CAUSAL || (STICK ? (kb < qw + 31) : (kb <= qw + 31));
        bool wdone = false;
        if constexpr (VAR == VD) {
            if (act) { const float nmax = ((const LAS float*)(lds + B_OFF + cur * 1024))[63]; wdone = __all((qnkn + nmax - m1) * SCALE < -40.f); } }
        if (act && !wdone) {
            const LAS unsigned char* krow = lds + K_OFF + cur * 16384 + r32 * 256;
            const unsigned vb = ldsbase + V_OFF + cur * 16384 + vrd;
            if constexpr (STICK) {
                f32x16 p0 = f32x16{}, p1 = f32x16{};
                qk<8>(p0, p1, krow, xr, hx, qr, 0);
                float L0[16], L1[16];
#pragma unroll
                for (int r = 0; r < 16; ++r) { const int key = kb + crow(r, hi);
                    { const float z = p0[r] * SCALE, e = __builtin_amdgcn_exp2f(-fabsf(z) * LOG2E), sp = fmaxf(z, 0.f) + __builtin_amdgcn_logf(1.f + e) * LN2; L0[r] = key < trow ? -sp : 0.f; p0[r] = z; }
                    { const float z = p1[r] * SCALE, e = __builtin_amdgcn_exp2f(-fabsf(z) * LOG2E), sp = fmaxf(z, 0.f) + __builtin_amdgcn_logf(1.f + e) * LN2; L1[r] = key + 32 < trow ? -sp : 0.f; p1[r] = z; } }
                float T[8], mb[8];
#pragma unroll
                for (int g = 0; g < 4; ++g) { T[g] = (L0[4 * g] + L0[4 * g + 1]) + (L0[4 * g + 2] + L0[4 * g + 3]); T[4 + g] = (L1[4 * g] + L1[4 * g + 1]) + (L1[4 * g + 2] + L1[4 * g + 3]); }
                float run = R;
#pragma unroll
                for (int k = 7; k >= 0; --k) { const float pt = partnerf(T[k], hi); const float T1 = hi ? T[k] : pt, T0 = hi ? pt : T[k];
                    const float b1 = run; run += T1; const float b0 = run; run += T0; mb[k] = hi ? b1 : b0; }
                R = run;
#pragma unroll
                for (int g = 0; g < 4; ++g) { float s0 = mb[g], s1 = mb[4 + g];
#pragma unroll
                    for (int e = 3; e >= 0; --e) { const int r = 4 * g + e, key = kb + crow(r, hi);
                        const float a0 = key < trow ? __builtin_amdgcn_exp2f((p0[r] + L0[r] + s0) * LOG2E) : 0.f; s0 += L0[r]; p0[r] = a0;
                        const float a1 = key + 32 < trow ? __builtin_amdgcn_exp2f((p1[r] + L1[r] + s1) * LOG2E) : 0.f; s1 += L1[r]; p1[r] = a1; } }
                bf16x8 pa0, pa1, pa2, pa3; pack_p(p0, p1, pa0, pa1, pa2, pa3);
                pv(o, vb, pa0, pa1, pa2, pa3);
            } else {
#pragma unroll
                for (int mp = 0; mp < (DIFF ? 2 : 1); ++mp) {
                    f32x16 p0, p1;
                    int xr_t = xr;
                    if constexpr (DIFF) { __builtin_amdgcn_sched_barrier(0); asm volatile("" : "+v"(pos_t), "+v"(xr_t)); }
                    if constexpr (VAR == VD) { const LAS float* nb = (const LAS float*)(lds + B_OFF + cur * 1024) + 4 * hi;
#pragma unroll
                        for (int g = 0; g < 4; ++g) { const f32x4 v0 = *(const LAS f32x4*)(nb + 8 * g), v1 = *(const LAS f32x4*)(nb + 32 + 8 * g);
#pragma unroll
                            for (int e = 0; e < 4; ++e) { p0[4 * g + e] = v0[e]; p1[4 * g + e] = v1[e]; } } }
                    else if constexpr (DIFF) {
                        if (wmin - C.TPMAX[b * 64 + t] >= 128) {
#pragma unroll
                            for (int r = 0; r < 16; ++r) { p0[r] = lut_far; p1[r] = lut_far; } }
                        else { const LAS int* pb = (const LAS int*)(lds + B_OFF + cur * 1024) + 4 * hi;
#pragma unroll
                            for (int g = 0; g < 4; ++g) { const i32x4 v0 = *(const LAS i32x4*)(pb + 8 * g), v1 = *(const LAS i32x4*)(pb + 32 + 8 * g);
#pragma unroll
                                for (int e = 0; e < 4; ++e) { p0[4 * g + e] = lut[min(max(pos_t - v0[e], 0), 128)]; p1[4 * g + e] = lut[min(max(pos_t - v1[e], 0), 128)]; }
                                __builtin_amdgcn_sched_barrier(0); } } }
                    else { p0 = f32x16{}; p1 = f32x16{}; }
                    if constexpr (DIFF) qk_l<4>(p0, p1, krow, xr_t, hx, qlds, 4 * mp);
                    else qk<8>(p0, p1, krow, xr, hx, qr, 0);
                    if constexpr (MLA) qk_pe(p0, p1, lds + KPE_OFF + cur * 8192 + r32 * 128, xpe, hx, qr + 8);
                    if (CAUSAL && kb + 63 > qw) { const float NEG = -__builtin_inff();
#pragma unroll
                        for (int r = 0; r < 16; ++r) { const int key = kb + crow(r, hi); if (key > trow) p0[r] = NEG; if (key + 32 > trow) p1[r] = NEG; } }
                    if (mp == 0) softmax_pv(p0, p1, m1, l1, o, wsf, vb, r32, hi, SCALE, C2);
                    else softmax_pv(p0, p1, m2, l2, o2, wsf, vb, r32, hi, SCALE, C2);
                }
            }
        }
        if constexpr (STICK) { const int dn_ = __all(R < -100.f) ? 1 : 0; if (lane == 0) ((LAS int*)(lds + FLG_OFF))[(i & 1) * 8 + wid] = dn_; }
        if constexpr (VAR == VD) { if (lane == 0) ((LAS int*)(lds + FLG_OFF))[(i & 1) * 8 + wid] = wdone ? 1 : 0; }
        WAITBAR(); cur ^= 1;
        if constexpr (STICK || VAR == VD) { const LAS i32x4* fl = (const LAS i32x4*)(lds + FLG_OFF + (i & 1) * 32); const i32x4 f0 = fl[0], f1 = fl[1];
            const int alld = (f0.x & f0.y & f0.z & f0.w) & (f1.x & f1.y & f1.z & f1.w); if (__builtin_amdgcn_readfirstlane(alld)) break; }
    }
#undef ISSUE
    const int lane_e = fresh_lane();
    const int r32e = lane_e & 31, hie = lane_e >> 5;
    bf16* Ob = Op + (size_t)(qw + 4 * hie) * opitch + r32e;
    if constexpr (DIFF) {
        if (hie == 0) { wsf[r32e] = l1; wsf[32 + r32e] = l2; } asm volatile("s_waitcnt lgkmcnt(0)" ::: "memory");
        const float lam = C.lam;
#pragma unroll
        for (int r = 0; r < 16; ++r) { const float i1 = __builtin_amdgcn_rcpf(wsf[crow(r, hie)]), i2 = lam * __builtin_amdgcn_rcpf(wsf[32 + crow(r, hie)]); float ss = 0.f;
#pragma unroll
            for (int d = 0; d < 4; ++d) { const float x = o[d][r] * i1 - o2[d][r] * i2; o[d][r] = x; ss += x * x; }
            ss = half_sum(ss);
            const float rstd = (1.0f / sqrtf(ss * (1.f / 128.f) + EPS)) * C.oml;
#pragma unroll
            for (int d = 0; d < 4; ++d) o[d][r] *= rstd; }
#pragma unroll
        for (int d = 0; d < 4; ++d) { const float g = C.sub_g[d * 32 + r32e];
#pragma unroll
            for (int r = 0; r < 16; ++r) o[d][r] *= g; }
    } else if constexpr (!STICK) {
        if (hie == 0) wsf[r32e] = l1; asm volatile("s_waitcnt lgkmcnt(0)" ::: "memory");
#pragma unroll
        for (int r = 0; r < 16; ++r) { const float i1 = __builtin_amdgcn_rcpf(wsf[crow(r, hie)]);
#pragma unroll
            for (int d = 0; d < 4; ++d) o[d][r] *= i1; }
    }
#pragma unroll
    for (int r = 0; r < 16; ++r) { const int orr = (r & 3) + 8 * (r >> 2);
#pragma unroll
        for (int d = 0; d < 4; ++d) { const float v = o[d][r], vn = shx<1>(v);
            if ((r32e & 1) == 0) *(GAS unsigned*)(Ob + (size_t)orr * opitch + d * 32) = cvtpk(v, vn); } }
}
template <int VAR> __device__ __forceinline__ void attn_queue(const Ctx& C, gu32* head, LAS unsigned char* lds, const int wid, const kaptr_t ka, unsigned char* ws, const int cvl) {
    constexpr int NH = VAR == VE ? 4 : 8, NU = NB * NH * 16;
    const int lane = fresh_lane(), tid = wid * 64 + lane;
    volatile LAS int* tk = (volatile LAS int*)(lds + LDSCTL_OFF);
    for (;;) {
        if (tid == 0) tk[0] = (int)__hip_atomic_fetch_add(head, 1u, RLX_AGENT);
        WAITBAR();
        const int n = __builtin_amdgcn_readfirstlane(tk[0]);
        if (n >= NU) break;
        const int qb = 15 - n / (NB * NH), bh = n % (NB * NH);
        attn_unit<VAR>(C, bh / NH, bh % NH, qb, lds, tid, wid, lane);
        if (cvl >= 0) {
            if (tid == 0) tk[1] = (int)__hip_atomic_fetch_add((gu32*)(ws + WS_CTL) + CW_TKT + (cvl * 16 + 10) * 64, 1u, RLX_AGENT);
            WAITBAR();
            const int c = __builtin_amdgcn_readfirstlane(tk[1]);
            if (c < KNCH(ka, cvl)) conv_chunk(ka, ws, cvl, c, (LAS float*)(lds + RING_OFF + wid * 16640), wid, lane);
        }
    }
}
}


namespace att {
template <int VAR> __device__ __forceinline__ void attn_phase(int l, int q, LAS unsigned char* lds, const int wid0) {
    const kaptr_t ka = ka_fresh(); unsigned char* ws = KWS(ka);
    const Ctx C{(const bf16*)(ws + WS_PROJ), (const bf16*)(ws + WS_QMLA), (const bf16*)(ws + WS_KVMLA), (const bf16*)(ws + WS_KPE), (bf16*)(ws + WS_MIX), (const bf16*)(ws + WS_QMEM),
                (const bf16*)(ws + WS_KVMEM) + (size_t)l * 512 * 1024, (bf16*)(ws + WS_OMEM), (const float*)(ws + WS_COS), (const float*)(ws + WS_SIN), (const float*)(ws + WS_LUT),
                (const int*)(ws + WS_TPMAX), (const int*)KIN(ka, 2), (const float*)(ws + WS_NEGC), (const float*)KIN(ka, 11) + l * 128, (const unsigned*)((gu32*)(ws + WS_CTL) + CW_KN + l * 64), ((const float*)(ws + WS_LAM))[l], 1.0f - KLAMI(ka, l)};
    attn_queue<VAR>(C, (gu32*)(ws + WS_CTL) + CW_TKT + (l * 16 + q) * 64, lds, wid0, ka, ws, (VAR == VE || gridDim.x == 256) ? -1 : l);
}
}

__global__ void __launch_bounds__(NWAVES * 64, 2) mk_fwd(Args args) {
    extern __shared__ __attribute__((aligned(16))) unsigned char lds_raw[];
    LAS unsigned char* lds = (LAS unsigned char*)lds_raw;
    const int G = gridDim.x, bx = blockIdx.x;
    const int vcu = (G % 8 == 0) ? (bx % 8) * (G / 8) + bx / 8 : bx;
    const int wid0 = __builtin_amdgcn_readfirstlane((int)threadIdx.x >> 6);
    const int gw = vcu * NWAVES + wid0, NGW = G * NWAVES;
    { const int tid = wid0 * 64 + fresh_lane();
      for (int u = tid; u < (LDS_BYTES - LDSCTL_OFF) / 4; u += NWAVES * 64) ((LAS unsigned*)(lds + LDSCTL_OFF))[u] = 0u; }
    __syncthreads();
    volatile LAS unsigned* MISC = (volatile LAS unsigned*)(lds + MISC_OFF);
    XcdBarrier bar = xcd_barrier_post((unsigned*)(args.ws + WS_CTL) + CW_BAR, MISC + 8, wid0);

    {
        const kaptr_t ka = ka_fresh(); unsigned char* ws = KWS(ka);
        const int lane = fresh_lane(), wid = wid0, tid = wid * 64 + lane;
        LAS float* scr = (LAS float*)(lds + RING_OFF + wid * 16640);
        {
            const int l = 0; unsigned char* wl = ws + WS_W;
#define TR_MAT(idx_, K_, N_, NP_, dst_, roff_, gain_) do { const float* s_ = (const float*)KIN(ka, idx_) + (size_t)l * (K_) * (N_); const int nblk_ = (NP_) / 64, nit_ = ((K_) / 64) * nblk_; \
            const float* gk_ = (gain_) >= 0 ? (const float*)KIN(ka, (gain_) >= 0 ? (gain_) : 0) + (size_t)l * (K_) : nullptr; \
            for (int it = gw; it < nit_; it += NGW) tr_item(s_, (K_), (N_), nblk_, (bf16*)(dst_), (roff_), scr, it, lane, gk_); } while (0)
            TR_MAT(4, DM, INC, INP, wl + W_IN, 0, 3);
            TR_MAT(14, QRANK, 1536, 1536, wl + W_UQ, 0, -1);
            TR_MAT(15, KVRANK, 2048, 2048, wl + W_UKV, 0, -1);
            TR_MAT(20, DM, 512, 512, wl + W_MKV, 0, -1);
            TR_MAT(21, DM, 512, 512, wl + W_MKV, 512, -1);
#undef TR_MAT
        }
        { const float* x0 = (const float*)KIN(ka, 0); bf16* H = (bf16*)(ws + WS_H); unsigned long long* SS = (unsigned long long*)((gu32*)(ws + WS_CTL) + CW_SS);
          for (int m = gw; m < M; m += NGW) cast_row(x0 + (size_t)m * DM, H + (size_t)m * DM, SS + m, lane); }
        { const float* mem = (const float*)KIN(ka, 1); bf16* MEMN = (bf16*)(ws + WS_MEMN);
          for (int r = gw; r < NL * NB * MEMT; r += NGW) { const int l = r / (NB * MEMT), mr = r - l * (NB * MEMT);
            rms_row<true>(mem + (size_t)mr * DM, (const float*)KIN(ka, 18) + (size_t)l * DM, MEMN + (size_t)r * DM, lane); } }
        const int* pos = (const int*)KIN(ka, 2);
        float* COS = (float*)(ws + WS_COS); float* SIN = (float*)(ws + WS_SIN); float* LUT = (float*)(ws + WS_LUT); int* TPMAX = (int*)(ws + WS_TPMAX); float* LAM = (float*)(ws + WS_LAM);
        const int gt = vcu * (NWAVES * 64) + tid, NGT = G * NWAVES * 64;
        for (int i = gt; i < M * 32; i += NGT) { const int row = i >> 5, f = i & 31; const float ang = (float)pos[row] * KINVF(ka, f);
            double rv = (double)ang * 0.15915494309189535; rv -= floor(rv); const float fr = (float)rv;
            COS[i] = __builtin_amdgcn_cosf(fr); SIN[i] = __builtin_amdgcn_sinf(fr); }
        for (int i = gt; i < 8 * 132; i += NGT) { const int h = i / 132, dd0 = i - h * 132; const int dd = dd0 > 128 ? 128 : dd0; int bk;
            if (dd < 16) bk = dd; else { bk = 16 + (int)(logf((float)dd / 16.0f) / 2.0794415416798357f * 16.0f); bk = bk > 31 ? 31 : bk; }
            LUT[i] = 8.0f * ((const float*)KIN(ka, 6))[bk * 8 + h]; }
        for (int i = gt; i < NB * 64; i += NGT) { int mx = pos[i * 64];
            for (int k = 1; k < 64; ++k) mx = max(mx, pos[i * 64 + k]);
            TPMAX[i] = mx; }
        if (gt < NL) { const int l = gt; float s1 = 0.f, s2 = 0.f;
            for (int k = 0; k < 64; ++k) { s1 += ((const float*)KIN(ka, 7))[l * 64 + k] * ((const float*)KIN(ka, 8))[l * 64 + k]; s2 += ((const float*)KIN(ka, 9))[l * 64 + k] * ((const float*)KIN(ka, 10))[l * 64 + k]; }
            LAM[l] = expf(s1) - expf(s2) + KLAMI(ka, l); }
    }
    xcd_barrier(bar, wid0);

    for (int l = 0; l < NL; ++l) {
        { const kaptr_t ka = ka_fresh(); unsigned char* ws = KWS(ka); unsigned char* wl = ws + WS_W + (size_t)l * W_LAYER;
          { pg8::Gemm g{(const bf16*)(ws + WS_H), (const bf16*)(wl + W_IN), M, INP, DM}; pg8::StaticOrder S; S.init(M, INP, G, bx);
            pg8::EpiBf16<0, true> E{(bf16*)(ws + WS_PROJ), INP, (const unsigned long long*)((gu32*)(ws + WS_CTL) + CW_SS) + (size_t)(3 * l) * M};
            pg8::gemm_phase<pg8::EpiBf16<0, true>, pg8::StaticOrder, true, true>(lds + RING_OFF, g, S, E, wid0); }
          { pg8::Gemm g{(const bf16*)(ws + WS_MEMN) + (size_t)l * 512 * DM, (const bf16*)(wl + W_MKV), 512, 1024, DM}; pg8::StaticOrder S; S.init(512, 1024, G, G - 1 - bx);
            pg8::EpiBf16<0, false> E{(bf16*)(ws + WS_KVMEM) + (size_t)l * 512 * 1024, 1024, nullptr};
            pg8::gemm_phase<pg8::EpiBf16<0, false>, pg8::StaticOrder, true, true>(lds + RING_OFF, g, S, E, wid0); }
          if (G == 256 && bx >= 160 && bx < 248) {
              const int lane = fresh_lane(); LAS float* scr = (LAS float*)(lds + RING_OFF + wid0 * 16640);
              for (int it = (bx - 160) * NWAVES + wid0; it < UPDEF; it += 88 * NWAVES) conv_item(ka, ws, 2 + l, it, scr, lane); } }
        xcd_barrier(bar, wid0);
        { const kaptr_t ka = ka_fresh(); unsigned char* ws = KWS(ka); FRESH_LANE(ln);
          for (int m = gw; m < M; m += NGW)
            prep_row((const bf16*)(ws + WS_PROJ), m, (const float*)KIN(ka, 12) + (size_t)l * QRANK, (const float*)KIN(ka, 13) + (size_t)l * KVRANK, (const float*)KIN(ka, 16) + l * 8,
                     (const float*)(ws + WS_COS), (const float*)(ws + WS_SIN), (bf16*)(ws + WS_CQN), (bf16*)(ws + WS_CKVN), (bf16*)(ws + WS_KPE), (float*)(ws + WS_LOGF), (unsigned*)((gu32*)(ws + WS_CTL) + CW_KN + l * 64), ln); }
        xcd_barrier(bar, wid0);
        { const kaptr_t ka = ka_fresh(); unsigned char* ws = KWS(ka); unsigned char* wl = ws + WS_W + (size_t)l * W_LAYER;
          if (gw < 16) { FRESH_LANE(ln); fox_scan((const float*)(ws + WS_LOGF) + (size_t)gw * SEQ, (float*)(ws + WS_NEGC) + (size_t)gw * SEQ, ln); }
          { pg8::Gemm g{(const bf16*)(ws + WS_CQN), (const bf16*)(wl + W_UQ), M, 1536, QRANK}; pg8::StaticOrder S; S.init(M, 1536, G, bx);
            pg8::EpiBf16<0, false> E{(bf16*)(ws + WS_QMLA), 1536, nullptr};
            pg8::gemm_phase<pg8::EpiBf16<0, false>, pg8::StaticOrder, true, true>(lds + RING_OFF, g, S, E, wid0); }
          { pg8::Gemm g{(const bf16*)(ws + WS_CKVN), (const bf16*)(wl + W_UKV), M, 2048, KVRANK}; pg8::StaticOrder S; S.init(M, 2048, G, G - 1 - bx);
            pg8::EpiBf16<0, false> E{(bf16*)(ws + WS_KVMLA), 2048, nullptr};
            pg8::gemm_phase<pg8::EpiBf16<0, false>, pg8::StaticOrder, true, true>(lds + RING_OFF, g, S, E, wid0); }
          if (G == 256 && bx >= 192) {
              const int lane = fresh_lane(); LAS float* scr = (LAS float*)(lds + RING_OFF + wid0 * 16640);
              for (int it = UPDEF + (bx - 192) * NWAVES + wid0; it < UPDEF + P4DEF; it += 64 * NWAVES) conv_item(ka, ws, 2 + l, it, scr, lane); } }
        xcd_barrier(bar, wid0);
#define CONV_DRAIN(l_) do { const kaptr_t ka = ka_fresh(); unsigned char* ws = KWS(ka); const int lane = fresh_lane(); volatile LAS int* tk = (volatile LAS int*)(lds + LDSCTL_OFF + 16); \
          for (;;) { if (wid0 == 0 && lane == 0) tk[0] = (int)__hip_atomic_fetch_add((gu32*)(ws + WS_CTL) + CW_TKT + ((l_) * 16 + 10) * 64, 1u, RLX_AGENT); \
              WAITBAR(); const int c = __builtin_amdgcn_readfirstlane(tk[0]); WAITBAR(); \
              if (c >= KNCH(ka, (l_))) break; \
              conv_chunk(ka, ws, (l_), c, (LAS float*)(lds + RING_OFF + wid0 * 16640), wid0, lane); } } while (0)
        if (G == 256 && ((bx >> 3) & 3) == 3) CONV_DRAIN(l);
        att::attn_phase<att::VA>(l, 0, lds, wid0);
        att::attn_phase<att::VB>(l, 1, lds, wid0);
        att::attn_phase<att::VD>(l, 2, lds, wid0);
        att::attn_phase<att::VC>(l, 3, lds, wid0);
        CONV_DRAIN(l);
        xcd_barrier(bar, wid0);
        { const kaptr_t ka = ka_fresh(); unsigned char* ws = KWS(ka); unsigned char* wl = ws + WS_W + (size_t)l * W_LAYER;
          pg8::Gemm g{(const bf16*)(ws + WS_MIX), (const bf16*)(wl + W_OUT), M, DM, DM}; pg8::StaticOrder S; S.init(M, DM, G, bx);
          pg8::EpiRes E{(bf16*)(ws + WS_H), DM, (unsigned long long*)((gu32*)(ws + WS_CTL) + CW_SS) + (size_t)(3 * l + 1) * M};
          pg8::gemm_phase<pg8::EpiRes, pg8::StaticOrder, true, true>(lds + RING_OFF, g, S, E, wid0); }
        xcd_barrier(bar, wid0);
        { const kaptr_t ka = ka_fresh(); unsigned char* ws = KWS(ka); unsigned char* wl = ws + WS_W + (size_t)l * W_LAYER;
          pg8::Gemm g{(const bf16*)(ws + WS_H), (const bf16*)(wl + W_MQ), M, 512, DM}; pg8::StaticOrder S; S.init(M, 512, G, bx);
          pg8::EpiBf16<0, true> E{(bf16*)(ws + WS_QMEM), 512, (const unsigned long long*)((gu32*)(ws + WS_CTL) + CW_SS) + (size_t)(3 * l + 1) * M};
          pg8::gemm_phase<pg8::EpiBf16<0, true>, pg8::StaticOrder, true, true>(lds + RING_OFF, g, S, E, wid0);
          if (G == 256 && bx >= 64) {
              const int lane = fresh_lane(); LAS float* scr = (LAS float*)(lds + RING_OFF + wid0 * 16640);
              for (int it = UPDEF + P4DEF + (bx - 64) * NWAVES + wid0; it < UPDEF + P4DEF + P8DEF; it += 192 * NWAVES) conv_item(ka, ws, 2 + l, it, scr, lane); } }
        xcd_barrier(bar, wid0);
        att::attn_phase<att::VE>(l, 4, lds, wid0);
        xcd_barrier(bar, wid0);
        { const kaptr_t ka = ka_fresh(); unsigned char* ws = KWS(ka); unsigned char* wl = ws + WS_W + (size_t)l * W_LAYER;
          pg8::Gemm g{(const bf16*)(ws + WS_OMEM), (const bf16*)(wl + W_MO), M, DM, 512}; pg8::StaticOrder S; S.init(M, DM, G, bx);
          pg8::EpiRes E{(bf16*)(ws + WS_H), DM, (unsigned long long*)((gu32*)(ws + WS_CTL) + CW_SS) + (size_t)(3 * l + 2) * M};
          pg8::gemm_phase<pg8::EpiRes, pg8::StaticOrder, true, true>(lds + RING_OFF, g, S, E, wid0); }
        xcd_barrier(bar, wid0);
        { const kaptr_t ka = ka_fresh(); unsigned char* ws = KWS(ka); unsigned char* wl = ws + WS_W + (size_t)l * W_LAYER;
          pg8::Gemm g{(const bf16*)(ws + WS_H), (const bf16*)(wl + W_UP), M, DFF, DM}; pg8::StaticOrder S; S.init(M, DFF, G, bx);
          pg8::EpiBf16<1, true> E{(bf16*)(ws + WS_U), DFF, (const unsigned long long*)((gu32*)(ws + WS_CTL) + CW_SS) + (size_t)(3 * l + 2) * M};
          pg8::gemm_phase<pg8::EpiBf16<1, true>, pg8::StaticOrder, true, true>(lds + RING_OFF, g, S, E, wid0); }
        xcd_barrier(bar, wid0);
        { const kaptr_t ka = ka_fresh(); unsigned char* ws = KWS(ka); unsigned char* wl = ws + WS_W + (size_t)l * W_LAYER;
          pg8::Gemm g{(const bf16*)(ws + WS_U), (const bf16*)(wl + W_DN), M, DM, DFF}; pg8::StaticOrder S; S.init(M, DM, G, bx);
          pg8::EpiRes E{(bf16*)(ws + WS_H), DM, (unsigned long long*)((gu32*)(ws + WS_CTL) + CW_SS) + (size_t)(3 * l + 3) * M};
          pg8::gemm_phase<pg8::EpiRes, pg8::StaticOrder, true, true>(lds + RING_OFF, g, S, E, wid0); }
        xcd_barrier(bar, wid0);
    }
    { const kaptr_t ka = ka_fresh(); unsigned char* ws = KWS(ka); FRESH_LANE(ln); float* O = KOUT(ka);
      for (int m = gw; m < M; m += NGW) final_row((const bf16*)(ws + WS_H) + (size_t)m * DM, (const float*)KIN(ka, 26), O + (size_t)m * DM, ln); }
}

extern "C" void kernel_launch(void* const* d_in, const int* in_sizes, int n_in, void* d_out, int out_size, void* d_ws, size_t ws_size, hipStream_t stream) {
    static int grid = 0;
    if (grid == 0) {
        if (n_in != 27 || in_sizes[0] != M * DM || out_size != M * DM || ws_size < WS_END) {
            fprintf(stderr, "kernel_launch: built for 27 inputs, x/out of %d floats, >= %zu bytes of workspace; got n_in %d, in0 %d, out %d, ws %zu; nothing launched\n", M * DM, (size_t)WS_END, n_in, n_in > 0 ? in_sizes[0] : -1, out_size, ws_size);
            grid = -1; return; }
        int dev = 0, cus = 0, per_cu = 0;
        if (hipGetDevice(&dev) != hipSuccess || hipDeviceGetAttribute(&cus, hipDeviceAttributeMultiprocessorCount, dev) != hipSuccess) { fprintf(stderr, "kernel_launch: device query failed\n"); grid = -1; return; }
        if (hipFuncSetAttribute((const void*)mk_fwd, hipFuncAttributeMaxDynamicSharedMemorySize, LDS_BYTES) != hipSuccess) { fprintf(stderr, "kernel_launch: hipFuncSetAttribute failed\n"); grid = -1; return; }
        if (hipOccupancyMaxActiveBlocksPerMultiprocessor(&per_cu, (const void*)mk_fwd, NWAVES * 64, LDS_BYTES) != hipSuccess || per_cu < 1)
            fprintf(stderr, "kernel_launch: note: occupancy query reports %d workgroups per CU\n", per_cu);
        (void)hipGetLastError();
        grid = cus;
    }
    if (grid < 0) return;
    if (hipMemsetAsync((char*)d_ws + WS_CTL, 0, CTL_ZERO_BYTES, stream) != hipSuccess) { fprintf(stderr, "kernel_launch: memset failed\n"); return; }
    Args a; memset(&a, 0, sizeof(a));
    for (int i = 0; i < 27; ++i) a.in[i] = d_in[i];
    a.out = (float*)d_out; a.ws = (unsigned char*)d_ws;
    for (int i = 0; i < 32; ++i) a.inv_freq[i] = (float)pow(10000.0, -(double)i / 32.0);
    for (int l = 0; l < NL; ++l) a.lam_init[l] = (float)(0.8 - 0.6 * exp(-0.3 * (double)l));
    {
        auto put = [&](int t, int idx, int K, int N, int NP, size_t off, int roff, int gain, int lay, int first, int cnt) {
            Cv& c = a.cv[t][a.ncv[t]++]; c.idx = idx; c.K = K; c.N = N; c.NP = NP; c.dst = (long long)(WS_W + (size_t)lay * W_LAYER + off); c.roff = roff; c.gain = gain; c.lay = lay;
            c.first = first; c.cnt = cnt < 0 ? (K / 64) * (NP / 64) - first : cnt; };
        put(0, 5, DM, DM, DM, W_OUT, 0, -1, 0, 0, -1); put(0, 19, DM, 512, 512, W_MQ, 0, 17, 0, 0, -1); put(0, 22, 512, DM, DM, W_MO, 0, -1, 0, 0, -1);
        put(0, 24, DM, DFF, DFF, W_UP, 0, 23, 0, 0, -1); put(0, 25, DFF, DM, DM, W_DN, 0, -1, 0, 0, -1);
        const bool idle = (grid == 256);
        const int te = idle ? 2 : 0, tl = idle ? 3 : 1;
        constexpr int UP2 = UPDEF + P4DEF + P8DEF - (11520 + 576 + 256 + 512 + 512);
        constexpr int DN3 = UPDEF + P4DEF + P8DEF - (16384 - UP2);
        static_assert(UP2 > 0 && UP2 < 16384 && DN3 > 0 && DN3 < 16384, "idle-window split");
        put(te, 4, DM, INC, INP, W_IN, 0, 3, 1, 0, -1); put(te, 14, QRANK, 1536, 1536, W_UQ, 0, -1, 1, 0, -1); put(te, 15, KVRANK, 2048, 2048, W_UKV, 0, -1, 1, 0, -1);
        put(te, 20, DM, 512, 512, W_MKV, 0, -1, 1, 0, -1); put(te, 21, DM, 512, 512, W_MKV, 512, -1, 1, 0, -1);
        put(1, 5, DM, DM, DM, W_OUT, 0, -1, 1, 0, -1); put(1, 19, DM, 512, 512, W_MQ, 0, 17, 1, 0, -1); put(1, 22, 512, DM, DM, W_MO, 0, -1, 1, 0, -1);
        if (idle) { put(2, 24, DM, DFF, DFF, W_UP, 0, 23, 1, 0, UP2); put(3, 24, DM, DFF, DFF, W_UP, 0, 23, 1, UP2, -1); put(3, 25, DFF, DM, DM, W_DN, 0, -1, 1, 0, DN3); put(1, 25, DFF, DM, DM, W_DN, 0, -1, 1, DN3, -1); }
        else { put(1, 24, DM, DFF, DFF, W_UP, 0, 23, 1, 0, -1); put(1, 25, DFF, DM, DM, W_DN, 0, -1, 1, 0, -1); }
        (void)tl;
        for (int t = 0; t < NTB; ++t) { long tot = 0; for (int j = 0; j < a.ncv[t]; ++j) tot += a.cv[t][j].cnt; a.nchunk[t] = (int)((tot + 63) / 64); }
    }
    hipLaunchKernelGGL(mk_fwd, dim3(grid), dim3(NWAVES * 64), LDS_BYTES, stream, a);
    const hipError_t le = hipPeekAtLastError();
    if (le != hipSuccess) fprintf(stderr, "kernel_launch: launch failed: %s\n", hipGetErrorName(le));
}
```

```cpp
#include <hip/hip_runtime.h>
#include <cstdio>
#include <cstdint>
#include <cstring>
#include <cmath>
__device__ __forceinline__ int fresh_lane() { unsigned z = 0u; asm volatile("" : "+v"(z)); return (int)__builtin_amdgcn_mbcnt_hi(~0u, __builtin_amdgcn_mbcnt_lo(~0u, z)); }
namespace pg8 {
#define PG8_LAS __attribute__((address_space(3)))
typedef unsigned short bf16_t;
typedef short bf16x8 __attribute__((ext_vector_type(8)));
typedef float f32x4 __attribute__((ext_vector_type(4)));
typedef unsigned u32x4 __attribute__((ext_vector_type(4)));
constexpr int BM = 256, BK = 64, HALF = 128, HTB = HALF * BK * 2  , STAGE_BYTES = 8 * HTB, NXCD = 8, WGM = 8;

__host__ __device__ __forceinline__ int lds_byte(int r, int c) { const int st = (r >> 4) * 2 + (c >> 5), rr = r & 15, cc = c & 31, ob = rr * 64 + cc * 2; return st * 1024 + (ob ^ (((ob >> 9) & 1) << 5)); }
__host__ __device__ __forceinline__ void stage_rc(int b, int& R, int& C) { const int st = b / 1024, sb = b % 1024, swz = sb ^ (((sb >> 9) & 1) << 5); R = (st >> 1) * 16 + swz / 64; C = (st & 1) * 32 + (swz % 64) / 2; }
__host__ __device__ __forceinline__ int perm32(int rho) { const int n = rho >> 4, i = rho & 15; return 8 * (i >> 2) + 4 * n + (i & 3); }

struct Unit { int pm, pn; };
struct Gemm { const bf16_t* A; const bf16_t* Bt; int M, N, K; };

struct StaticOrder {
    int nM, nN, nwg, G, c;
    __host__ __device__ void init(int M, int N, int G_, int c_) { nM = M / BM; nN = N / BM; nwg = nM * nN; G = G_; c = c_; }
    __host__ __device__ bool next(int i, Unit& u) const {
        const long L = (long)i * G + c; if (L >= nwg) return false;
        int wgid = (int)L; { const int q = nwg / NXCD, r = nwg % NXCD, xcd = wgid % NXCD, off = wgid / NXCD; wgid = (xcd < r ? xcd * (q + 1) : r * (q + 1) + (xcd - r) * q) + off; }
        const int nig = WGM * nN, gid = wgid / nig, fm = gid * WGM, gsz = (nM - fm) < WGM ? (nM - fm) : WGM;
        u.pm = fm + ((wgid % nig) % gsz); u.pn = (wgid % nig) / gsz; return true;
    }
    __device__ __forceinline__ void a_ready(const Unit&) const {}
    __device__ __forceinline__ void done(const Unit&) const {}
};

__device__ __forceinline__ unsigned cvt_pk_bf16(float lo, float hi) { unsigned r; asm volatile("v_cvt_pk_bf16_f32 %0, %1, %2" : "=v"(r) : "v"(lo), "v"(hi)); return r; }
typedef float f32x2 __attribute__((ext_vector_type(2)));
template <int ACT, bool RS> struct EpiBf16 {
    static constexpr bool PERM = true, AFTER_DRAIN = false;
    bf16_t* O; int ldc; const unsigned long long* ss;
    __device__ __forceinline__ void operator()(const f32x4 (&acc)[2][2][4][2], const Unit& u, int wr, int wc, int fr, int fq) const {
        const int row0 = u.pm * BM + wr * 64 + fr, col0 = u.pn * BM + wc * 32 + 8 * fq;
#pragma unroll
        for (int ai = 0; ai < 2; ++ai)
#pragma unroll
            for (int m = 0; m < 4; ++m) { const int row = row0 + ai * HALF + m * 16; bf16_t* rowp = O + (size_t)row * ldc + col0;
                float rs = 1.f; if (RS) rs = 1.0f / sqrtf((float)ss[row] * (1.f / 1048576.f / 4096.f) + 1e-6f);
#pragma unroll
                for (int bj = 0; bj < 2; ++bj) { f32x4 v0 = acc[ai][bj][m][0], v1 = acc[ai][bj][m][1];
                    if (RS) { v0 = v0 * rs; v1 = v1 * rs; }
                    if (ACT == 1) {
#pragma unroll
                        for (int e = 0; e < 4; ++e) { const float a = fmaxf(v0[e], 0.f), b = fmaxf(v1[e], 0.f); v0[e] = a * a; v1[e] = b * b; } }
                    u32x4 w; w.x = cvt_pk_bf16(v0[0], v0[1]); w.y = cvt_pk_bf16(v0[2], v0[3]); w.z = cvt_pk_bf16(v1[0], v1[1]); w.w = cvt_pk_bf16(v1[2], v1[3]);
                    *(u32x4*)(rowp + bj * HALF) = w; } }
    }
};
struct EpiRes {
    static constexpr bool PERM = true, AFTER_DRAIN = false;
    bf16_t* xh; int ldc; unsigned long long* ss;
    __device__ __forceinline__ void operator()(const f32x4 (&acc)[2][2][4][2], const Unit& u, int wr, int wc, int fr, int fq) const {
        const int row0 = u.pm * BM + wr * 64 + fr, col0 = u.pn * BM + wc * 32 + 8 * fq;
#pragma unroll
        for (int ai = 0; ai < 2; ++ai)
#pragma unroll
            for (int m = 0; m < 4; ++m) { const int row = row0 + ai * HALF + m * 16; const size_t off = (size_t)row * ldc + col0; float sq = 0.f;
#pragma unroll
                for (int bj = 0; bj < 2; ++bj) { const u32x4 hv = *(const u32x4*)(xh + off + bj * HALF); u32x4 ho;
#pragma unroll
                    for (int e = 0; e < 4; ++e) { const f32x4& a = acc[ai][bj][m][e >> 1]; const int j = (e & 1) * 2;
                        const float v0 = __uint_as_float(hv[e] << 16) + a[j], v1 = __uint_as_float(hv[e] & 0xffff0000u) + a[j + 1];
                        ho[e] = cvt_pk_bf16(v0, v1); sq += v0 * v0 + v1 * v1; }
                    *(u32x4*)(xh + off + bj * HALF) = ho; }
                sq += __int_as_float(__builtin_amdgcn_ds_swizzle(__float_as_int(sq), 0x1f | (16 << 10)));
                { auto rr = __builtin_amdgcn_permlane32_swap(__float_as_uint(sq), __float_as_uint(sq), false, false); sq = __uint_as_float(rr[0]) + __uint_as_float(rr[1]); }
                if (fq == 0) __hip_atomic_fetch_add(ss + row, (unsigned long long)((double)sq * 1048576.0), __ATOMIC_RELAXED, __HIP_MEMORY_SCOPE_AGENT); }
    }
};
template <class Epi, class Sched, bool ALIGN_EPI = false, bool SP2 = false>
__device__ __forceinline__ void gemm_phase(PG8_LAS unsigned char* lds, const Gemm g, const Sched& S, const Epi& E, const int wid0) {
    int wid_ = wid0; asm volatile("" : "+s"(wid_));
    const int wid = wid_, lane = fresh_lane(), tid = wid * 64 + lane, wr = wid >> 2, wc = wid & 3, fr = lane & 15, fq = lane >> 4;
    const int K = g.K, nt = K / BK;
    unsigned voffA[2], voffB[2];
#pragma unroll
    for (int i = 0; i < 2; ++i) { int R, C; stage_rc(tid * 16 + i * 8192, R, C); const int Rb = Epi::PERM ? ((R & ~31) + perm32(R & 31)) : R;
        voffA[i] = (unsigned)(R * K + C) * 2u; voffB[i] = (unsigned)(Rb * K + C) * 2u; }
    const size_t kstep = (size_t)(BK * 2);
    const size_t hstep = (size_t)HALF * K * 2;
    const size_t tstep = 2 * hstep;
    const unsigned ldsw = (unsigned)wid * 1024u;
    const int aoff = lds_byte(wr * 64 + fr, fq * 8), boff = lds_byte(wc * 32 + fr, fq * 8);
#define PG8_SA(b, h) (((b) * 2 + (h)) * HTB)
#define PG8_SB(b, h) ((4 + (b) * 2 + (h)) * HTB)
#define PG8_STAGE(bufoff, gbase, voff) do { _Pragma("unroll") for (int _i = 0; _i < 2; ++_i) \
        __builtin_amdgcn_global_load_lds((const unsigned*)((const char*)(gbase) + (voff)[_i]), (PG8_LAS unsigned*)(lds + (bufoff) + ldsw + _i * 8192), 16, 0, 0); } while (0)
#define PG8_LDA(dst, b, h) do { _Pragma("unroll") for (int m = 0; m < 4; ++m) _Pragma("unroll") for (int k = 0; k < 2; ++k) dst[m][k] = *(const PG8_LAS bf16x8*)(lds + PG8_SA(b, h) + aoff + m * 2048 + k * 1024); } while (0)
#define PG8_LDB(dst, b, h) do { _Pragma("unroll") for (int n = 0; n < 2; ++n) _Pragma("unroll") for (int k = 0; k < 2; ++k) dst[n][k] = *(const PG8_LAS bf16x8*)(lds + PG8_SB(b, h) + boff + n * 2048 + k * 1024); } while (0)
#define PG8_MMA(ai, bj, At, Bt) do { __builtin_amdgcn_s_setprio(1); _Pragma("unroll") for (int m = 0; m < 4; ++m) _Pragma("unroll") for (int n = 0; n < 2; ++n) _Pragma("unroll") for (int k = 0; k < 2; ++k) \
        acc[ai][bj][m][n] = __builtin_amdgcn_mfma_f32_16x16x32_bf16(Bt[n][k], At[m][k], acc[ai][bj][m][n], 0, 0, 0); __builtin_amdgcn_s_setprio(0); } while (0)
#define PG8_WAIT_V(n) asm volatile("s_waitcnt vmcnt(" #n ")" ::: "memory")
#define PG8_WAIT_L(n) asm volatile("s_waitcnt lgkmcnt(" #n ")" ::: "memory")
#define PG8_BAR __builtin_amdgcn_s_barrier()
#define PG8_SCHED __builtin_amdgcn_sched_barrier(0)
    Unit cur, nxt; int ui = 0;
    if (!S.next(0, cur)) return;
    f32x4 acc[2][2][4][2];
#pragma unroll
    for (int a = 0; a < 2; ++a)
#pragma unroll
        for (int b = 0; b < 2; ++b)
#pragma unroll
            for (int m = 0; m < 4; ++m)
#pragma unroll
                for (int n = 0; n < 2; ++n) acc[a][b][m][n] = (f32x4){0.f, 0.f, 0.f, 0.f};
    bf16x8 At[4][2], B0[2][2], B1[2][2];
    const char* cA = (const char*)g.A + (size_t)cur.pm * tstep; const char* cB = (const char*)g.Bt + (size_t)cur.pn * tstep;
    S.a_ready(cur);
    if constexpr (SP2) {
        PG8_STAGE(PG8_SB(0, 0), cB, voffB); PG8_STAGE(PG8_SB(0, 1), cB + hstep, voffB); PG8_STAGE(PG8_SA(0, 0), cA, voffA); PG8_STAGE(PG8_SA(0, 1), cA + hstep, voffA);
        if (wr == 1) PG8_BAR;
        PG8_WAIT_V(2); PG8_BAR;
        PG8_STAGE(PG8_SB(1, 0), cB + kstep, voffB); PG8_STAGE(PG8_SA(1, 0), cA + kstep, voffA); PG8_STAGE(PG8_SB(1, 1), cB + hstep + kstep, voffB);
        PG8_WAIT_V(6); PG8_BAR;
    } else {
        PG8_STAGE(PG8_SB(0, 0), cB, voffB); PG8_STAGE(PG8_SA(0, 0), cA, voffA); PG8_STAGE(PG8_SB(0, 1), cB + hstep, voffB); PG8_STAGE(PG8_SA(0, 1), cA + hstep, voffA);
        if (wr == 1) PG8_BAR;
        PG8_WAIT_V(4); PG8_BAR;
        PG8_STAGE(PG8_SB(1, 0), cB + kstep, voffB); PG8_STAGE(PG8_SA(1, 0), cA + kstep, voffA); PG8_STAGE(PG8_SB(1, 1), cB + hstep + kstep, voffB);
        PG8_WAIT_V(6); PG8_BAR;
    }
    for (;;) {
        const bool has_next = S.next(ui + 1, nxt);
        const char* nA = has_next ? (const char*)g.A + (size_t)nxt.pm * tstep : cA; const char* nB = has_next ? (const char*)g.Bt + (size_t)nxt.pn * tstep : cB;
        for (int t = 0; t < nt; t += 2) {
            const bool last = (t == nt - 2);
            const char* a1 = cA + (size_t)(t + 1) * kstep;
            const char* a2 = last ? nA : cA + (size_t)(t + 2) * kstep; const char* b2 = last ? nB : cB + (size_t)(t + 2) * kstep;
            const char* a3 = a2 + kstep; const char* b3 = b2 + kstep;
            if (last && has_next) S.a_ready(nxt);
            if constexpr (SP2) {
            PG8_LDB(B0, 0, 0); PG8_LDB(B1, 0, 1); PG8_SCHED; PG8_LDA(At, 0, 0); PG8_STAGE(PG8_SA(1, 1), a1 + hstep, voffA);
            PG8_WAIT_V(8); PG8_WAIT_L(0); PG8_BAR; PG8_MMA(0, 0, At, B0); PG8_MMA(0, 1, At, B1); PG8_BAR; PG8_SCHED;
            PG8_LDA(At, 0, 1); PG8_STAGE(PG8_SB(0, 0), b2, voffB); PG8_STAGE(PG8_SB(0, 1), b2 + hstep, voffB); PG8_STAGE(PG8_SA(0, 0), a2, voffA);
            PG8_WAIT_V(8); PG8_WAIT_L(0); PG8_BAR; PG8_MMA(1, 0, At, B0); PG8_MMA(1, 1, At, B1); PG8_BAR; PG8_SCHED;
            PG8_LDB(B0, 1, 0); PG8_LDB(B1, 1, 1); PG8_SCHED; PG8_LDA(At, 1, 0); PG8_STAGE(PG8_SA(0, 1), a2 + hstep, voffA);
            PG8_WAIT_V(8); PG8_WAIT_L(0); PG8_BAR; PG8_MMA(0, 0, At, B0); PG8_MMA(0, 1, At, B1); PG8_BAR; PG8_SCHED;
            PG8_LDA(At, 1, 1); PG8_STAGE(PG8_SB(1, 0), b3, voffB); PG8_STAGE(PG8_SB(1, 1), b3 + hstep, voffB); PG8_STAGE(PG8_SA(1, 0), a3, voffA);
            PG8_WAIT_V(8); PG8_WAIT_L(0); PG8_BAR; PG8_MMA(1, 0, At, B0); PG8_MMA(1, 1, At, B1); PG8_BAR; PG8_SCHED;
            } else {
            PG8_LDB(B0, 0, 0); PG8_SCHED; PG8_LDA(At, 0, 0); PG8_STAGE(PG8_SA(1, 1), a1 + hstep, voffA);
            PG8_WAIT_L(8); PG8_BAR; PG8_WAIT_L(0); PG8_MMA(0, 0, At, B0); PG8_BAR; PG8_SCHED;
            PG8_LDB(B1, 0, 1); PG8_STAGE(PG8_SB(0, 0), b2, voffB);
            PG8_BAR; PG8_WAIT_L(0); PG8_MMA(0, 1, At, B1); PG8_BAR;
            PG8_LDA(At, 0, 1); PG8_STAGE(PG8_SA(0, 0), a2, voffA);
            PG8_BAR; PG8_WAIT_L(0); PG8_MMA(1, 0, At, B0); PG8_BAR; PG8_SCHED;
            PG8_STAGE(PG8_SB(0, 1), b2 + hstep, voffB);
            PG8_WAIT_V(6); PG8_BAR; PG8_MMA(1, 1, At, B1); PG8_BAR;
            PG8_LDB(B0, 1, 0); PG8_SCHED; PG8_LDA(At, 1, 0); PG8_STAGE(PG8_SA(0, 1), a2 + hstep, voffA);
            PG8_WAIT_L(8); PG8_BAR; PG8_WAIT_L(0); PG8_MMA(0, 0, At, B0); PG8_BAR; PG8_SCHED;
            PG8_LDB(B1, 1, 1); PG8_STAGE(PG8_SB(1, 0), b3, voffB);
            PG8_BAR; PG8_WAIT_L(0); PG8_MMA(0, 1, At, B1); PG8_BAR;
            PG8_LDA(At, 1, 1); PG8_STAGE(PG8_SA(1, 0), a3, voffA);
            PG8_BAR; PG8_WAIT_L(0); PG8_MMA(1, 0, At, B0); PG8_BAR; PG8_SCHED;
            PG8_STAGE(PG8_SB(1, 1), b3 + hstep, voffB);
            PG8_WAIT_V(6); PG8_BAR; PG8_MMA(1, 1, At, B1); PG8_BAR;
            }
        }
        if constexpr (ALIGN_EPI) { if (wr == 0) PG8_BAR; }
        if constexpr (!Epi::AFTER_DRAIN) { E(acc, cur, wr, wc, fr, fq); S.done(cur); }
        if (!has_next) break;
#pragma unroll
        for (int a = 0; a < 2; ++a)
#pragma unroll
            for (int b = 0; b < 2; ++b)
#pragma unroll
                for (int m = 0; m < 4; ++m)
#pragma unroll
                    for (int n = 0; n < 2; ++n) acc[a][b][m][n] = (f32x4){0.f, 0.f, 0.f, 0.f};
        cur = nxt; cA = nA; cB = nB; ++ui;
        if constexpr (ALIGN_EPI) { if (wr == 1) PG8_BAR; }
    }
    PG8_WAIT_V(0);
    if constexpr (!ALIGN_EPI) { if (wr == 0) PG8_BAR; }
    PG8_BAR;
    if constexpr (Epi::AFTER_DRAIN) { E.fused(acc, cur, wr, wc, fr, fq, lds, wid, lane); S.done(cur); }
#undef PG8_SA
#undef PG8_SB
#undef PG8_STAGE
#undef PG8_LDA
#undef PG8_LDB
#undef PG8_MMA
#undef PG8_WAIT_V
#undef PG8_WAIT_L
#undef PG8_BAR
#undef PG8_SCHED
}
}
#define GAS __attribute__((address_space(1)))
#define LAS __attribute__((address_space(3)))
typedef unsigned short bf16;
typedef unsigned v4u __attribute__((ext_vector_type(4)));
typedef float f32x4 __attribute__((ext_vector_type(4)));
typedef short bf16x8 __attribute__((ext_vector_type(8)));
typedef GAS unsigned gu32;
typedef GAS unsigned long long gu64;
#define RLX_AGENT __ATOMIC_RELAXED, __HIP_MEMORY_SCOPE_AGENT
#define LDS_WAIT() asm volatile("s_waitcnt lgkmcnt(0)" ::: "memory")
#define VM_WAIT() asm volatile("s_waitcnt vmcnt(0)" ::: "memory")
__device__ __forceinline__ unsigned long long rt() { return __builtin_amdgcn_s_memrealtime(); }
__device__ __forceinline__ unsigned f2bf(float f) { unsigned u = __builtin_bit_cast(unsigned, f); return (u + 0x7fffu + ((u >> 16) & 1u)) >> 16; }
__device__ __forceinline__ unsigned pk2(float lo, float hi) { return f2bf(lo) | (f2bf(hi) << 16); }

#define XB_TMO      128
#define XB_XCNT(j)  (256  + 64 * (j))
#define XB_XSUB(j)  (1280 + 64 * (j))
#define XB_XGEN(j)  (2304 + 64 * (j))
#define XB_TOP      3328
#define XB_TOPGEN   3392
#define XCD_BAR_WORDS 3456
#define XB_SPIN_CAP (1u << 18)

__device__ __forceinline__ unsigned xb_ld(unsigned* p)              { return __hip_atomic_load(p, __ATOMIC_RELAXED, __HIP_MEMORY_SCOPE_AGENT); }
__device__ __forceinline__ unsigned xb_add(unsigned* p, unsigned v) { return __hip_atomic_fetch_add(p, v, __ATOMIC_RELAXED, __HIP_MEMORY_SCOPE_AGENT); }
__device__ __forceinline__ unsigned xb_xcc_id() { return (unsigned)__builtin_amdgcn_s_getreg((3 << 11) | 20) & 0xFu; }
#define XB_SPIN(cond, bar) do { unsigned _sp = 0; while (cond) { __builtin_amdgcn_s_sleep(1); \
    if ((++_sp & 255u) == 0u) { if (xb_ld(&(bar)[XB_TMO])) break; if (_sp > XB_SPIN_CAP) { atomicAdd(&(bar)[XB_TMO], 1u); break; } } } } while (0)

struct XcdBarrier {
    unsigned* bar; unsigned x;
    volatile LAS unsigned* st;
};

__device__ __forceinline__ XcdBarrier xcd_barrier_post(unsigned* bar, volatile LAS unsigned* st, const int wid0) {
    XcdBarrier b; b.bar = bar; b.x = xb_xcc_id(); b.st = st;
    if (wid0 == 0 && fresh_lane() == 0) (void)xb_add(&bar[XB_XCNT(b.x)], 1u);
    return b;
}
__device__ __forceinline__ void xcd_barrier_complete(unsigned* bar, unsigned x, unsigned& nloc, unsigned& nx) {
    const unsigned G = gridDim.x * gridDim.y * gridDim.z;
    unsigned sum, cnt, mine, sp = 0u;
    for (;;) {
        sum = 0u; cnt = 0u; mine = 0u;
#pragma unroll 1
        for (unsigned j = 0; j < 16; ++j) { const unsigned c = xb_ld(&bar[XB_XCNT(j)]); sum += c; cnt += (c > 0u) ? 1u : 0u; mine = (j == x) ? c : mine; }
        if (sum == G) break;
        __builtin_amdgcn_s_sleep(1);
        if ((++sp & 255u) == 0u) { if (xb_ld(&bar[XB_TMO])) break; if (sp > XB_SPIN_CAP) { atomicAdd(&bar[XB_TMO], 1u); break; } }
    }
    nloc = mine > 0u ? mine : 1u; nx = cnt > 0u ? cnt : 1u;
}

__device__ __forceinline__ void xcd_barrier(const XcdBarrier& b, const int wid0) {
    asm volatile("s_waitcnt vmcnt(0)" ::: "memory");
    __syncthreads();
    if (wid0 == 0 && fresh_lane() == 0) {
        unsigned* bar = b.bar;
        __builtin_amdgcn_s_waitcnt(0);
        unsigned nloc = b.st[0], nx = b.st[1];
        const unsigned bx_ = xb_xcc_id();
        if (nloc == 0u) { xcd_barrier_complete(bar, bx_, nloc, nx); b.st[0] = nloc; b.st[1] = nx; }
        const unsigned old = xb_add(&bar[XB_XSUB(bx_)], 1u);
        const unsigned gen = old / nloc;
        if (old + 1u == (gen + 1u) * nloc) {
            __builtin_amdgcn_fence(__ATOMIC_RELEASE, "agent");
            asm volatile("s_waitcnt vmcnt(0)" ::: "memory");
            const unsigned og = xb_add(&bar[XB_TOP], 1u);
            const unsigned tg = og / nx;
            if (og + 1u == (tg + 1u) * nx) xb_add(&bar[XB_TOPGEN], 1u);
            else XB_SPIN(xb_ld(&bar[XB_TOPGEN]) == tg, bar);
            __builtin_amdgcn_fence(__ATOMIC_ACQUIRE, "agent");
            xb_add(&bar[XB_XGEN(bx_)], 1u);
            asm volatile("s_waitcnt vmcnt(0)" ::: "memory");
        } else {
            XB_SPIN(xb_ld(&bar[XB_XGEN(bx_)]) == gen, bar);
            __builtin_amdgcn_fence(__ATOMIC_ACQUIRE, "agent");
            asm volatile("s_waitcnt vmcnt(0)" ::: "memory");
        }
    }
    __syncthreads();
}
constexpr int NWAVES = 8;
constexpr int NB = 2, SEQ = 4096, DM = 4096, NL = 2, M = NB * SEQ;
constexpr int INC = 11336, INP = 11520;
constexpr int A_Q = 0, B_CQ = 3072, B_CKV = 4608, B_KR = 5120, C_Q = 5184, D_Q = 8256, D_F = 11328;
constexpr int QRANK = 1536, KVRANK = 512, DFF = 16384, MEMT = 256;
constexpr int P4DEF = 64 * 8 * 4;
constexpr int P8DEF = 8192;
constexpr int UPDEF = 88 * 8 * 8;
constexpr float EPS = 1e-6f;

constexpr size_t MiB = 1u << 20;
constexpr size_t WS_CTL = 0, CTL_ZERO_BYTES = 1 * MiB;
constexpr size_t WS_COS = 1 * MiB, WS_SIN = 2 * MiB;
constexpr size_t WS_LUT = 3 * MiB;
constexpr size_t WS_TPMAX = 3 * MiB + 8192;
constexpr size_t WS_LAM = 3 * MiB + 12288;
constexpr size_t WS_LOGF = 4 * MiB, WS_NEGC = 4 * MiB + 512 * 1024;
constexpr size_t WS_W = 8 * MiB;
constexpr size_t SZ_IN = (size_t)INP * DM * 2, SZ_OUT = (size_t)DM * DM * 2, SZ_UQ = (size_t)1536 * 1536 * 2, SZ_UKV = (size_t)2048 * 512 * 2,
                 SZ_MQ = (size_t)512 * DM * 2, SZ_MKV = (size_t)1024 * DM * 2, SZ_MO = (size_t)DM * 512 * 2, SZ_UP = (size_t)DFF * DM * 2, SZ_DN = SZ_UP;
constexpr size_t W_IN = 0, W_OUT = W_IN + SZ_IN, W_UQ = W_OUT + SZ_OUT, W_UKV = W_UQ + SZ_UQ, W_MQ = W_UKV + SZ_UKV, W_MKV = W_MQ + SZ_MQ, W_MO = W_MKV + SZ_MKV,
                 W_UP = W_MO + SZ_MO, W_DN = W_UP + SZ_UP, W_LAYER = W_DN + SZ_DN;
static_assert(W_LAYER % 256 == 0, "weight block alignment");
constexpr size_t WS_MEMN = WS_W + NL * W_LAYER;
constexpr size_t WS_KVMEM = WS_MEMN + (size_t)NL * 512 * DM * 2;
constexpr size_t WS_H = WS_KVMEM + (size_t)NL * 512 * 1024 * 2;
constexpr size_t WS_CQN = WS_H + (size_t)M * DM * 2;
constexpr size_t WS_CKVN = WS_CQN + (size_t)M * 1536 * 2;
constexpr size_t WS_KPE = WS_CKVN + (size_t)M * 512 * 2;
constexpr size_t WS_QMLA = WS_KPE + (size_t)M * 64 * 2;
constexpr size_t WS_KVMLA = WS_QMLA + (size_t)M * 1536 * 2;
constexpr size_t WS_QMEM = WS_KVMLA + (size_t)M * 2048 * 2;
constexpr size_t WS_OMEM = WS_QMEM + (size_t)M * 512 * 2;
constexpr size_t WS_XL = WS_OMEM + (size_t)M * 512 * 2;
constexpr size_t WS_U = WS_XL + (size_t)M * DM * 2;
constexpr size_t WS_PROJ = WS_U;
constexpr size_t WS_MIX = WS_PROJ + (size_t)M * INP * 2;
static_assert(WS_MIX + (size_t)M * DM * 2 <= WS_U + (size_t)M * DFF * 2, "PROJ + MIX fit inside U");
constexpr size_t WS_END = WS_U + (size_t)M * DFF * 2;
constexpr int CW_BAR = 4096;
constexpr int CW_SS = 32768;
constexpr int CW_KN = 24576;
constexpr int CW_TKT = 16384;

constexpr int RING_OFF = 0, RING_BYTES = 137216;
constexpr int LDSCTL_OFF = RING_BYTES, MISC_OFF = LDSCTL_OFF + 320;
constexpr int LDS_BYTES = 147456;

typedef unsigned short bf16;
typedef short bf16x8 __attribute__((ext_vector_type(8)));
typedef short s16x4 __attribute__((ext_vector_type(4)));
typedef float f32x4 __attribute__((ext_vector_type(4)));
typedef float f32x16 __attribute__((ext_vector_type(16)));
typedef unsigned v4u __attribute__((ext_vector_type(4)));
typedef unsigned v2u __attribute__((ext_vector_type(2)));
typedef int i32x4 __attribute__((ext_vector_type(4)));

__device__ __forceinline__ unsigned cvtpk(float lo, float hi) { unsigned r; asm volatile("v_cvt_pk_bf16_f32 %0, %1, %2" : "=v"(r) : "v"(lo), "v"(hi)); return r; }
__device__ __forceinline__ float bf2f(short s) { return __uint_as_float(((unsigned)(unsigned short)s) << 16); }
template <int X> __device__ __forceinline__ float shx(float v) { return __int_as_float(__builtin_amdgcn_ds_swizzle(__float_as_int(v), 0x1f | (X << 10))); }
template <int X> __device__ __forceinline__ int shxi(int v) { return __builtin_amdgcn_ds_swizzle(v, 0x1f | (X << 10)); }
__device__ __forceinline__ float half_sum(float v) { v += shx<1>(v); v += shx<2>(v); v += shx<4>(v); v += shx<8>(v); v += shx<16>(v); return v; }
__device__ __forceinline__ float wave_sum(float v) { v = half_sum(v);
    auto rr = __builtin_amdgcn_permlane32_swap(__float_as_uint(v), __float_as_uint(v), false, false); return __uint_as_float(rr[0]) + __uint_as_float(rr[1]); }
#define FRESH_LANE(name) const int name = fresh_lane()
#define WAITBAR() asm volatile("s_waitcnt vmcnt(0) lgkmcnt(0)\n\ts_barrier" ::: "memory")

__device__ __forceinline__ void tr_item(const float* W, int K, int N, int nblk, bf16* WT, int row_off, LAS float* scr, int item, int lane, const float* gk) {
    const int kb = item / nblk, nb = item - kb * nblk, k0 = 64 * kb, n0 = 64 * nb;
    const int c4 = (lane & 15) * 4, rr = lane >> 4; const bool ok = n0 + c4 < N;
    const GAS f32x4* src = (const GAS f32x4*)(W + (size_t)(k0 + rr) * N + n0 + c4);
    f32x4 v[16];
#pragma unroll
    for (int i = 0; i < 16; ++i) v[i] = ok ? __builtin_nontemporal_load((const GAS f32x4*)((const GAS float*)src + (size_t)(4 * i) * N)) : (f32x4){0.f, 0.f, 0.f, 0.f};
    if (gk) {
#pragma unroll
        for (int i = 0; i < 16; ++i) v[i] = v[i] * gk[k0 + 4 * i + rr]; }
#pragma unroll
    for (int i = 0; i < 16; ++i) { LAS float* s = scr + (4 * i + rr) * 65 + c4; s[0] = v[i].x; s[1] = v[i].y; s[2] = v[i].z; s[3] = v[i].w; }
    LDS_WAIT(); asm volatile("" ::: "memory");
    const int c = lane & 7;
#pragma unroll
    for (int j = 0; j < 8; ++j) { const int nn = (lane >> 3) + 8 * j; const LAS float* s = scr + (8 * c) * 65 + nn;
        v4u o; o.x = cvtpk(s[0 * 65], s[1 * 65]); o.y = cvtpk(s[2 * 65], s[3 * 65]); o.z = cvtpk(s[4 * 65], s[5 * 65]); o.w = cvtpk(s[6 * 65], s[7 * 65]);
        *(GAS v4u*)(WT + (size_t)(row_off + n0 + nn) * K + k0 + 8 * c) = o; }
    LDS_WAIT(); asm volatile("" ::: "memory");
}
template <bool BF> __device__ __forceinline__ void rms_row(const float* xrow, const float* g, void* orow, int lane) {
    const GAS f32x4* xr = (const GAS f32x4*)xrow + lane; const GAS f32x4* gr = (const GAS f32x4*)g + lane;
    f32x4 v[16]; float s = 0.f;
#pragma unroll
    for (int j = 0; j < 16; ++j) { v[j] = xr[64 * j]; s += (v[j].x * v[j].x + v[j].y * v[j].y) + (v[j].z * v[j].z + v[j].w * v[j].w); }
    const float rstd = 1.0f / sqrtf(wave_sum(s) * (1.f / DM) + EPS);
#pragma unroll
    for (int j = 0; j < 16; ++j) { const f32x4 gg = gr[64 * j]; const f32x4 y = v[j] * rstd * gg;
        if (BF) { v2u w; w.x = cvtpk(y.x, y.y); w.y = cvtpk(y.z, y.w); ((GAS v2u*)orow)[64 * j + lane] = w; }
        else ((GAS f32x4*)orow)[64 * j + lane] = y; }
}
__device__ __forceinline__ void cast_row(const float* xrow, bf16* hrow, unsigned long long* ss, int lane) {
    const GAS f32x4* xr = (const GAS f32x4*)xrow + lane; float s = 0.f;
#pragma unroll
    for (int j = 0; j < 16; ++j) { const f32x4 v = xr[64 * j]; s += (v.x * v.x + v.y * v.y) + (v.z * v.z + v.w * v.w);
        v2u h; h.x = cvtpk(v.x, v.y); h.y = cvtpk(v.z, v.w); ((GAS v2u*)hrow)[64 * j + lane] = h; }
    s = wave_sum(s); if (lane == 0) *ss = (unsigned long long)((double)s * 1048576.0);
}
__device__ __forceinline__ void final_row(const bf16* hrow, const float* g, float* orow, int lane) {
    f32x4 v[16]; float s = 0.f;
#pragma unroll
    for (int j = 0; j < 16; ++j) { const v2u h = ((const GAS v2u*)hrow)[64 * j + lane];
        v[j].x = __uint_as_float(h.x << 16); v[j].y = __uint_as_float(h.x & 0xffff0000u); v[j].z = __uint_as_float(h.y << 16); v[j].w = __uint_as_float(h.y & 0xffff0000u);
        s += (v[j].x * v[j].x + v[j].y * v[j].y) + (v[j].z * v[j].z + v[j].w * v[j].w); }
    const float rstd = 1.0f / sqrtf(wave_sum(s) * (1.f / DM) + EPS);
#pragma unroll
    for (int j = 0; j < 16; ++j) { const f32x4 gg = ((const GAS f32x4*)g)[64 * j + lane]; ((GAS f32x4*)orow)[64 * j + lane] = v[j] * rstd * gg; }
}
__device__ __forceinline__ float logsigmoidf_(float x) {
    const float e = __expf(-fabsf(x)); return fminf(x, 0.f) - __logf(1.f + e);
}
__device__ __forceinline__ void prep_row(const bf16* proj, int m, const float* gq, const float* gkv, const float* bf, const float* COS, const float* SIN,
                                         bf16* CQN, bf16* CKVN, bf16* KPE, float* LOGF, unsigned* KN2, int lane) {
    const bf16* pr = proj + (size_t)m * INP;
    bf16x8 q[3]; float sq = 0.f;
#pragma unroll
    for (int j = 0; j < 3; ++j) { q[j] = *(const GAS bf16x8*)(pr + B_CQ + (j * 64 + lane) * 8);
#pragma unroll
        for (int e = 0; e < 8; ++e) { const float f = bf2f(q[j][e]); sq += f * f; } }
    const bf16x8 kv = *(const GAS bf16x8*)(pr + B_CKV + lane * 8); float skv = 0.f;
#pragma unroll
    for (int e = 0; e < 8; ++e) { const float f = bf2f(kv[e]); skv += f * f; }
    const float rq = 1.0f / sqrtf(wave_sum(sq) * (1.f / QRANK) + EPS), rkv = 1.0f / sqrtf(wave_sum(skv) * (1.f / KVRANK) + EPS);
#pragma unroll
    for (int j = 0; j < 3; ++j) { const int c0 = (j * 64 + lane) * 8; const f32x4 g0 = *(const GAS f32x4*)(gq + c0), g1 = *(const GAS f32x4*)(gq + c0 + 4);
        v4u w; w.x = cvtpk(bf2f(q[j][0]) * rq * g0.x, bf2f(q[j][1]) * rq * g0.y); w.y = cvtpk(bf2f(q[j][2]) * rq * g0.z, bf2f(q[j][3]) * rq * g0.w);
        w.z = cvtpk(bf2f(q[j][4]) * rq * g1.x, bf2f(q[j][5]) * rq * g1.y); w.w = cvtpk(bf2f(q[j][6]) * rq * g1.z, bf2f(q[j][7]) * rq * g1.w);
        *(GAS v4u*)(CQN + (size_t)m * QRANK + c0) = w; }
    { const int c0 = lane * 8; const f32x4 g0 = *(const GAS f32x4*)(gkv + c0), g1 = *(const GAS f32x4*)(gkv + c0 + 4);
        v4u w; w.x = cvtpk(bf2f(kv[0]) * rkv * g0.x, bf2f(kv[1]) * rkv * g0.y); w.y = cvtpk(bf2f(kv[2]) * rkv * g0.z, bf2f(kv[3]) * rkv * g0.w);
        w.z = cvtpk(bf2f(kv[4]) * rkv * g1.x, bf2f(kv[5]) * rkv * g1.y); w.w = cvtpk(bf2f(kv[6]) * rkv * g1.z, bf2f(kv[7]) * rkv * g1.w);
        *(GAS v4u*)(CKVN + (size_t)m * KVRANK + c0) = w; }
    { const float v = bf2f((short)pr[B_KR + lane]); float pv; { auto rr = __builtin_amdgcn_permlane32_swap(__float_as_uint(v), __float_as_uint(v), false, false); pv = __uint_as_float(lane >= 32 ? rr[0] : rr[1]); } const int i = lane & 31;
      const float c = COS[(size_t)m * 32 + i], s = SIN[(size_t)m * 32 + i];
      const float o = lane < 32 ? v * c - pv * s : pv * s + v * c;
      const float on = shx<1>(o);
      if ((lane & 1) == 0) *(GAS unsigned*)(KPE + (size_t)m * 64 + lane) = cvtpk(o, on); }
    if (lane < 8) { const float f = bf2f((short)pr[D_F + lane]) + bf[lane]; const int b = m / SEQ, s = m - b * SEQ; LOGF[(size_t)(b * 8 + lane) * SEQ + s] = logsigmoidf_(f); }
    { const bf16x8 k0 = *(const GAS bf16x8*)(pr + D_Q + 1024 + lane * 16), k1 = *(const GAS bf16x8*)(pr + D_Q + 1024 + lane * 16 + 8); float s = 0.f;
#pragma unroll
      for (int e = 0; e < 8; ++e) { const float a = bf2f(k0[e]), c = bf2f(k1[e]); s += a * a + c * c; }
      s += shx<1>(s); s += shx<2>(s); s += shx<4>(s);
      if ((lane & 7) == 0) { unsigned* p = KN2 + (m / SEQ) * 8 + (lane >> 3); const unsigned v = __float_as_uint(s);
          if (v > __hip_atomic_load(p, __ATOMIC_RELAXED, __HIP_MEMORY_SCOPE_AGENT)) __hip_atomic_fetch_max(p, v, __ATOMIC_RELAXED, __HIP_MEMORY_SCOPE_AGENT); } }
}
__device__ __forceinline__ void fox_scan(const float* logf, float* negc, int lane) {
    const GAS f32x4* src = (const GAS f32x4*)(logf + lane * 64); f32x4 v[16]; float tot = 0.f;
#pragma unroll
    for (int j = 0; j < 16; ++j) { v[j] = src[j]; tot += (v[j].x + v[j].y) + (v[j].z + v[j].w); }
    float inc = tot;
#pragma unroll
    for (int o = 1; o < 64; o <<= 1) { const float t = __int_as_float(__builtin_amdgcn_ds_bpermute((lane - o) << 2, __float_as_int(inc))); if (lane >= o) inc += t; }
    float run = inc - tot; const float k = -11.313708498984761f;
    GAS f32x4* dst = (GAS f32x4*)(negc + lane * 64);
#pragma unroll
    for (int j = 0; j < 16; ++j) { f32x4 o; run += v[j].x; o.x = run * k; run += v[j].y; o.y = run * k; run += v[j].z; o.z = run * k; run += v[j].w; o.w = run * k; dst[j] = o; }
}

struct Cv { int idx, K, N, NP; long long dst; int roff, gain, lay, first, cnt, pad; };
constexpr int NCV = 12;
constexpr int NTB = 4;
struct Args { const void* in[27]; float* out; unsigned char* ws; float inv_freq[32]; float lam_init[2]; Cv cv[NTB][NCV]; int ncv[NTB]; int nchunk[NTB]; };
static_assert(sizeof(Cv) == 48 && sizeof(Args) == 27 * 8 + 16 + 128 + 8 + NTB * NCV * 48 + 8 * NTB, "Args has no padding");
typedef const unsigned char __attribute__((address_space(4)))* kaptr_t;
__device__ __forceinline__ kaptr_t ka_fresh() { kaptr_t p = (kaptr_t)__builtin_amdgcn_kernarg_segment_ptr(); asm volatile("" : "+s"(p)); return p; }
#define KIN(ka, i) (*(const void* const __attribute__((address_space(4)))*)((ka) + 8 * (i)))
#define KOUT(ka) ((float*)KIN(ka, 27))
#define KWS(ka) ((unsigned char*)KIN(ka, 28))
#define KINVF(ka, i) (*(const float __attribute__((address_space(4)))*)((ka) + 232 + 4 * (i)))
#define KLAMI(ka, l) (*(const float __attribute__((address_space(4)))*)((ka) + 360 + 4 * (l)))
#define KCVI(ka, l, j, f) (*(const int __attribute__((address_space(4)))*)((ka) + 368 + ((l) * NCV + (j)) * 48 + 4 * (f)))
#define KCVD(ka, l, j) (*(const long long __attribute__((address_space(4)))*)((ka) + 368 + ((l) * NCV + (j)) * 48 + 16))
#define KNCV(ka, l) (*(const int __attribute__((address_space(4)))*)((ka) + 368 + NTB * NCV * 48 + 4 * (l)))
#define KNCH(ka, l) (*(const int __attribute__((address_space(4)))*)((ka) + 368 + NTB * NCV * 48 + 4 * NTB + 4 * (l)))
__device__ __forceinline__ void conv_item(const kaptr_t ka, unsigned char* ws, int t, int it, LAS float* scr, int lane) {
    const int n = KNCV(ka, t); int rem = it, j = 0;
    for (; j < n; ++j) { const int cnt = KCVI(ka, t, j, 10); if (rem < cnt) break; rem -= cnt; }
    if (j >= n) return;
    const int idx = KCVI(ka, t, j, 0), K = KCVI(ka, t, j, 1), N = KCVI(ka, t, j, 2), NP = KCVI(ka, t, j, 3), roff = KCVI(ka, t, j, 6), gain = KCVI(ka, t, j, 7), lay = KCVI(ka, t, j, 8), first = KCVI(ka, t, j, 9);
    const float* gk = nullptr; if (gain >= 0) gk = (const float*)KIN(ka, gain) + (size_t)lay * K;
    tr_item((const float*)KIN(ka, idx) + (size_t)lay * K * N, K, N, NP / 64, (bf16*)(ws + KCVD(ka, t, j)), roff, scr, first + rem, lane, gk);
}
struct CvD { const float* W; bf16* WT; const float* gk; int K, N, nblk, roff, item; };
struct TrBuf { f32x4 v[16]; f32x4 g0, g1; };
__device__ __forceinline__ bool cv_desc(const kaptr_t ka, unsigned char* ws, int t, int it, CvD& d) {
    const int n = KNCV(ka, t); int rem = it, j = 0;
    for (; j < n; ++j) { const int cnt = KCVI(ka, t, j, 10); if (rem < cnt) break; rem -= cnt; }
    if (j >= n) return false;
    const int idx = KCVI(ka, t, j, 0), K = KCVI(ka, t, j, 1), N = KCVI(ka, t, j, 2), NP = KCVI(ka, t, j, 3), gain = KCVI(ka, t, j, 7), lay = KCVI(ka, t, j, 8);
    d.gk = nullptr; if (gain >= 0) d.gk = (const float*)KIN(ka, gain) + (size_t)lay * K;
    d.W = (const float*)KIN(ka, idx) + (size_t)lay * K * N; d.WT = (bf16*)(ws + KCVD(ka, t, j)); d.K = K; d.N = N; d.nblk = NP / 64; d.roff = KCVI(ka, t, j, 6); d.item = KCVI(ka, t, j, 9) + rem;
    return true;
}
__device__ __forceinline__ void tr_load(const CvD& d, int lane, TrBuf& b) {
    const int kb = d.item / d.nblk, nb = d.item - kb * d.nblk, k0 = 64 * kb, n0 = 64 * nb;
    const int c4 = (lane & 15) * 4, rr = lane >> 4; const bool ok = n0 + c4 < d.N;
    const GAS float* src = (const GAS float*)(d.W + (size_t)(k0 + rr) * d.N + n0 + c4);
#pragma unroll
    for (int i = 0; i < 16; ++i) b.v[i] = ok ? __builtin_nontemporal_load((const GAS f32x4*)(src + (size_t)(4 * i) * d.N)) : (f32x4){0.f, 0.f, 0.f, 0.f};
    b.g0 = (f32x4){1.f, 1.f, 1.f, 1.f}; b.g1 = b.g0;
    if (d.gk) { const GAS f32x4* gp = (const GAS f32x4*)(d.gk + k0 + 8 * (lane & 7)); b.g0 = gp[0]; b.g1 = gp[1]; }
}
__device__ __forceinline__ void tr_fin(const CvD& d, const TrBuf& b, LAS float* scr, int lane) {
    const int kb = d.item / d.nblk, nb = d.item - kb * d.nblk, k0 = 64 * kb, n0 = 64 * nb;
    const int c4 = (lane & 15) * 4, rr = lane >> 4;
#pragma unroll
    for (int i = 0; i < 16; ++i) { LAS float* s = scr + (4 * i + rr) * 65 + c4; s[0] = b.v[i].x; s[1] = b.v[i].y; s[2] = b.v[i].z; s[3] = b.v[i].w; }
    LDS_WAIT(); asm volatile("" ::: "memory");
    const int c = lane & 7;
#pragma unroll
    for (int j = 0; j < 8; ++j) { const int nn = (lane >> 3) + 8 * j; const LAS float* s = scr + (8 * c) * 65 + nn;
        v4u o; o.x = cvtpk(s[0 * 65] * b.g0.x, s[1 * 65] * b.g0.y); o.y = cvtpk(s[2 * 65] * b.g0.z, s[3 * 65] * b.g0.w); o.z = cvtpk(s[4 * 65] * b.g1.x, s[5 * 65] * b.g1.y); o.w = cvtpk(s[6 * 65] * b.g1.z, s[7 * 65] * b.g1.w);
        *(GAS v4u*)(d.WT + (size_t)(d.roff + n0 + nn) * d.K + k0 + 8 * c) = o; }
    LDS_WAIT(); asm volatile("" ::: "memory");
}
__device__ __forceinline__ void conv_run(const kaptr_t ka, unsigned char* ws, int t, int it0, int end, int st, LAS float* scr, int lane) {
    TrBuf b0, b1; int it = it0;
    bool h0; { CvD d; h0 = it < end && cv_desc(ka, ws, t, it, d); if (h0) tr_load(d, lane, b0); }
    while (h0) {
        bool h1; { CvD d; h1 = it + st < end && cv_desc(ka, ws, t, it + st, d); if (h1) tr_load(d, lane, b1); }
        { CvD d; cv_desc(ka, ws, t, it, d); tr_fin(d, b0, scr, lane); }
        if (!h1) break;
        it += st;
        { CvD d; h0 = it + st < end && cv_desc(ka, ws, t, it + st, d); if (h0) tr_load(d, lane, b0); }
        { CvD d; cv_desc(ka, ws, t, it, d); tr_fin(d, b1, scr, lane); }
        it += st;
    }
}
__device__ __forceinline__ void conv_chunk(const kaptr_t ka, unsigned char* ws, int l, int c, LAS float* scr, int wid, int lane) {
    conv_run(ka, ws, l, c * 64 + wid * 8, c * 64 + wid * 8 + 8, 1, scr, lane);
}

namespace att {
constexpr int VA = 0, VB = 1, VC = 2, VD = 3, VE = 4;
constexpr int K_OFF = 0, V_OFF = 32768, B_OFF = 65536, WS_OFF = 67584, LUT_OFF = 69632, FLG_OFF = 70656, TKT_OFF = 70784, KPE_OFF = 71680, QF_OFF = 71680, ATT_END = QF_OFF + 65536;
constexpr float LOG2E = 1.4426950408889634f, LN2 = 0.6931471805599453f, THR = 8.f;
struct Ctx { const bf16* PROJ; const bf16* QMLA; const bf16* KVMLA; const bf16* KPE; bf16* MIX; const bf16* QMEM; const bf16* KVMEM; bf16* OMEM;
             const float* COS; const float* SIN; const float* LUT; const int* TPMAX; const int* pos; const float* NEGC; const float* sub_g; const unsigned* KN2; float lam, oml; };

__device__ __forceinline__ int crow(int r, int hi) { return (r & 3) + 8 * (r >> 2) + 4 * hi; }
__device__ __forceinline__ int swap23(int k) { return (k & ~0xC) | ((k & 4) << 1) | ((k & 8) >> 1); }
__device__ __forceinline__ float pmaxf(float v) { auto rr = __builtin_amdgcn_permlane32_swap(__float_as_uint(v), __float_as_uint(v), false, false); return fmaxf(__uint_as_float(rr[0]), __uint_as_float(rr[1])); }
__device__ __forceinline__ float psumf(float v) { auto rr = __builtin_amdgcn_permlane32_swap(__float_as_uint(v), __float_as_uint(v), false, false); return __uint_as_float(rr[0]) + __uint_as_float(rr[1]); }
__device__ __forceinline__ float partnerf(float v, int hi) { auto rr = __builtin_amdgcn_permlane32_swap(__float_as_uint(v), __float_as_uint(v), false, false); return __uint_as_float(hi ? rr[0] : rr[1]); }
__device__ __forceinline__ void dma16(const void* sbase, unsigned voff, unsigned ldsaddr) { unsigned keep;
    asm volatile("s_mov_b32 %0, m0\n\ts_mov_b32 m0, %3\n\ts_nop 0\n\tglobal_load_lds_dwordx4 %1, %2\n\ts_mov_b32 m0, %0" : "=&s"(keep) : "v"(voff), "s"(sbase), "s"(ldsaddr) : "memory"); }

template <int NK> __device__ __forceinline__ void qk(f32x16& p0, f32x16& p1, const LAS unsigned char* krow, int xr, int hx, const bf16x8* qf, int dstart) {
#pragma unroll
    for (int d0 = 0; d0 < NK; ++d0) { const int off = (((dstart + d0) * 32 + hx) ^ xr);
        const bf16x8 b0 = *(const LAS bf16x8*)(krow + off), b1 = *(const LAS bf16x8*)(krow + off + 8192);
        p0 = __builtin_amdgcn_mfma_f32_32x32x16_bf16(b0, qf[d0], p0, 0, 0, 0); p1 = __builtin_amdgcn_mfma_f32_32x32x16_bf16(b1, qf[d0], p1, 0, 0, 0); }
}
template <int NK> __device__ __forceinline__ void qk_l(f32x16& p0, f32x16& p1, const LAS unsigned char* krow, int xr, int hx, const LAS unsigned char* qlds, int dstart) {
#pragma unroll
    for (int d0 = 0; d0 < NK; ++d0) { const int off = (((dstart + d0) * 32 + hx) ^ xr);
        const bf16x8 b0 = *(const LAS bf16x8*)(krow + off), b1 = *(const LAS bf16x8*)(krow + off + 8192), q = *(const LAS bf16x8*)(qlds + (dstart + d0) * 1024);
        p0 = __builtin_amdgcn_mfma_f32_32x32x16_bf16(b0, q, p0, 0, 0, 0); p1 = __builtin_amdgcn_mfma_f32_32x32x16_bf16(b1, q, p1, 0, 0, 0); }
}
__device__ __forceinline__ void qk_pe(f32x16& p0, f32x16& p1, const LAS unsigned char* perow, int xpe, int hx, const bf16x8* qf) {
#pragma unroll
    for (int d0 = 0; d0 < 4; ++d0) { const int off = ((d0 * 32 + hx) ^ xpe);
        const bf16x8 b0 = *(const LAS bf16x8*)(perow + off), b1 = *(const LAS bf16x8*)(perow + off + 4096);
        p0 = __builtin_amdgcn_mfma_f32_32x32x16_bf16(b0, qf[d0], p0, 0, 0, 0); p1 = __builtin_amdgcn_mfma_f32_32x32x16_bf16(b1, qf[d0], p1, 0, 0, 0); }
}
__device__ __forceinline__ void pv(f32x16* o, unsigned vb, bf16x8 pa0, bf16x8 pa1, bf16x8 pa2, bf16x8 pa3) {
#define TRRD(dst, off) asm volatile("ds_read_b64_tr_b16 %0, %1 offset:%2" : "=&v"(dst) : "v"(vb), "i"(off) : "memory")
#define PV_D0(d0) do { s16x4 l0, l1, l2, l3, h0, h1, h2, h3; constexpr int b_ = (d0) * 512; \
        TRRD(l0, b_); TRRD(h0, b_ + 2048); TRRD(l1, b_ + 4096); TRRD(h1, b_ + 6144); TRRD(l2, b_ + 8192); TRRD(h2, b_ + 10240); TRRD(l3, b_ + 12288); TRRD(h3, b_ + 14336); \
        asm volatile("s_waitcnt lgkmcnt(0)" ::: "memory"); __builtin_amdgcn_sched_barrier(0); \
        o[d0] = __builtin_amdgcn_mfma_f32_32x32x16_bf16(pa0, (bf16x8){l0[0], l0[1], l0[2], l0[3], h0[0], h0[1], h0[2], h0[3]}, o[d0], 0, 0, 0); \
        o[d0] = __builtin_amdgcn_mfma_f32_32x32x16_bf16(pa1, (bf16x8){l1[0], l1[1], l1[2], l1[3], h1[0], h1[1], h1[2], h1[3]}, o[d0], 0, 0, 0); \
        o[d0] = __builtin_amdgcn_mfma_f32_32x32x16_bf16(pa2, (bf16x8){l2[0], l2[1], l2[2], l2[3], h2[0], h2[1], h2[2], h2[3]}, o[d0], 0, 0, 0); \
        o[d0] = __builtin_amdgcn_mfma_f32_32x32x16_bf16(pa3, (bf16x8){l3[0], l3[1], l3[2], l3[3], h3[0], h3[1], h3[2], h3[3]}, o[d0], 0, 0, 0); } while (0)
    PV_D0(0); PV_D0(1); PV_D0(2); PV_D0(3);
#undef PV_D0
#undef TRRD
}
__device__ __forceinline__ void pack_p(const f32x16& p0, const f32x16& p1, bf16x8& pa0, bf16x8& pa1, bf16x8& pa2, bf16x8& pa3) {
#define PK4(P, B_, OUT) do { unsigned a0 = cvtpk(P[B_ + 0], P[B_ + 1]), a1 = cvtpk(P[B_ + 2], P[B_ + 3]), b0 = cvtpk(P[B_ + 4], P[B_ + 5]), b1 = cvtpk(P[B_ + 6], P[B_ + 7]); \
        auto r0 = __builtin_amdgcn_permlane32_swap(a0, b0, false, false); auto r1 = __builtin_amdgcn_permlane32_swap(a1, b1, false, false); \
        v4u w = {r0[0], r1[0], r0[1], r1[1]}; OUT = __builtin_bit_cast(bf16x8, w); } while (0)
    PK4(p0, 0, pa0); PK4(p0, 8, pa1); PK4(p1, 0, pa2); PK4(p1, 8, pa3);
#undef PK4
}
__device__ __forceinline__ void softmax_pv(f32x16& p0, f32x16& p1, float& m, float& l, f32x16* o, LAS float* wsf, unsigned vb, int r32, int hi, const float SCALE, const float C2) {
    float mx0 = fmaxf(p0[0], p1[0]), mx1 = fmaxf(p0[1], p1[1]), mx2 = fmaxf(p0[2], p1[2]), mx3 = fmaxf(p0[3], p1[3]);
#pragma unroll
    for (int r = 4; r < 16; r += 4) { mx0 = fmaxf(fmaxf(mx0, p0[r]), p1[r]); mx1 = fmaxf(fmaxf(mx1, p0[r + 1]), p1[r + 1]); mx2 = fmaxf(fmaxf(mx2, p0[r + 2]), p1[r + 2]); mx3 = fmaxf(fmaxf(mx3, p0[r + 3]), p1[r + 3]); }
    float pmax = pmaxf(fmaxf(fmaxf(mx0, mx1), fmaxf(mx2, mx3)));
    float mn, alpha;
    if (__all((pmax - m) * SCALE <= THR)) { mn = m; alpha = 1.f; }
    else { mn = fmaxf(m, pmax); alpha = __builtin_amdgcn_exp2f((m - mn) * C2); m = mn; }
    const float mnL = -mn * C2;
#pragma unroll
    for (int r = 0; r < 16; ++r) { p0[r] = __builtin_amdgcn_exp2f(fmaf(p0[r], C2, mnL)); p1[r] = __builtin_amdgcn_exp2f(fmaf(p1[r], C2, mnL)); }
    float s0 = p0[0] + p1[0], s1 = p0[1] + p1[1], s2 = p0[2] + p1[2], s3 = p0[3] + p1[3];
#pragma unroll
    for (int r = 4; r < 16; r += 4) { s0 += p0[r] + p1[r]; s1 += p0[r + 1] + p1[r + 1]; s2 += p0[r + 2] + p1[r + 2]; s3 += p0[r + 3] + p1[r + 3]; }
    const float ps = psumf((s0 + s1) + (s2 + s3)); l = l * alpha + ps;
    bf16x8 pa0, pa1, pa2, pa3; pack_p(p0, p1, pa0, pa1, pa2, pa3);
    if (__any(alpha < 1.f)) { const int fl = fresh_lane(), fh = fl >> 5;
        if (fh == 0) wsf[fl] = alpha; asm volatile("s_waitcnt lgkmcnt(0)" ::: "memory");
#pragma unroll
        for (int r = 0; r < 16; ++r) { const float a = wsf[crow(r, fh)];
#pragma unroll
            for (int d = 0; d < 4; ++d) o[d][r] *= a; } }
    pv(o, vb, pa0, pa1, pa2, pa3);
}

template <int VAR>
__device__ __forceinline__ void attn_unit(const Ctx& C, int b, int h, int qb, LAS unsigned char* lds, int tid, int wid, int lane) {
    constexpr bool CAUSAL = VAR != VE, DESC = (VAR == VC || VAR == VD), MLA = (VAR == VB), DIFF = (VAR == VA), STICK = (VAR == VC), HASB = (VAR == VA || VAR == VD);
    constexpr int NQF = MLA ? 12 : 8;
    constexpr float SCALE = DIFF ? 0.125f : (MLA ? 0.07216878364870323f : 0.08838834764831845f);
    constexpr float C2 = SCALE * LOG2E;
    const int r32 = lane & 31, hi = lane >> 5;
    const int q0 = qb * 256, qw = q0 + wid * 32, trow = qw + r32;
    const size_t rb = (size_t)b * SEQ;
    const bf16 *Qp, *Kp, *Vp; bf16* Op; int qpitch, kpitch, opitch;
    if constexpr (VAR == VA || VAR == VC || VAR == VD) {
        constexpr int base = VAR == VA ? A_Q : (VAR == VC ? C_Q : D_Q);
        Qp = C.PROJ + rb * INP + base + h * 128; Kp = Qp + 1024; Vp = Qp + 2048; qpitch = INP; kpitch = INP;
        Op = C.MIX + rb * DM + VAR * 1024 + h * 128; opitch = DM;
    } else if constexpr (VAR == VB) {
        Qp = C.QMLA + rb * 1536 + h * 192; qpitch = 1536; Kp = C.KVMLA + rb * 2048 + h * 256; Vp = Kp + 128; kpitch = 2048;
        Op = C.MIX + rb * DM + 1024 + h * 128; opitch = DM;
    } else {
        Qp = C.QMEM + rb * 512 + h * 128; qpitch = 512; Kp = C.KVMEM + (size_t)b * MEMT * 1024 + h * 128; Vp = Kp + 512; kpitch = 1024;
        Op = C.OMEM + rb * 512 + h * 128; opitch = 512;
    }
    const char* Bp = nullptr;
    if constexpr (VAR == VA) Bp = (const char*)(C.pos + rb);
    if constexpr (VAR == VD) Bp = (const char*)(C.NEGC + (size_t)(b * 8 + h) * SEQ);
    const char* KPEp = nullptr;
    if constexpr (MLA) KPEp = (const char*)(C.KPE + rb * 64);
    bf16x8 qr[DIFF ? 1 : NQF];
    const LAS unsigned char* qlds = lds + QF_OFF + wid * 8192 + lane * 16;
    { const bf16* qrow = Qp + (size_t)trow * qpitch + hi * 8;
      if constexpr (DIFF) {
#pragma unroll
          for (int d0 = 0; d0 < 8; ++d0) { const bf16x8 q = *(const GAS bf16x8*)(qrow + d0 * 16); *(LAS bf16x8*)(lds + QF_OFF + wid * 8192 + lane * 16 + d0 * 1024) = q; }
      } else {
#pragma unroll
          for (int d0 = 0; d0 < NQF; ++d0) qr[d0] = *(const GAS bf16x8*)(qrow + d0 * 16); } }
    if constexpr (MLA) {
        const float* cs = C.COS + (rb + trow) * 32 + hi * 8; const float* sn = C.SIN + (rb + trow) * 32 + hi * 8;
#pragma unroll
        for (int j = 0; j < 2; ++j) {
            const f32x4 c0 = *(const GAS f32x4*)(cs + j * 16), c1 = *(const GAS f32x4*)(cs + j * 16 + 4), s0 = *(const GAS f32x4*)(sn + j * 16), s1 = *(const GAS f32x4*)(sn + j * 16 + 4);
            const bf16x8 a = qr[8 + j], bb = qr[10 + j]; float lo[8], hh[8];
#pragma unroll
            for (int e = 0; e < 8; ++e) { const float t1 = bf2f(a[e]), t2 = bf2f(bb[e]), c = e < 4 ? c0[e & 3] : c1[e & 3], s = e < 4 ? s0[e & 3] : s1[e & 3]; lo[e] = t1 * c - t2 * s; hh[e] = t1 * s + t2 * c; }
            v4u wl = {cvtpk(lo[0], lo[1]), cvtpk(lo[2], lo[3]), cvtpk(lo[4], lo[5]), cvtpk(lo[6], lo[7])}, wh = {cvtpk(hh[0], hh[1]), cvtpk(hh[2], hh[3]), cvtpk(hh[4], hh[5]), cvtpk(hh[6], hh[7])};
            qr[8 + j] = __builtin_bit_cast(bf16x8, wl); qr[10 + j] = __builtin_bit_cast(bf16x8, wh); }
    }
    unsigned koff[2], voff[2], peoff = 0;
#pragma unroll
    for (int i = 0; i < 2; ++i) { const int j = wid * 2 + i, row = 4 * j + (lane >> 4); koff[i] = (unsigned)(row * kpitch + (((lane & 15) ^ (row & 15)) << 3)) * 2u;
        const int st = 2 * j + (lane >> 5), kk = (st >> 2) * 8 + ((lane & 31) >> 2), c = (st & 3) * 32 + (lane & 3) * 8; voff[i] = (unsigned)(swap23(kk) * kpitch + c) * 2u; }
    if constexpr (MLA) { const int row = 8 * wid + (lane >> 3); peoff = (unsigned)(row * 64 + (((lane & 7) ^ ((row >> 1) & 7)) << 3)) * 2u; }
    const unsigned boff = (unsigned)(lane & 15) * 16u;
    const unsigned ldsbase = (unsigned)(unsigned long long)lds;
#define ISSUE(t_, buf_) do { const size_t tb_ = (size_t)(t_) * 64 * kpitch * 2; const char* kg_ = (const char*)Kp + tb_; const char* vg_ = (const char*)Vp + tb_; \
        _Pragma("unroll") for (int i_ = 0; i_ < 2; ++i_) dma16(kg_, koff[i_], ldsbase + K_OFF + (buf_) * 16384 + (wid * 2 + i_) * 1024); \
        _Pragma("unroll") for (int i_ = 0; i_ < 2; ++i_) dma16(vg_, voff[i_], ldsbase + V_OFF + (buf_) * 16384 + (wid * 2 + i_) * 1024); \
        if constexpr (MLA) dma16(KPEp + (size_t)(t_) * 64 * 64 * 2, peoff, ldsbase + KPE_OFF + (buf_) * 8192 + wid * 1024); \
        if constexpr (HASB) { if (wid == 0) dma16(Bp + (size_t)(t_) * 64 * 4, boff, ldsbase + B_OFF + (buf_) * 1024); } } while (0)
    const int NT = CAUSAL ? (q0 + 256) / 64 : MEMT / 64;
    LAS float* wsf = (LAS float*)(lds + WS_OFF) + wid * 64;
    LAS float* lut = (LAS float*)(lds + LUT_OFF);
    int pos_t = 0, wmin = 0; float lut_far = 0.f;
    if constexpr (DIFF) { if (tid < 132) lut[tid] = C.LUT[h * 132 + tid];
        pos_t = C.pos[rb + trow]; int mnp = pos_t;
        mnp = min(mnp, shxi<1>(mnp)); mnp = min(mnp, shxi<2>(mnp)); mnp = min(mnp, shxi<4>(mnp)); mnp = min(mnp, shxi<8>(mnp)); mnp = min(mnp, shxi<16>(mnp));
        wmin = __builtin_amdgcn_readfirstlane(mnp); lut_far = C.LUT[h * 132 + 128]; }
    const int xr = (r32 & 15) << 4, hx = hi << 4, xpe = ((r32 >> 1) & 7) << 4;
    const unsigned vrd = (unsigned)(((lane & 3) << 3) | (((lane >> 2) & 3) << 6) | (((lane >> 4) & 1) << 5) | (((lane >> 5) & 1) << 8));
    f32x16 o[4]; f32x16 o2[DIFF ? 4 : 1];
#pragma unroll
    for (int d = 0; d < 4; ++d) { o[d] = f32x16{}; if constexpr (DIFF) o2[d] = f32x16{}; }
    float m1 = -1e30f, l1 = 0.f, m2 = -1e30f, l2 = 0.f, R = 0.f;
    float qnkn = 0.f;
    if constexpr (VAR == VD) { float s = 0.f;
#pragma unroll
        for (int d0 = 0; d0 < 8; ++d0)
#pragma unroll
            for (int e = 0; e < 8; ++e) { const float a = bf2f(qr[d0][e]); s += a * a; }
        s = psumf(s); qnkn = sqrtf(s) * sqrtf(__uint_as_float(C.KN2[b * 8 + h])) * 1.001f + 1.f; }
    ISSUE(DESC ? NT - 1 : 0, 0);
    WAITBAR();
    int cur = 0;
    for (int i = 0; i < NT; ++i) {
        const int t = DESC ? NT - 1 - i : i, kb = t * 64;
        if (i + 1 < NT) ISSUE(DESC ? t - 1 : t + 1, cur ^ 1);
        const bool act = !CAUSAL || (STICK ? (kb < qw + 31) : (kb <= qw + 31));
        bool wdone = false;
        if constexpr (VAR == VD) {
            if (act) { const float nmax = ((const LAS float*)(lds + B_OFF + cur * 1024))[63]; wdone = __all((qnkn + nmax - m1) * SCALE < -40.f); } }
        if (act && !wdone) {
            const LAS unsigned char* krow = lds + K_OFF + cur * 16384 + r32 * 256;
            const unsigned vb = ldsbase + V_OFF + cur * 16384 + vrd;
            if constexpr (STICK) {
                f32x16 p0 = f32x16{}, p1 = f32x16{};
                qk<8>(p0, p1, krow, xr, hx, qr, 0);
                float L0[16], L1[16];
#pragma unroll
                for (int r = 0; r < 16; ++r) { const int key = kb + crow(r, hi);
                    { const float z = p0[r] * SCALE, e = __builtin_amdgcn_exp2f(-fabsf(z) * LOG2E), sp = fmaxf(z, 0.f) + __builtin_amdgcn_logf(1.f + e) * LN2; L0[r] = key < trow ? -sp : 0.f; p0[r] = z; }
                    { const float z = p1[r] * SCALE, e = __builtin_amdgcn_exp2f(-fabsf(z) * LOG2E), sp = fmaxf(z, 0.f) + __builtin_amdgcn_logf(1.f + e) * LN2; L1[r] = key + 32 < trow ? -sp : 0.f; p1[r] = z; } }
                float T[8], mb[8];
#pragma unroll
                for (int g = 0; g < 4; ++g) { T[g] = (L0[4 * g] + L0[4 * g + 1]) + (L0[4 * g + 2] + L0[4 * g + 3]); T[4 + g] = (L1[4 * g] + L1[4 * g + 1]) + (L1[4 * g + 2] + L1[4 * g + 3]); }
                float run = R;
#pragma unroll
                for (int k = 7; k >= 0; --k) { const float pt = partnerf(T[k], hi); const float T1 = hi ? T[k] : pt, T0 = hi ? pt : T[k];
                    const float b1 = run; run += T1; const float b0 = run; run += T0; mb[k] = hi ? b1 : b0; }
                R = run;
#pragma unroll
                for (int g = 0; g < 4; ++g) { float s0 = mb[g], s1 = mb[4 + g];
#pragma unroll
                    for (int e = 3; e >= 0; --e) { const int r = 4 * g + e, key = kb + crow(r, hi);
                        const float a0 = key < trow ? __builtin_amdgcn_exp2f((p0[r] + L0[r] + s0) * LOG2E) : 0.f; s0 += L0[r]; p0[r] = a0;
                        const float a1 = key + 32 < trow ? __builtin_amdgcn_exp2f((p1[r] + L1[r] + s1) * LOG2E) : 0.f; s1 += L1[r]; p1[r] = a1; } }
                bf16x8 pa0, pa1, pa2, pa3; pack_p(p0, p1, pa0, pa1, pa2, pa3);
                pv(o, vb, pa0, pa1, pa2, pa3);
            } else {
#pragma unroll
                for (int mp = 0; mp < (DIFF ? 2 : 1); ++mp) {
                    f32x16 p0, p1;
                    int xr_t = xr;
                    if constexpr (DIFF) { __builtin_amdgcn_sched_barrier(0); asm volatile("" : "+v"(pos_t), "+v"(xr_t)); }
                    if constexpr (VAR == VD) { const LAS float* nb = (const LAS float*)(lds + B_OFF + cur * 1024) + 4 * hi;
#pragma unroll
                        for (int g = 0; g < 4; ++g) { const f32x4 v0 = *(const LAS f32x4*)(nb + 8 * g), v1 = *(const LAS f32x4*)(nb + 32 + 8 * g);
#pragma unroll
                            for (int e = 0; e < 4; ++e) { p0[4 * g + e] = v0[e]; p1[4 * g + e] = v1[e]; } } }
                    else if constexpr (DIFF) {
                        if (wmin - C.TPMAX[b * 64 + t] >= 128) {
#pragma unroll
                            for (int r = 0; r < 16; ++r) { p0[r] = lut_far; p1[r] = lut_far; } }
                        else { const LAS int* pb = (const LAS int*)(lds + B_OFF + cur * 1024) + 4 * hi;
#pragma unroll
                            for (int g = 0; g < 4; ++g) { const i32x4 v0 = *(const LAS i32x4*)(pb + 8 * g), v1 = *(const LAS i32x4*)(pb + 32 + 8 * g);
#pragma unroll
                                for (int e = 0; e < 4; ++e) { p0[4 * g + e] = lut[min(max(pos_t - v0[e], 0), 128)]; p1[4 * g + e] = lut[min(max(pos_t - v1[e], 0), 128)]; }
                                __builtin_amdgcn_sched_barrier(0); } } }
                    else { p0 = f32x16{}; p1 = f32x16{}; }
                    if constexpr (DIFF) qk_l<4>(p0, p1, krow, xr_t, hx, qlds, 4 * mp);
                    else qk<8>(p0, p1, krow, xr, hx, qr, 0);
                    if constexpr (MLA) qk_pe(p0, p1, lds + KPE_OFF + cur * 8192 + r32 * 128, xpe, hx, qr + 8);
                    if (CAUSAL && kb + 63 > qw) { const float NEG = -__builtin_inff();
#pragma unroll
                        for (int r = 0; r < 16; ++r) { const int key = kb + crow(r, hi); if (key > trow) p0[r] = NEG; if (key + 32 > trow) p1[r] = NEG; } }
                    if (mp == 0) softmax_pv(p0, p1, m1, l1, o, wsf, vb, r32, hi, SCALE, C2);
                    else softmax_pv(p0, p1, m2, l2, o2, wsf, vb, r32, hi, SCALE, C2);
                }
            }
        }
        if constexpr (STICK) { const int dn_ = __all(R < -100.f) ? 1 : 0; if (lane == 0) ((LAS int*)(lds + FLG_OFF))[(i & 1) * 8 + wid] = dn_; }
        if constexpr (VAR == VD) { if (lane == 0) ((LAS int*)(lds + FLG_OFF))[(i & 1) * 8 + wid] = wdone ? 1 : 0; }
        WAITBAR(); cur ^= 1;
        if constexpr (STICK || VAR == VD) { const LAS i32x4* fl = (const LAS i32x4*)(lds + FLG_OFF + (i & 1) * 32); const i32x4 f0 = fl[0], f1 = fl[1];
            const int alld = (f0.x & f0.y & f0.z & f0.w) & (f1.x & f1.y & f1.z & f1.w); if (__builtin_amdgcn_readfirstlane(alld)) break; }
    }
#undef ISSUE
    const int lane_e = fresh_lane();
    const int r32e = lane_e & 31, hie = lane_e >> 5;
    bf16* Ob = Op + (size_t)(qw + 4 * hie) * opitch + r32e;
    if constexpr (DIFF) {
        if (hie == 0) { wsf[r32e] = l1; wsf[32 + r32e] = l2; } asm volatile("s_waitcnt lgkmcnt(0)" ::: "memory");
        const float lam = C.lam;
#pragma unroll
        for (int r = 0; r < 16; ++r) { const float i1 = __builtin_amdgcn_rcpf(wsf[crow(r, hie)]), i2 = lam * __builtin_amdgcn_rcpf(wsf[32 + crow(r, hie)]); float ss = 0.f;
#pragma unroll
            for (int d = 0; d < 4; ++d) { const float x = o[d][r] * i1 - o2[d][r] * i2; o[d][r] = x; ss += x * x; }
            ss = half_sum(ss);
            const float rstd = (1.0f / sqrtf(ss * (1.f / 128.f) + EPS)) * C.oml;
#pragma unroll
            for (int d = 0; d < 4; ++d) o[d][r] *= rstd; }
#pragma unroll
        for (int d = 0; d < 4; ++d) { const float g = C.sub_g[d * 32 + r32e];
#pragma unroll
            for (int r = 0; r < 16; ++r) o[d][r] *= g; }
    } else if constexpr (!STICK) {
        if (hie == 0) wsf[r32e] = l1; asm volatile("s_waitcnt lgkmcnt(0)" ::: "memory");
#pragma unroll
        for (int r = 0; r < 16; ++r) { const float i1 = __builtin_amdgcn_rcpf(wsf[crow(r, hie)]);
#pragma unroll
            for (int d = 0; d < 4; ++d) o[d][r] *= i1; }
    }
#pragma unroll
    for (int r = 0; r < 16; ++r) { const int orr = (r & 3) + 8 * (r >> 2);
#pragma unroll
        for (int d = 0; d < 4; ++d) { const float v = o[d][r], vn = shx<1>(v);
            if ((r32e & 1) == 0) *(GAS unsigned*)(Ob + (size_t)orr * opitch + d * 32) = cvtpk(v, vn); } }
}
template <int VAR> __device__ __forceinline__ void attn_queue(const Ctx& C, gu32* head, LAS unsigned char* lds, const int wid, const kaptr_t ka, unsigned char* ws, const int cvl) {
    constexpr int NH = VAR == VE ? 4 : 8, NU = NB * NH * 16;
    const int lane = fresh_lane(), tid = wid * 64 + lane;
    volatile LAS int* tk = (volatile LAS int*)(lds + LDSCTL_OFF);
    for (;;) {
        if (tid == 0) tk[0] = (int)__hip_atomic_fetch_add(head, 1u, RLX_AGENT);
        WAITBAR();
        const int n = __builtin_amdgcn_readfirstlane(tk[0]);
        if (n >= NU) break;
        const int qb = 15 - n / (NB * NH), bh = n % (NB * NH);
        attn_unit<VAR>(C, bh / NH, bh % NH, qb, lds, tid, wid, lane);
        if (cvl >= 0) {
            if (tid == 0) tk[1] = (int)__hip_atomic_fetch_add((gu32*)(ws + WS_CTL) + CW_TKT + (cvl * 16 + 10) * 64, 1u, RLX_AGENT);
            WAITBAR();
            const int c = __builtin_amdgcn_readfirstlane(tk[1]);
            if (c < KNCH(ka, cvl)) conv_chunk(ka, ws, cvl, c, (LAS float*)(lds + RING_OFF + wid * 16640), wid, lane);
        }
    }
}
}


namespace att {
template <int VAR> __device__ __forceinline__ void attn_phase(int l, int q, LAS unsigned char* lds, const int wid0) {
    const kaptr_t ka = ka_fresh(); unsigned char* ws = KWS(ka);
    const Ctx C{(const bf16*)(ws + WS_PROJ), (const bf16*)(ws + WS_QMLA), (const bf16*)(ws + WS_KVMLA), (const bf16*)(ws + WS_KPE), (bf16*)(ws + WS_MIX), (const bf16*)(ws + WS_QMEM),
                (const bf16*)(ws + WS_KVMEM) + (size_t)l * 512 * 1024, (bf16*)(ws + WS_OMEM), (const float*)(ws + WS_COS), (const float*)(ws + WS_SIN), (const float*)(ws + WS_LUT),
                (const int*)(ws + WS_TPMAX), (const int*)KIN(ka, 2), (const float*)(ws + WS_NEGC), (const float*)KIN(ka, 11) + l * 128, (const unsigned*)((gu32*)(ws + WS_CTL) + CW_KN + l * 64), ((const float*)(ws + WS_LAM))[l], 1.0f - KLAMI(ka, l)};
    attn_queue<VAR>(C, (gu32*)(ws + WS_CTL) + CW_TKT + (l * 16 + q) * 64, lds, wid0, ka, ws, (VAR == VE || gridDim.x == 256) ? -1 : l);
}
}

__global__ void __launch_bounds__(NWAVES * 64, 2) mk_fwd(Args args) {
    extern __shared__ __attribute__((aligned(16))) unsigned char lds_raw[];
    LAS unsigned char* lds = (LAS unsigned char*)lds_raw;
    const int G = gridDim.x, bx = blockIdx.x;
    const int vcu = (G % 8 == 0) ? (bx % 8) * (G / 8) + bx / 8 : bx;
    const int wid0 = __builtin_amdgcn_readfirstlane((int)threadIdx.x >> 6);
    const int gw = vcu * NWAVES + wid0, NGW = G * NWAVES;
    { const int tid = wid0 * 64 + fresh_lane();
      for (int u = tid; u < (LDS_BYTES - LDSCTL_OFF) / 4; u += NWAVES * 64) ((LAS unsigned*)(lds + LDSCTL_OFF))[u] = 0u; }
    __syncthreads();
    volatile LAS unsigned* MISC = (volatile LAS unsigned*)(lds + MISC_OFF);
    XcdBarrier bar = xcd_barrier_post((unsigned*)(args.ws + WS_CTL) + CW_BAR, MISC + 8, wid0);

    {
        const kaptr_t ka = ka_fresh(); unsigned char* ws = KWS(ka);
        const int lane = fresh_lane(), wid = wid0, tid = wid * 64 + lane;
        LAS float* scr = (LAS float*)(lds + RING_OFF + wid * 16640);
        {
            const int l = 0; unsigned char* wl = ws + WS_W;
#define TR_MAT(idx_, K_, N_, NP_, dst_, roff_, gain_) do { const float* s_ = (const float*)KIN(ka, idx_) + (size_t)l * (K_) * (N_); const int nblk_ = (NP_) / 64, nit_ = ((K_) / 64) * nblk_; \
            const float* gk_ = (gain_) >= 0 ? (const float*)KIN(ka, (gain_) >= 0 ? (gain_) : 0) + (size_t)l * (K_) : nullptr; \
            for (int it = gw; it < nit_; it += NGW) tr_item(s_, (K_), (N_), nblk_, (bf16*)(dst_), (roff_), scr, it, lane, gk_); } while (0)
            TR_MAT(4, DM, INC, INP, wl + W_IN, 0, 3);
            TR_MAT(14, QRANK, 1536, 1536, wl + W_UQ, 0, -1);
            TR_MAT(15, KVRANK, 2048, 2048, wl + W_UKV, 0, -1);
            TR_MAT(20, DM, 512, 512, wl + W_MKV, 0, -1);
            TR_MAT(21, DM, 512, 512, wl + W_MKV, 512, -1);
#undef TR_MAT
        }
        { const float* x0 = (const float*)KIN(ka, 0); bf16* H = (bf16*)(ws + WS_H); unsigned long long* SS = (unsigned long long*)((gu32*)(ws + WS_CTL) + CW_SS);
          for (int m = gw; m < M; m += NGW) cast_row(x0 + (size_t)m * DM, H + (size_t)m * DM, SS + m, lane); }
        { const float* mem = (const float*)KIN(ka, 1); bf16* MEMN = (bf16*)(ws + WS_MEMN);
          for (int r = gw; r < NL * NB * MEMT; r += NGW) { const int l = r / (NB * MEMT), mr = r - l * (NB * MEMT);
            rms_row<true>(mem + (size_t)mr * DM, (const float*)KIN(ka, 18) + (size_t)l * DM, MEMN + (size_t)r * DM, lane); } }
        const int* pos = (const int*)KIN(ka, 2);
        float* COS = (float*)(ws + WS_COS); float* SIN = (float*)(ws + WS_SIN); float* LUT = (float*)(ws + WS_LUT); int* TPMAX = (int*)(ws + WS_TPMAX); float* LAM = (float*)(ws + WS_LAM);
        const int gt = vcu * (NWAVES * 64) + tid, NGT = G * NWAVES * 64;
        for (int i = gt; i < M * 32; i += NGT) { const int row = i >> 5, f = i & 31; const float ang = (float)pos[row] * KINVF(ka, f);
            double rv = (double)ang * 0.15915494309189535; rv -= floor(rv); const float fr = (float)rv;
            COS[i] = __builtin_amdgcn_cosf(fr); SIN[i] = __builtin_amdgcn_sinf(fr); }
        for (int i = gt; i < 8 * 132; i += NGT) { const int h = i / 132, dd0 = i - h * 132; const int dd = dd0 > 128 ? 128 : dd0; int bk;
            if (dd < 16) bk = dd; else { bk = 16 + (int)(logf((float)dd / 16.0f) / 2.0794415416798357f * 16.0f); bk = bk > 31 ? 31 : bk; }
            LUT[i] = 8.0f * ((const float*)KIN(ka, 6))[bk * 8 + h]; }
        for (int i = gt; i < NB * 64; i += NGT) { int mx = pos[i * 64];
            for (int k = 1; k < 64; ++k) mx = max(mx, pos[i * 64 + k]);
            TPMAX[i] = mx; }
        if (gt < NL) { const int l = gt; float s1 = 0.f, s2 = 0.f;
            for (int k = 0; k < 64; ++k) { s1 += ((const float*)KIN(ka, 7))[l * 64 + k] * ((const float*)KIN(ka, 8))[l * 64 + k]; s2 += ((const float*)KIN(ka, 9))[l * 64 + k] * ((const float*)KIN(ka, 10))[l * 64 + k]; }
            LAM[l] = expf(s1) - expf(s2) + KLAMI(ka, l); }
    }
    xcd_barrier(bar, wid0);

    for (int l = 0; l < NL; ++l) {
        { const kaptr_t ka = ka_fresh(); unsigned char* ws = KWS(ka); unsigned char* wl = ws + WS_W + (size_t)l * W_LAYER;
          { pg8::Gemm g{(const bf16*)(ws + WS_H), (const bf16*)(wl + W_IN), M, INP, DM}; pg8::StaticOrder S; S.init(M, INP, G, bx);
            pg8::EpiBf16<0, true> E{(bf16*)(ws + WS_PROJ), INP, (const unsigned long long*)((gu32*)(ws + WS_CTL) + CW_SS) + (size_t)(3 * l) * M};
            pg8::gemm_phase<pg8::EpiBf16<0, true>, pg8::StaticOrder, true, true>(lds + RING_OFF, g, S, E, wid0); }
          { pg8::Gemm g{(const bf16*)(ws + WS_MEMN) + (size_t)l * 512 * DM, (const bf16*)(wl + W_MKV), 512, 1024, DM}; pg8::StaticOrder S; S.init(512, 1024, G, G - 1 - bx);
            pg8::EpiBf16<0, false> E{(bf16*)(ws + WS_KVMEM) + (size_t)l * 512 * 1024, 1024, nullptr};
            pg8::gemm_phase<pg8::EpiBf16<0, false>, pg8::StaticOrder, true, true>(lds + RING_OFF, g, S, E, wid0); }
          if (G == 256 && bx >= 160 && bx < 248) {
              const int lane = fresh_lane(); LAS float* scr = (LAS float*)(lds + RING_OFF + wid0 * 16640);
              conv_run(ka, ws, 2 + l, (bx - 160) * NWAVES + wid0, UPDEF, 88 * NWAVES, scr, lane); } }
        xcd_barrier(bar, wid0);
        { const kaptr_t ka = ka_fresh(); unsigned char* ws = KWS(ka); FRESH_LANE(ln);
          for (int m = gw; m < M; m += NGW)
            prep_row((const bf16*)(ws + WS_PROJ), m, (const float*)KIN(ka, 12) + (size_t)l * QRANK, (const float*)KIN(ka, 13) + (size_t)l * KVRANK, (const float*)KIN(ka, 16) + l * 8,
                     (const float*)(ws + WS_COS), (const float*)(ws + WS_SIN), (bf16*)(ws + WS_CQN), (bf16*)(ws + WS_CKVN), (bf16*)(ws + WS_KPE), (float*)(ws + WS_LOGF), (unsigned*)((gu32*)(ws + WS_CTL) + CW_KN + l * 64), ln); }
        xcd_barrier(bar, wid0);
        { const kaptr_t ka = ka_fresh(); unsigned char* ws = KWS(ka); unsigned char* wl = ws + WS_W + (size_t)l * W_LAYER;
          if (gw < 16) { FRESH_LANE(ln); fox_scan((const float*)(ws + WS_LOGF) + (size_t)gw * SEQ, (float*)(ws + WS_NEGC) + (size_t)gw * SEQ, ln); }
          { pg8::Gemm g{(const bf16*)(ws + WS_CQN), (const bf16*)(wl + W_UQ), M, 1536, QRANK}; pg8::StaticOrder S; S.init(M, 1536, G, bx);
            pg8::EpiBf16<0, false> E{(bf16*)(ws + WS_QMLA), 1536, nullptr};
            pg8::gemm_phase<pg8::EpiBf16<0, false>, pg8::StaticOrder, true, true>(lds + RING_OFF, g, S, E, wid0); }
          { pg8::Gemm g{(const bf16*)(ws + WS_CKVN), (const bf16*)(wl + W_UKV), M, 2048, KVRANK}; pg8::StaticOrder S; S.init(M, 2048, G, G - 1 - bx);
            pg8::EpiBf16<0, false> E{(bf16*)(ws + WS_KVMLA), 2048, nullptr};
            pg8::gemm_phase<pg8::EpiBf16<0, false>, pg8::StaticOrder, true, true>(lds + RING_OFF, g, S, E, wid0); }
          if (G == 256 && bx >= 192) {
              const int lane = fresh_lane(); LAS float* scr = (LAS float*)(lds + RING_OFF + wid0 * 16640);
              conv_run(ka, ws, 2 + l, UPDEF + (bx - 192) * NWAVES + wid0, UPDEF + P4DEF, 64 * NWAVES, scr, lane); } }
        xcd_barrier(bar, wid0);
#define CONV_DRAIN(l_) do { const kaptr_t ka = ka_fresh(); unsigned char* ws = KWS(ka); const int lane = fresh_lane(); volatile LAS int* tk = (volatile LAS int*)(lds + LDSCTL_OFF + 16); \
          for (;;) { if (wid0 == 0 && lane == 0) tk[0] = (int)__hip_atomic_fetch_add((gu32*)(ws + WS_CTL) + CW_TKT + ((l_) * 16 + 10) * 64, 1u, RLX_AGENT); \
              WAITBAR(); const int c = __builtin_amdgcn_readfirstlane(tk[0]); WAITBAR(); \
              if (c >= KNCH(ka, (l_))) break; \
              conv_chunk(ka, ws, (l_), c, (LAS float*)(lds + RING_OFF + wid0 * 16640), wid0, lane); } } while (0)
        if (G == 256 && ((bx >> 3) & 3) == 3) CONV_DRAIN(l);
        att::attn_phase<att::VA>(l, 0, lds, wid0);
        att::attn_phase<att::VB>(l, 1, lds, wid0);
        att::attn_phase<att::VD>(l, 2, lds, wid0);
        att::attn_phase<att::VC>(l, 3, lds, wid0);
        CONV_DRAIN(l);
        xcd_barrier(bar, wid0);
        { const kaptr_t ka = ka_fresh(); unsigned char* ws = KWS(ka); unsigned char* wl = ws + WS_W + (size_t)l * W_LAYER;
          pg8::Gemm g{(const bf16*)(ws + WS_MIX), (const bf16*)(wl + W_OUT), M, DM, DM}; pg8::StaticOrder S; S.init(M, DM, G, bx);
          pg8::EpiRes E{(bf16*)(ws + WS_H), DM, (unsigned long long*)((gu32*)(ws + WS_CTL) + CW_SS) + (size_t)(3 * l + 1) * M};
          pg8::gemm_phase<pg8::EpiRes, pg8::StaticOrder, true, true>(lds + RING_OFF, g, S, E, wid0); }
        xcd_barrier(bar, wid0);
        { const kaptr_t ka = ka_fresh(); unsigned char* ws = KWS(ka); unsigned char* wl = ws + WS_W + (size_t)l * W_LAYER;
          pg8::Gemm g{(const bf16*)(ws + WS_H), (const bf16*)(wl + W_MQ), M, 512, DM}; pg8::StaticOrder S; S.init(M, 512, G, bx);
          pg8::EpiBf16<0, true> E{(bf16*)(ws + WS_QMEM), 512, (const unsigned long long*)((gu32*)(ws + WS_CTL) + CW_SS) + (size_t)(3 * l + 1) * M};
          pg8::gemm_phase<pg8::EpiBf16<0, true>, pg8::StaticOrder, true, true>(lds + RING_OFF, g, S, E, wid0);
          if (G == 256 && bx >= 64) {
              const int lane = fresh_lane(); LAS float* scr = (LAS float*)(lds + RING_OFF + wid0 * 16640);
              conv_run(ka, ws, 2 + l, UPDEF + P4DEF + (bx - 64) * NWAVES + wid0, UPDEF + P4DEF + P8DEF, 192 * NWAVES, scr, lane); } }
        xcd_barrier(bar, wid0);
        att::attn_phase<att::VE>(l, 4, lds, wid0);
        xcd_barrier(bar, wid0);
        { const kaptr_t ka = ka_fresh(); unsigned char* ws = KWS(ka); unsigned char* wl = ws + WS_W + (size_t)l * W_LAYER;
          pg8::Gemm g{(const bf16*)(ws + WS_OMEM), (const bf16*)(wl + W_MO), M, DM, 512}; pg8::StaticOrder S; S.init(M, DM, G, bx);
          pg8::EpiRes E{(bf16*)(ws + WS_H), DM, (unsigned long long*)((gu32*)(ws + WS_CTL) + CW_SS) + (size_t)(3 * l + 2) * M};
          pg8::gemm_phase<pg8::EpiRes, pg8::StaticOrder, true, true>(lds + RING_OFF, g, S, E, wid0); }
        xcd_barrier(bar, wid0);
        { const kaptr_t ka = ka_fresh(); unsigned char* ws = KWS(ka); unsigned char* wl = ws + WS_W + (size_t)l * W_LAYER;
          pg8::Gemm g{(const bf16*)(ws + WS_H), (const bf16*)(wl + W_UP), M, DFF, DM}; pg8::StaticOrder S; S.init(M, DFF, G, bx);
          pg8::EpiBf16<1, true> E{(bf16*)(ws + WS_U), DFF, (const unsigned long long*)((gu32*)(ws + WS_CTL) + CW_SS) + (size_t)(3 * l + 2) * M};
          pg8::gemm_phase<pg8::EpiBf16<1, true>, pg8::StaticOrder, true, true>(lds + RING_OFF, g, S, E, wid0); }
        xcd_barrier(bar, wid0);
        { const kaptr_t ka = ka_fresh(); unsigned char* ws = KWS(ka); unsigned char* wl = ws + WS_W + (size_t)l * W_LAYER;
          pg8::Gemm g{(const bf16*)(ws + WS_U), (const bf16*)(wl + W_DN), M, DM, DFF}; pg8::StaticOrder S; S.init(M, DM, G, bx);
          pg8::EpiRes E{(bf16*)(ws + WS_H), DM, (unsigned long long*)((gu32*)(ws + WS_CTL) + CW_SS) + (size_t)(3 * l + 3) * M};
          pg8::gemm_phase<pg8::EpiRes, pg8::StaticOrder, true, true>(lds + RING_OFF, g, S, E, wid0); }
        xcd_barrier(bar, wid0);
    }
    { const kaptr_t ka = ka_fresh(); unsigned char* ws = KWS(ka); FRESH_LANE(ln); float* O = KOUT(ka);
      for (int m = gw; m < M; m += NGW) final_row((const bf16*)(ws + WS_H) + (size_t)m * DM, (const float*)KIN(ka, 26), O + (size_t)m * DM, ln); }
}

extern "C" void kernel_launch(void* const* d_in, const int* in_sizes, int n_in, void* d_out, int out_size, void* d_ws, size_t ws_size, hipStream_t stream) {
    static int grid = 0;
    if (grid == 0) {
        if (n_in != 27 || in_sizes[0] != M * DM || out_size != M * DM || ws_size < WS_END) {
            fprintf(stderr, "kernel_launch: built for 27 inputs, x/out of %d floats, >= %zu bytes of workspace; got n_in %d, in0 %d, out %d, ws %zu; nothing launched\n", M * DM, (size_t)WS_END, n_in, n_in > 0 ? in_sizes[0] : -1, out_size, ws_size);
            grid = -1; return; }
        int dev = 0, cus = 0, per_cu = 0;
        if (hipGetDevice(&dev) != hipSuccess || hipDeviceGetAttribute(&cus, hipDeviceAttributeMultiprocessorCount, dev) != hipSuccess) { fprintf(stderr, "kernel_launch: device query failed\n"); grid = -1; return; }
        if (hipFuncSetAttribute((const void*)mk_fwd, hipFuncAttributeMaxDynamicSharedMemorySize, LDS_BYTES) != hipSuccess) { fprintf(stderr, "kernel_launch: hipFuncSetAttribute failed\n"); grid = -1; return; }
        if (hipOccupancyMaxActiveBlocksPerMultiprocessor(&per_cu, (const void*)mk_fwd, NWAVES * 64, LDS_BYTES) != hipSuccess || per_cu < 1)
            fprintf(stderr, "kernel_launch: note: occupancy query reports %d workgroups per CU\n", per_cu);
        (void)hipGetLastError();
        grid = cus;
    }
    if (grid < 0) return;
    if (hipMemsetAsync((char*)d_ws + WS_CTL, 0, CTL_ZERO_BYTES, stream) != hipSuccess) { fprintf(stderr, "kernel_launch: memset failed\n"); return; }
    Args a; memset(&a, 0, sizeof(a));
    for (int i = 0; i < 27; ++i) a.in[i] = d_in[i];
    a.out = (float*)d_out; a.ws = (unsigned char*)d_ws;
    for (int i = 0; i < 32; ++i) a.inv_freq[i] = (float)pow(10000.0, -(double)i / 32.0);
    for (int l = 0; l < NL; ++l) a.lam_init[l] = (float)(0.8 - 0.6 * exp(-0.3 * (double)l));
    {
        auto put = [&](int t, int idx, int K, int N, int NP, size_t off, int roff, int gain, int lay, int first, int cnt) {
            Cv& c = a.cv[t][a.ncv[t]++]; c.idx = idx; c.K = K; c.N = N; c.NP = NP; c.dst = (long long)(WS_W + (size_t)lay * W_LAYER + off); c.roff = roff; c.gain = gain; c.lay = lay;
            c.first = first; c.cnt = cnt < 0 ? (K / 64) * (NP / 64) - first : cnt; };
        put(0, 5, DM, DM, DM, W_OUT, 0, -1, 0, 0, -1); put(0, 19, DM, 512, 512, W_MQ, 0, 17, 0, 0, -1); put(0, 22, 512, DM, DM, W_MO, 0, -1, 0, 0, -1);
        put(0, 24, DM, DFF, DFF, W_UP, 0, 23, 0, 0, -1); put(0, 25, DFF, DM, DM, W_DN, 0, -1, 0, 0, -1);
        const bool idle = (grid == 256);
        const int te = idle ? 2 : 0, tl = idle ? 3 : 1;
        constexpr int UP2 = UPDEF + P4DEF + P8DEF - (11520 + 576 + 256 + 512 + 512);
        constexpr int DN3 = UPDEF + P4DEF + P8DEF - (16384 - UP2);
        static_assert(UP2 > 0 && UP2 < 16384 && DN3 > 0 && DN3 < 16384, "idle-window split");
        put(te, 4, DM, INC, INP, W_IN, 0, 3, 1, 0, -1); put(te, 14, QRANK, 1536, 1536, W_UQ, 0, -1, 1, 0, -1); put(te, 15, KVRANK, 2048, 2048, W_UKV, 0, -1, 1, 0, -1);
        put(te, 20, DM, 512, 512, W_MKV, 0, -1, 1, 0, -1); put(te, 21, DM, 512, 512, W_MKV, 512, -1, 1, 0, -1);
        put(1, 5, DM, DM, DM, W_OUT, 0, -1, 1, 0, -1); put(1, 19, DM, 512, 512, W_MQ, 0, 17, 1, 0, -1); put(1, 22, 512, DM, DM, W_MO, 0, -1, 1, 0, -1);
        if (idle) { put(2, 24, DM, DFF, DFF, W_UP, 0, 23, 1, 0, UP2); put(3, 24, DM, DFF, DFF, W_UP, 0, 23, 1, UP2, -1); put(3, 25, DFF, DM, DM, W_DN, 0, -1, 1, 0, DN3); put(1, 25, DFF, DM, DM, W_DN, 0, -1, 1, DN3, -1); }
        else { put(1, 24, DM, DFF, DFF, W_UP, 0, 23, 1, 0, -1); put(1, 25, DFF, DM, DM, W_DN, 0, -1, 1, 0, -1); }
        (void)tl;
        for (int t = 0; t < NTB; ++t) { long tot = 0; for (int j = 0; j < a.ncv[t]; ++j) tot += a.cv[t][j].cnt; a.nchunk[t] = (int)((tot + 63) / 64); }
    }
    hipLaunchKernelGGL(mk_fwd, dim3(grid), dim3(NWAVES * 64), LDS_BYTES, stream, a);
    const hipError_t le = hipPeekAtLastError();
    if (le != hipSuccess) fprintf(stderr, "kernel_launch: launch failed: %s\n", hipGetErrorName(le));
}
```

```cpp
#include <hip/hip_runtime.h>
#include <cstdio>
#include <cstdint>
#include <cstring>
#include <cmath>
__device__ __forceinline__ int fresh_lane() { unsigned z = 0u; asm volatile("" : "+v"(z)); return (int)__builtin_amdgcn_mbcnt_hi(~0u, __builtin_amdgcn_mbcnt_lo(~0u, z)); }
namespace pg8 {
#define PG8_LAS __attribute__((address_space(3)))
typedef unsigned short bf16_t;
typedef short bf16x8 __attribute__((ext_vector_type(8)));
typedef float f32x4 __attribute__((ext_vector_type(4)));
typedef unsigned u32x4 __attribute__((ext_vector_type(4)));
constexpr int BM = 256, BK = 64, HALF = 128, HTB = HALF * BK * 2  , STAGE_BYTES = 8 * HTB, NXCD = 8, WGM = 8;

__host__ __device__ __forceinline__ int lds_byte(int r, int c) { const int st = (r >> 4) * 2 + (c >> 5), rr = r & 15, cc = c & 31, ob = rr * 64 + cc * 2; return st * 1024 + (ob ^ (((ob >> 9) & 1) << 5)); }
__host__ __device__ __forceinline__ void stage_rc(int b, int& R, int& C) { const int st = b / 1024, sb = b % 1024, swz = sb ^ (((sb >> 9) & 1) << 5); R = (st >> 1) * 16 + swz / 64; C = (st & 1) * 32 + (swz % 64) / 2; }
__host__ __device__ __forceinline__ int perm32(int rho) { const int n = rho >> 4, i = rho & 15; return 8 * (i >> 2) + 4 * n + (i & 3); }

struct Unit { int pm, pn; };
struct Gemm { const bf16_t* A; const bf16_t* Bt; int M, N, K; };

struct StaticOrder {
    int nM, nN, nwg, G, c;
    __host__ __device__ void init(int M, int N, int G_, int c_) { nM = M / BM; nN = N / BM; nwg = nM * nN; G = G_; c = c_; }
    __host__ __device__ bool next(int i, Unit& u) const {
        const long L = (long)i * G + c; if (L >= nwg) return false;
        int wgid = (int)L; { const int q = nwg / NXCD, r = nwg % NXCD, xcd = wgid % NXCD, off = wgid / NXCD; wgid = (xcd < r ? xcd * (q + 1) : r * (q + 1) + (xcd - r) * q) + off; }
        const int nig = WGM * nN, gid = wgid / nig, fm = gid * WGM, gsz = (nM - fm) < WGM ? (nM - fm) : WGM;
        u.pm = fm + ((wgid % nig) % gsz); u.pn = (wgid % nig) / gsz; return true;
    }
    __device__ __forceinline__ void a_ready(const Unit&) const {}
    __device__ __forceinline__ void done(const Unit&) const {}
};

__device__ __forceinline__ unsigned cvt_pk_bf16(float lo, float hi) { unsigned r; asm volatile("v_cvt_pk_bf16_f32 %0, %1, %2" : "=v"(r) : "v"(lo), "v"(hi)); return r; }
typedef float f32x2 __attribute__((ext_vector_type(2)));
template <int ACT, bool RS> struct EpiBf16 {
    static constexpr bool PERM = true, AFTER_DRAIN = false;
    bf16_t* O; int ldc; const unsigned long long* ss;
    __device__ __forceinline__ void operator()(const f32x4 (&acc)[2][2][4][2], const Unit& u, int wr, int wc, int fr, int fq) const {
        const int row0 = u.pm * BM + wr * 64 + fr, col0 = u.pn * BM + wc * 32 + 8 * fq;
#pragma unroll
        for (int ai = 0; ai < 2; ++ai)
#pragma unroll
            for (int m = 0; m < 4; ++m) { const int row = row0 + ai * HALF + m * 16; bf16_t* rowp = O + (size_t)row * ldc + col0;
                float rs = 1.f; if (RS) rs = 1.0f / sqrtf((float)ss[row] * (1.f / 1048576.f / 4096.f) + 1e-6f);
#pragma unroll
                for (int bj = 0; bj < 2; ++bj) { f32x4 v0 = acc[ai][bj][m][0], v1 = acc[ai][bj][m][1];
                    if (RS) { v0 = v0 * rs; v1 = v1 * rs; }
                    if (ACT == 1) {
#pragma unroll
                        for (int e = 0; e < 4; ++e) { const float a = fmaxf(v0[e], 0.f), b = fmaxf(v1[e], 0.f); v0[e] = a * a; v1[e] = b * b; } }
                    u32x4 w; w.x = cvt_pk_bf16(v0[0], v0[1]); w.y = cvt_pk_bf16(v0[2], v0[3]); w.z = cvt_pk_bf16(v1[0], v1[1]); w.w = cvt_pk_bf16(v1[2], v1[3]);
                    *(u32x4*)(rowp + bj * HALF) = w; } }
    }
};
struct EpiRes {
    static constexpr bool PERM = true, AFTER_DRAIN = false;
    bf16_t* xh; int ldc; unsigned long long* ss;
    __device__ __forceinline__ void operator()(const f32x4 (&acc)[2][2][4][2], const Unit& u, int wr, int wc, int fr, int fq) const {
        const int row0 = u.pm * BM + wr * 64 + fr, col0 = u.pn * BM + wc * 32 + 8 * fq;
#pragma unroll
        for (int ai = 0; ai < 2; ++ai)
#pragma unroll
            for (int m = 0; m < 4; ++m) { const int row = row0 + ai * HALF + m * 16; const size_t off = (size_t)row * ldc + col0; float sq = 0.f;
#pragma unroll
                for (int bj = 0; bj < 2; ++bj) { const u32x4 hv = *(const u32x4*)(xh + off + bj * HALF); u32x4 ho;
#pragma unroll
                    for (int e = 0; e < 4; ++e) { const f32x4& a = acc[ai][bj][m][e >> 1]; const int j = (e & 1) * 2;
                        const float v0 = __uint_as_float(hv[e] << 16) + a[j], v1 = __uint_as_float(hv[e] & 0xffff0000u) + a[j + 1];
                        ho[e] = cvt_pk_bf16(v0, v1); sq += v0 * v0 + v1 * v1; }
                    *(u32x4*)(xh + off + bj * HALF) = ho; }
                sq += __int_as_float(__builtin_amdgcn_ds_swizzle(__float_as_int(sq), 0x1f | (16 << 10)));
                { auto rr = __builtin_amdgcn_permlane32_swap(__float_as_uint(sq), __float_as_uint(sq), false, false); sq = __uint_as_float(rr[0]) + __uint_as_float(rr[1]); }
                if (fq == 0) __hip_atomic_fetch_add(ss + row, (unsigned long long)((double)sq * 1048576.0), __ATOMIC_RELAXED, __HIP_MEMORY_SCOPE_AGENT); }
    }
};
template <class Epi, class Sched, bool ALIGN_EPI = false, bool SP2 = false>
__device__ __forceinline__ void gemm_phase(PG8_LAS unsigned char* lds, const Gemm g, const Sched& S, const Epi& E, const int wid0) {
    int wid_ = wid0; asm volatile("" : "+s"(wid_));
    const int wid = wid_, lane = fresh_lane(), tid = wid * 64 + lane, wr = wid >> 2, wc = wid & 3, fr = lane & 15, fq = lane >> 4;
    const int K = g.K, nt = K / BK;
    unsigned voffA[2], voffB[2];
#pragma unroll
    for (int i = 0; i < 2; ++i) { int R, C; stage_rc(tid * 16 + i * 8192, R, C); const int Rb = Epi::PERM ? ((R & ~31) + perm32(R & 31)) : R;
        voffA[i] = (unsigned)(R * K + C) * 2u; voffB[i] = (unsigned)(Rb * K + C) * 2u; }
    const size_t kstep = (size_t)(BK * 2);
    const size_t hstep = (size_t)HALF * K * 2;
    const size_t tstep = 2 * hstep;
    const unsigned ldsw = (unsigned)wid * 1024u;
    const int aoff = lds_byte(wr * 64 + fr, fq * 8), boff = lds_byte(wc * 32 + fr, fq * 8);
#define PG8_SA(b, h) (((b) * 2 + (h)) * HTB)
#define PG8_SB(b, h) ((4 + (b) * 2 + (h)) * HTB)
#define PG8_STAGE(bufoff, gbase, voff) do { _Pragma("unroll") for (int _i = 0; _i < 2; ++_i) \
        __builtin_amdgcn_global_load_lds((const unsigned*)((const char*)(gbase) + (voff)[_i]), (PG8_LAS unsigned*)(lds + (bufoff) + ldsw + _i * 8192), 16, 0, 0); } while (0)
#define PG8_LDA(dst, b, h) do { _Pragma("unroll") for (int m = 0; m < 4; ++m) _Pragma("unroll") for (int k = 0; k < 2; ++k) dst[m][k] = *(const PG8_LAS bf16x8*)(lds + PG8_SA(b, h) + aoff + m * 2048 + k * 1024); } while (0)
#define PG8_LDB(dst, b, h) do { _Pragma("unroll") for (int n = 0; n < 2; ++n) _Pragma("unroll") for (int k = 0; k < 2; ++k) dst[n][k] = *(const PG8_LAS bf16x8*)(lds + PG8_SB(b, h) + boff + n * 2048 + k * 1024); } while (0)
#define PG8_MMA(ai, bj, At, Bt) do { __builtin_amdgcn_s_setprio(1); _Pragma("unroll") for (int m = 0; m < 4; ++m) _Pragma("unroll") for (int n = 0; n < 2; ++n) _Pragma("unroll") for (int k = 0; k < 2; ++k) \
        acc[ai][bj][m][n] = __builtin_amdgcn_mfma_f32_16x16x32_bf16(Bt[n][k], At[m][k], acc[ai][bj][m][n], 0, 0, 0); __builtin_amdgcn_s_setprio(0); } while (0)
#define PG8_WAIT_V(n) asm volatile("s_waitcnt vmcnt(" #n ")" ::: "memory")
#define PG8_WAIT_L(n) asm volatile("s_waitcnt lgkmcnt(" #n ")" ::: "memory")
#define PG8_BAR __builtin_amdgcn_s_barrier()
#define PG8_SCHED __builtin_amdgcn_sched_barrier(0)
    Unit cur, nxt; int ui = 0;
    if (!S.next(0, cur)) return;
    f32x4 acc[2][2][4][2];
#pragma unroll
    for (int a = 0; a < 2; ++a)
#pragma unroll
        for (int b = 0; b < 2; ++b)
#pragma unroll
            for (int m = 0; m < 4; ++m)
#pragma unroll
                for (int n = 0; n < 2; ++n) acc[a][b][m][n] = (f32x4){0.f, 0.f, 0.f, 0.f};
    bf16x8 At[4][2], B0[2][2], B1[2][2];
    const char* cA = (const char*)g.A + (size_t)cur.pm * tstep; const char* cB = (const char*)g.Bt + (size_t)cur.pn * tstep;
    S.a_ready(cur);
    if constexpr (SP2) {
        PG8_STAGE(PG8_SB(0, 0), cB, voffB); PG8_STAGE(PG8_SB(0, 1), cB + hstep, voffB); PG8_STAGE(PG8_SA(0, 0), cA, voffA); PG8_STAGE(PG8_SA(0, 1), cA + hstep, voffA);
        if (wr == 1) PG8_BAR;
        PG8_WAIT_V(2); PG8_BAR;
        PG8_STAGE(PG8_SB(1, 0), cB + kstep, voffB); PG8_STAGE(PG8_SA(1, 0), cA + kstep, voffA); PG8_STAGE(PG8_SB(1, 1), cB + hstep + kstep, voffB);
        PG8_WAIT_V(6); PG8_BAR;
    } else {
        PG8_STAGE(PG8_SB(0, 0), cB, voffB); PG8_STAGE(PG8_SA(0, 0), cA, voffA); PG8_STAGE(PG8_SB(0, 1), cB + hstep, voffB); PG8_STAGE(PG8_SA(0, 1), cA + hstep, voffA);
        if (wr == 1) PG8_BAR;
        PG8_WAIT_V(4); PG8_BAR;
        PG8_STAGE(PG8_SB(1, 0), cB + kstep, voffB); PG8_STAGE(PG8_SA(1, 0), cA + kstep, voffA); PG8_STAGE(PG8_SB(1, 1), cB + hstep + kstep, voffB);
        PG8_WAIT_V(6); PG8_BAR;
    }
    for (;;) {
        const bool has_next = S.next(ui + 1, nxt);
        const char* nA = has_next ? (const char*)g.A + (size_t)nxt.pm * tstep : cA; const char* nB = has_next ? (const char*)g.Bt + (size_t)nxt.pn * tstep : cB;
        for (int t = 0; t < nt; t += 2) {
            const bool last = (t == nt - 2);
            const char* a1 = cA + (size_t)(t + 1) * kstep;
            const char* a2 = last ? nA : cA + (size_t)(t + 2) * kstep; const char* b2 = last ? nB : cB + (size_t)(t + 2) * kstep;
            const char* a3 = a2 + kstep; const char* b3 = b2 + kstep;
            if (last && has_next) S.a_ready(nxt);
            if constexpr (SP2) {
            PG8_LDB(B0, 0, 0); PG8_LDB(B1, 0, 1); PG8_SCHED; PG8_LDA(At, 0, 0); PG8_STAGE(PG8_SA(1, 1), a1 + hstep, voffA);
            PG8_WAIT_V(8); PG8_WAIT_L(0); PG8_BAR; PG8_MMA(0, 0, At, B0); PG8_MMA(0, 1, At, B1); PG8_BAR; PG8_SCHED;
            PG8_LDA(At, 0, 1); PG8_STAGE(PG8_SB(0, 0), b2, voffB); PG8_STAGE(PG8_SB(0, 1), b2 + hstep, voffB); PG8_STAGE(PG8_SA(0, 0), a2, voffA);
            PG8_WAIT_V(8); PG8_WAIT_L(0); PG8_BAR; PG8_MMA(1, 0, At, B0); PG8_MMA(1, 1, At, B1); PG8_BAR; PG8_SCHED;
            PG8_LDB(B0, 1, 0); PG8_LDB(B1, 1, 1); PG8_SCHED; PG8_LDA(At, 1, 0); PG8_STAGE(PG8_SA(0, 1), a2 + hstep, voffA);
            PG8_WAIT_V(8); PG8_WAIT_L(0); PG8_BAR; PG8_MMA(0, 0, At, B0); PG8_MMA(0, 1, At, B1); PG8_BAR; PG8_SCHED;
            PG8_LDA(At, 1, 1); PG8_STAGE(PG8_SB(1, 0), b3, voffB); PG8_STAGE(PG8_SB(1, 1), b3 + hstep, voffB); PG8_STAGE(PG8_SA(1, 0), a3, voffA);
            PG8_WAIT_V(8); PG8_WAIT_L(0); PG8_BAR; PG8_MMA(1, 0, At, B0); PG8_MMA(1, 1, At, B1); PG8_BAR; PG8_SCHED;
            } else {
            PG8_LDB(B0, 0, 0); PG8_SCHED; PG8_LDA(At, 0, 0); PG8_STAGE(PG8_SA(1, 1), a1 + hstep, voffA);
            PG8_WAIT_L(8); PG8_BAR; PG8_WAIT_L(0); PG8_MMA(0, 0, At, B0); PG8_BAR; PG8_SCHED;
            PG8_LDB(B1, 0, 1); PG8_STAGE(PG8_SB(0, 0), b2, voffB);
            PG8_BAR; PG8_WAIT_L(0); PG8_MMA(0, 1, At, B1); PG8_BAR;
            PG8_LDA(At, 0, 1); PG8_STAGE(PG8_SA(0, 0), a2, voffA);
            PG8_BAR; PG8_WAIT_L(0); PG8_MMA(1, 0, At, B0); PG8_BAR; PG8_SCHED;
            PG8_STAGE(PG8_SB(0, 1), b2 + hstep, voffB);
            PG8_WAIT_V(6); PG8_BAR; PG8_MMA(1, 1, At, B1); PG8_BAR;
            PG8_LDB(B0, 1, 0); PG8_SCHED; PG8_LDA(At, 1, 0); PG8_STAGE(PG8_SA(0, 1), a2 + hstep, voffA);
            PG8_WAIT_L(8); PG8_BAR; PG8_WAIT_L(0); PG8_MMA(0, 0, At, B0); PG8_BAR; PG8_SCHED;
            PG8_LDB(B1, 1, 1); PG8_STAGE(PG8_SB(1, 0), b3, voffB);
            PG8_BAR; PG8_WAIT_L(0); PG8_MMA(0, 1, At, B1); PG8_BAR;
            PG8_LDA(At, 1, 1); PG8_STAGE(PG8_SA(1, 0), a3, voffA);
            PG8_BAR; PG8_WAIT_L(0); PG8_MMA(1, 0, At, B0); PG8_BAR; PG8_SCHED;
            PG8_STAGE(PG8_SB(1, 1), b3 + hstep, voffB);
            PG8_WAIT_V(6); PG8_BAR; PG8_MMA(1, 1, At, B1); PG8_BAR;
            }
        }
        if constexpr (ALIGN_EPI) { if (wr == 0) PG8_BAR; }
        if constexpr (!Epi::AFTER_DRAIN) { E(acc, cur, wr, wc, fr, fq); S.done(cur); }
        if (!has_next) break;
#pragma unroll
        for (int a = 0; a < 2; ++a)
#pragma unroll
            for (int b = 0; b < 2; ++b)
#pragma unroll
                for (int m = 0; m < 4; ++m)
#pragma unroll
                    for (int n = 0; n < 2; ++n) acc[a][b][m][n] = (f32x4){0.f, 0.f, 0.f, 0.f};
        cur = nxt; cA = nA; cB = nB; ++ui;
        if constexpr (ALIGN_EPI) { if (wr == 1) PG8_BAR; }
    }
    PG8_WAIT_V(0);
    if constexpr (!ALIGN_EPI) { if (wr == 0) PG8_BAR; }
    PG8_BAR;
    if constexpr (Epi::AFTER_DRAIN) { E.fused(acc, cur, wr, wc, fr, fq, lds, wid, lane); S.done(cur); }
#undef PG8_SA
#undef PG8_SB
#undef PG8_STAGE
#undef PG8_LDA
#undef PG8_LDB
#undef PG8_MMA
#undef PG8_WAIT_V
#undef PG8_WAIT_L
#undef PG8_BAR
#undef PG8_SCHED
}
}
#define GAS __attribute__((address_space(1)))
#define LAS __attribute__((address_space(3)))
typedef unsigned short bf16;
typedef unsigned v4u __attribute__((ext_vector_type(4)));
typedef float f32x4 __attribute__((ext_vector_type(4)));
typedef short bf16x8 __attribute__((ext_vector_type(8)));
typedef GAS unsigned gu32;
typedef GAS unsigned long long gu64;
#define RLX_AGENT __ATOMIC_RELAXED, __HIP_MEMORY_SCOPE_AGENT
#define LDS_WAIT() asm volatile("s_waitcnt lgkmcnt(0)" ::: "memory")
#define VM_WAIT() asm volatile("s_waitcnt vmcnt(0)" ::: "memory")
__device__ __forceinline__ unsigned long long rt() { return __builtin_amdgcn_s_memrealtime(); }
__device__ __forceinline__ unsigned f2bf(float f) { unsigned u = __builtin_bit_cast(unsigned, f); return (u + 0x7fffu + ((u >> 16) & 1u)) >> 16; }
__device__ __forceinline__ unsigned pk2(float lo, float hi) { return f2bf(lo) | (f2bf(hi) << 16); }

#define XB_TMO      128
#define XB_XCNT(j)  (256  + 64 * (j))
#define XB_XSUB(j)  (1280 + 64 * (j))
#define XB_XGEN(j)  (2304 + 64 * (j))
#define XB_TOP      3328
#define XB_TOPGEN   3392
#define XCD_BAR_WORDS 3456
#define XB_SPIN_CAP (1u << 18)

__device__ __forceinline__ unsigned xb_ld(unsigned* p)              { return __hip_atomic_load(p, __ATOMIC_RELAXED, __HIP_MEMORY_SCOPE_AGENT); }
__device__ __forceinline__ unsigned xb_add(unsigned* p, unsigned v) { return __hip_atomic_fetch_add(p, v, __ATOMIC_RELAXED, __HIP_MEMORY_SCOPE_AGENT); }
__device__ __forceinline__ unsigned xb_xcc_id() { return (unsigned)__builtin_amdgcn_s_getreg((3 << 11) | 20) & 0xFu; }
#define XB_SPIN(cond, bar) do { unsigned _sp = 0; while (cond) { __builtin_amdgcn_s_sleep(1); \
    if ((++_sp & 255u) == 0u) { if (xb_ld(&(bar)[XB_TMO])) break; if (_sp > XB_SPIN_CAP) { atomicAdd(&(bar)[XB_TMO], 1u); break; } } } } while (0)

struct XcdBarrier {
    unsigned* bar; unsigned x;
    volatile LAS unsigned* st;
};

__device__ __forceinline__ XcdBarrier xcd_barrier_post(unsigned* bar, volatile LAS unsigned* st, const int wid0) {
    XcdBarrier b; b.bar = bar; b.x = xb_xcc_id(); b.st = st;
    if (wid0 == 0 && fresh_lane() == 0) (void)xb_add(&bar[XB_XCNT(b.x)], 1u);
    return b;
}
__device__ __forceinline__ void xcd_barrier_complete(unsigned* bar, unsigned x, unsigned& nloc, unsigned& nx) {
    const unsigned G = gridDim.x * gridDim.y * gridDim.z;
    unsigned sum, cnt, mine, sp = 0u;
    for (;;) {
        sum = 0u; cnt = 0u; mine = 0u;
#pragma unroll 1
        for (unsigned j = 0; j < 16; ++j) { const unsigned c = xb_ld(&bar[XB_XCNT(j)]); sum += c; cnt += (c > 0u) ? 1u : 0u; mine = (j == x) ? c : mine; }
        if (sum == G) break;
        __builtin_amdgcn_s_sleep(1);
        if ((++sp & 255u) == 0u) { if (xb_ld(&bar[XB_TMO])) break; if (sp > XB_SPIN_CAP) { atomicAdd(&bar[XB_TMO], 1u); break; } }
    }
    nloc = mine > 0u ? mine : 1u; nx = cnt > 0u ? cnt : 1u;
}

__device__ __forceinline__ void xcd_barrier(const XcdBarrier& b, const int wid0) {
    asm volatile("s_waitcnt vmcnt(0)" ::: "memory");
    __syncthreads();
    if (wid0 == 0 && fresh_lane() == 0) {
        unsigned* bar = b.bar;
        __builtin_amdgcn_s_waitcnt(0);
        unsigned nloc = b.st[0], nx = b.st[1];
        const unsigned bx_ = xb_xcc_id();
        if (nloc == 0u) { xcd_barrier_complete(bar, bx_, nloc, nx); b.st[0] = nloc; b.st[1] = nx; }
        const unsigned old = xb_add(&bar[XB_XSUB(bx_)], 1u);
        const unsigned gen = old / nloc;
        if (old + 1u == (gen + 1u) * nloc) {
            __builtin_amdgcn_fence(__ATOMIC_RELEASE, "agent");
            asm volatile("s_waitcnt vmcnt(0)" ::: "memory");
            const unsigned og = xb_add(&bar[XB_TOP], 1u);
            const unsigned tg = og / nx;
            if (og + 1u == (tg + 1u) * nx) xb_add(&bar[XB_TOPGEN], 1u);
            else XB_SPIN(xb_ld(&bar[XB_TOPGEN]) == tg, bar);
            __builtin_amdgcn_fence(__ATOMIC_ACQUIRE, "agent");
            xb_add(&bar[XB_XGEN(bx_)], 1u);
            asm volatile("s_waitcnt vmcnt(0)" ::: "memory");
        } else {
            XB_SPIN(xb_ld(&bar[XB_XGEN(bx_)]) == gen, bar);
            __builtin_amdgcn_fence(__ATOMIC_ACQUIRE, "agent");
            asm volatile("s_waitcnt vmcnt(0)" ::: "memory");
        }
    }
    __syncthreads();
}
constexpr int NWAVES = 8;
constexpr int NB = 2, SEQ = 4096, DM = 4096, NL = 2, M = NB * SEQ;
constexpr int INC = 11336, INP = 11520;
constexpr int A_Q = 0, B_CQ = 3072, B_CKV = 4608, B_KR = 5120, C_Q = 5184, D_Q = 8256, D_F = 11328;
constexpr int QRANK = 1536, KVRANK = 512, DFF = 16384, MEMT = 256;
constexpr int P4DEF = 64 * 8 * 4;
constexpr int P8DEF = 8192;
constexpr int UPDEF = 88 * 8 * 8;
constexpr float EPS = 1e-6f;

constexpr size_t MiB = 1u << 20;
constexpr size_t WS_CTL = 0, CTL_ZERO_BYTES = 1 * MiB;
constexpr size_t WS_COS = 1 * MiB, WS_SIN = 2 * MiB;
constexpr size_t WS_LUT = 3 * MiB;
constexpr size_t WS_TPMAX = 3 * MiB + 8192;
constexpr size_t WS_LAM = 3 * MiB + 12288;
constexpr size_t WS_LOGF = 4 * MiB, WS_NEGC = 4 * MiB + 512 * 1024;
constexpr size_t WS_W = 8 * MiB;
constexpr size_t SZ_IN = (size_t)INP * DM * 2, SZ_OUT = (size_t)DM * DM * 2, SZ_UQ = (size_t)1536 * 1536 * 2, SZ_UKV = (size_t)2048 * 512 * 2,
                 SZ_MQ = (size_t)512 * DM * 2, SZ_MKV = (size_t)1024 * DM * 2, SZ_MO = (size_t)DM * 512 * 2, SZ_UP = (size_t)DFF * DM * 2, SZ_DN = SZ_UP;
constexpr size_t W_IN = 0, W_OUT = W_IN + SZ_IN, W_UQ = W_OUT + SZ_OUT, W_UKV = W_UQ + SZ_UQ, W_MQ = W_UKV + SZ_UKV, W_MKV = W_MQ + SZ_MQ, W_MO = W_MKV + SZ_MKV,
                 W_UP = W_MO + SZ_MO, W_DN = W_UP + SZ_UP, W_LAYER = W_DN + SZ_DN;
static_assert(W_LAYER % 256 == 0, "weight block alignment");
constexpr size_t WS_MEMN = WS_W + NL * W_LAYER;
constexpr size_t WS_KVMEM = WS_MEMN + (size_t)NL * 512 * DM * 2;
constexpr size_t WS_H = WS_KVMEM + (size_t)NL * 512 * 1024 * 2;
constexpr size_t WS_CQN = WS_H + (size_t)M * DM * 2;
constexpr size_t WS_CKVN = WS_CQN + (size_t)M * 1536 * 2;
constexpr size_t WS_KPE = WS_CKVN + (size_t)M * 512 * 2;
constexpr size_t WS_QMLA = WS_KPE + (size_t)M * 64 * 2;
constexpr size_t WS_KVMLA = WS_QMLA + (size_t)M * 1536 * 2;
constexpr size_t WS_QMEM = WS_KVMLA + (size_t)M * 2048 * 2;
constexpr size_t WS_OMEM = WS_QMEM + (size_t)M * 512 * 2;
constexpr size_t WS_XL = WS_OMEM + (size_t)M * 512 * 2;
constexpr size_t WS_U = WS_XL + (size_t)M * DM * 2;
constexpr size_t WS_PROJ = WS_U;
constexpr size_t WS_MIX = WS_PROJ + (size_t)M * INP * 2;
static_assert(WS_MIX + (size_t)M * DM * 2 <= WS_U + (size_t)M * DFF * 2, "PROJ + MIX fit inside U");
constexpr size_t WS_END = WS_U + (size_t)M * DFF * 2;
constexpr int CW_BAR = 4096;
constexpr int CW_SS = 32768;
constexpr int CW_KN = 24576;
constexpr int CW_TKT = 16384;

constexpr int RING_OFF = 0, RING_BYTES = 137216;
constexpr int LDSCTL_OFF = RING_BYTES, MISC_OFF = LDSCTL_OFF + 320;
constexpr int KNL_OFF = MISC_OFF + 128;
constexpr int LDS_BYTES = 147456;

typedef unsigned short bf16;
typedef short bf16x8 __attribute__((ext_vector_type(8)));
typedef short s16x4 __attribute__((ext_vector_type(4)));
typedef float f32x4 __attribute__((ext_vector_type(4)));
typedef float f32x16 __attribute__((ext_vector_type(16)));
typedef unsigned v4u __attribute__((ext_vector_type(4)));
typedef unsigned v2u __attribute__((ext_vector_type(2)));
typedef int i32x4 __attribute__((ext_vector_type(4)));

__device__ __forceinline__ unsigned cvtpk(float lo, float hi) { unsigned r; asm volatile("v_cvt_pk_bf16_f32 %0, %1, %2" : "=v"(r) : "v"(lo), "v"(hi)); return r; }
__device__ __forceinline__ float bf2f(short s) { return __uint_as_float(((unsigned)(unsigned short)s) << 16); }
template <int X> __device__ __forceinline__ float shx(float v) { return __int_as_float(__builtin_amdgcn_ds_swizzle(__float_as_int(v), 0x1f | (X << 10))); }
template <int X> __device__ __forceinline__ int shxi(int v) { return __builtin_amdgcn_ds_swizzle(v, 0x1f | (X << 10)); }
__device__ __forceinline__ float half_sum(float v) { v += shx<1>(v); v += shx<2>(v); v += shx<4>(v); v += shx<8>(v); v += shx<16>(v); return v; }
__device__ __forceinline__ float wave_sum(float v) { v = half_sum(v);
    auto rr = __builtin_amdgcn_permlane32_swap(__float_as_uint(v), __float_as_uint(v), false, false); return __uint_as_float(rr[0]) + __uint_as_float(rr[1]); }
#define FRESH_LANE(name) const int name = fresh_lane()
#define WAITBAR() asm volatile("s_waitcnt vmcnt(0) lgkmcnt(0)\n\ts_barrier" ::: "memory")

__device__ __forceinline__ void tr_item(const float* W, int K, int N, int nblk, bf16* WT, int row_off, LAS float* scr, int item, int lane, const float* gk) {
    const int kb = item / nblk, nb = item - kb * nblk, k0 = 64 * kb, n0 = 64 * nb;
    const int c4 = (lane & 15) * 4, rr = lane >> 4; const bool ok = n0 + c4 < N;
    const GAS f32x4* src = (const GAS f32x4*)(W + (size_t)(k0 + rr) * N + n0 + c4);
    f32x4 v[16];
#pragma unroll
    for (int i = 0; i < 16; ++i) v[i] = ok ? __builtin_nontemporal_load((const GAS f32x4*)((const GAS float*)src + (size_t)(4 * i) * N)) : (f32x4){0.f, 0.f, 0.f, 0.f};
    if (gk) {
#pragma unroll
        for (int i = 0; i < 16; ++i) v[i] = v[i] * gk[k0 + 4 * i + rr]; }
#pragma unroll
    for (int i = 0; i < 16; ++i) { LAS float* s = scr + (4 * i + rr) * 65 + c4; s[0] = v[i].x; s[1] = v[i].y; s[2] = v[i].z; s[3] = v[i].w; }
    LDS_WAIT(); asm volatile("" ::: "memory");
    const int c = lane & 7;
#pragma unroll
    for (int j = 0; j < 8; ++j) { const int nn = (lane >> 3) + 8 * j; const LAS float* s = scr + (8 * c) * 65 + nn;
        v4u o; o.x = cvtpk(s[0 * 65], s[1 * 65]); o.y = cvtpk(s[2 * 65], s[3 * 65]); o.z = cvtpk(s[4 * 65], s[5 * 65]); o.w = cvtpk(s[6 * 65], s[7 * 65]);
        *(GAS v4u*)(WT + (size_t)(row_off + n0 + nn) * K + k0 + 8 * c) = o; }
    LDS_WAIT(); asm volatile("" ::: "memory");
}
template <bool BF> __device__ __forceinline__ void rms_row(const float* xrow, const float* g, void* orow, int lane) {
    const GAS f32x4* xr = (const GAS f32x4*)xrow + lane; const GAS f32x4* gr = (const GAS f32x4*)g + lane;
    f32x4 v[16]; float s = 0.f;
#pragma unroll
    for (int j = 0; j < 16; ++j) { v[j] = xr[64 * j]; s += (v[j].x * v[j].x + v[j].y * v[j].y) + (v[j].z * v[j].z + v[j].w * v[j].w); }
    const float rstd = 1.0f / sqrtf(wave_sum(s) * (1.f / DM) + EPS);
#pragma unroll
    for (int j = 0; j < 16; ++j) { const f32x4 gg = gr[64 * j]; const f32x4 y = v[j] * rstd * gg;
        if (BF) { v2u w; w.x = cvtpk(y.x, y.y); w.y = cvtpk(y.z, y.w); ((GAS v2u*)orow)[64 * j + lane] = w; }
        else ((GAS f32x4*)orow)[64 * j + lane] = y; }
}
__device__ __forceinline__ void cast_row(const float* xrow, bf16* hrow, unsigned long long* ss, int lane) {
    const GAS f32x4* xr = (const GAS f32x4*)xrow + lane; float s = 0.f;
#pragma unroll
    for (int j = 0; j < 16; ++j) { const f32x4 v = xr[64 * j]; s += (v.x * v.x + v.y * v.y) + (v.z * v.z + v.w * v.w);
        v2u h; h.x = cvtpk(v.x, v.y); h.y = cvtpk(v.z, v.w); ((GAS v2u*)hrow)[64 * j + lane] = h; }
    s = wave_sum(s); if (lane == 0) *ss = (unsigned long long)((double)s * 1048576.0);
}
__device__ __forceinline__ void final_row(const bf16* hrow, const float* g, float* orow, int lane) {
    f32x4 v[16]; float s = 0.f;
#pragma unroll
    for (int j = 0; j < 16; ++j) { const v2u h = ((const GAS v2u*)hrow)[64 * j + lane];
        v[j].x = __uint_as_float(h.x << 16); v[j].y = __uint_as_float(h.x & 0xffff0000u); v[j].z = __uint_as_float(h.y << 16); v[j].w = __uint_as_float(h.y & 0xffff0000u);
        s += (v[j].x * v[j].x + v[j].y * v[j].y) + (v[j].z * v[j].z + v[j].w * v[j].w); }
    const float rstd = 1.0f / sqrtf(wave_sum(s) * (1.f / DM) + EPS);
#pragma unroll
    for (int j = 0; j < 16; ++j) { const f32x4 gg = ((const GAS f32x4*)g)[64 * j + lane]; ((GAS f32x4*)orow)[64 * j + lane] = v[j] * rstd * gg; }
}
__device__ __forceinline__ float logsigmoidf_(float x) {
    const float e = __expf(-fabsf(x)); return fminf(x, 0.f) - __logf(1.f + e);
}
__device__ __forceinline__ void prep_row(const bf16* proj, int m, const float* gq, const float* gkv, const float* bf, const float* COS, const float* SIN,
                                         bf16* CQN, bf16* CKVN, bf16* KPE, float* LOGF, LAS unsigned* KNL, int lane) {
    const bf16* pr = proj + (size_t)m * INP;
    bf16x8 q[3]; float sq = 0.f;
#pragma unroll
    for (int j = 0; j < 3; ++j) { q[j] = *(const GAS bf16x8*)(pr + B_CQ + (j * 64 + lane) * 8);
#pragma unroll
        for (int e = 0; e < 8; ++e) { const float f = bf2f(q[j][e]); sq += f * f; } }
    const bf16x8 kv = *(const GAS bf16x8*)(pr + B_CKV + lane * 8); float skv = 0.f;
#pragma unroll
    for (int e = 0; e < 8; ++e) { const float f = bf2f(kv[e]); skv += f * f; }
    const float rq = 1.0f / sqrtf(wave_sum(sq) * (1.f / QRANK) + EPS), rkv = 1.0f / sqrtf(wave_sum(skv) * (1.f / KVRANK) + EPS);
#pragma unroll
    for (int j = 0; j < 3; ++j) { const int c0 = (j * 64 + lane) * 8; const f32x4 g0 = *(const GAS f32x4*)(gq + c0), g1 = *(const GAS f32x4*)(gq + c0 + 4);
        v4u w; w.x = cvtpk(bf2f(q[j][0]) * rq * g0.x, bf2f(q[j][1]) * rq * g0.y); w.y = cvtpk(bf2f(q[j][2]) * rq * g0.z, bf2f(q[j][3]) * rq * g0.w);
        w.z = cvtpk(bf2f(q[j][4]) * rq * g1.x, bf2f(q[j][5]) * rq * g1.y); w.w = cvtpk(bf2f(q[j][6]) * rq * g1.z, bf2f(q[j][7]) * rq * g1.w);
        *(GAS v4u*)(CQN + (size_t)m * QRANK + c0) = w; }
    { const int c0 = lane * 8; const f32x4 g0 = *(const GAS f32x4*)(gkv + c0), g1 = *(const GAS f32x4*)(gkv + c0 + 4);
        v4u w; w.x = cvtpk(bf2f(kv[0]) * rkv * g0.x, bf2f(kv[1]) * rkv * g0.y); w.y = cvtpk(bf2f(kv[2]) * rkv * g0.z, bf2f(kv[3]) * rkv * g0.w);
        w.z = cvtpk(bf2f(kv[4]) * rkv * g1.x, bf2f(kv[5]) * rkv * g1.y); w.w = cvtpk(bf2f(kv[6]) * rkv * g1.z, bf2f(kv[7]) * rkv * g1.w);
        *(GAS v4u*)(CKVN + (size_t)m * KVRANK + c0) = w; }
    { const float v = bf2f((short)pr[B_KR + lane]); float pv; { auto rr = __builtin_amdgcn_permlane32_swap(__float_as_uint(v), __float_as_uint(v), false, false); pv = __uint_as_float(lane >= 32 ? rr[0] : rr[1]); } const int i = lane & 31;
      const float c = COS[(size_t)m * 32 + i], s = SIN[(size_t)m * 32 + i];
      const float o = lane < 32 ? v * c - pv * s : pv * s + v * c;
      const float on = shx<1>(o);
      if ((lane & 1) == 0) *(GAS unsigned*)(KPE + (size_t)m * 64 + lane) = cvtpk(o, on); }
    if (lane < 8) { const float f = bf2f((short)pr[D_F + lane]) + bf[lane]; const int b = m / SEQ, s = m - b * SEQ; LOGF[(size_t)(b * 8 + lane) * SEQ + s] = logsigmoidf_(f); }
    { const bf16x8 k0 = *(const GAS bf16x8*)(pr + D_Q + 1024 + lane * 16), k1 = *(const GAS bf16x8*)(pr + D_Q + 1024 + lane * 16 + 8); float s = 0.f;
#pragma unroll
      for (int e = 0; e < 8; ++e) { const float a = bf2f(k0[e]), c = bf2f(k1[e]); s += a * a + c * c; }
      s += shx<1>(s); s += shx<2>(s); s += shx<4>(s);
      if ((lane & 7) == 0) __hip_atomic_fetch_max(KNL + (m / SEQ) * 8 + (lane >> 3), __float_as_uint(s), __ATOMIC_RELAXED, __HIP_MEMORY_SCOPE_WORKGROUP); }
}
__device__ __forceinline__ void fox_scan(const float* logf, float* negc, int lane) {
    const GAS f32x4* src = (const GAS f32x4*)(logf + lane * 64); f32x4 v[16]; float tot = 0.f;
#pragma unroll
    for (int j = 0; j < 16; ++j) { v[j] = src[j]; tot += (v[j].x + v[j].y) + (v[j].z + v[j].w); }
    float inc = tot;
#pragma unroll
    for (int o = 1; o < 64; o <<= 1) { const float t = __int_as_float(__builtin_amdgcn_ds_bpermute((lane - o) << 2, __float_as_int(inc))); if (lane >= o) inc += t; }
    float run = inc - tot; const float k = -11.313708498984761f;
    GAS f32x4* dst = (GAS f32x4*)(negc + lane * 64);
#pragma unroll
    for (int j = 0; j < 16; ++j) { f32x4 o; run += v[j].x; o.x = run * k; run += v[j].y; o.y = run * k; run += v[j].z; o.z = run * k; run += v[j].w; o.w = run * k; dst[j] = o; }
}

struct Cv { int idx, K, N, NP; long long dst; int roff, gain, lay, first, cnt, pad; };
constexpr int NCV = 12;
constexpr int NTB = 4;
struct Args { const void* in[27]; float* out; unsigned char* ws; float inv_freq[32]; float lam_init[2]; Cv cv[NTB][NCV]; int ncv[NTB]; int nchunk[NTB]; };
static_assert(sizeof(Cv) == 48 && sizeof(Args) == 27 * 8 + 16 + 128 + 8 + NTB * NCV * 48 + 8 * NTB, "Args has no padding");
typedef const unsigned char __attribute__((address_space(4)))* kaptr_t;
__device__ __forceinline__ kaptr_t ka_fresh() { kaptr_t p = (kaptr_t)__builtin_amdgcn_kernarg_segment_ptr(); asm volatile("" : "+s"(p)); return p; }
#define KIN(ka, i) (*(const void* const __attribute__((address_space(4)))*)((ka) + 8 * (i)))
#define KOUT(ka) ((float*)KIN(ka, 27))
#define KWS(ka) ((unsigned char*)KIN(ka, 28))
#define KINVF(ka, i) (*(const float __attribute__((address_space(4)))*)((ka) + 232 + 4 * (i)))
#define KLAMI(ka, l) (*(const float __attribute__((address_space(4)))*)((ka) + 360 + 4 * (l)))
#define KCVI(ka, l, j, f) (*(const int __attribute__((address_space(4)))*)((ka) + 368 + ((l) * NCV + (j)) * 48 + 4 * (f)))
#define KCVD(ka, l, j) (*(const long long __attribute__((address_space(4)))*)((ka) + 368 + ((l) * NCV + (j)) * 48 + 16))
#define KNCV(ka, l) (*(const int __attribute__((address_space(4)))*)((ka) + 368 + NTB * NCV * 48 + 4 * (l)))
#define KNCH(ka, l) (*(const int __attribute__((address_space(4)))*)((ka) + 368 + NTB * NCV * 48 + 4 * NTB + 4 * (l)))
__device__ __forceinline__ void conv_item(const kaptr_t ka, unsigned char* ws, int t, int it, LAS float* scr, int lane) {
    const int n = KNCV(ka, t); int rem = it, j = 0;
    for (; j < n; ++j) { const int cnt = KCVI(ka, t, j, 10); if (rem < cnt) break; rem -= cnt; }
    if (j >= n) return;
    const int idx = KCVI(ka, t, j, 0), K = KCVI(ka, t, j, 1), N = KCVI(ka, t, j, 2), NP = KCVI(ka, t, j, 3), roff = KCVI(ka, t, j, 6), gain = KCVI(ka, t, j, 7), lay = KCVI(ka, t, j, 8), first = KCVI(ka, t, j, 9);
    const float* gk = nullptr; if (gain >= 0) gk = (const float*)KIN(ka, gain) + (size_t)lay * K;
    tr_item((const float*)KIN(ka, idx) + (size_t)lay * K * N, K, N, NP / 64, (bf16*)(ws + KCVD(ka, t, j)), roff, scr, first + rem, lane, gk);
}
struct CvD { const float* W; bf16* WT; const float* gk; int K, N, nblk, roff, item; };
struct TrBuf { f32x4 v[16]; f32x4 g0, g1; };
__device__ __forceinline__ bool cv_desc(const kaptr_t ka, unsigned char* ws, int t, int it, CvD& d) {
    const int n = KNCV(ka, t); int rem = it, j = 0;
    for (; j < n; ++j) { const int cnt = KCVI(ka, t, j, 10); if (rem < cnt) break; rem -= cnt; }
    if (j >= n) return false;
    const int idx = KCVI(ka, t, j, 0), K = KCVI(ka, t, j, 1), N = KCVI(ka, t, j, 2), NP = KCVI(ka, t, j, 3), gain = KCVI(ka, t, j, 7), lay = KCVI(ka, t, j, 8);
    d.gk = nullptr; if (gain >= 0) d.gk = (const float*)KIN(ka, gain) + (size_t)lay * K;
    d.W = (const float*)KIN(ka, idx) + (size_t)lay * K * N; d.WT = (bf16*)(ws + KCVD(ka, t, j)); d.K = K; d.N = N; d.nblk = NP / 64; d.roff = KCVI(ka, t, j, 6); d.item = KCVI(ka, t, j, 9) + rem;
    return true;
}
__device__ __forceinline__ void tr_load(const CvD& d, int lane, TrBuf& b) {
    const int kb = d.item / d.nblk, nb = d.item - kb * d.nblk, k0 = 64 * kb, n0 = 64 * nb;
    const int c4 = (lane & 15) * 4, rr = lane >> 4; const bool ok = n0 + c4 < d.N;
    const GAS float* src = (const GAS float*)(d.W + (size_t)(k0 + rr) * d.N + n0 + c4);
#pragma unroll
    for (int i = 0; i < 16; ++i) b.v[i] = ok ? __builtin_nontemporal_load((const GAS f32x4*)(src + (size_t)(4 * i) * d.N)) : (f32x4){0.f, 0.f, 0.f, 0.f};
    b.g0 = (f32x4){1.f, 1.f, 1.f, 1.f}; b.g1 = b.g0;
    if (d.gk) { const GAS f32x4* gp = (const GAS f32x4*)(d.gk + k0 + 8 * (lane & 7)); b.g0 = gp[0]; b.g1 = gp[1]; }
}
__device__ __forceinline__ void tr_fin(const CvD& d, const TrBuf& b, LAS float* scr, int lane) {
    const int kb = d.item / d.nblk, nb = d.item - kb * d.nblk, k0 = 64 * kb, n0 = 64 * nb;
    const int c4 = (lane & 15) * 4, rr = lane >> 4;
#pragma unroll
    for (int i = 0; i < 16; ++i) { LAS float* s = scr + (4 * i + rr) * 65 + c4; s[0] = b.v[i].x; s[1] = b.v[i].y; s[2] = b.v[i].z; s[3] = b.v[i].w; }
    LDS_WAIT(); asm volatile("" ::: "memory");
    const int c = lane & 7;
#pragma unroll
    for (int j = 0; j < 8; ++j) { const int nn = (lane >> 3) + 8 * j; const LAS float* s = scr + (8 * c) * 65 + nn;
        v4u o; o.x = cvtpk(s[0 * 65] * b.g0.x, s[1 * 65] * b.g0.y); o.y = cvtpk(s[2 * 65] * b.g0.z, s[3 * 65] * b.g0.w); o.z = cvtpk(s[4 * 65] * b.g1.x, s[5 * 65] * b.g1.y); o.w = cvtpk(s[6 * 65] * b.g1.z, s[7 * 65] * b.g1.w);
        *(GAS v4u*)(d.WT + (size_t)(d.roff + n0 + nn) * d.K + k0 + 8 * c) = o; }
    LDS_WAIT(); asm volatile("" ::: "memory");
}
__device__ __forceinline__ void conv_run(const kaptr_t ka, unsigned char* ws, int t, int it0, int end, int st, LAS float* scr, int lane) {
    TrBuf b0, b1; int it = it0;
    bool h0; { CvD d; h0 = it < end && cv_desc(ka, ws, t, it, d); if (h0) tr_load(d, lane, b0); }
    while (h0) {
        bool h1; { CvD d; h1 = it + st < end && cv_desc(ka, ws, t, it + st, d); if (h1) tr_load(d, lane, b1); }
        { CvD d; cv_desc(ka, ws, t, it, d); tr_fin(d, b0, scr, lane); }
        if (!h1) break;
        it += st;
        { CvD d; h0 = it + st < end && cv_desc(ka, ws, t, it + st, d); if (h0) tr_load(d, lane, b0); }
        { CvD d; cv_desc(ka, ws, t, it, d); tr_fin(d, b1, scr, lane); }
        it += st;
    }
}
__device__ __forceinline__ void conv_chunk(const kaptr_t ka, unsigned char* ws, int l, int c, LAS float* scr, int wid, int lane) {
    conv_run(ka, ws, l, c * 64 + wid * 8, c * 64 + wid * 8 + 8, 1, scr, lane);
}

namespace att {
constexpr int VA = 0, VB = 1, VC = 2, VD = 3, VE = 4;
constexpr int K_OFF = 0, V_OFF = 32768, B_OFF = 65536, WS_OFF = 67584, LUT_OFF = 69632, FLG_OFF = 70656, TKT_OFF = 70784, KPE_OFF = 71680, QF_OFF = 71680, ATT_END = QF_OFF + 65536;
constexpr float LOG2E = 1.4426950408889634f, LN2 = 0.6931471805599453f, THR = 8.f;
struct Ctx { const bf16* PROJ; const bf16* QMLA; const bf16* KVMLA; const bf16* KPE; bf16* MIX; const bf16* QMEM; const bf16* KVMEM; bf16* OMEM;
             const float* COS; const float* SIN; const float* LUT; const int* TPMAX; const int* pos; const float* NEGC; const float* sub_g; const unsigned* KN2; float lam, oml; };

__device__ __forceinline__ int crow(int r, int hi) { return (r & 3) + 8 * (r >> 2) + 4 * hi; }
__device__ __forceinline__ int swap23(int k) { return (k & ~0xC) | ((k & 4) << 1) | ((k & 8) >> 1); }
__device__ __forceinline__ float pmaxf(float v) { auto rr = __builtin_amdgcn_permlane32_swap(__float_as_uint(v), __float_as_uint(v), false, false); return fmaxf(__uint_as_float(rr[0]), __uint_as_float(rr[1])); }
__device__ __forceinline__ float psumf(float v) { auto rr = __builtin_amdgcn_permlane32_swap(__float_as_uint(v), __float_as_uint(v), false, false); return __uint_as_float(rr[0]) + __uint_as_float(rr[1]); }
__device__ __forceinline__ float partnerf(float v, int hi) { auto rr = __builtin_amdgcn_permlane32_swap(__float_as_uint(v), __float_as_uint(v), false, false); return __uint_as_float(hi ? rr[0] : rr[1]); }
__device__ __forceinline__ void dma16(const void* sbase, unsigned voff, unsigned ldsaddr) { unsigned keep;
    asm volatile("s_mov_b32 %0, m0\n\ts_mov_b32 m0, %3\n\ts_nop 0\n\tglobal_load_lds_dwordx4 %1, %2\n\ts_mov_b32 m0, %0" : "=&s"(keep) : "v"(voff), "s"(sbase), "s"(ldsaddr) : "memory"); }

template <int NK> __device__ __forceinline__ void qk(f32x16& p0, f32x16& p1, const LAS unsigned char* krow, int xr, int hx, const bf16x8* qf, int dstart) {
#pragma unroll
    for (int d0 = 0; d0 < NK; ++d0) { const int off = (((dstart + d0) * 32 + hx) ^ xr);
        const bf16x8 b0 = *(const LAS bf16x8*)(krow + off), b1 = *(const LAS bf16x8*)(krow + off + 8192);
        p0 = __builtin_amdgcn_mfma_f32_32x32x16_bf16(b0, qf[d0], p0, 0, 0, 0); p1 = __builtin_amdgcn_mfma_f32_32x32x16_bf16(b1, qf[d0], p1, 0, 0, 0); }
}
template <int NK> __device__ __forceinline__ void qk_l(f32x16& p0, f32x16& p1, const LAS unsigned char* krow, int xr, int hx, const LAS unsigned char* qlds, int dstart) {
#pragma unroll
    for (int d0 = 0; d0 < NK; ++d0) { const int off = (((dstart + d0) * 32 + hx) ^ xr);
        const bf16x8 b0 = *(const LAS bf16x8*)(krow + off), b1 = *(const LAS bf16x8*)(krow + off + 8192), q = *(const LAS bf16x8*)(qlds + (dstart + d0) * 1024);
        p0 = __builtin_amdgcn_mfma_f32_32x32x16_bf16(b0, q, p0, 0, 0, 0); p1 = __builtin_amdgcn_mfma_f32_32x32x16_bf16(b1, q, p1, 0, 0, 0); }
}
__device__ __forceinline__ void qk_pe(f32x16& p0, f32x16& p1, const LAS unsigned char* perow, int xpe, int hx, const bf16x8* qf) {
#pragma unroll
    for (int d0 = 0; d0 < 4; ++d0) { const int off = ((d0 * 32 + hx) ^ xpe);
        const bf16x8 b0 = *(const LAS bf16x8*)(perow + off), b1 = *(const LAS bf16x8*)(perow + off + 4096);
        p0 = __builtin_amdgcn_mfma_f32_32x32x16_bf16(b0, qf[d0], p0, 0, 0, 0); p1 = __builtin_amdgcn_mfma_f32_32x32x16_bf16(b1, qf[d0], p1, 0, 0, 0); }
}
__device__ __forceinline__ void pv(f32x16* o, unsigned vb, bf16x8 pa0, bf16x8 pa1, bf16x8 pa2, bf16x8 pa3) {
#define TRRD(dst, off) asm volatile("ds_read_b64_tr_b16 %0, %1 offset:%2" : "=&v"(dst) : "v"(vb), "i"(off) : "memory")
#define PV_D0(d0) do { s16x4 l0, l1, l2, l3, h0, h1, h2, h3; constexpr int b_ = (d0) * 512; \
        TRRD(l0, b_); TRRD(h0, b_ + 2048); TRRD(l1, b_ + 4096); TRRD(h1, b_ + 6144); TRRD(l2, b_ + 8192); TRRD(h2, b_ + 10240); TRRD(l3, b_ + 12288); TRRD(h3, b_ + 14336); \
        asm volatile("s_waitcnt lgkmcnt(0)" ::: "memory"); __builtin_amdgcn_sched_barrier(0); \
        o[d0] = __builtin_amdgcn_mfma_f32_32x32x16_bf16(pa0, (bf16x8){l0[0], l0[1], l0[2], l0[3], h0[0], h0[1], h0[2], h0[3]}, o[d0], 0, 0, 0); \
        o[d0] = __builtin_amdgcn_mfma_f32_32x32x16_bf16(pa1, (bf16x8){l1[0], l1[1], l1[2], l1[3], h1[0], h1[1], h1[2], h1[3]}, o[d0], 0, 0, 0); \
        o[d0] = __builtin_amdgcn_mfma_f32_32x32x16_bf16(pa2, (bf16x8){l2[0], l2[1], l2[2], l2[3], h2[0], h2[1], h2[2], h2[3]}, o[d0], 0, 0, 0); \
        o[d0] = __builtin_amdgcn_mfma_f32_32x32x16_bf16(pa3, (bf16x8){l3[0], l3[1], l3[2], l3[3], h3[0], h3[1], h3[2], h3[3]}, o[d0], 0, 0, 0); } while (0)
    PV_D0(0); PV_D0(1); PV_D0(2); PV_D0(3);
#undef PV_D0
#undef TRRD
}
__device__ __forceinline__ void pack_p(const f32x16& p0, const f32x16& p1, bf16x8& pa0, bf16x8& pa1, bf16x8& pa2, bf16x8& pa3) {
#define PK4(P, B_, OUT) do { unsigned a0 = cvtpk(P[B_ + 0], P[B_ + 1]), a1 = cvtpk(P[B_ + 2], P[B_ + 3]), b0 = cvtpk(P[B_ + 4], P[B_ + 5]), b1 = cvtpk(P[B_ + 6], P[B_ + 7]); \
        auto r0 = __builtin_amdgcn_permlane32_swap(a0, b0, false, false); auto r1 = __builtin_amdgcn_permlane32_swap(a1, b1, false, false); \
        v4u w = {r0[0], r1[0], r0[1], r1[1]}; OUT = __builtin_bit_cast(bf16x8, w); } while (0)
    PK4(p0, 0, pa0); PK4(p0, 8, pa1); PK4(p1, 0, pa2); PK4(p1, 8, pa3);
#undef PK4
}
__device__ __forceinline__ void softmax_pv(f32x16& p0, f32x16& p1, float& m, float& l, f32x16* o, LAS float* wsf, unsigned vb, int r32, int hi, const float SCALE, const float C2) {
    float mx0 = fmaxf(p0[0], p1[0]), mx1 = fmaxf(p0[1], p1[1]), mx2 = fmaxf(p0[2], p1[2]), mx3 = fmaxf(p0[3], p1[3]);
#pragma unroll
    for (int r = 4; r < 16; r += 4) { mx0 = fmaxf(fmaxf(mx0, p0[r]), p1[r]); mx1 = fmaxf(fmaxf(mx1, p0[r + 1]), p1[r + 1]); mx2 = fmaxf(fmaxf(mx2, p0[r + 2]), p1[r + 2]); mx3 = fmaxf(fmaxf(mx3, p0[r + 3]), p1[r + 3]); }
    float pmax = pmaxf(fmaxf(fmaxf(mx0, mx1), fmaxf(mx2, mx3)));
    float mn, alpha;
    if (__all((pmax - m) * SCALE <= THR)) { mn = m; alpha = 1.f; }
    else { mn = fmaxf(m, pmax); alpha = __builtin_amdgcn_exp2f((m - mn) * C2); m = mn; }
    const float mnL = -mn * C2;
#pragma unroll
    for (int r = 0; r < 16; ++r) { p0[r] = __builtin_amdgcn_exp2f(fmaf(p0[r], C2, mnL)); p1[r] = __builtin_amdgcn_exp2f(fmaf(p1[r], C2, mnL)); }
    float s0 = p0[0] + p1[0], s1 = p0[1] + p1[1], s2 = p0[2] + p1[2], s3 = p0[3] + p1[3];
#pragma unroll
    for (int r = 4; r < 16; r += 4) { s0 += p0[r] + p1[r]; s1 += p0[r + 1] + p1[r + 1]; s2 += p0[r + 2] + p1[r + 2]; s3 += p0[r + 3] + p1[r + 3]; }
    const float ps = psumf((s0 + s1) + (s2 + s3)); l = l * alpha + ps;
    bf16x8 pa0, pa1, pa2, pa3; pack_p(p0, p1, pa0, pa1, pa2, pa3);
    if (__any(alpha < 1.f)) { const int fl = fresh_lane(), fh = fl >> 5;
        if (fh == 0) wsf[fl] = alpha; asm volatile("s_waitcnt lgkmcnt(0)" ::: "memory");
#pragma unroll
        for (int r = 0; r < 16; ++r) { const float a = wsf[crow(r, fh)];
#pragma unroll
            for (int d = 0; d < 4; ++d) o[d][r] *= a; } }
    pv(o, vb, pa0, pa1, pa2, pa3);
}

template <int VAR>
__device__ __forceinline__ void attn_unit(const Ctx& C, int b, int h, int qb, LAS unsigned char* lds, int tid, int wid, int lane) {
    constexpr bool CAUSAL = VAR != VE, DESC = (VAR == VC || VAR == VD), MLA = (VAR == VB), DIFF = (VAR == VA), STICK = (VAR == VC), HASB = (VAR == VA || VAR == VD);
    constexpr int NQF = MLA ? 12 : 8;
    constexpr float SCALE = DIFF ? 0.125f : (MLA ? 0.07216878364870323f : 0.08838834764831845f);
    constexpr float C2 = SCALE * LOG2E;
    const int r32 = lane & 31, hi = lane >> 5;
    const int q0 = qb * 256, qw = q0 + wid * 32, trow = qw + r32;
    const size_t rb = (size_t)b * SEQ;
    const bf16 *Qp, *Kp, *Vp; bf16* Op; int qpitch, kpitch, opitch;
    if constexpr (VAR == VA || VAR == VC || VAR == VD) {
        constexpr int base = VAR == VA ? A_Q : (VAR == VC ? C_Q : D_Q);
        Qp = C.PROJ + rb * INP + base + h * 128; Kp = Qp + 1024; Vp = Qp + 2048; qpitch = INP; kpitch = INP;
        Op = C.MIX + rb * DM + VAR * 1024 + h * 128; opitch = DM;
    } else if constexpr (VAR == VB) {
        Qp = C.QMLA + rb * 1536 + h * 192; qpitch = 1536; Kp = C.KVMLA + rb * 2048 + h * 256; Vp = Kp + 128; kpitch = 2048;
        Op = C.MIX + rb * DM + 1024 + h * 128; opitch = DM;
    } else {
        Qp = C.QMEM + rb * 512 + h * 128; qpitch = 512; Kp = C.KVMEM + (size_t)b * MEMT * 1024 + h * 128; Vp = Kp + 512; kpitch = 1024;
        Op = C.OMEM + rb * 512 + h * 128; opitch = 512;
    }
    const char* Bp = nullptr;
    if constexpr (VAR == VA) Bp = (const char*)(C.pos + rb);
    if constexpr (VAR == VD) Bp = (const char*)(C.NEGC + (size_t)(b * 8 + h) * SEQ);
    const char* KPEp = nullptr;
    if constexpr (MLA) KPEp = (const char*)(C.KPE + rb * 64);
    bf16x8 qr[DIFF ? 1 : NQF];
    const LAS unsigned char* qlds = lds + QF_OFF + wid * 8192 + lane * 16;
    { const bf16* qrow = Qp + (size_t)trow * qpitch + hi * 8;
      if constexpr (DIFF) {
#pragma unroll
          for (int d0 = 0; d0 < 8; ++d0) { const bf16x8 q = *(const GAS bf16x8*)(qrow + d0 * 16); *(LAS bf16x8*)(lds + QF_OFF + wid * 8192 + lane * 16 + d0 * 1024) = q; }
      } else {
#pragma unroll
          for (int d0 = 0; d0 < NQF; ++d0) qr[d0] = *(const GAS bf16x8*)(qrow + d0 * 16); } }
    if constexpr (MLA) {
        const float* cs = C.COS + (rb + trow) * 32 + hi * 8; const float* sn = C.SIN + (rb + trow) * 32 + hi * 8;
#pragma unroll
        for (int j = 0; j < 2; ++j) {
            const f32x4 c0 = *(const GAS f32x4*)(cs + j * 16), c1 = *(const GAS f32x4*)(cs + j * 16 + 4), s0 = *(const GAS f32x4*)(sn + j * 16), s1 = *(const GAS f32x4*)(sn + j * 16 + 4);
            const bf16x8 a = qr[8 + j], bb = qr[10 + j]; float lo[8], hh[8];
#pragma unroll
            for (int e = 0; e < 8; ++e) { const float t1 = bf2f(a[e]), t2 = bf2f(bb[e]), c = e < 4 ? c0[e & 3] : c1[e & 3], s = e < 4 ? s0[e & 3] : s1[e & 3]; lo[e] = t1 * c - t2 * s; hh[e] = t1 * s + t2 * c; }
            v4u wl = {cvtpk(lo[0], lo[1]), cvtpk(lo[2], lo[3]), cvtpk(lo[4], lo[5]), cvtpk(lo[6], lo[7])}, wh = {cvtpk(hh[0], hh[1]), cvtpk(hh[2], hh[3]), cvtpk(hh[4], hh[5]), cvtpk(hh[6], hh[7])};
            qr[8 + j] = __builtin_bit_cast(bf16x8, wl); qr[10 + j] = __builtin_bit_cast(bf16x8, wh); }
    }
    unsigned koff[2], voff[2], peoff = 0;
#pragma unroll
    for (int i = 0; i < 2; ++i) { const int j = wid * 2 + i, row = 4 * j + (lane >> 4); koff[i] = (unsigned)(row * kpitch + (((lane & 15) ^ (row & 15)) << 3)) * 2u;
        const int st = 2 * j + (lane >> 5), kk = (st >> 2) * 8 + ((lane & 31) >> 2), c = (st & 3) * 32 + (lane & 3) * 8; voff[i] = (unsigned)(swap23(kk) * kpitch + c) * 2u; }
    if constexpr (MLA) { const int row = 8 * wid + (lane >> 3); peoff = (unsigned)(row * 64 + (((lane & 7) ^ ((row >> 1) & 7)) << 3)) * 2u; }
    const unsigned boff = (unsigned)(lane & 15) * 16u;
    const unsigned ldsbase = (unsigned)(unsigned long long)lds;
#define ISSUE(t_, buf_) do { const size_t tb_ = (size_t)(t_) * 64 * kpitch * 2; const char* kg_ = (const char*)Kp + tb_; const char* vg_ = (const char*)Vp + tb_; \
        _Pragma("unroll") for (int i_ = 0; i_ < 2; ++i_) dma16(kg_, koff[i_], ldsbase + K_OFF + (buf_) * 16384 + (wid * 2 + i_) * 1024); \
        _Pragma("unroll") for (int i_ = 0; i_ < 2; ++i_) dma16(vg_, voff[i_], ldsbase + V_OFF + (buf_) * 16384 + (wid * 2 + i_) * 1024); \
        if constexpr (MLA) dma16(KPEp + (size_t)(t_) * 64 * 64 * 2, peoff, ldsbase + KPE_OFF + (buf_) * 8192 + wid * 1024); \
        if constexpr (HASB) { if (wid == 0) dma16(Bp + (size_t)(t_) * 64 * 4, boff, ldsbase + B_OFF + (buf_) * 1024); } } while (0)
    const int NT = CAUSAL ? (q0 + 256) / 64 : MEMT / 64;
    LAS float* wsf = (LAS float*)(lds + WS_OFF) + wid * 64;
    LAS float* lut = (LAS float*)(lds + LUT_OFF);
    int pos_t = 0, wmin = 0; float lut_far = 0.f;
    if constexpr (DIFF) { if (tid < 132) lut[tid] = C.LUT[h * 132 + tid];
        pos_t = C.pos[rb + trow]; int mnp = pos_t;
        mnp = min(mnp, shxi<1>(mnp)); mnp = min(mnp, shxi<2>(mnp)); mnp = min(mnp, shxi<4>(mnp)); mnp = min(mnp, shxi<8>(mnp)); mnp = min(mnp, shxi<16>(mnp));
        wmin = __builtin_amdgcn_readfirstlane(mnp); lut_far = C.LUT[h * 132 + 128]; }
    const int xr = (r32 & 15) << 4, hx = hi << 4, xpe = ((r32 >> 1) & 7) << 4;
    const unsigned vrd = (unsigned)(((lane & 3) << 3) | (((lane >> 2) & 3) << 6) | (((lane >> 4) & 1) << 5) | (((lane >> 5) & 1) << 8));
    f32x16 o[4]; f32x16 o2[DIFF ? 4 : 1];
#pragma unroll
    for (int d = 0; d < 4; ++d) { o[d] = f32x16{}; if constexpr (DIFF) o2[d] = f32x16{}; }
    float m1 = -1e30f, l1 = 0.f, m2 = -1e30f, l2 = 0.f, R = 0.f;
    float qnkn = 0.f;
    if constexpr (VAR == VD) { float s = 0.f;
#pragma unroll
        for (int d0 = 0; d0 < 8; ++d0)
#pragma unroll
            for (int e = 0; e < 8; ++e) { const float a = bf2f(qr[d0][e]); s += a * a; }
        s = psumf(s); qnkn = sqrtf(s) * sqrtf(__uint_as_float(C.KN2[b * 8 + h])) * 1.001f + 1.f; }
    ISSUE(DESC ? NT - 1 : 0, 0);
    WAITBAR();
    int cur = 0;
    for (int i = 0; i < NT; ++i) {
        const int t = DESC ? NT - 1 - i : i, kb = t * 64;
        if (i + 1 < NT) ISSUE(DESC ? t - 1 : t + 1, cur ^ 1);
        const bool act = !CAUSAL || (STICK ? (kb < qw + 31) : (kb <= qw + 31));
        bool wdone = false;
        if constexpr (VAR == VD) {
            if (act) { const float nmax = ((const LAS float*)(lds + B_OFF + cur * 1024))[63]; wdone = __all((qnkn + nmax - m1) * SCALE < -40.f); } }
        if (act && !wdone) {
            const LAS unsigned char* krow = lds + K_OFF + cur * 16384 + r32 * 256;
            const unsigned vb = ldsbase + V_OFF + cur * 16384 + vrd;
            if constexpr (STICK) {
                f32x16 p0 = f32x16{}, p1 = f32x16{};
                qk<8>(p0, p1, krow, xr, hx, qr, 0);
                float L0[16], L1[16];
#pragma unroll
                for (int r = 0; r < 16; ++r) { const int key = kb + crow(r, hi);
                    { const float z = p0[r] * SCALE, e = __builtin_amdgcn_exp2f(-fabsf(z) * LOG2E), sp = fmaxf(z, 0.f) + __builtin_amdgcn_logf(1.f + e) * LN2; L0[r] = key < trow ? -sp : 0.f; p0[r] = z; }
                    { const float z = p1[r] * SCALE, e = __builtin_amdgcn_exp2f(-fabsf(z) * LOG2E), sp = fmaxf(z, 0.f) + __builtin_amdgcn_logf(1.f + e) * LN2; L1[r] = key + 32 < trow ? -sp : 0.f; p1[r] = z; } }
                float T[8], mb[8];
#pragma unroll
                for (int g = 0; g < 4; ++g) { T[g] = (L0[4 * g] + L0[4 * g + 1]) + (L0[4 * g + 2] + L0[4 * g + 3]); T[4 + g] = (L1[4 * g] + L1[4 * g + 1]) + (L1[4 * g + 2] + L1[4 * g + 3]); }
                float run = R;
#pragma unroll
                for (int k = 7; k >= 0; --k) { const float pt = partnerf(T[k], hi); const float T1 = hi ? T[k] : pt, T0 = hi ? pt : T[k];
                    const float b1 = run; run += T1; const float b0 = run; run += T0; mb[k] = hi ? b1 : b0; }
                R = run;
#pragma unroll
                for (int g = 0; g < 4; ++g) { float s0 = mb[g], s1 = mb[4 + g];
#pragma unroll
                    for (int e = 3; e >= 0; --e) { const int r = 4 * g + e, key = kb + crow(r, hi);
                        const float a0 = key < trow ? __builtin_amdgcn_exp2f((p0[r] + L0[r] + s0) * LOG2E) : 0.f; s0 += L0[r]; p0[r] = a0;
                        const float a1 = key + 32 < trow ? __builtin_amdgcn_exp2f((p1[r] + L1[r] + s1) * LOG2E) : 0.f; s1 += L1[r]; p1[r] = a1; } }
                bf16x8 pa0, pa1, pa2, pa3; pack_p(p0, p1, pa0, pa1, pa2, pa3);
                pv(o, vb, pa0, pa1, pa2, pa3);
            } else {
#pragma unroll
                for (int mp = 0; mp < (DIFF ? 2 : 1); ++mp) {
                    f32x16 p0, p1;
                    int xr_t = xr;
                    if constexpr (DIFF) { __builtin_amdgcn_sched_barrier(0); asm volatile("" : "+v"(pos_t), "+v"(xr_t)); }
                    if constexpr (VAR == VD) { const LAS float* nb = (const LAS float*)(lds + B_OFF + cur * 1024) + 4 * hi;
#pragma unroll
                        for (int g = 0; g < 4; ++g) { const f32x4 v0 = *(const LAS f32x4*)(nb + 8 * g), v1 = *(const LAS f32x4*)(nb + 32 + 8 * g);
#pragma unroll
                            for (int e = 0; e < 4; ++e) { p0[4 * g + e] = v0[e]; p1[4 * g + e] = v1[e]; } } }
                    else if constexpr (DIFF) {
                        if (wmin - C.TPMAX[b * 64 + t] >= 128) {
#pragma unroll
                            for (int r = 0; r < 16; ++r) { p0[r] = lut_far; p1[r] = lut_far; } }
                        else { const LAS int* pb = (const LAS int*)(lds + B_OFF + cur * 1024) + 4 * hi;
#pragma unroll
                            for (int g = 0; g < 4; ++g) { const i32x4 v0 = *(const LAS i32x4*)(pb + 8 * g), v1 = *(const LAS i32x4*)(pb + 32 + 8 * g);
#pragma unroll
                                for (int e = 0; e < 4; ++e) { p0[4 * g + e] = lut[min(max(pos_t - v0[e], 0), 128)]; p1[4 * g + e] = lut[min(max(pos_t - v1[e], 0), 128)]; }
                                __builtin_amdgcn_sched_barrier(0); } } }
                    else { p0 = f32x16{}; p1 = f32x16{}; }
                    if constexpr (DIFF) qk_l<4>(p0, p1, krow, xr_t, hx, qlds, 4 * mp);
                    else qk<8>(p0, p1, krow, xr, hx, qr, 0);
                    if constexpr (MLA) qk_pe(p0, p1, lds + KPE_OFF + cur * 8192 + r32 * 128, xpe, hx, qr + 8);
                    if (CAUSAL && kb + 63 > qw) { const float NEG = -__builtin_inff();
#pragma unroll
                        for (int r = 0; r < 16; ++r) { const int key = kb + crow(r, hi); if (key > trow) p0[r] = NEG; if (key + 32 > trow) p1[r] = NEG; } }
                    if (mp == 0) softmax_pv(p0, p1, m1, l1, o, wsf, vb, r32, hi, SCALE, C2);
                    else softmax_pv(p0, p1, m2, l2, o2, wsf, vb, r32, hi, SCALE, C2);
                }
            }
        }
        if constexpr (STICK) { const int dn_ = __all(R < -100.f) ? 1 : 0; if (lane == 0) ((LAS int*)(lds + FLG_OFF))[(i & 1) * 8 + wid] = dn_; }
        if constexpr (VAR == VD) { if (lane == 0) ((LAS int*)(lds + FLG_OFF))[(i & 1) * 8 + wid] = wdone ? 1 : 0; }
        WAITBAR(); cur ^= 1;
        if constexpr (STICK || VAR == VD) { const LAS i32x4* fl = (const LAS i32x4*)(lds + FLG_OFF + (i & 1) * 32); const i32x4 f0 = fl[0], f1 = fl[1];
            const int alld = (f0.x & f0.y & f0.z & f0.w) & (f1.x & f1.y & f1.z & f1.w); if (__builtin_amdgcn_readfirstlane(alld)) break; }
    }
#undef ISSUE
    const int lane_e = fresh_lane();
    const int r32e = lane_e & 31, hie = lane_e >> 5;
    bf16* Ob = Op + (size_t)(qw + 4 * hie) * opitch + r32e;
    if constexpr (DIFF) {
        if (hie == 0) { wsf[r32e] = l1; wsf[32 + r32e] = l2; } asm volatile("s_waitcnt lgkmcnt(0)" ::: "memory");
        const float lam = C.lam;
#pragma unroll
        for (int r = 0; r < 16; ++r) { const float i1 = __builtin_amdgcn_rcpf(wsf[crow(r, hie)]), i2 = lam * __builtin_amdgcn_rcpf(wsf[32 + crow(r, hie)]); float ss = 0.f;
#pragma unroll
            for (int d = 0; d < 4; ++d) { const float x = o[d][r] * i1 - o2[d][r] * i2; o[d][r] = x; ss += x * x; }
            ss = half_sum(ss);
            const float rstd = (1.0f / sqrtf(ss * (1.f / 128.f) + EPS)) * C.oml;
#pragma unroll
            for (int d = 0; d < 4; ++d) o[d][r] *= rstd; }
#pragma unroll
        for (int d = 0; d < 4; ++d) { const float g = C.sub_g[d * 32 + r32e];
#pragma unroll
            for (int r = 0; r < 16; ++r) o[d][r] *= g; }
    } else if constexpr (!STICK) {
        if (hie == 0) wsf[r32e] = l1; asm volatile("s_waitcnt lgkmcnt(0)" ::: "memory");
#pragma unroll
        for (int r = 0; r < 16; ++r) { const float i1 = __builtin_amdgcn_rcpf(wsf[crow(r, hie)]);
#pragma unroll
            for (int d = 0; d < 4; ++d) o[d][r] *= i1; }
    }
#pragma unroll
    for (int r = 0; r < 16; ++r) { const int orr = (r & 3) + 8 * (r >> 2);
#pragma unroll
        for (int d = 0; d < 4; ++d) { const float v = o[d][r], vn = shx<1>(v);
            if ((r32e & 1) == 0) *(GAS unsigned*)(Ob + (size_t)orr * opitch + d * 32) = cvtpk(v, vn); } }
}
template <int VAR> __device__ __forceinline__ void attn_queue(const Ctx& C, gu32* head, LAS unsigned char* lds, const int wid, const kaptr_t ka, unsigned char* ws, const int cvl) {
    constexpr int NH = VAR == VE ? 4 : 8, NU = NB * NH * 16;
    const int lane = fresh_lane(), tid = wid * 64 + lane;
    volatile LAS int* tk = (volatile LAS int*)(lds + LDSCTL_OFF);
    for (;;) {
        if (tid == 0) tk[0] = (int)__hip_atomic_fetch_add(head, 1u, RLX_AGENT);
        WAITBAR();
        const int n = __builtin_amdgcn_readfirstlane(tk[0]);
        if (n >= NU) break;
        const int qb = 15 - n / (NB * NH), bh = n % (NB * NH);
        attn_unit<VAR>(C, bh / NH, bh % NH, qb, lds, tid, wid, lane);
        if (cvl >= 0) {
            if (tid == 0) tk[1] = (int)__hip_atomic_fetch_add((gu32*)(ws + WS_CTL) + CW_TKT + (cvl * 16 + 10) * 64, 1u, RLX_AGENT);
            WAITBAR();
            const int c = __builtin_amdgcn_readfirstlane(tk[1]);
            if (c < KNCH(ka, cvl)) conv_chunk(ka, ws, cvl, c, (LAS float*)(lds + RING_OFF + wid * 16640), wid, lane);
        }
    }
}
}


namespace att {
template <int VAR> __device__ __forceinline__ void attn_phase(int l, int q, LAS unsigned char* lds, const int wid0) {
    const kaptr_t ka = ka_fresh(); unsigned char* ws = KWS(ka);
    const Ctx C{(const bf16*)(ws + WS_PROJ), (const bf16*)(ws + WS_QMLA), (const bf16*)(ws + WS_KVMLA), (const bf16*)(ws + WS_KPE), (bf16*)(ws + WS_MIX), (const bf16*)(ws + WS_QMEM),
                (const bf16*)(ws + WS_KVMEM) + (size_t)l * 512 * 1024, (bf16*)(ws + WS_OMEM), (const float*)(ws + WS_COS), (const float*)(ws + WS_SIN), (const float*)(ws + WS_LUT),
                (const int*)(ws + WS_TPMAX), (const int*)KIN(ka, 2), (const float*)(ws + WS_NEGC), (const float*)KIN(ka, 11) + l * 128, (const unsigned*)((gu32*)(ws + WS_CTL) + CW_KN + l * 64), ((const float*)(ws + WS_LAM))[l], 1.0f - KLAMI(ka, l)};
    attn_queue<VAR>(C, (gu32*)(ws + WS_CTL) + CW_TKT + (l * 16 + q) * 64, lds, wid0, ka, ws, (VAR == VE || gridDim.x == 256) ? -1 : l);
}
}

__global__ void __launch_bounds__(NWAVES * 64, 2) mk_fwd(Args args) {
    extern __shared__ __attribute__((aligned(16))) unsigned char lds_raw[];
    LAS unsigned char* lds = (LAS unsigned char*)lds_raw;
    const int G = gridDim.x, bx = blockIdx.x;
    const int vcu = (G % 8 == 0) ? (bx % 8) * (G / 8) + bx / 8 : bx;
    const int wid0 = __builtin_amdgcn_readfirstlane((int)threadIdx.x >> 6);
    const int gw = vcu * NWAVES + wid0, NGW = G * NWAVES;
    { const int tid = wid0 * 64 + fresh_lane();
      for (int u = tid; u < (LDS_BYTES - LDSCTL_OFF) / 4; u += NWAVES * 64) ((LAS unsigned*)(lds + LDSCTL_OFF))[u] = 0u; }
    __syncthreads();
    volatile LAS unsigned* MISC = (volatile LAS unsigned*)(lds + MISC_OFF);
    XcdBarrier bar = xcd_barrier_post((unsigned*)(args.ws + WS_CTL) + CW_BAR, MISC + 8, wid0);

    {
        const kaptr_t ka = ka_fresh(); unsigned char* ws = KWS(ka);
        const int lane = fresh_lane(), wid = wid0, tid = wid * 64 + lane;
        LAS float* scr = (LAS float*)(lds + RING_OFF + wid * 16640);
        {
            const int l = 0; unsigned char* wl = ws + WS_W;
#define TR_MAT(idx_, K_, N_, NP_, dst_, roff_, gain_) do { const float* s_ = (const float*)KIN(ka, idx_) + (size_t)l * (K_) * (N_); const int nblk_ = (NP_) / 64, nit_ = ((K_) / 64) * nblk_; \
            const float* gk_ = (gain_) >= 0 ? (const float*)KIN(ka, (gain_) >= 0 ? (gain_) : 0) + (size_t)l * (K_) : nullptr; \
            for (int it = gw; it < nit_; it += NGW) tr_item(s_, (K_), (N_), nblk_, (bf16*)(dst_), (roff_), scr, it, lane, gk_); } while (0)
            TR_MAT(4, DM, INC, INP, wl + W_IN, 0, 3);
            TR_MAT(14, QRANK, 1536, 1536, wl + W_UQ, 0, -1);
            TR_MAT(15, KVRANK, 2048, 2048, wl + W_UKV, 0, -1);
            TR_MAT(20, DM, 512, 512, wl + W_MKV, 0, -1);
            TR_MAT(21, DM, 512, 512, wl + W_MKV, 512, -1);
#undef TR_MAT
        }
        { const float* x0 = (const float*)KIN(ka, 0); bf16* H = (bf16*)(ws + WS_H); unsigned long long* SS = (unsigned long long*)((gu32*)(ws + WS_CTL) + CW_SS);
          for (int m = gw; m < M; m += NGW) cast_row(x0 + (size_t)m * DM, H + (size_t)m * DM, SS + m, lane); }
        { const float* mem = (const float*)KIN(ka, 1); bf16* MEMN = (bf16*)(ws + WS_MEMN);
          for (int r = gw; r < NL * NB * MEMT; r += NGW) { const int l = r / (NB * MEMT), mr = r - l * (NB * MEMT);
            rms_row<true>(mem + (size_t)mr * DM, (const float*)KIN(ka, 18) + (size_t)l * DM, MEMN + (size_t)r * DM, lane); } }
        const int* pos = (const int*)KIN(ka, 2);
        float* COS = (float*)(ws + WS_COS); float* SIN = (float*)(ws + WS_SIN); float* LUT = (float*)(ws + WS_LUT); int* TPMAX = (int*)(ws + WS_TPMAX); float* LAM = (float*)(ws + WS_LAM);
        const int gt = vcu * (NWAVES * 64) + tid, NGT = G * NWAVES * 64;
        for (int i = gt; i < M * 32; i += NGT) { const int row = i >> 5, f = i & 31; const float ang = (float)pos[row] * KINVF(ka, f);
            double rv = (double)ang * 0.15915494309189535; rv -= floor(rv); const float fr = (float)rv;
            COS[i] = __builtin_amdgcn_cosf(fr); SIN[i] = __builtin_amdgcn_sinf(fr); }
        for (int i = gt; i < 8 * 132; i += NGT) { const int h = i / 132, dd0 = i - h * 132; const int dd = dd0 > 128 ? 128 : dd0; int bk;
            if (dd < 16) bk = dd; else { bk = 16 + (int)(logf((float)dd / 16.0f) / 2.0794415416798357f * 16.0f); bk = bk > 31 ? 31 : bk; }
            LUT[i] = 8.0f * ((const float*)KIN(ka, 6))[bk * 8 + h]; }
        for (int i = gt; i < NB * 64; i += NGT) { int mx = pos[i * 64];
            for (int k = 1; k < 64; ++k) mx = max(mx, pos[i * 64 + k]);
            TPMAX[i] = mx; }
        if (gt < NL) { const int l = gt; float s1 = 0.f, s2 = 0.f;
            for (int k = 0; k < 64; ++k) { s1 += ((const float*)KIN(ka, 7))[l * 64 + k] * ((const float*)KIN(ka, 8))[l * 64 + k]; s2 += ((const float*)KIN(ka, 9))[l * 64 + k] * ((const float*)KIN(ka, 10))[l * 64 + k]; }
            LAM[l] = expf(s1) - expf(s2) + KLAMI(ka, l); }
    }
    xcd_barrier(bar, wid0);

    for (int l = 0; l < NL; ++l) {
        { const kaptr_t ka = ka_fresh(); unsigned char* ws = KWS(ka); unsigned char* wl = ws + WS_W + (size_t)l * W_LAYER;
          { pg8::Gemm g{(const bf16*)(ws + WS_H), (const bf16*)(wl + W_IN), M, INP, DM}; pg8::StaticOrder S; S.init(M, INP, G, bx);
            pg8::EpiBf16<0, true> E{(bf16*)(ws + WS_PROJ), INP, (const unsigned long long*)((gu32*)(ws + WS_CTL) + CW_SS) + (size_t)(3 * l) * M};
            pg8::gemm_phase<pg8::EpiBf16<0, true>, pg8::StaticOrder, true, true>(lds + RING_OFF, g, S, E, wid0); }
          { pg8::Gemm g{(const bf16*)(ws + WS_MEMN) + (size_t)l * 512 * DM, (const bf16*)(wl + W_MKV), 512, 1024, DM}; pg8::StaticOrder S; S.init(512, 1024, G, G - 1 - bx);
            pg8::EpiBf16<0, false> E{(bf16*)(ws + WS_KVMEM) + (size_t)l * 512 * 1024, 1024, nullptr};
            pg8::gemm_phase<pg8::EpiBf16<0, false>, pg8::StaticOrder, true, true>(lds + RING_OFF, g, S, E, wid0); }
          if (G == 256 && bx >= 160 && bx < 248) {
              const int lane = fresh_lane(); LAS float* scr = (LAS float*)(lds + RING_OFF + wid0 * 16640);
              conv_run(ka, ws, 2 + l, (bx - 160) * NWAVES + wid0, UPDEF, 88 * NWAVES, scr, lane); } }
        xcd_barrier(bar, wid0);
        { const kaptr_t ka = ka_fresh(); unsigned char* ws = KWS(ka); FRESH_LANE(ln);
          for (int m = gw; m < M; m += NGW)
            prep_row((const bf16*)(ws + WS_PROJ), m, (const float*)KIN(ka, 12) + (size_t)l * QRANK, (const float*)KIN(ka, 13) + (size_t)l * KVRANK, (const float*)KIN(ka, 16) + l * 8,
                     (const float*)(ws + WS_COS), (const float*)(ws + WS_SIN), (bf16*)(ws + WS_CQN), (bf16*)(ws + WS_CKVN), (bf16*)(ws + WS_KPE), (float*)(ws + WS_LOGF), (LAS unsigned*)(lds + KNL_OFF), ln);
          asm volatile("s_waitcnt lgkmcnt(0)" ::: "memory"); __builtin_amdgcn_s_barrier();
          if (wid0 == 0 && ln < 16) { LAS unsigned* kl = (LAS unsigned*)(lds + KNL_OFF) + ln; const unsigned v = *kl; unsigned z = 0u; asm volatile("" : "+v"(z)); *kl = z;
              if (v) __hip_atomic_fetch_max((unsigned*)((gu32*)(ws + WS_CTL) + CW_KN + l * 64) + ln, v, __ATOMIC_RELAXED, __HIP_MEMORY_SCOPE_AGENT); } }
        xcd_barrier(bar, wid0);
        { const kaptr_t ka = ka_fresh(); unsigned char* ws = KWS(ka); unsigned char* wl = ws + WS_W + (size_t)l * W_LAYER;
          if (gw < 16) { FRESH_LANE(ln); fox_scan((const float*)(ws + WS_LOGF) + (size_t)gw * SEQ, (float*)(ws + WS_NEGC) + (size_t)gw * SEQ, ln); }
          { pg8::Gemm g{(const bf16*)(ws + WS_CQN), (const bf16*)(wl + W_UQ), M, 1536, QRANK}; pg8::StaticOrder S; S.init(M, 1536, G, bx);
            pg8::EpiBf16<0, false> E{(bf16*)(ws + WS_QMLA), 1536, nullptr};
            pg8::gemm_phase<pg8::EpiBf16<0, false>, pg8::StaticOrder, true, true>(lds + RING_OFF, g, S, E, wid0); }
          { pg8::Gemm g{(const bf16*)(ws + WS_CKVN), (const bf16*)(wl + W_UKV), M, 2048, KVRANK}; pg8::StaticOrder S; S.init(M, 2048, G, G - 1 - bx);
            pg8::EpiBf16<0, false> E{(bf16*)(ws + WS_KVMLA), 2048, nullptr};
            pg8::gemm_phase<pg8::EpiBf16<0, false>, pg8::StaticOrder, true, true>(lds + RING_OFF, g, S, E, wid0); }
          if (G == 256 && bx >= 192) {
              const int lane = fresh_lane(); LAS float* scr = (LAS float*)(lds + RING_OFF + wid0 * 16640);
              conv_run(ka, ws, 2 + l, UPDEF + (bx - 192) * NWAVES + wid0, UPDEF + P4DEF, 64 * NWAVES, scr, lane); } }
        xcd_barrier(bar, wid0);
#define CONV_DRAIN(l_) do { const kaptr_t ka = ka_fresh(); unsigned char* ws = KWS(ka); const int lane = fresh_lane(); volatile LAS int* tk = (volatile LAS int*)(lds + LDSCTL_OFF + 16); \
          for (;;) { if (wid0 == 0 && lane == 0) tk[0] = (int)__hip_atomic_fetch_add((gu32*)(ws + WS_CTL) + CW_TKT + ((l_) * 16 + 10) * 64, 1u, RLX_AGENT); \
              WAITBAR(); const int c = __builtin_amdgcn_readfirstlane(tk[0]); WAITBAR(); \
              if (c >= KNCH(ka, (l_))) break; \
              conv_chunk(ka, ws, (l_), c, (LAS float*)(lds + RING_OFF + wid0 * 16640), wid0, lane); } } while (0)
        if (G == 256 && ((bx >> 3) & 3) == 3) CONV_DRAIN(l);
        att::attn_phase<att::VA>(l, 0, lds, wid0);
        att::attn_phase<att::VB>(l, 1, lds, wid0);
        att::attn_phase<att::VD>(l, 2, lds, wid0);
        att::attn_phase<att::VC>(l, 3, lds, wid0);
        CONV_DRAIN(l);
        xcd_barrier(bar, wid0);
        { const kaptr_t ka = ka_fresh(); unsigned char* ws = KWS(ka); unsigned char* wl = ws + WS_W + (size_t)l * W_LAYER;
          pg8::Gemm g{(const bf16*)(ws + WS_MIX), (const bf16*)(wl + W_OUT), M, DM, DM}; pg8::StaticOrder S; S.init(M, DM, G, bx);
          pg8::EpiRes E{(bf16*)(ws + WS_H), DM, (unsigned long long*)((gu32*)(ws + WS_CTL) + CW_SS) + (size_t)(3 * l + 1) * M};
          pg8::gemm_phase<pg8::EpiRes, pg8::StaticOrder, true, true>(lds + RING_OFF, g, S, E, wid0); }
        xcd_barrier(bar, wid0);
        { const kaptr_t ka = ka_fresh(); unsigned char* ws = KWS(ka); unsigned char* wl = ws + WS_W + (size_t)l * W_LAYER;
          pg8::Gemm g{(const bf16*)(ws + WS_H), (const bf16*)(wl + W_MQ), M, 512, DM}; pg8::StaticOrder S; S.init(M, 512, G, bx);
          pg8::EpiBf16<0, true> E{(bf16*)(ws + WS_QMEM), 512, (const unsigned long long*)((gu32*)(ws + WS_CTL) + CW_SS) + (size_t)(3 * l + 1) * M};
          pg8::gemm_phase<pg8::EpiBf16<0, true>, pg8::StaticOrder, true, true>(lds + RING_OFF, g, S, E, wid0);
          if (G == 256 && bx >= 64) {
              const int lane = fresh_lane(); LAS float* scr = (LAS float*)(lds + RING_OFF + wid0 * 16640);
              conv_run(ka, ws, 2 + l, UPDEF + P4DEF + (bx - 64) * NWAVES + wid0, UPDEF + P4DEF + P8DEF, 192 * NWAVES, scr, lane); } }
        xcd_barrier(bar, wid0);
        att::attn_phase<att::VE>(l, 4, lds, wid0);
        xcd_barrier(bar, wid0);
        { const kaptr_t ka = ka_fresh(); unsigned char* ws = KWS(ka); unsigned char* wl = ws + WS_W + (size_t)l * W_LAYER;
          pg8::Gemm g{(const bf16*)(ws + WS_OMEM), (const bf16*)(wl + W_MO), M, DM, 512}; pg8::StaticOrder S; S.init(M, DM, G, bx);
          pg8::EpiRes E{(bf16*)(ws + WS_H), DM, (unsigned long long*)((gu32*)(ws + WS_CTL) + CW_SS) + (size_t)(3 * l + 2) * M};
          pg8::gemm_phase<pg8::EpiRes, pg8::StaticOrder, true, true>(lds + RING_OFF, g, S, E, wid0); }
        xcd_barrier(bar, wid0);
        { const kaptr_t ka = ka_fresh(); unsigned char* ws = KWS(ka); unsigned char* wl = ws + WS_W + (size_t)l * W_LAYER;
          pg8::Gemm g{(const bf16*)(ws + WS_H), (const bf16*)(wl + W_UP), M, DFF, DM}; pg8::StaticOrder S; S.init(M, DFF, G, bx);
          pg8::EpiBf16<1, true> E{(bf16*)(ws + WS_U), DFF, (const unsigned long long*)((gu32*)(ws + WS_CTL) + CW_SS) + (size_t)(3 * l + 2) * M};
          pg8::gemm_phase<pg8::EpiBf16<1, true>, pg8::StaticOrder, true, true>(lds + RING_OFF, g, S, E, wid0); }
        xcd_barrier(bar, wid0);
        { const kaptr_t ka = ka_fresh(); unsigned char* ws = KWS(ka); unsigned char* wl = ws + WS_W + (size_t)l * W_LAYER;
          pg8::Gemm g{(const bf16*)(ws + WS_U), (const bf16*)(wl + W_DN), M, DM, DFF}; pg8::StaticOrder S; S.init(M, DM, G, bx);
          pg8::EpiRes E{(bf16*)(ws + WS_H), DM, (unsigned long long*)((gu32*)(ws + WS_CTL) + CW_SS) + (size_t)(3 * l + 3) * M};
          pg8::gemm_phase<pg8::EpiRes, pg8::StaticOrder, true, true>(lds + RING_OFF, g, S, E, wid0); }
        xcd_barrier(bar, wid0);
    }
    { const kaptr_t ka = ka_fresh(); unsigned char* ws = KWS(ka); FRESH_LANE(ln); float* O = KOUT(ka);
      for (int m = gw; m < M; m += NGW) final_row((const bf16*)(ws + WS_H) + (size_t)m * DM, (const float*)KIN(ka, 26), O + (size_t)m * DM, ln); }
}

extern "C" void kernel_launch(void* const* d_in, const int* in_sizes, int n_in, void* d_out, int out_size, void* d_ws, size_t ws_size, hipStream_t stream) {
    static int grid = 0;
    if (grid == 0) {
        if (n_in != 27 || in_sizes[0] != M * DM || out_size != M * DM || ws_size < WS_END) {
            fprintf(stderr, "kernel_launch: built for 27 inputs, x/out of %d floats, >= %zu bytes of workspace; got n_in %d, in0 %d, out %d, ws %zu; nothing launched\n", M * DM, (size_t)WS_END, n_in, n_in > 0 ? in_sizes[0] : -1, out_size, ws_size);
            grid = -1; return; }
        int dev = 0, cus = 0, per_cu = 0;
        if (hipGetDevice(&dev) != hipSuccess || hipDeviceGetAttribute(&cus, hipDeviceAttributeMultiprocessorCount, dev) != hipSuccess) { fprintf(stderr, "kernel_launch: device query failed\n"); grid = -1; return; }
        if (hipFuncSetAttribute((const void*)mk_fwd, hipFuncAttributeMaxDynamicSharedMemorySize, LDS_BYTES) != hipSuccess) { fprintf(stderr, "kernel_launch: hipFuncSetAttribute failed\n"); grid = -1; return; }
        if (hipOccupancyMaxActiveBlocksPerMultiprocessor(&per_cu, (const void*)mk_fwd, NWAVES * 64, LDS_BYTES) != hipSuccess || per_cu < 1)
            fprintf(stderr, "kernel_launch: note: occupancy query reports %d workgroups per CU\n", per_cu);
        (void)hipGetLastError();
        grid = cus;
    }
    if (grid < 0) return;
    if (hipMemsetAsync((char*)d_ws + WS_CTL, 0, CTL_ZERO_BYTES, stream) != hipSuccess) { fprintf(stderr, "kernel_launch: memset failed\n"); return; }
    Args a; memset(&a, 0, sizeof(a));
    for (int i = 0; i < 27; ++i) a.in[i] = d_in[i];
    a.out = (float*)d_out; a.ws = (unsigned char*)d_ws;
    for (int i = 0; i < 32; ++i) a.inv_freq[i] = (float)pow(10000.0, -(double)i / 32.0);
    for (int l = 0; l < NL; ++l) a.lam_init[l] = (float)(0.8 - 0.6 * exp(-0.3 * (double)l));
    {
        auto put = [&](int t, int idx, int K, int N, int NP, size_t off, int roff, int gain, int lay, int first, int cnt) {
            Cv& c = a.cv[t][a.ncv[t]++]; c.idx = idx; c.K = K; c.N = N; c.NP = NP; c.dst = (long long)(WS_W + (size_t)lay * W_LAYER + off); c.roff = roff; c.gain = gain; c.lay = lay;
            c.first = first; c.cnt = cnt < 0 ? (K / 64) * (NP / 64) - first : cnt; };
        put(0, 5, DM, DM, DM, W_OUT, 0, -1, 0, 0, -1); put(0, 19, DM, 512, 512, W_MQ, 0, 17, 0, 0, -1); put(0, 22, 512, DM, DM, W_MO, 0, -1, 0, 0, -1);
        put(0, 24, DM, DFF, DFF, W_UP, 0, 23, 0, 0, -1); put(0, 25, DFF, DM, DM, W_DN, 0, -1, 0, 0, -1);
        const bool idle = (grid == 256);
        const int te = idle ? 2 : 0, tl = idle ? 3 : 1;
        constexpr int UP2 = UPDEF + P4DEF + P8DEF - (11520 + 576 + 256 + 512 + 512);
        constexpr int DN3 = UPDEF + P4DEF + P8DEF - (16384 - UP2);
        static_assert(UP2 > 0 && UP2 < 16384 && DN3 > 0 && DN3 < 16384, "idle-window split");
        put(te, 4, DM, INC, INP, W_IN, 0, 3, 1, 0, -1); put(te, 14, QRANK, 1536, 1536, W_UQ, 0, -1, 1, 0, -1); put(te, 15, KVRANK, 2048, 2048, W_UKV, 0, -1, 1, 0, -1);
        put(te, 20, DM, 512, 512, W_MKV, 0, -1, 1, 0, -1); put(te, 21, DM, 512, 512, W_MKV, 512, -1, 1, 0, -1);
        put(1, 5, DM, DM, DM, W_OUT, 0, -1, 1, 0, -1); put(1, 19, DM, 512, 512, W_MQ, 0, 17, 1, 0, -1); put(1, 22, 512, DM, DM, W_MO, 0, -1, 1, 0, -1);
        if (idle) { put(2, 24, DM, DFF, DFF, W_UP, 0, 23, 1, 0, UP2); put(3, 24, DM, DFF, DFF, W_UP, 0, 23, 1, UP2, -1); put(3, 25, DFF, DM, DM, W_DN, 0, -1, 1, 0, DN3); put(1, 25, DFF, DM, DM, W_DN, 0, -1, 1, DN3, -1); }
        else { put(1, 24, DM, DFF, DFF, W_UP, 0, 23, 1, 0, -1); put(1, 25, DFF, DM, DM, W_DN, 0, -1, 1, 0, -1); }
        (void)tl;
        for (int t = 0; t < NTB; ++t) { long tot = 0; for (int j = 0; j < a.ncv[t]; ++j) tot += a.cv[t][j].cnt; a.nchunk[t] = (int)((tot + 63) / 64); }
    }
    hipLaunchKernelGGL(mk_fwd, dim3(grid), dim3(NWAVES * 64), LDS_BYTES, stream, a);
    const hipError_t le = hipPeekAtLastError();
    if (le != hipSuccess) fprintf(stderr, "kernel_launch: launch failed: %s\n", hipGetErrorName(le));
}
```

```cpp
#include <hip/hip_runtime.h>
#include <cstdio>
#include <cstdint>
#include <cstring>
#include <cmath>
__device__ __forceinline__ int fresh_lane() { unsigned z = 0u; asm volatile("" : "+v"(z)); return (int)__builtin_amdgcn_mbcnt_hi(~0u, __builtin_amdgcn_mbcnt_lo(~0u, z)); }
namespace pg8 {
#define PG8_LAS __attribute__((address_space(3)))
typedef unsigned short bf16_t;
typedef short bf16x8 __attribute__((ext_vector_type(8)));
typedef float f32x4 __attribute__((ext_vector_type(4)));
typedef unsigned u32x4 __attribute__((ext_vector_type(4)));
constexpr int BM = 256, BK = 64, HALF = 128, HTB = HALF * BK * 2  , STAGE_BYTES = 8 * HTB, NXCD = 8, WGM = 8;

__host__ __device__ __forceinline__ int lds_byte(int r, int c) { const int st = (r >> 4) * 2 + (c >> 5), rr = r & 15, cc = c & 31, ob = rr * 64 + cc * 2; return st * 1024 + (ob ^ (((ob >> 9) & 1) << 5)); }
__host__ __device__ __forceinline__ void stage_rc(int b, int& R, int& C) { const int st = b / 1024, sb = b % 1024, swz = sb ^ (((sb >> 9) & 1) << 5); R = (st >> 1) * 16 + swz / 64; C = (st & 1) * 32 + (swz % 64) / 2; }
__host__ __device__ __forceinline__ int perm32(int rho) { const int n = rho >> 4, i = rho & 15; return 8 * (i >> 2) + 4 * n + (i & 3); }

struct Unit { int pm, pn; };
struct Gemm { const bf16_t* A; const bf16_t* Bt; int M, N, K; int lda = 0, ldb = 0, ash = 31, aoff = 0; };

struct StaticOrder {
    int nM, nN, nwg, G, c;
    __host__ __device__ void init(int M, int N, int G_, int c_) { nM = M / BM; nN = N / BM; nwg = nM * nN; G = G_; c = c_; }
    __host__ __device__ bool next(int i, Unit& u) const {
        const long L = (long)i * G + c; if (L >= nwg) return false;
        int wgid = (int)L; { const int q = nwg / NXCD, r = nwg % NXCD, xcd = wgid % NXCD, off = wgid / NXCD; wgid = (xcd < r ? xcd * (q + 1) : r * (q + 1) + (xcd - r) * q) + off; }
        const int nig = WGM * nN, gid = wgid / nig, fm = gid * WGM, gsz = (nM - fm) < WGM ? (nM - fm) : WGM;
        u.pm = fm + ((wgid % nig) % gsz); u.pn = (wgid % nig) / gsz; return true;
    }
    __device__ __forceinline__ void a_ready(const Unit&) const {}
    __device__ __forceinline__ void done(const Unit&) const {}
};

__device__ __forceinline__ unsigned cvt_pk_bf16(float lo, float hi) { unsigned r; asm volatile("v_cvt_pk_bf16_f32 %0, %1, %2" : "=v"(r) : "v"(lo), "v"(hi)); return r; }
typedef float f32x2 __attribute__((ext_vector_type(2)));
template <int ACT, bool RS> struct EpiBf16 {
    static constexpr bool PERM = true, AFTER_DRAIN = false;
    bf16_t* O; int ldc; const unsigned long long* ss;
    __device__ __forceinline__ void operator()(const f32x4 (&acc)[2][2][4][2], const Unit& u, int wr, int wc, int fr, int fq) const {
        const int row0 = u.pm * BM + wr * 64 + fr, col0 = u.pn * BM + wc * 32 + 8 * fq;
#pragma unroll
        for (int ai = 0; ai < 2; ++ai)
#pragma unroll
            for (int m = 0; m < 4; ++m) { const int row = row0 + ai * HALF + m * 16; bf16_t* rowp = O + (size_t)row * ldc + col0;
                float rs = 1.f; if (RS) rs = 1.0f / sqrtf((float)ss[row] * (1.f / 1048576.f / 4096.f) + 1e-6f);
#pragma unroll
                for (int bj = 0; bj < 2; ++bj) { f32x4 v0 = acc[ai][bj][m][0], v1 = acc[ai][bj][m][1];
                    if (RS) { v0 = v0 * rs; v1 = v1 * rs; }
                    if (ACT == 1) {
#pragma unroll
                        for (int e = 0; e < 4; ++e) { const float a = fmaxf(v0[e], 0.f), b = fmaxf(v1[e], 0.f); v0[e] = a * a; v1[e] = b * b; } }
                    u32x4 w; w.x = cvt_pk_bf16(v0[0], v0[1]); w.y = cvt_pk_bf16(v0[2], v0[3]); w.z = cvt_pk_bf16(v1[0], v1[1]); w.w = cvt_pk_bf16(v1[2], v1[3]);
                    *(u32x4*)(rowp + bj * HALF) = w; } }
    }
};
struct EpiF32 {
    static constexpr bool PERM = true, AFTER_DRAIN = false;
    float* O; int ldc;
    __device__ __forceinline__ void operator()(const f32x4 (&acc)[2][2][4][2], const Unit& u, int wr, int wc, int fr, int fq) const {
        const int row0 = u.pm * BM + wr * 64 + fr, col0 = u.pn * BM + wc * 32 + 8 * fq;
#pragma unroll
        for (int ai = 0; ai < 2; ++ai)
#pragma unroll
            for (int m = 0; m < 4; ++m) { float* rowp = O + (size_t)(row0 + ai * HALF + m * 16) * ldc + col0;
#pragma unroll
                for (int bj = 0; bj < 2; ++bj) { *(f32x4*)(rowp + bj * HALF) = acc[ai][bj][m][0]; *(f32x4*)(rowp + bj * HALF + 4) = acc[ai][bj][m][1]; } }
    }
};
struct EpiRes {
    static constexpr bool PERM = true, AFTER_DRAIN = false;
    bf16_t* xh; int ldc; unsigned long long* ss;
    __device__ __forceinline__ void operator()(const f32x4 (&acc)[2][2][4][2], const Unit& u, int wr, int wc, int fr, int fq) const {
        const int row0 = u.pm * BM + wr * 64 + fr, col0 = u.pn * BM + wc * 32 + 8 * fq;
#pragma unroll
        for (int ai = 0; ai < 2; ++ai)
#pragma unroll
            for (int m = 0; m < 4; ++m) { const int row = row0 + ai * HALF + m * 16; const size_t off = (size_t)row * ldc + col0; float sq = 0.f;
#pragma unroll
                for (int bj = 0; bj < 2; ++bj) { const u32x4 hv = *(const u32x4*)(xh + off + bj * HALF); u32x4 ho;
#pragma unroll
                    for (int e = 0; e < 4; ++e) { const f32x4& a = acc[ai][bj][m][e >> 1]; const int j = (e & 1) * 2;
                        const float v0 = __uint_as_float(hv[e] << 16) + a[j], v1 = __uint_as_float(hv[e] & 0xffff0000u) + a[j + 1];
                        ho[e] = cvt_pk_bf16(v0, v1); sq += v0 * v0 + v1 * v1; }
                    *(u32x4*)(xh + off + bj * HALF) = ho; }
                sq += __int_as_float(__builtin_amdgcn_ds_swizzle(__float_as_int(sq), 0x1f | (16 << 10)));
                { auto rr = __builtin_amdgcn_permlane32_swap(__float_as_uint(sq), __float_as_uint(sq), false, false); sq = __uint_as_float(rr[0]) + __uint_as_float(rr[1]); }
                if (fq == 0) __hip_atomic_fetch_add(ss + row, (unsigned long long)((double)sq * 1048576.0), __ATOMIC_RELAXED, __HIP_MEMORY_SCOPE_AGENT); }
    }
};
template <class Epi, class Sched, bool ALIGN_EPI = false, bool SP2 = false>
__device__ __forceinline__ void gemm_phase(PG8_LAS unsigned char* lds, const Gemm g, const Sched& S, const Epi& E, const int wid0) {
    int wid_ = wid0; asm volatile("" : "+s"(wid_));
    const int wid = wid_, lane = fresh_lane(), tid = wid * 64 + lane, wr = wid >> 2, wc = wid & 3, fr = lane & 15, fq = lane >> 4;
    const int K = g.K, nt = K / BK, lda = g.lda ? g.lda : K, ldb = g.ldb ? g.ldb : K;
    unsigned voffA[2], voffB[2];
#pragma unroll
    for (int i = 0; i < 2; ++i) { int R, C; stage_rc(tid * 16 + i * 8192, R, C); const int Rb = Epi::PERM ? ((R & ~31) + perm32(R & 31)) : R;
        voffA[i] = (unsigned)(R * lda + C) * 2u; voffB[i] = (unsigned)(Rb * ldb + C) * 2u; }
    const size_t kstep = (size_t)(BK * 2);
    const size_t hstepA = (size_t)HALF * lda * 2, hstepB = (size_t)HALF * ldb * 2;
    const size_t tstepA = 2 * hstepA, tstepB = 2 * hstepB;
    const unsigned ldsw = (unsigned)wid * 1024u;
    const int aoff = lds_byte(wr * 64 + fr, fq * 8), boff = lds_byte(wc * 32 + fr, fq * 8);
#define PG8_SA(b, h) (((b) * 2 + (h)) * HTB)
#define PG8_SB(b, h) ((4 + (b) * 2 + (h)) * HTB)
#define PG8_STAGE(bufoff, gbase, voff) do { _Pragma("unroll") for (int _i = 0; _i < 2; ++_i) \
        __builtin_amdgcn_global_load_lds((const unsigned*)((const char*)(gbase) + (voff)[_i]), (PG8_LAS unsigned*)(lds + (bufoff) + ldsw + _i * 8192), 16, 0, 0); } while (0)
#define PG8_LDA(dst, b, h) do { _Pragma("unroll") for (int m = 0; m < 4; ++m) _Pragma("unroll") for (int k = 0; k < 2; ++k) dst[m][k] = *(const PG8_LAS bf16x8*)(lds + PG8_SA(b, h) + aoff + m * 2048 + k * 1024); } while (0)
#define PG8_LDB(dst, b, h) do { _Pragma("unroll") for (int n = 0; n < 2; ++n) _Pragma("unroll") for (int k = 0; k < 2; ++k) dst[n][k] = *(const PG8_LAS bf16x8*)(lds + PG8_SB(b, h) + boff + n * 2048 + k * 1024); } while (0)
#define PG8_MMA(ai, bj, At, Bt) do { __builtin_amdgcn_s_setprio(1); _Pragma("unroll") for (int m = 0; m < 4; ++m) _Pragma("unroll") for (int n = 0; n < 2; ++n) _Pragma("unroll") for (int k = 0; k < 2; ++k) \
        acc[ai][bj][m][n] = __builtin_amdgcn_mfma_f32_16x16x32_bf16(Bt[n][k], At[m][k], acc[ai][bj][m][n], 0, 0, 0); __builtin_amdgcn_s_setprio(0); } while (0)
#define PG8_WAIT_V(n) asm volatile("s_waitcnt vmcnt(" #n ")" ::: "memory")
#define PG8_WAIT_L(n) asm volatile("s_waitcnt lgkmcnt(" #n ")" ::: "memory")
#define PG8_BAR __builtin_amdgcn_s_barrier()
#define PG8_SCHED __builtin_amdgcn_sched_barrier(0)
    Unit cur, nxt; int ui = 0;
    if (!S.next(0, cur)) return;
    f32x4 acc[2][2][4][2];
#pragma unroll
    for (int a = 0; a < 2; ++a)
#pragma unroll
        for (int b = 0; b < 2; ++b)
#pragma unroll
            for (int m = 0; m < 4; ++m)
#pragma unroll
                for (int n = 0; n < 2; ++n) acc[a][b][m][n] = (f32x4){0.f, 0.f, 0.f, 0.f};
    bf16x8 At[4][2], B0[2][2], B1[2][2];
    const char* cA = (const char*)g.A + (size_t)cur.pm * tstepA + (size_t)((cur.pn >> g.ash) * g.aoff) * 2; const char* cB = (const char*)g.Bt + (size_t)cur.pn * tstepB;
    S.a_ready(cur);
    if constexpr (SP2) {
        PG8_STAGE(PG8_SB(0, 0), cB, voffB); PG8_STAGE(PG8_SB(0, 1), cB + hstepB, voffB); PG8_STAGE(PG8_SA(0, 0), cA, voffA); PG8_STAGE(PG8_SA(0, 1), cA + hstepA, voffA);
        if (wr == 1) PG8_BAR;
        PG8_WAIT_V(2); PG8_BAR;
        PG8_STAGE(PG8_SB(1, 0), cB + kstep, voffB); PG8_STAGE(PG8_SA(1, 0), cA + kstep, voffA); PG8_STAGE(PG8_SB(1, 1), cB + hstepB + kstep, voffB);
        PG8_WAIT_V(6); PG8_BAR;
    } else {
        PG8_STAGE(PG8_SB(0, 0), cB, voffB); PG8_STAGE(PG8_SA(0, 0), cA, voffA); PG8_STAGE(PG8_SB(0, 1), cB + hstepB, voffB); PG8_STAGE(PG8_SA(0, 1), cA + hstepA, voffA);
        if (wr == 1) PG8_BAR;
        PG8_WAIT_V(4); PG8_BAR;
        PG8_STAGE(PG8_SB(1, 0), cB + kstep, voffB); PG8_STAGE(PG8_SA(1, 0), cA + kstep, voffA); PG8_STAGE(PG8_SB(1, 1), cB + hstepB + kstep, voffB);
        PG8_WAIT_V(6); PG8_BAR;
    }
    for (;;) {
        const bool has_next = S.next(ui + 1, nxt);
        const char* nA = has_next ? (const char*)g.A + (size_t)nxt.pm * tstepA + (size_t)((nxt.pn >> g.ash) * g.aoff) * 2 : cA; const char* nB = has_next ? (const char*)g.Bt + (size_t)nxt.pn * tstepB : cB;
        for (int t = 0; t < nt; t += 2) {
            const bool last = (t == nt - 2);
            const char* a1 = cA + (size_t)(t + 1) * kstep;
            const char* a2 = last ? nA : cA + (size_t)(t + 2) * kstep; const char* b2 = last ? nB : cB + (size_t)(t + 2) * kstep;
            const char* a3 = a2 + kstep; const char* b3 = b2 + kstep;
            if (last && has_next) S.a_ready(nxt);
            if constexpr (SP2) {
            PG8_LDB(B0, 0, 0); PG8_LDB(B1, 0, 1); PG8_SCHED; PG8_LDA(At, 0, 0); PG8_STAGE(PG8_SA(1, 1), a1 + hstepA, voffA);
            PG8_WAIT_V(8); PG8_WAIT_L(0); PG8_BAR; PG8_MMA(0, 0, At, B0); PG8_MMA(0, 1, At, B1); PG8_BAR; PG8_SCHED;
            PG8_LDA(At, 0, 1); PG8_STAGE(PG8_SB(0, 0), b2, voffB); PG8_STAGE(PG8_SB(0, 1), b2 + hstepB, voffB); PG8_STAGE(PG8_SA(0, 0), a2, voffA);
            PG8_WAIT_V(8); PG8_WAIT_L(0); PG8_BAR; PG8_MMA(1, 0, At, B0); PG8_MMA(1, 1, At, B1); PG8_BAR; PG8_SCHED;
            PG8_LDB(B0, 1, 0); PG8_LDB(B1, 1, 1); PG8_SCHED; PG8_LDA(At, 1, 0); PG8_STAGE(PG8_SA(0, 1), a2 + hstepA, voffA);
            PG8_WAIT_V(8); PG8_WAIT_L(0); PG8_BAR; PG8_MMA(0, 0, At, B0); PG8_MMA(0, 1, At, B1); PG8_BAR; PG8_SCHED;
            PG8_LDA(At, 1, 1); PG8_STAGE(PG8_SB(1, 0), b3, voffB); PG8_STAGE(PG8_SB(1, 1), b3 + hstepB, voffB); PG8_STAGE(PG8_SA(1, 0), a3, voffA);
            PG8_WAIT_V(8); PG8_WAIT_L(0); PG8_BAR; PG8_MMA(1, 0, At, B0); PG8_MMA(1, 1, At, B1); PG8_BAR; PG8_SCHED;
            } else {
            PG8_LDB(B0, 0, 0); PG8_SCHED; PG8_LDA(At, 0, 0); PG8_STAGE(PG8_SA(1, 1), a1 + hstepA, voffA);
            PG8_WAIT_L(8); PG8_BAR; PG8_WAIT_L(0); PG8_MMA(0, 0, At, B0); PG8_BAR; PG8_SCHED;
            PG8_LDB(B1, 0, 1); PG8_STAGE(PG8_SB(0, 0), b2, voffB);
            PG8_BAR; PG8_WAIT_L(0); PG8_MMA(0, 1, At, B1); PG8_BAR;
            PG8_LDA(At, 0, 1); PG8_STAGE(PG8_SA(0, 0), a2, voffA);
            PG8_BAR; PG8_WAIT_L(0); PG8_MMA(1, 0, At, B0); PG8_BAR; PG8_SCHED;
            PG8_STAGE(PG8_SB(0, 1), b2 + hstepB, voffB);
            PG8_WAIT_V(6); PG8_BAR; PG8_MMA(1, 1, At, B1); PG8_BAR;
            PG8_LDB(B0, 1, 0); PG8_SCHED; PG8_LDA(At, 1, 0); PG8_STAGE(PG8_SA(0, 1), a2 + hstepA, voffA);
            PG8_WAIT_L(8); PG8_BAR; PG8_WAIT_L(0); PG8_MMA(0, 0, At, B0); PG8_BAR; PG8_SCHED;
            PG8_LDB(B1, 1, 1); PG8_STAGE(PG8_SB(1, 0), b3, voffB);
            PG8_BAR; PG8_WAIT_L(0); PG8_MMA(0, 1, At, B1); PG8_BAR;
            PG8_LDA(At, 1, 1); PG8_STAGE(PG8_SA(1, 0), a3, voffA);
            PG8_BAR; PG8_WAIT_L(0); PG8_MMA(1, 0, At, B0); PG8_BAR; PG8_SCHED;
            PG8_STAGE(PG8_SB(1, 1), b3 + hstepB, voffB);
            PG8_WAIT_V(6); PG8_BAR; PG8_MMA(1, 1, At, B1); PG8_BAR;
            }
        }
        if constexpr (ALIGN_EPI) { if (wr == 0) PG8_BAR; }
        if constexpr (!Epi::AFTER_DRAIN) { E(acc, cur, wr, wc, fr, fq); S.done(cur); }
        if (!has_next) break;
#pragma unroll
        for (int a = 0; a < 2; ++a)
#pragma unroll
            for (int b = 0; b < 2; ++b)
#pragma unroll
                for (int m = 0; m < 4; ++m)
#pragma unroll
                    for (int n = 0; n < 2; ++n) acc[a][b][m][n] = (f32x4){0.f, 0.f, 0.f, 0.f};
        cur = nxt; cA = nA; cB = nB; ++ui;
        if constexpr (ALIGN_EPI) { if (wr == 1) PG8_BAR; }
    }
    PG8_WAIT_V(0);
    if constexpr (!ALIGN_EPI) { if (wr == 0) PG8_BAR; }
    PG8_BAR;
    if constexpr (Epi::AFTER_DRAIN) { E.fused(acc, cur, wr, wc, fr, fq, lds, wid, lane); S.done(cur); }
#undef PG8_SA
#undef PG8_SB
#undef PG8_STAGE
#undef PG8_LDA
#undef PG8_LDB
#undef PG8_MMA
#undef PG8_WAIT_V
#undef PG8_WAIT_L
#undef PG8_BAR
#undef PG8_SCHED
}
}
#define GAS __attribute__((address_space(1)))
#define LAS __attribute__((address_space(3)))
typedef unsigned short bf16;
typedef unsigned v4u __attribute__((ext_vector_type(4)));
typedef float f32x4 __attribute__((ext_vector_type(4)));
typedef short bf16x8 __attribute__((ext_vector_type(8)));
typedef GAS unsigned gu32;
typedef GAS unsigned long long gu64;
#define RLX_AGENT __ATOMIC_RELAXED, __HIP_MEMORY_SCOPE_AGENT
#define LDS_WAIT() asm volatile("s_waitcnt lgkmcnt(0)" ::: "memory")
#define VM_WAIT() asm volatile("s_waitcnt vmcnt(0)" ::: "memory")
__device__ __forceinline__ unsigned long long rt() { return __builtin_amdgcn_s_memrealtime(); }
__device__ __forceinline__ unsigned f2bf(float f) { unsigned u = __builtin_bit_cast(unsigned, f); return (u + 0x7fffu + ((u >> 16) & 1u)) >> 16; }
__device__ __forceinline__ unsigned pk2(float lo, float hi) { return f2bf(lo) | (f2bf(hi) << 16); }

#define XB_TMO      128
#define XB_XCNT(j)  (256  + 64 * (j))
#define XB_XSUB(j)  (1280 + 64 * (j))
#define XB_XGEN(j)  (2304 + 64 * (j))
#define XB_TOP      3328
#define XB_TOPGEN   3392
#define XCD_BAR_WORDS 3456
#define XB_SPIN_CAP (1u << 18)

__device__ __forceinline__ unsigned xb_ld(unsigned* p)              { return __hip_atomic_load(p, __ATOMIC_RELAXED, __HIP_MEMORY_SCOPE_AGENT); }
__device__ __forceinline__ unsigned xb_add(unsigned* p, unsigned v) { return __hip_atomic_fetch_add(p, v, __ATOMIC_RELAXED, __HIP_MEMORY_SCOPE_AGENT); }
__device__ __forceinline__ unsigned xb_xcc_id() { return (unsigned)__builtin_amdgcn_s_getreg((3 << 11) | 20) & 0xFu; }
#define XB_SPIN(cond, bar) do { unsigned _sp = 0; while (cond) { __builtin_amdgcn_s_sleep(1); \
    if ((++_sp & 255u) == 0u) { if (xb_ld(&(bar)[XB_TMO])) break; if (_sp > XB_SPIN_CAP) { atomicAdd(&(bar)[XB_TMO], 1u); break; } } } } while (0)

struct XcdBarrier {
    unsigned* bar; unsigned x;
    volatile LAS unsigned* st;
};

__device__ __forceinline__ XcdBarrier xcd_barrier_post(unsigned* bar, volatile LAS unsigned* st, const int wid0) {
    XcdBarrier b; b.bar = bar; b.x = xb_xcc_id(); b.st = st;
    if (wid0 == 0 && fresh_lane() == 0) (void)xb_add(&bar[XB_XCNT(b.x)], 1u);
    return b;
}
__device__ __forceinline__ void xcd_barrier_complete(unsigned* bar, unsigned x, unsigned& nloc, unsigned& nx) {
    const unsigned G = gridDim.x * gridDim.y * gridDim.z;
    unsigned sum, cnt, mine, sp = 0u;
    for (;;) {
        sum = 0u; cnt = 0u; mine = 0u;
#pragma unroll 1
        for (unsigned j = 0; j < 16; ++j) { const unsigned c = xb_ld(&bar[XB_XCNT(j)]); sum += c; cnt += (c > 0u) ? 1u : 0u; mine = (j == x) ? c : mine; }
        if (sum == G) break;
        __builtin_amdgcn_s_sleep(1);
        if ((++sp & 255u) == 0u) { if (xb_ld(&bar[XB_TMO])) break; if (sp > XB_SPIN_CAP) { atomicAdd(&bar[XB_TMO], 1u); break; } }
    }
    nloc = mine > 0u ? mine : 1u; nx = cnt > 0u ? cnt : 1u;
}

__device__ __forceinline__ void xcd_barrier(const XcdBarrier& b, const int wid0) {
    asm volatile("s_waitcnt vmcnt(0)" ::: "memory");
    __syncthreads();
    if (wid0 == 0 && fresh_lane() == 0) {
        unsigned* bar = b.bar;
        __builtin_amdgcn_s_waitcnt(0);
        unsigned nloc = b.st[0], nx = b.st[1];
        const unsigned bx_ = xb_xcc_id();
        if (nloc == 0u) { xcd_barrier_complete(bar, bx_, nloc, nx); b.st[0] = nloc; b.st[1] = nx; }
        const unsigned old = xb_add(&bar[XB_XSUB(bx_)], 1u);
        const unsigned gen = old / nloc;
        if (old + 1u == (gen + 1u) * nloc) {
            __builtin_amdgcn_fence(__ATOMIC_RELEASE, "agent");
            asm volatile("s_waitcnt vmcnt(0)" ::: "memory");
            const unsigned og = xb_add(&bar[XB_TOP], 1u);
            const unsigned tg = og / nx;
            if (og + 1u == (tg + 1u) * nx) xb_add(&bar[XB_TOPGEN], 1u);
            else XB_SPIN(xb_ld(&bar[XB_TOPGEN]) == tg, bar);
            __builtin_amdgcn_fence(__ATOMIC_ACQUIRE, "agent");
            xb_add(&bar[XB_XGEN(bx_)], 1u);
            asm volatile("s_waitcnt vmcnt(0)" ::: "memory");
        } else {
            XB_SPIN(xb_ld(&bar[XB_XGEN(bx_)]) == gen, bar);
            __builtin_amdgcn_fence(__ATOMIC_ACQUIRE, "agent");
            asm volatile("s_waitcnt vmcnt(0)" ::: "memory");
        }
    }
    __syncthreads();
}
constexpr int NWAVES = 8;
constexpr int NB = 2, SEQ = 4096, DM = 4096, NL = 2, M = NB * SEQ;
constexpr int INC = 11336, INP = 11520;
constexpr int A_Q = 0, B_CQ = 3072, B_CKV = 4608, B_KR = 5120, C_Q = 5184, D_Q = 8256, D_F = 11328;
constexpr int QRANK = 1536, KVRANK = 512, DFF = 16384, MEMT = 256;
constexpr int QKS = 4;
constexpr int P4DEF = 64 * 8 * 4;
constexpr int P8DEF = 0;
constexpr int UPDEF = 88 * 8 * 8;
constexpr float EPS = 1e-6f;

constexpr size_t MiB = 1u << 20;
constexpr size_t WS_CTL = 0, CTL_ZERO_BYTES = 1 * MiB;
constexpr size_t WS_COS = 1 * MiB, WS_SIN = 2 * MiB;
constexpr size_t WS_LUT = 3 * MiB;
constexpr size_t WS_TPMAX = 3 * MiB + 8192;
constexpr size_t WS_LAM = 3 * MiB + 12288;
constexpr size_t WS_LOGF = 4 * MiB, WS_NEGC = 4 * MiB + 512 * 1024;
constexpr size_t WS_W = 8 * MiB;
constexpr size_t SZ_IN = (size_t)INP * DM * 2, SZ_OUT = (size_t)DM * DM * 2, SZ_UQ = (size_t)1536 * 1536 * 2, SZ_UKV = (size_t)2048 * 512 * 2,
                 SZ_MQ = (size_t)512 * DM * 2, SZ_MKV = (size_t)1024 * DM * 2, SZ_MO = (size_t)DM * 512 * 2, SZ_UP = (size_t)DFF * DM * 2, SZ_DN = SZ_UP;
constexpr size_t W_IN = 0, W_OUT = W_IN + SZ_IN, W_UQ = W_OUT + SZ_OUT, W_UKV = W_UQ + SZ_UQ, W_MQ = W_UKV + SZ_UKV, W_MKV = W_MQ + SZ_MQ, W_MO = W_MKV + SZ_MKV,
                 W_UP = W_MO + SZ_MO, W_DN = W_UP + SZ_UP, W_LAYER = W_DN + SZ_DN;
static_assert(W_LAYER % 256 == 0, "weight block alignment");
constexpr size_t WS_MEMN = WS_W + NL * W_LAYER;
constexpr size_t WS_KVMEM = WS_MEMN + (size_t)NL * 512 * DM * 2;
constexpr size_t WS_H = WS_KVMEM + (size_t)NL * 512 * 1024 * 2;
constexpr size_t WS_CQN = WS_H + (size_t)M * DM * 2;
constexpr size_t WS_CKVN = WS_CQN + (size_t)M * 1536 * 2;
constexpr size_t WS_KPE = WS_CKVN + (size_t)M * 512 * 2;
constexpr size_t WS_QMLA = WS_KPE + (size_t)M * 64 * 2;
constexpr size_t WS_KVMLA = WS_QMLA + (size_t)M * 1536 * 2;
constexpr size_t WS_QMEM = WS_KVMLA + (size_t)M * 2048 * 2;
constexpr size_t WS_OMEM = WS_QMEM + (size_t)M * 512 * 2;
constexpr size_t WS_XL = WS_OMEM + (size_t)M * 512 * 2;
constexpr size_t WS_U = WS_XL + (size_t)M * DM * 2;
constexpr size_t WS_PROJ = WS_U;
constexpr size_t WS_MIX = WS_PROJ + (size_t)M * INP * 2;
static_assert(WS_MIX + (size_t)M * DM * 2 <= WS_U + (size_t)M * DFF * 2, "PROJ + MIX fit inside U");
constexpr size_t WS_END = WS_U + (size_t)M * DFF * 2;
constexpr int CW_BAR = 4096;
constexpr int CW_SS = 32768;
constexpr int CW_KN = 24576;
constexpr int CW_TKT = 16384;

constexpr int RING_OFF = 0, RING_BYTES = 137216;
constexpr int LDSCTL_OFF = RING_BYTES, MISC_OFF = LDSCTL_OFF + 320;
constexpr int KNL_OFF = MISC_OFF + 128;
constexpr int LDS_BYTES = 147456;

typedef unsigned short bf16;
typedef short bf16x8 __attribute__((ext_vector_type(8)));
typedef short s16x4 __attribute__((ext_vector_type(4)));
typedef float f32x4 __attribute__((ext_vector_type(4)));
typedef float f32x16 __attribute__((ext_vector_type(16)));
typedef unsigned v4u __attribute__((ext_vector_type(4)));
typedef unsigned v2u __attribute__((ext_vector_type(2)));
typedef int i32x4 __attribute__((ext_vector_type(4)));

__device__ __forceinline__ unsigned cvtpk(float lo, float hi) { unsigned r; asm volatile("v_cvt_pk_bf16_f32 %0, %1, %2" : "=v"(r) : "v"(lo), "v"(hi)); return r; }
__device__ __forceinline__ float bf2f(short s) { return __uint_as_float(((unsigned)(unsigned short)s) << 16); }
template <int X> __device__ __forceinline__ float shx(float v) { return __int_as_float(__builtin_amdgcn_ds_swizzle(__float_as_int(v), 0x1f | (X << 10))); }
template <int X> __device__ __forceinline__ int shxi(int v) { return __builtin_amdgcn_ds_swizzle(v, 0x1f | (X << 10)); }
__device__ __forceinline__ float half_sum(float v) { v += shx<1>(v); v += shx<2>(v); v += shx<4>(v); v += shx<8>(v); v += shx<16>(v); return v; }
__device__ __forceinline__ float wave_sum(float v) { v = half_sum(v);
    auto rr = __builtin_amdgcn_permlane32_swap(__float_as_uint(v), __float_as_uint(v), false, false); return __uint_as_float(rr[0]) + __uint_as_float(rr[1]); }
#define FRESH_LANE(name) const int name = fresh_lane()
#define WAITBAR() asm volatile("s_waitcnt vmcnt(0) lgkmcnt(0)\n\ts_barrier" ::: "memory")

__device__ __forceinline__ void tr_item(const float* W, int K, int N, int nblk, bf16* WT, int row_off, LAS float* scr, int item, int lane, const float* gk) {
    const int kb = item / nblk, nb = item - kb * nblk, k0 = 64 * kb, n0 = 64 * nb;
    const int c4 = (lane & 15) * 4, rr = lane >> 4; const bool ok = n0 + c4 < N;
    const GAS f32x4* src = (const GAS f32x4*)(W + (size_t)(k0 + rr) * N + n0 + c4);
    f32x4 v[16];
#pragma unroll
    for (int i = 0; i < 16; ++i) v[i] = ok ? __builtin_nontemporal_load((const GAS f32x4*)((const GAS float*)src + (size_t)(4 * i) * N)) : (f32x4){0.f, 0.f, 0.f, 0.f};
    if (gk) {
#pragma unroll
        for (int i = 0; i < 16; ++i) v[i] = v[i] * gk[k0 + 4 * i + rr]; }
#pragma unroll
    for (int i = 0; i < 16; ++i) { LAS float* s = scr + (4 * i + rr) * 65 + c4; s[0] = v[i].x; s[1] = v[i].y; s[2] = v[i].z; s[3] = v[i].w; }
    LDS_WAIT(); asm volatile("" ::: "memory");
    const int c = lane & 7;
#pragma unroll
    for (int j = 0; j < 8; ++j) { const int nn = (lane >> 3) + 8 * j; const LAS float* s = scr + (8 * c) * 65 + nn;
        v4u o; o.x = cvtpk(s[0 * 65], s[1 * 65]); o.y = cvtpk(s[2 * 65], s[3 * 65]); o.z = cvtpk(s[4 * 65], s[5 * 65]); o.w = cvtpk(s[6 * 65], s[7 * 65]);
        *(GAS v4u*)(WT + (size_t)(row_off + n0 + nn) * K + k0 + 8 * c) = o; }
    LDS_WAIT(); asm volatile("" ::: "memory");
}
template <bool BF> __device__ __forceinline__ void rms_row(const float* xrow, const float* g, void* orow, int lane) {
    const GAS f32x4* xr = (const GAS f32x4*)xrow + lane; const GAS f32x4* gr = (const GAS f32x4*)g + lane;
    f32x4 v[16]; float s = 0.f;
#pragma unroll
    for (int j = 0; j < 16; ++j) { v[j] = xr[64 * j]; s += (v[j].x * v[j].x + v[j].y * v[j].y) + (v[j].z * v[j].z + v[j].w * v[j].w); }
    const float rstd = 1.0f / sqrtf(wave_sum(s) * (1.f / DM) + EPS);
#pragma unroll
    for (int j = 0; j < 16; ++j) { const f32x4 gg = gr[64 * j]; const f32x4 y = v[j] * rstd * gg;
        if (BF) { v2u w; w.x = cvtpk(y.x, y.y); w.y = cvtpk(y.z, y.w); ((GAS v2u*)orow)[64 * j + lane] = w; }
        else ((GAS f32x4*)orow)[64 * j + lane] = y; }
}
__device__ __forceinline__ void cast_row(const float* xrow, bf16* hrow, unsigned long long* ss, int lane) {
    const GAS f32x4* xr = (const GAS f32x4*)xrow + lane; float s = 0.f;
#pragma unroll
    for (int j = 0; j < 16; ++j) { const f32x4 v = xr[64 * j]; s += (v.x * v.x + v.y * v.y) + (v.z * v.z + v.w * v.w);
        v2u h; h.x = cvtpk(v.x, v.y); h.y = cvtpk(v.z, v.w); ((GAS v2u*)hrow)[64 * j + lane] = h; }
    s = wave_sum(s); if (lane == 0) *ss = (unsigned long long)((double)s * 1048576.0);
}
__device__ __forceinline__ void final_row(const bf16* hrow, const float* g, float* orow, int lane) {
    f32x4 v[16]; float s = 0.f;
#pragma unroll
    for (int j = 0; j < 16; ++j) { const v2u h = ((const GAS v2u*)hrow)[64 * j + lane];
        v[j].x = __uint_as_float(h.x << 16); v[j].y = __uint_as_float(h.x & 0xffff0000u); v[j].z = __uint_as_float(h.y << 16); v[j].w = __uint_as_float(h.y & 0xffff0000u);
        s += (v[j].x * v[j].x + v[j].y * v[j].y) + (v[j].z * v[j].z + v[j].w * v[j].w); }
    const float rstd = 1.0f / sqrtf(wave_sum(s) * (1.f / DM) + EPS);
#pragma unroll
    for (int j = 0; j < 16; ++j) { const f32x4 gg = ((const GAS f32x4*)g)[64 * j + lane]; ((GAS f32x4*)orow)[64 * j + lane] = v[j] * rstd * gg; }
}
__device__ __forceinline__ float logsigmoidf_(float x) {
    const float e = __expf(-fabsf(x)); return fminf(x, 0.f) - __logf(1.f + e);
}
__device__ __forceinline__ void prep_row(const bf16* proj, int m, const float* gq, const float* gkv, const float* bf, const float* COS, const float* SIN,
                                         bf16* CQN, bf16* CKVN, bf16* KPE, float* LOGF, LAS unsigned* KNL, int lane) {
    const bf16* pr = proj + (size_t)m * INP;
    bf16x8 q[3]; float sq = 0.f;
#pragma unroll
    for (int j = 0; j < 3; ++j) { q[j] = *(const GAS bf16x8*)(pr + B_CQ + (j * 64 + lane) * 8);
#pragma unroll
        for (int e = 0; e < 8; ++e) { const float f = bf2f(q[j][e]); sq += f * f; } }
    const bf16x8 kv = *(const GAS bf16x8*)(pr + B_CKV + lane * 8); float skv = 0.f;
#pragma unroll
    for (int e = 0; e < 8; ++e) { const float f = bf2f(kv[e]); skv += f * f; }
    const float rq = 1.0f / sqrtf(wave_sum(sq) * (1.f / QRANK) + EPS), rkv = 1.0f / sqrtf(wave_sum(skv) * (1.f / KVRANK) + EPS);
#pragma unroll
    for (int j = 0; j < 3; ++j) { const int c0 = (j * 64 + lane) * 8; const f32x4 g0 = *(const GAS f32x4*)(gq + c0), g1 = *(const GAS f32x4*)(gq + c0 + 4);
        v4u w; w.x = cvtpk(bf2f(q[j][0]) * rq * g0.x, bf2f(q[j][1]) * rq * g0.y); w.y = cvtpk(bf2f(q[j][2]) * rq * g0.z, bf2f(q[j][3]) * rq * g0.w);
        w.z = cvtpk(bf2f(q[j][4]) * rq * g1.x, bf2f(q[j][5]) * rq * g1.y); w.w = cvtpk(bf2f(q[j][6]) * rq * g1.z, bf2f(q[j][7]) * rq * g1.w);
        *(GAS v4u*)(CQN + (size_t)m * QRANK + c0) = w; }
    { const int c0 = lane * 8; const f32x4 g0 = *(const GAS f32x4*)(gkv + c0), g1 = *(const GAS f32x4*)(gkv + c0 + 4);
        v4u w; w.x = cvtpk(bf2f(kv[0]) * rkv * g0.x, bf2f(kv[1]) * rkv * g0.y); w.y = cvtpk(bf2f(kv[2]) * rkv * g0.z, bf2f(kv[3]) * rkv * g0.w);
        w.z = cvtpk(bf2f(kv[4]) * rkv * g1.x, bf2f(kv[5]) * rkv * g1.y); w.w = cvtpk(bf2f(kv[6]) * rkv * g1.z, bf2f(kv[7]) * rkv * g1.w);
        *(GAS v4u*)(CKVN + (size_t)m * KVRANK + c0) = w; }
    { const float v = bf2f((short)pr[B_KR + lane]); float pv; { auto rr = __builtin_amdgcn_permlane32_swap(__float_as_uint(v), __float_as_uint(v), false, false); pv = __uint_as_float(lane >= 32 ? rr[0] : rr[1]); } const int i = lane & 31;
      const float c = COS[(size_t)m * 32 + i], s = SIN[(size_t)m * 32 + i];
      const float o = lane < 32 ? v * c - pv * s : pv * s + v * c;
      const float on = shx<1>(o);
      if ((lane & 1) == 0) *(GAS unsigned*)(KPE + (size_t)m * 64 + lane) = cvtpk(o, on); }
    if (lane < 8) { const float f = bf2f((short)pr[D_F + lane]) + bf[lane]; const int b = m / SEQ, s = m - b * SEQ; LOGF[(size_t)(b * 8 + lane) * SEQ + s] = logsigmoidf_(f); }
    { const bf16x8 k0 = *(const GAS bf16x8*)(pr + D_Q + 1024 + lane * 16), k1 = *(const GAS bf16x8*)(pr + D_Q + 1024 + lane * 16 + 8); float s = 0.f;
#pragma unroll
      for (int e = 0; e < 8; ++e) { const float a = bf2f(k0[e]), c = bf2f(k1[e]); s += a * a + c * c; }
      s += shx<1>(s); s += shx<2>(s); s += shx<4>(s);
      if ((lane & 7) == 0) __hip_atomic_fetch_max(KNL + (m / SEQ) * 8 + (lane >> 3), __float_as_uint(s), __ATOMIC_RELAXED, __HIP_MEMORY_SCOPE_WORKGROUP); }
}
__device__ __forceinline__ void fox_scan(const float* logf, float* negc, int lane) {
    const GAS f32x4* src = (const GAS f32x4*)(logf + lane * 64); f32x4 v[16]; float tot = 0.f;
#pragma unroll
    for (int j = 0; j < 16; ++j) { v[j] = src[j]; tot += (v[j].x + v[j].y) + (v[j].z + v[j].w); }
    float inc = tot;
#pragma unroll
    for (int o = 1; o < 64; o <<= 1) { const float t = __int_as_float(__builtin_amdgcn_ds_bpermute((lane - o) << 2, __float_as_int(inc))); if (lane >= o) inc += t; }
    float run = inc - tot; const float k = -11.313708498984761f;
    GAS f32x4* dst = (GAS f32x4*)(negc + lane * 64);
#pragma unroll
    for (int j = 0; j < 16; ++j) { f32x4 o; run += v[j].x; o.x = run * k; run += v[j].y; o.y = run * k; run += v[j].z; o.z = run * k; run += v[j].w; o.w = run * k; dst[j] = o; }
}

struct Cv { int idx, K, N, NP; long long dst; int roff, gain, lay, first, cnt, pad; };
constexpr int NCV = 16;
constexpr int NTB = 4;
struct Args { const void* in[27]; float* out; unsigned char* ws; float inv_freq[32]; float lam_init[2]; Cv cv[NTB][NCV]; int ncv[NTB]; int nchunk[NTB]; };
static_assert(sizeof(Cv) == 48 && sizeof(Args) == 27 * 8 + 16 + 128 + 8 + NTB * NCV * 48 + 8 * NTB, "Args has no padding");
typedef const unsigned char __attribute__((address_space(4)))* kaptr_t;
__device__ __forceinline__ kaptr_t ka_fresh() { kaptr_t p = (kaptr_t)__builtin_amdgcn_kernarg_segment_ptr(); asm volatile("" : "+s"(p)); return p; }
#define KIN(ka, i) (*(const void* const __attribute__((address_space(4)))*)((ka) + 8 * (i)))
#define KOUT(ka) ((float*)KIN(ka, 27))
#define KWS(ka) ((unsigned char*)KIN(ka, 28))
#define KINVF(ka, i) (*(const float __attribute__((address_space(4)))*)((ka) + 232 + 4 * (i)))
#define KLAMI(ka, l) (*(const float __attribute__((address_space(4)))*)((ka) + 360 + 4 * (l)))
#define KCVI(ka, l, j, f) (*(const int __attribute__((address_space(4)))*)((ka) + 368 + ((l) * NCV + (j)) * 48 + 4 * (f)))
#define KCVD(ka, l, j) (*(const long long __attribute__((address_space(4)))*)((ka) + 368 + ((l) * NCV + (j)) * 48 + 16))
#define KNCV(ka, l) (*(const int __attribute__((address_space(4)))*)((ka) + 368 + NTB * NCV * 48 + 4 * (l)))
#define KNCH(ka, l) (*(const int __attribute__((address_space(4)))*)((ka) + 368 + NTB * NCV * 48 + 4 * NTB + 4 * (l)))
__device__ __forceinline__ void conv_item(const kaptr_t ka, unsigned char* ws, int t, int it, LAS float* scr, int lane) {
    const int n = KNCV(ka, t); int rem = it, j = 0;
    for (; j < n; ++j) { const int cnt = KCVI(ka, t, j, 10); if (rem < cnt) break; rem -= cnt; }
    if (j >= n) return;
    const int idx = KCVI(ka, t, j, 0), K = KCVI(ka, t, j, 1), N = KCVI(ka, t, j, 2), NP = KCVI(ka, t, j, 3), roff = KCVI(ka, t, j, 6), gain = KCVI(ka, t, j, 7), lay = KCVI(ka, t, j, 8), first = KCVI(ka, t, j, 9);
    const float* gk = nullptr; if (gain >= 0) gk = (const float*)KIN(ka, gain) + (size_t)lay * K;
    tr_item((const float*)KIN(ka, idx) + (size_t)lay * K * N, K, N, NP / 64, (bf16*)(ws + KCVD(ka, t, j)), roff, scr, first + rem, lane, gk);
}
struct CvD { const float* W; bf16* WT; const float* gk; int K, N, nblk, roff, item; };
struct TrBuf { f32x4 v[16]; f32x4 g0, g1; };
__device__ __forceinline__ bool cv_desc(const kaptr_t ka, unsigned char* ws, int t, int it, CvD& d) {
    const int n = KNCV(ka, t); int rem = it, j = 0;
    for (; j < n; ++j) { const int cnt = KCVI(ka, t, j, 10); if (rem < cnt) break; rem -= cnt; }
    if (j >= n) return false;
    const int idx = KCVI(ka, t, j, 0), K = KCVI(ka, t, j, 1), N = KCVI(ka, t, j, 2), NP = KCVI(ka, t, j, 3), gain = KCVI(ka, t, j, 7), lay = KCVI(ka, t, j, 8);
    d.gk = nullptr; if (gain >= 0) d.gk = (const float*)KIN(ka, gain) + (size_t)lay * K;
    d.W = (const float*)KIN(ka, idx) + (size_t)lay * K * N; d.WT = (bf16*)(ws + KCVD(ka, t, j)); d.K = K; d.N = N; d.nblk = NP / 64; d.roff = KCVI(ka, t, j, 6); d.item = KCVI(ka, t, j, 9) + rem;
    return true;
}
__device__ __forceinline__ void tr_load(const CvD& d, int lane, TrBuf& b) {
    const int kb = d.item / d.nblk, nb = d.item - kb * d.nblk, k0 = 64 * kb, n0 = 64 * nb;
    const int c4 = (lane & 15) * 4, rr = lane >> 4; const bool ok = n0 + c4 < d.N;
    const GAS float* src = (const GAS float*)(d.W + (size_t)(k0 + rr) * d.N + n0 + c4);
#pragma unroll
    for (int i = 0; i < 16; ++i) b.v[i] = ok ? __builtin_nontemporal_load((const GAS f32x4*)(src + (size_t)(4 * i) * d.N)) : (f32x4){0.f, 0.f, 0.f, 0.f};
    b.g0 = (f32x4){1.f, 1.f, 1.f, 1.f}; b.g1 = b.g0;
    if (d.gk) { const GAS f32x4* gp = (const GAS f32x4*)(d.gk + k0 + 8 * (lane & 7)); b.g0 = gp[0]; b.g1 = gp[1]; }
}
__device__ __forceinline__ void tr_fin(const CvD& d, const TrBuf& b, LAS float* scr, int lane) {
    const int kb = d.item / d.nblk, nb = d.item - kb * d.nblk, k0 = 64 * kb, n0 = 64 * nb;
    const int c4 = (lane & 15) * 4, rr = lane >> 4;
#pragma unroll
    for (int i = 0; i < 16; ++i) { LAS float* s = scr + (4 * i + rr) * 65 + c4; s[0] = b.v[i].x; s[1] = b.v[i].y; s[2] = b.v[i].z; s[3] = b.v[i].w; }
    LDS_WAIT(); asm volatile("" ::: "memory");
    const int c = lane & 7;
#pragma unroll
    for (int j = 0; j < 8; ++j) { const int nn = (lane >> 3) + 8 * j; const LAS float* s = scr + (8 * c) * 65 + nn;
        v4u o; o.x = cvtpk(s[0 * 65] * b.g0.x, s[1 * 65] * b.g0.y); o.y = cvtpk(s[2 * 65] * b.g0.z, s[3 * 65] * b.g0.w); o.z = cvtpk(s[4 * 65] * b.g1.x, s[5 * 65] * b.g1.y); o.w = cvtpk(s[6 * 65] * b.g1.z, s[7 * 65] * b.g1.w);
        *(GAS v4u*)(d.WT + (size_t)(d.roff + n0 + nn) * d.K + k0 + 8 * c) = o; }
    LDS_WAIT(); asm volatile("" ::: "memory");
}
__device__ __forceinline__ void conv_run(const kaptr_t ka, unsigned char* ws, int t, int it0, int end, int st, LAS float* scr, int lane) {
    TrBuf b0, b1; int it = it0;
    bool h0; { CvD d; h0 = it < end && cv_desc(ka, ws, t, it, d); if (h0) tr_load(d, lane, b0); }
    while (h0) {
        bool h1; { CvD d; h1 = it + st < end && cv_desc(ka, ws, t, it + st, d); if (h1) tr_load(d, lane, b1); }
        { CvD d; cv_desc(ka, ws, t, it, d); tr_fin(d, b0, scr, lane); }
        if (!h1) break;
        it += st;
        { CvD d; h0 = it + st < end && cv_desc(ka, ws, t, it + st, d); if (h0) tr_load(d, lane, b0); }
        { CvD d; cv_desc(ka, ws, t, it, d); tr_fin(d, b1, scr, lane); }
        it += st;
    }
}
__device__ __forceinline__ void conv_chunk(const kaptr_t ka, unsigned char* ws, int l, int c, LAS float* scr, int wid, int lane) {
    conv_run(ka, ws, l, c * 64 + wid * 8, c * 64 + wid * 8 + 8, 1, scr, lane);
}

namespace att {
constexpr int VA = 0, VB = 1, VC = 2, VD = 3, VE = 4;
constexpr int K_OFF = 0, V_OFF = 32768, B_OFF = 65536, WS_OFF = 67584, LUT_OFF = 69632, FLG_OFF = 70656, TKT_OFF = 70784, KPE_OFF = 71680, QF_OFF = 71680, ATT_END = QF_OFF + 65536;
constexpr float LOG2E = 1.4426950408889634f, LN2 = 0.6931471805599453f, THR = 8.f;
struct Ctx { const bf16* PROJ; const bf16* QMLA; const bf16* KVMLA; const bf16* KPE; bf16* MIX; const bf16* QMEM; const bf16* KVMEM; bf16* OMEM;
             const float* COS; const float* SIN; const float* LUT; const int* TPMAX; const int* pos; const float* NEGC; const float* sub_g; const unsigned* KN2; float lam, oml; const unsigned long long* SSQ; };

__device__ __forceinline__ int crow(int r, int hi) { return (r & 3) + 8 * (r >> 2) + 4 * hi; }
__device__ __forceinline__ int swap23(int k) { return (k & ~0xC) | ((k & 4) << 1) | ((k & 8) >> 1); }
__device__ __forceinline__ float pmaxf(float v) { auto rr = __builtin_amdgcn_permlane32_swap(__float_as_uint(v), __float_as_uint(v), false, false); return fmaxf(__uint_as_float(rr[0]), __uint_as_float(rr[1])); }
__device__ __forceinline__ float psumf(float v) { auto rr = __builtin_amdgcn_permlane32_swap(__float_as_uint(v), __float_as_uint(v), false, false); return __uint_as_float(rr[0]) + __uint_as_float(rr[1]); }
__device__ __forceinline__ float partnerf(float v, int hi) { auto rr = __builtin_amdgcn_permlane32_swap(__float_as_uint(v), __float_as_uint(v), false, false); return __uint_as_float(hi ? rr[0] : rr[1]); }
__device__ __forceinline__ void dma16(const void* sbase, unsigned voff, unsigned ldsaddr) { unsigned keep;
    asm volatile("s_mov_b32 %0, m0\n\ts_mov_b32 m0, %3\n\ts_nop 0\n\tglobal_load_lds_dwordx4 %1, %2\n\ts_mov_b32 m0, %0" : "=&s"(keep) : "v"(voff), "s"(sbase), "s"(ldsaddr) : "memory"); }

template <int NK> __device__ __forceinline__ void qk(f32x16& p0, f32x16& p1, const LAS unsigned char* krow, int xr, int hx, const bf16x8* qf, int dstart) {
#pragma unroll
    for (int d0 = 0; d0 < NK; ++d0) { const int off = (((dstart + d0) * 32 + hx) ^ xr);
        const bf16x8 b0 = *(const LAS bf16x8*)(krow + off), b1 = *(const LAS bf16x8*)(krow + off + 8192);
        p0 = __builtin_amdgcn_mfma_f32_32x32x16_bf16(b0, qf[d0], p0, 0, 0, 0); p1 = __builtin_amdgcn_mfma_f32_32x32x16_bf16(b1, qf[d0], p1, 0, 0, 0); }
}
template <int NK> __device__ __forceinline__ void qk_l(f32x16& p0, f32x16& p1, const LAS unsigned char* krow, int xr, int hx, const LAS unsigned char* qlds, int dstart) {
#pragma unroll
    for (int d0 = 0; d0 < NK; ++d0) { const int off = (((dstart + d0) * 32 + hx) ^ xr);
        const bf16x8 b0 = *(const LAS bf16x8*)(krow + off), b1 = *(const LAS bf16x8*)(krow + off + 8192), q = *(const LAS bf16x8*)(qlds + (dstart + d0) * 1024);
        p0 = __builtin_amdgcn_mfma_f32_32x32x16_bf16(b0, q, p0, 0, 0, 0); p1 = __builtin_amdgcn_mfma_f32_32x32x16_bf16(b1, q, p1, 0, 0, 0); }
}
__device__ __forceinline__ void qk_pe(f32x16& p0, f32x16& p1, const LAS unsigned char* perow, int xpe, int hx, const bf16x8* qf) {
#pragma unroll
    for (int d0 = 0; d0 < 4; ++d0) { const int off = ((d0 * 32 + hx) ^ xpe);
        const bf16x8 b0 = *(const LAS bf16x8*)(perow + off), b1 = *(const LAS bf16x8*)(perow + off + 4096);
        p0 = __builtin_amdgcn_mfma_f32_32x32x16_bf16(b0, qf[d0], p0, 0, 0, 0); p1 = __builtin_amdgcn_mfma_f32_32x32x16_bf16(b1, qf[d0], p1, 0, 0, 0); }
}
__device__ __forceinline__ void pv(f32x16* o, unsigned vb, bf16x8 pa0, bf16x8 pa1, bf16x8 pa2, bf16x8 pa3) {
#define TRRD(dst, off) asm volatile("ds_read_b64_tr_b16 %0, %1 offset:%2" : "=&v"(dst) : "v"(vb), "i"(off) : "memory")
#define PV_D0(d0) do { s16x4 l0, l1, l2, l3, h0, h1, h2, h3; constexpr int b_ = (d0) * 512; \
        TRRD(l0, b_); TRRD(h0, b_ + 2048); TRRD(l1, b_ + 4096); TRRD(h1, b_ + 6144); TRRD(l2, b_ + 8192); TRRD(h2, b_ + 10240); TRRD(l3, b_ + 12288); TRRD(h3, b_ + 14336); \
        asm volatile("s_waitcnt lgkmcnt(0)" ::: "memory"); __builtin_amdgcn_sched_barrier(0); \
        o[d0] = __builtin_amdgcn_mfma_f32_32x32x16_bf16(pa0, (bf16x8){l0[0], l0[1], l0[2], l0[3], h0[0], h0[1], h0[2], h0[3]}, o[d0], 0, 0, 0); \
        o[d0] = __builtin_amdgcn_mfma_f32_32x32x16_bf16(pa1, (bf16x8){l1[0], l1[1], l1[2], l1[3], h1[0], h1[1], h1[2], h1[3]}, o[d0], 0, 0, 0); \
        o[d0] = __builtin_amdgcn_mfma_f32_32x32x16_bf16(pa2, (bf16x8){l2[0], l2[1], l2[2], l2[3], h2[0], h2[1], h2[2], h2[3]}, o[d0], 0, 0, 0); \
        o[d0] = __builtin_amdgcn_mfma_f32_32x32x16_bf16(pa3, (bf16x8){l3[0], l3[1], l3[2], l3[3], h3[0], h3[1], h3[2], h3[3]}, o[d0], 0, 0, 0); } while (0)
    PV_D0(0); PV_D0(1); PV_D0(2); PV_D0(3);
#undef PV_D0
#undef TRRD
}
__device__ __forceinline__ void pack_p(const f32x16& p0, const f32x16& p1, bf16x8& pa0, bf16x8& pa1, bf16x8& pa2, bf16x8& pa3) {
#define PK4(P, B_, OUT) do { unsigned a0 = cvtpk(P[B_ + 0], P[B_ + 1]), a1 = cvtpk(P[B_ + 2], P[B_ + 3]), b0 = cvtpk(P[B_ + 4], P[B_ + 5]), b1 = cvtpk(P[B_ + 6], P[B_ + 7]); \
        auto r0 = __builtin_amdgcn_permlane32_swap(a0, b0, false, false); auto r1 = __builtin_amdgcn_permlane32_swap(a1, b1, false, false); \
        v4u w = {r0[0], r1[0], r0[1], r1[1]}; OUT = __builtin_bit_cast(bf16x8, w); } while (0)
    PK4(p0, 0, pa0); PK4(p0, 8, pa1); PK4(p1, 0, pa2); PK4(p1, 8, pa3);
#undef PK4
}
__device__ __forceinline__ void softmax_pv(f32x16& p0, f32x16& p1, float& m, float& l, f32x16* o, LAS float* wsf, unsigned vb, int r32, int hi, const float SCALE, const float C2) {
    float mx0 = fmaxf(p0[0], p1[0]), mx1 = fmaxf(p0[1], p1[1]), mx2 = fmaxf(p0[2], p1[2]), mx3 = fmaxf(p0[3], p1[3]);
#pragma unroll
    for (int r = 4; r < 16; r += 4) { mx0 = fmaxf(fmaxf(mx0, p0[r]), p1[r]); mx1 = fmaxf(fmaxf(mx1, p0[r + 1]), p1[r + 1]); mx2 = fmaxf(fmaxf(mx2, p0[r + 2]), p1[r + 2]); mx3 = fmaxf(fmaxf(mx3, p0[r + 3]), p1[r + 3]); }
    float pmax = pmaxf(fmaxf(fmaxf(mx0, mx1), fmaxf(mx2, mx3)));
    float mn, alpha;
    if (__all((pmax - m) * SCALE <= THR)) { mn = m; alpha = 1.f; }
    else { mn = fmaxf(m, pmax); alpha = __builtin_amdgcn_exp2f((m - mn) * C2); m = mn; }
    const float mnL = -mn * C2;
#pragma unroll
    for (int r = 0; r < 16; ++r) { p0[r] = __builtin_amdgcn_exp2f(fmaf(p0[r], C2, mnL)); p1[r] = __builtin_amdgcn_exp2f(fmaf(p1[r], C2, mnL)); }
    float s0 = p0[0] + p1[0], s1 = p0[1] + p1[1], s2 = p0[2] + p1[2], s3 = p0[3] + p1[3];
#pragma unroll
    for (int r = 4; r < 16; r += 4) { s0 += p0[r] + p1[r]; s1 += p0[r + 1] + p1[r + 1]; s2 += p0[r + 2] + p1[r + 2]; s3 += p0[r + 3] + p1[r + 3]; }
    const float ps = psumf((s0 + s1) + (s2 + s3)); l = l * alpha + ps;
    bf16x8 pa0, pa1, pa2, pa3; pack_p(p0, p1, pa0, pa1, pa2, pa3);
    if (__any(alpha < 1.f)) { const int fl = fresh_lane(), fh = fl >> 5;
        if (fh == 0) wsf[fl] = alpha; asm volatile("s_waitcnt lgkmcnt(0)" ::: "memory");
#pragma unroll
        for (int r = 0; r < 16; ++r) { const float a = wsf[crow(r, fh)];
#pragma unroll
            for (int d = 0; d < 4; ++d) o[d][r] *= a; } }
    pv(o, vb, pa0, pa1, pa2, pa3);
}

template <int VAR>
__device__ __forceinline__ void attn_unit(const Ctx& C, int b, int h, int qb, LAS unsigned char* lds, int tid, int wid, int lane) {
    constexpr bool CAUSAL = VAR != VE, DESC = (VAR == VC || VAR == VD), MLA = (VAR == VB), DIFF = (VAR == VA), STICK = (VAR == VC), HASB = (VAR == VA || VAR == VD);
    constexpr int NQF = MLA ? 12 : 8;
    constexpr float SCALE = DIFF ? 0.125f : (MLA ? 0.07216878364870323f : 0.08838834764831845f);
    constexpr float C2 = SCALE * LOG2E;
    const int r32 = lane & 31, hi = lane >> 5;
    const int q0 = qb * 256, qw = q0 + wid * 32, trow = qw + r32;
    const size_t rb = (size_t)b * SEQ;
    const bf16 *Qp, *Kp, *Vp; bf16* Op; int qpitch, kpitch, opitch;
    if constexpr (VAR == VA || VAR == VC || VAR == VD) {
        constexpr int base = VAR == VA ? A_Q : (VAR == VC ? C_Q : D_Q);
        Qp = C.PROJ + rb * INP + base + h * 128; Kp = Qp + 1024; Vp = Qp + 2048; qpitch = INP; kpitch = INP;
        Op = C.MIX + rb * DM + VAR * 1024 + h * 128; opitch = DM;
    } else if constexpr (VAR == VB) {
        Qp = C.QMLA + rb * 1536 + h * 192; qpitch = 1536; Kp = C.KVMLA + rb * 2048 + h * 256; Vp = Kp + 128; kpitch = 2048;
        Op = C.MIX + rb * DM + 1024 + h * 128; opitch = DM;
    } else {
        Qp = C.QMEM + rb * 512 + h * 128; qpitch = 512; Kp = C.KVMEM + (size_t)b * MEMT * 1024 + h * 128; Vp = Kp + 512; kpitch = 1024;
        Op = C.OMEM + rb * 512 + h * 128; opitch = 512;
    }
    const char* Bp = nullptr;
    if constexpr (VAR == VA) Bp = (const char*)(C.pos + rb);
    if constexpr (VAR == VD) Bp = (const char*)(C.NEGC + (size_t)(b * 8 + h) * SEQ);
    const char* KPEp = nullptr;
    if constexpr (MLA) KPEp = (const char*)(C.KPE + rb * 64);
    bf16x8 qr[DIFF ? 1 : NQF];
    const LAS unsigned char* qlds = lds + QF_OFF + wid * 8192 + lane * 16;
    { const bf16* qrow = Qp + (size_t)trow * qpitch + hi * 8;
      if constexpr (DIFF) {
#pragma unroll
          for (int d0 = 0; d0 < 8; ++d0) { const bf16x8 q = *(const GAS bf16x8*)(qrow + d0 * 16); *(LAS bf16x8*)(lds + QF_OFF + wid * 8192 + lane * 16 + d0 * 1024) = q; }
      } else if constexpr (VAR == VE) {
          const float* qp = (const float*)C.QMEM + (rb + trow) * (size_t)(512 * QKS) + h * 128 + hi * 8;
          const float rs = 1.0f / sqrtf((float)C.SSQ[rb + trow] * (1.f / 1048576.f / 4096.f) + 1e-6f);
#pragma unroll
          for (int d0 = 0; d0 < NQF; ++d0) { f32x4 a0 = *(const GAS f32x4*)(qp + d0 * 16), a1 = *(const GAS f32x4*)(qp + d0 * 16 + 4);
#pragma unroll
              for (int kh = 1; kh < QKS; ++kh) { a0 = a0 + *(const GAS f32x4*)(qp + kh * 512 + d0 * 16); a1 = a1 + *(const GAS f32x4*)(qp + kh * 512 + d0 * 16 + 4); }
              const v4u w = {cvtpk(a0.x * rs, a0.y * rs), cvtpk(a0.z * rs, a0.w * rs), cvtpk(a1.x * rs, a1.y * rs), cvtpk(a1.z * rs, a1.w * rs)};
              qr[d0] = __builtin_bit_cast(bf16x8, w); }
      } else {
#pragma unroll
          for (int d0 = 0; d0 < NQF; ++d0) qr[d0] = *(const GAS bf16x8*)(qrow + d0 * 16); } }
    if constexpr (MLA) {
        const float* cs = C.COS + (rb + trow) * 32 + hi * 8; const float* sn = C.SIN + (rb + trow) * 32 + hi * 8;
#pragma unroll
        for (int j = 0; j < 2; ++j) {
            const f32x4 c0 = *(const GAS f32x4*)(cs + j * 16), c1 = *(const GAS f32x4*)(cs + j * 16 + 4), s0 = *(const GAS f32x4*)(sn + j * 16), s1 = *(const GAS f32x4*)(sn + j * 16 + 4);
            const bf16x8 a = qr[8 + j], bb = qr[10 + j]; float lo[8], hh[8];
#pragma unroll
            for (int e = 0; e < 8; ++e) { const float t1 = bf2f(a[e]), t2 = bf2f(bb[e]), c = e < 4 ? c0[e & 3] : c1[e & 3], s = e < 4 ? s0[e & 3] : s1[e & 3]; lo[e] = t1 * c - t2 * s; hh[e] = t1 * s + t2 * c; }
            v4u wl = {cvtpk(lo[0], lo[1]), cvtpk(lo[2], lo[3]), cvtpk(lo[4], lo[5]), cvtpk(lo[6], lo[7])}, wh = {cvtpk(hh[0], hh[1]), cvtpk(hh[2], hh[3]), cvtpk(hh[4], hh[5]), cvtpk(hh[6], hh[7])};
            qr[8 + j] = __builtin_bit_cast(bf16x8, wl); qr[10 + j] = __builtin_bit_cast(bf16x8, wh); }
    }
    unsigned koff[2], voff[2], peoff = 0;
#pragma unroll
    for (int i = 0; i < 2; ++i) { const int j = wid * 2 + i, row = 4 * j + (lane >> 4); koff[i] = (unsigned)(row * kpitch + (((lane & 15) ^ (row & 15)) << 3)) * 2u;
        const int st = 2 * j + (lane >> 5), kk = (st >> 2) * 8 + ((lane & 31) >> 2), c = (st & 3) * 32 + (lane & 3) * 8; voff[i] = (unsigned)(swap23(kk) * kpitch + c) * 2u; }
    if constexpr (MLA) { const int row = 8 * wid + (lane >> 3); peoff = (unsigned)(row * 64 + (((lane & 7) ^ ((row >> 1) & 7)) << 3)) * 2u; }
    const unsigned boff = (unsigned)(lane & 15) * 16u;
    const unsigned ldsbase = (unsigned)(unsigned long long)lds;
#define ISSUE(t_, buf_) do { const size_t tb_ = (size_t)(t_) * 64 * kpitch * 2; const char* kg_ = (const char*)Kp + tb_; const char* vg_ = (const char*)Vp + tb_; \
        _Pragma("unroll") for (int i_ = 0; i_ < 2; ++i_) dma16(kg_, koff[i_], ldsbase + K_OFF + (buf_) * 16384 + (wid * 2 + i_) * 1024); \
        _Pragma("unroll") for (int i_ = 0; i_ < 2; ++i_) dma16(vg_, voff[i_], ldsbase + V_OFF + (buf_) * 16384 + (wid * 2 + i_) * 1024); \
        if constexpr (MLA) dma16(KPEp + (size_t)(t_) * 64 * 64 * 2, peoff, ldsbase + KPE_OFF + (buf_) * 8192 + wid * 1024); \
        if constexpr (HASB) { if (wid == 0) dma16(Bp + (size_t)(t_) * 64 * 4, boff, ldsbase + B_OFF + (buf_) * 1024); } } while (0)
    const int NT = CAUSAL ? (q0 + 256) / 64 : MEMT / 64;
    LAS float* wsf = (LAS float*)(lds + WS_OFF) + wid * 64;
    LAS float* lut = (LAS float*)(lds + LUT_OFF);
    int pos_t = 0, wmin = 0; float lut_far = 0.f;
    if constexpr (DIFF) { if (tid < 132) lut[tid] = C.LUT[h * 132 + tid];
        pos_t = C.pos[rb + trow]; int mnp = pos_t;
        mnp = min(mnp, shxi<1>(mnp)); mnp = min(mnp, shxi<2>(mnp)); mnp = min(mnp, shxi<4>(mnp)); mnp = min(mnp, shxi<8>(mnp)); mnp = min(mnp, shxi<16>(mnp));
        wmin = __builtin_amdgcn_readfirstlane(mnp); lut_far = C.LUT[h * 132 + 128]; }
    const int xr = (r32 & 15) << 4, hx = hi << 4, xpe = ((r32 >> 1) & 7) << 4;
    const unsigned vrd = (unsigned)(((lane & 3) << 3) | (((lane >> 2) & 3) << 6) | (((lane >> 4) & 1) << 5) | (((lane >> 5) & 1) << 8));
    f32x16 o[4]; f32x16 o2[DIFF ? 4 : 1];
#pragma unroll
    for (int d = 0; d < 4; ++d) { o[d] = f32x16{}; if constexpr (DIFF) o2[d] = f32x16{}; }
    float m1 = -1e30f, l1 = 0.f, m2 = -1e30f, l2 = 0.f, R = 0.f;
    float qnkn = 0.f;
    if constexpr (VAR == VD) { float s = 0.f;
#pragma unroll
        for (int d0 = 0; d0 < 8; ++d0)
#pragma unroll
            for (int e = 0; e < 8; ++e) { const float a = bf2f(qr[d0][e]); s += a * a; }
        s = psumf(s); qnkn = sqrtf(s) * sqrtf(__uint_as_float(C.KN2[b * 8 + h])) * 1.001f + 1.f; }
    ISSUE(DESC ? NT - 1 : 0, 0);
    WAITBAR();
    int cur = 0;
    for (int i = 0; i < NT; ++i) {
        const int t = DESC ? NT - 1 - i : i, kb = t * 64;
        if (i + 1 < NT) ISSUE(DESC ? t - 1 : t + 1, cur ^ 1);
        const bool act = !CAUSAL || (STICK ? (kb < qw + 31) : (kb <= qw + 31));
        bool wdone = false;
        if constexpr (VAR == VD) {
            if (act) { const float nmax = ((const LAS float*)(lds + B_OFF + cur * 1024))[63]; wdone = __all((qnkn + nmax - m1) * SCALE < -40.f); } }
        if (act && !wdone) {
            const LAS unsigned char* krow = lds + K_OFF + cur * 16384 + r32 * 256;
            const unsigned vb = ldsbase + V_OFF + cur * 16384 + vrd;
            if constexpr (STICK) {
                f32x16 p0 = f32x16{}, p1 = f32x16{};
                qk<8>(p0, p1, krow, xr, hx, qr, 0);
                float L0[16], L1[16];
#pragma unroll
                for (int r = 0; r < 16; ++r) { const int key = kb + crow(r, hi);
                    { const float z = p0[r] * SCALE, e = __builtin_amdgcn_exp2f(-fabsf(z) * LOG2E), sp = fmaxf(z, 0.f) + __builtin_amdgcn_logf(1.f + e) * LN2; L0[r] = key < trow ? -sp : 0.f; p0[r] = z; }
                    { const float z = p1[r] * SCALE, e = __builtin_amdgcn_exp2f(-fabsf(z) * LOG2E), sp = fmaxf(z, 0.f) + __builtin_amdgcn_logf(1.f + e) * LN2; L1[r] = key + 32 < trow ? -sp : 0.f; p1[r] = z; } }
                float T[8], mb[8];
#pragma unroll
                for (int g = 0; g < 4; ++g) { T[g] = (L0[4 * g] + L0[4 * g + 1]) + (L0[4 * g + 2] + L0[4 * g + 3]); T[4 + g] = (L1[4 * g] + L1[4 * g + 1]) + (L1[4 * g + 2] + L1[4 * g + 3]); }
                float run = R;
#pragma unroll
                for (int k = 7; k >= 0; --k) { const float pt = partnerf(T[k], hi); const float T1 = hi ? T[k] : pt, T0 = hi ? pt : T[k];
                    const float b1 = run; run += T1; const float b0 = run; run += T0; mb[k] = hi ? b1 : b0; }
                R = run;
#pragma unroll
                for (int g = 0; g < 4; ++g) { float s0 = mb[g], s1 = mb[4 + g];
#pragma unroll
                    for (int e = 3; e >= 0; --e) { const int r = 4 * g + e, key = kb + crow(r, hi);
                        const float a0 = key < trow ? __builtin_amdgcn_exp2f((p0[r] + L0[r] + s0) * LOG2E) : 0.f; s0 += L0[r]; p0[r] = a0;
                        const float a1 = key + 32 < trow ? __builtin_amdgcn_exp2f((p1[r] + L1[r] + s1) * LOG2E) : 0.f; s1 += L1[r]; p1[r] = a1; } }
                bf16x8 pa0, pa1, pa2, pa3; pack_p(p0, p1, pa0, pa1, pa2, pa3);
                pv(o, vb, pa0, pa1, pa2, pa3);
            } else {
#pragma unroll
                for (int mp = 0; mp < (DIFF ? 2 : 1); ++mp) {
                    f32x16 p0, p1;
                    int xr_t = xr;
                    if constexpr (DIFF) { __builtin_amdgcn_sched_barrier(0); asm volatile("" : "+v"(pos_t), "+v"(xr_t)); }
                    if constexpr (VAR == VD) { const LAS float* nb = (const LAS float*)(lds + B_OFF + cur * 1024) + 4 * hi;
#pragma unroll
                        for (int g = 0; g < 4; ++g) { const f32x4 v0 = *(const LAS f32x4*)(nb + 8 * g), v1 = *(const LAS f32x4*)(nb + 32 + 8 * g);
#pragma unroll
                            for (int e = 0; e < 4; ++e) { p0[4 * g + e] = v0[e]; p1[4 * g + e] = v1[e]; } } }
                    else if constexpr (DIFF) {
                        if (wmin - C.TPMAX[b * 64 + t] >= 128) {
#pragma unroll
                            for (int r = 0; r < 16; ++r) { p0[r] = lut_far; p1[r] = lut_far; } }
                        else { const LAS int* pb = (const LAS int*)(lds + B_OFF + cur * 1024) + 4 * hi;
#pragma unroll
                            for (int g = 0; g < 4; ++g) { const i32x4 v0 = *(const LAS i32x4*)(pb + 8 * g), v1 = *(const LAS i32x4*)(pb + 32 + 8 * g);
#pragma unroll
                                for (int e = 0; e < 4; ++e) { p0[4 * g + e] = lut[min(max(pos_t - v0[e], 0), 128)]; p1[4 * g + e] = lut[min(max(pos_t - v1[e], 0), 128)]; }
                                __builtin_amdgcn_sched_barrier(0); } } }
                    else { p0 = f32x16{}; p1 = f32x16{}; }
                    if constexpr (DIFF) qk_l<4>(p0, p1, krow, xr_t, hx, qlds, 4 * mp);
                    else qk<8>(p0, p1, krow, xr, hx, qr, 0);
                    if constexpr (MLA) qk_pe(p0, p1, lds + KPE_OFF + cur * 8192 + r32 * 128, xpe, hx, qr + 8);
                    if (CAUSAL && kb + 63 > qw) { const float NEG = -__builtin_inff();
#pragma unroll
                        for (int r = 0; r < 16; ++r) { const int key = kb + crow(r, hi); if (key > trow) p0[r] = NEG; if (key + 32 > trow) p1[r] = NEG; } }
                    if (mp == 0) softmax_pv(p0, p1, m1, l1, o, wsf, vb, r32, hi, SCALE, C2);
                    else softmax_pv(p0, p1, m2, l2, o2, wsf, vb, r32, hi, SCALE, C2);
                }
            }
        }
        if constexpr (STICK) { const int dn_ = __all(R < -100.f) ? 1 : 0; if (lane == 0) ((LAS int*)(lds + FLG_OFF))[(i & 1) * 8 + wid] = dn_; }
        if constexpr (VAR == VD) { if (lane == 0) ((LAS int*)(lds + FLG_OFF))[(i & 1) * 8 + wid] = wdone ? 1 : 0; }
        WAITBAR(); cur ^= 1;
        if constexpr (STICK || VAR == VD) { const LAS i32x4* fl = (const LAS i32x4*)(lds + FLG_OFF + (i & 1) * 32); const i32x4 f0 = fl[0], f1 = fl[1];
            const int alld = (f0.x & f0.y & f0.z & f0.w) & (f1.x & f1.y & f1.z & f1.w); if (__builtin_amdgcn_readfirstlane(alld)) break; }
    }
#undef ISSUE
    const int lane_e = fresh_lane();
    const int r32e = lane_e & 31, hie = lane_e >> 5;
    bf16* Ob = Op + (size_t)(qw + 4 * hie) * opitch + r32e;
    if constexpr (DIFF) {
        if (hie == 0) { wsf[r32e] = l1; wsf[32 + r32e] = l2; } asm volatile("s_waitcnt lgkmcnt(0)" ::: "memory");
        const float lam = C.lam;
#pragma unroll
        for (int r = 0; r < 16; ++r) { const float i1 = __builtin_amdgcn_rcpf(wsf[crow(r, hie)]), i2 = lam * __builtin_amdgcn_rcpf(wsf[32 + crow(r, hie)]); float ss = 0.f;
#pragma unroll
            for (int d = 0; d < 4; ++d) { const float x = o[d][r] * i1 - o2[d][r] * i2; o[d][r] = x; ss += x * x; }
            ss = half_sum(ss);
            const float rstd = (1.0f / sqrtf(ss * (1.f / 128.f) + EPS)) * C.oml;
#pragma unroll
            for (int d = 0; d < 4; ++d) o[d][r] *= rstd; }
#pragma unroll
        for (int d = 0; d < 4; ++d) { const float g = C.sub_g[d * 32 + r32e];
#pragma unroll
            for (int r = 0; r < 16; ++r) o[d][r] *= g; }
    } else if constexpr (!STICK) {
        if (hie == 0) wsf[r32e] = l1; asm volatile("s_waitcnt lgkmcnt(0)" ::: "memory");
#pragma unroll
        for (int r = 0; r < 16; ++r) { const float i1 = __builtin_amdgcn_rcpf(wsf[crow(r, hie)]);
#pragma unroll
            for (int d = 0; d < 4; ++d) o[d][r] *= i1; }
    }
#pragma unroll
    for (int r = 0; r < 16; ++r) { const int orr = (r & 3) + 8 * (r >> 2);
#pragma unroll
        for (int d = 0; d < 4; ++d) { const float v = o[d][r], vn = shx<1>(v);
            if ((r32e & 1) == 0) *(GAS unsigned*)(Ob + (size_t)orr * opitch + d * 32) = cvtpk(v, vn); } }
}
template <int VAR> __device__ __forceinline__ void attn_queue(const Ctx& C, gu32* head, LAS unsigned char* lds, const int wid, const kaptr_t ka, unsigned char* ws, const int cvl) {
    constexpr int NH = VAR == VE ? 4 : 8, NU = NB * NH * 16;
    const int lane = fresh_lane(), tid = wid * 64 + lane;
    volatile LAS int* tk = (volatile LAS int*)(lds + LDSCTL_OFF);
    for (;;) {
        if (tid == 0) tk[0] = (int)__hip_atomic_fetch_add(head, 1u, RLX_AGENT);
        WAITBAR();
        const int n = __builtin_amdgcn_readfirstlane(tk[0]);
        if (n >= NU) break;
        const int qb = 15 - n / (NB * NH), bh = n % (NB * NH);
        attn_unit<VAR>(C, bh / NH, bh % NH, qb, lds, tid, wid, lane);
        if (cvl >= 0) {
            if (tid == 0) tk[1] = (int)__hip_atomic_fetch_add((gu32*)(ws + WS_CTL) + CW_TKT + (cvl * 16 + 10) * 64, 1u, RLX_AGENT);
            WAITBAR();
            const int c = __builtin_amdgcn_readfirstlane(tk[1]);
            if (c < KNCH(ka, cvl)) conv_chunk(ka, ws, cvl, c, (LAS float*)(lds + RING_OFF + wid * 16640), wid, lane);
        }
    }
}
}


namespace att {
template <int VAR> __device__ __forceinline__ void attn_phase(int l, int q, LAS unsigned char* lds, const int wid0) {
    const kaptr_t ka = ka_fresh(); unsigned char* ws = KWS(ka);
    const Ctx C{(const bf16*)(ws + WS_PROJ), (const bf16*)(ws + WS_QMLA), (const bf16*)(ws + WS_KVMLA), (const bf16*)(ws + WS_KPE), (bf16*)(ws + WS_MIX), (const bf16*)(ws + WS_XL),
                (const bf16*)(ws + WS_KVMEM) + (size_t)l * 512 * 1024, (bf16*)(ws + WS_OMEM), (const float*)(ws + WS_COS), (const float*)(ws + WS_SIN), (const float*)(ws + WS_LUT),
                (const int*)(ws + WS_TPMAX), (const int*)KIN(ka, 2), (const float*)(ws + WS_NEGC), (const float*)KIN(ka, 11) + l * 128, (const unsigned*)((gu32*)(ws + WS_CTL) + CW_KN + l * 64), ((const float*)(ws + WS_LAM))[l], 1.0f - KLAMI(ka, l),
                (const unsigned long long*)((gu32*)(ws + WS_CTL) + CW_SS) + (size_t)(3 * l + 1) * M};
    attn_queue<VAR>(C, (gu32*)(ws + WS_CTL) + CW_TKT + (l * 16 + q) * 64, lds, wid0, ka, ws, (VAR == VE || gridDim.x == 256) ? -1 : l);
}
}

__global__ void __launch_bounds__(NWAVES * 64, 2) mk_fwd(Args args) {
    extern __shared__ __attribute__((aligned(16))) unsigned char lds_raw[];
    LAS unsigned char* lds = (LAS unsigned char*)lds_raw;
    const int G = gridDim.x, bx = blockIdx.x;
    const int vcu = (G % 8 == 0) ? (bx % 8) * (G / 8) + bx / 8 : bx;
    const int wid0 = __builtin_amdgcn_readfirstlane((int)threadIdx.x >> 6);
    const int gw = vcu * NWAVES + wid0, NGW = G * NWAVES;
    { const int tid = wid0 * 64 + fresh_lane();
      for (int u = tid; u < (LDS_BYTES - LDSCTL_OFF) / 4; u += NWAVES * 64) ((LAS unsigned*)(lds + LDSCTL_OFF))[u] = 0u; }
    __syncthreads();
    volatile LAS unsigned* MISC = (volatile LAS unsigned*)(lds + MISC_OFF);
    XcdBarrier bar = xcd_barrier_post((unsigned*)(args.ws + WS_CTL) + CW_BAR, MISC + 8, wid0);

    {
        const kaptr_t ka = ka_fresh(); unsigned char* ws = KWS(ka);
        const int lane = fresh_lane(), wid = wid0, tid = wid * 64 + lane;
        LAS float* scr = (LAS float*)(lds + RING_OFF + wid * 16640);
        {
            const int l = 0; unsigned char* wl = ws + WS_W;
#define TR_MAT(idx_, K_, N_, NP_, dst_, roff_, gain_) do { const float* s_ = (const float*)KIN(ka, idx_) + (size_t)l * (K_) * (N_); const int nblk_ = (NP_) / 64, nit_ = ((K_) / 64) * nblk_; \
            const float* gk_ = (gain_) >= 0 ? (const float*)KIN(ka, (gain_) >= 0 ? (gain_) : 0) + (size_t)l * (K_) : nullptr; \
            for (int it = gw; it < nit_; it += NGW) tr_item(s_, (K_), (N_), nblk_, (bf16*)(dst_), (roff_), scr, it, lane, gk_); } while (0)
            TR_MAT(4, DM, INC, INP, wl + W_IN, 0, 3);
            TR_MAT(14, QRANK, 1536, 1536, wl + W_UQ, 0, -1);
            TR_MAT(15, KVRANK, 2048, 2048, wl + W_UKV, 0, -1);
            TR_MAT(20, DM, 512, 512, wl + W_MKV, 0, -1);
            TR_MAT(21, DM, 512, 512, wl + W_MKV, 512, -1);
#undef TR_MAT
        }
        { const float* x0 = (const float*)KIN(ka, 0); bf16* H = (bf16*)(ws + WS_H); unsigned long long* SS = (unsigned long long*)((gu32*)(ws + WS_CTL) + CW_SS);
          for (int m = gw; m < M; m += NGW) cast_row(x0 + (size_t)m * DM, H + (size_t)m * DM, SS + m, lane); }
        { const float* mem = (const float*)KIN(ka, 1); bf16* MEMN = (bf16*)(ws + WS_MEMN);
          for (int r = gw; r < NL * NB * MEMT; r += NGW) { const int l = r / (NB * MEMT), mr = r - l * (NB * MEMT);
            rms_row<true>(mem + (size_t)mr * DM, (const float*)KIN(ka, 18) + (size_t)l * DM, MEMN + (size_t)r * DM, lane); } }
        const int* pos = (const int*)KIN(ka, 2);
        float* COS = (float*)(ws + WS_COS); float* SIN = (float*)(ws + WS_SIN); float* LUT = (float*)(ws + WS_LUT); int* TPMAX = (int*)(ws + WS_TPMAX); float* LAM = (float*)(ws + WS_LAM);
        const int gt = vcu * (NWAVES * 64) + tid, NGT = G * NWAVES * 64;
        for (int i = gt; i < M * 32; i += NGT) { const int row = i >> 5, f = i & 31; const float ang = (float)pos[row] * KINVF(ka, f);
            double rv = (double)ang * 0.15915494309189535; rv -= floor(rv); const float fr = (float)rv;
            COS[i] = __builtin_amdgcn_cosf(fr); SIN[i] = __builtin_amdgcn_sinf(fr); }
        for (int i = gt; i < 8 * 132; i += NGT) { const int h = i / 132, dd0 = i - h * 132; const int dd = dd0 > 128 ? 128 : dd0; int bk;
            if (dd < 16) bk = dd; else { bk = 16 + (int)(logf((float)dd / 16.0f) / 2.0794415416798357f * 16.0f); bk = bk > 31 ? 31 : bk; }
            LUT[i] = 8.0f * ((const float*)KIN(ka, 6))[bk * 8 + h]; }
        for (int i = gt; i < NB * 64; i += NGT) { int mx = pos[i * 64];
            for (int k = 1; k < 64; ++k) mx = max(mx, pos[i * 64 + k]);
            TPMAX[i] = mx; }
        if (gt < NL) { const int l = gt; float s1 = 0.f, s2 = 0.f;
            for (int k = 0; k < 64; ++k) { s1 += ((const float*)KIN(ka, 7))[l * 64 + k] * ((const float*)KIN(ka, 8))[l * 64 + k]; s2 += ((const float*)KIN(ka, 9))[l * 64 + k] * ((const float*)KIN(ka, 10))[l * 64 + k]; }
            LAM[l] = expf(s1) - expf(s2) + KLAMI(ka, l); }
    }
    xcd_barrier(bar, wid0);

    for (int l = 0; l < NL; ++l) {
        { const kaptr_t ka = ka_fresh(); unsigned char* ws = KWS(ka); unsigned char* wl = ws + WS_W + (size_t)l * W_LAYER;
          { pg8::Gemm g{(const bf16*)(ws + WS_H), (const bf16*)(wl + W_IN), M, INP, DM}; pg8::StaticOrder S; S.init(M, INP, G, bx);
            pg8::EpiBf16<0, true> E{(bf16*)(ws + WS_PROJ), INP, (const unsigned long long*)((gu32*)(ws + WS_CTL) + CW_SS) + (size_t)(3 * l) * M};
            pg8::gemm_phase<pg8::EpiBf16<0, true>, pg8::StaticOrder, true, true>(lds + RING_OFF, g, S, E, wid0); }
          { pg8::Gemm g{(const bf16*)(ws + WS_MEMN) + (size_t)l * 512 * DM, (const bf16*)(wl + W_MKV), 512, 1024, DM}; pg8::StaticOrder S; S.init(512, 1024, G, G - 1 - bx);
            pg8::EpiBf16<0, false> E{(bf16*)(ws + WS_KVMEM) + (size_t)l * 512 * 1024, 1024, nullptr};
            pg8::gemm_phase<pg8::EpiBf16<0, false>, pg8::StaticOrder, true, true>(lds + RING_OFF, g, S, E, wid0); }
          if (G == 256 && bx >= 160 && bx < 248) {
              const int lane = fresh_lane(); LAS float* scr = (LAS float*)(lds + RING_OFF + wid0 * 16640);
              conv_run(ka, ws, 2 + l, (bx - 160) * NWAVES + wid0, UPDEF, 88 * NWAVES, scr, lane); } }
        xcd_barrier(bar, wid0);
        { const kaptr_t ka = ka_fresh(); unsigned char* ws = KWS(ka); FRESH_LANE(ln);
          for (int m = gw; m < M; m += NGW)
            prep_row((const bf16*)(ws + WS_PROJ), m, (const float*)KIN(ka, 12) + (size_t)l * QRANK, (const float*)KIN(ka, 13) + (size_t)l * KVRANK, (const float*)KIN(ka, 16) + l * 8,
                     (const float*)(ws + WS_COS), (const float*)(ws + WS_SIN), (bf16*)(ws + WS_CQN), (bf16*)(ws + WS_CKVN), (bf16*)(ws + WS_KPE), (float*)(ws + WS_LOGF), (LAS unsigned*)(lds + KNL_OFF), ln);
          asm volatile("s_waitcnt lgkmcnt(0)" ::: "memory"); __builtin_amdgcn_s_barrier();
          if (wid0 == 0 && ln < 16) { LAS unsigned* kl = (LAS unsigned*)(lds + KNL_OFF) + ln; const unsigned v = *kl; unsigned z = 0u; asm volatile("" : "+v"(z)); *kl = z;
              if (v) __hip_atomic_fetch_max((unsigned*)((gu32*)(ws + WS_CTL) + CW_KN + l * 64) + ln, v, __ATOMIC_RELAXED, __HIP_MEMORY_SCOPE_AGENT); } }
        xcd_barrier(bar, wid0);
        { const kaptr_t ka = ka_fresh(); unsigned char* ws = KWS(ka); unsigned char* wl = ws + WS_W + (size_t)l * W_LAYER;
          if (gw < 16) { FRESH_LANE(ln); fox_scan((const float*)(ws + WS_LOGF) + (size_t)gw * SEQ, (float*)(ws + WS_NEGC) + (size_t)gw * SEQ, ln); }
          { pg8::Gemm g{(const bf16*)(ws + WS_CQN), (const bf16*)(wl + W_UQ), M, 1536, QRANK}; pg8::StaticOrder S; S.init(M, 1536, G, bx);
            pg8::EpiBf16<0, false> E{(bf16*)(ws + WS_QMLA), 1536, nullptr};
            pg8::gemm_phase<pg8::EpiBf16<0, false>, pg8::StaticOrder, true, true>(lds + RING_OFF, g, S, E, wid0); }
          { pg8::Gemm g{(const bf16*)(ws + WS_CKVN), (const bf16*)(wl + W_UKV), M, 2048, KVRANK}; pg8::StaticOrder S; S.init(M, 2048, G, G - 1 - bx);
            pg8::EpiBf16<0, false> E{(bf16*)(ws + WS_KVMLA), 2048, nullptr};
            pg8::gemm_phase<pg8::EpiBf16<0, false>, pg8::StaticOrder, true, true>(lds + RING_OFF, g, S, E, wid0); }
          if (G == 256 && bx >= 192) {
              const int lane = fresh_lane(); LAS float* scr = (LAS float*)(lds + RING_OFF + wid0 * 16640);
              conv_run(ka, ws, 2 + l, UPDEF + (bx - 192) * NWAVES + wid0, UPDEF + P4DEF, 64 * NWAVES, scr, lane); } }
        xcd_barrier(bar, wid0);
#define CONV_DRAIN(l_) do { const kaptr_t ka = ka_fresh(); unsigned char* ws = KWS(ka); const int lane = fresh_lane(); volatile LAS int* tk = (volatile LAS int*)(lds + LDSCTL_OFF + 16); \
          for (;;) { if (wid0 == 0 && lane == 0) tk[0] = (int)__hip_atomic_fetch_add((gu32*)(ws + WS_CTL) + CW_TKT + ((l_) * 16 + 10) * 64, 1u, RLX_AGENT); \
              WAITBAR(); const int c = __builtin_amdgcn_readfirstlane(tk[0]); WAITBAR(); \
              if (c >= KNCH(ka, (l_))) break; \
              conv_chunk(ka, ws, (l_), c, (LAS float*)(lds + RING_OFF + wid0 * 16640), wid0, lane); } } while (0)
        if (G == 256 && ((bx >> 3) & 3) == 3) CONV_DRAIN(l);
        att::attn_phase<att::VA>(l, 0, lds, wid0);
        att::attn_phase<att::VB>(l, 1, lds, wid0);
        att::attn_phase<att::VD>(l, 2, lds, wid0);
        att::attn_phase<att::VC>(l, 3, lds, wid0);
        CONV_DRAIN(l);
        xcd_barrier(bar, wid0);
        { const kaptr_t ka = ka_fresh(); unsigned char* ws = KWS(ka); unsigned char* wl = ws + WS_W + (size_t)l * W_LAYER;
          pg8::Gemm g{(const bf16*)(ws + WS_MIX), (const bf16*)(wl + W_OUT), M, DM, DM}; pg8::StaticOrder S; S.init(M, DM, G, bx);
          pg8::EpiRes E{(bf16*)(ws + WS_H), DM, (unsigned long long*)((gu32*)(ws + WS_CTL) + CW_SS) + (size_t)(3 * l + 1) * M};
          pg8::gemm_phase<pg8::EpiRes, pg8::StaticOrder, true, true>(lds + RING_OFF, g, S, E, wid0); }
        xcd_barrier(bar, wid0);
        { const kaptr_t ka = ka_fresh(); unsigned char* ws = KWS(ka); unsigned char* wl = ws + WS_W + (size_t)l * W_LAYER;
          pg8::Gemm g{(const bf16*)(ws + WS_H), (const bf16*)(wl + W_MQ), M, 512 * QKS, DM / QKS, DM, DM / QKS, 1, DM / QKS}; pg8::StaticOrder S; S.init(M, 512 * QKS, G, bx);
          pg8::EpiF32 E{(float*)(ws + WS_XL), 512 * QKS};
          pg8::gemm_phase<pg8::EpiF32, pg8::StaticOrder, true, true>(lds + RING_OFF, g, S, E, wid0);
          if (G == 256 && P8DEF > 0 && bx >= 64 * QKS) {
              const int lane = fresh_lane(); LAS float* scr = (LAS float*)(lds + RING_OFF + wid0 * 16640);
              conv_run(ka, ws, 2 + l, UPDEF + P4DEF + (bx - 64 * QKS) * NWAVES + wid0, UPDEF + P4DEF + P8DEF, (256 - 64 * QKS) * NWAVES, scr, lane); } }
        xcd_barrier(bar, wid0);
        att::attn_phase<att::VE>(l, 4, lds, wid0);
        xcd_barrier(bar, wid0);
        { const kaptr_t ka = ka_fresh(); unsigned char* ws = KWS(ka); unsigned char* wl = ws + WS_W + (size_t)l * W_LAYER;
          pg8::Gemm g{(const bf16*)(ws + WS_OMEM), (const bf16*)(wl + W_MO), M, DM, 512}; pg8::StaticOrder S; S.init(M, DM, G, bx);
          pg8::EpiRes E{(bf16*)(ws + WS_H), DM, (unsigned long long*)((gu32*)(ws + WS_CTL) + CW_SS) + (size_t)(3 * l + 2) * M};
          pg8::gemm_phase<pg8::EpiRes, pg8::StaticOrder, true, true>(lds + RING_OFF, g, S, E, wid0); }
        xcd_barrier(bar, wid0);
        { const kaptr_t ka = ka_fresh(); unsigned char* ws = KWS(ka); unsigned char* wl = ws + WS_W + (size_t)l * W_LAYER;
          pg8::Gemm g{(const bf16*)(ws + WS_H), (const bf16*)(wl + W_UP), M, DFF, DM}; pg8::StaticOrder S; S.init(M, DFF, G, bx);
          pg8::EpiBf16<1, true> E{(bf16*)(ws + WS_U), DFF, (const unsigned long long*)((gu32*)(ws + WS_CTL) + CW_SS) + (size_t)(3 * l + 2) * M};
          pg8::gemm_phase<pg8::EpiBf16<1, true>, pg8::StaticOrder, true, true>(lds + RING_OFF, g, S, E, wid0); }
        xcd_barrier(bar, wid0);
        { const kaptr_t ka = ka_fresh(); unsigned char* ws = KWS(ka); unsigned char* wl = ws + WS_W + (size_t)l * W_LAYER;
          pg8::Gemm g{(const bf16*)(ws + WS_U), (const bf16*)(wl + W_DN), M, DM, DFF}; pg8::StaticOrder S; S.init(M, DM, G, bx);
          pg8::EpiRes E{(bf16*)(ws + WS_H), DM, (unsigned long long*)((gu32*)(ws + WS_CTL) + CW_SS) + (size_t)(3 * l + 3) * M};
          pg8::gemm_phase<pg8::EpiRes, pg8::StaticOrder, true, true>(lds + RING_OFF, g, S, E, wid0); }
        xcd_barrier(bar, wid0);
    }
    { const kaptr_t ka = ka_fresh(); unsigned char* ws = KWS(ka); FRESH_LANE(ln); float* O = KOUT(ka);
      for (int m = gw; m < M; m += NGW) final_row((const bf16*)(ws + WS_H) + (size_t)m * DM, (const float*)KIN(ka, 26), O + (size_t)m * DM, ln); }
}

extern "C" void kernel_launch(void* const* d_in, const int* in_sizes, int n_in, void* d_out, int out_size, void* d_ws, size_t ws_size, hipStream_t stream) {
    static int grid = 0;
    if (grid == 0) {
        if (n_in != 27 || in_sizes[0] != M * DM || out_size != M * DM || ws_size < WS_END) {
            fprintf(stderr, "kernel_launch: built for 27 inputs, x/out of %d floats, >= %zu bytes of workspace; got n_in %d, in0 %d, out %d, ws %zu; nothing launched\n", M * DM, (size_t)WS_END, n_in, n_in > 0 ? in_sizes[0] : -1, out_size, ws_size);
            grid = -1; return; }
        int dev = 0, cus = 0, per_cu = 0;
        if (hipGetDevice(&dev) != hipSuccess || hipDeviceGetAttribute(&cus, hipDeviceAttributeMultiprocessorCount, dev) != hipSuccess) { fprintf(stderr, "kernel_launch: device query failed\n"); grid = -1; return; }
        if (hipFuncSetAttribute((const void*)mk_fwd, hipFuncAttributeMaxDynamicSharedMemorySize, LDS_BYTES) != hipSuccess) { fprintf(stderr, "kernel_launch: hipFuncSetAttribute failed\n"); grid = -1; return; }
        if (hipOccupancyMaxActiveBlocksPerMultiprocessor(&per_cu, (const void*)mk_fwd, NWAVES * 64, LDS_BYTES) != hipSuccess || per_cu < 1)
            fprintf(stderr, "kernel_launch: note: occupancy query reports %d workgroups per CU\n", per_cu);
        (void)hipGetLastError();
        grid = cus;
    }
    if (grid < 0) return;
    if (hipMemsetAsync((char*)d_ws + WS_CTL, 0, CTL_ZERO_BYTES, stream) != hipSuccess) { fprintf(stderr, "kernel_launch: memset failed\n"); return; }
    Args a; memset(&a, 0, sizeof(a));
    for (int i = 0; i < 27; ++i) a.in[i] = d_in[i];
    a.out = (float*)d_out; a.ws = (unsigned char*)d_ws;
    for (int i = 0; i < 32; ++i) a.inv_freq[i] = (float)pow(10000.0, -(double)i / 32.0);
    for (int l = 0; l < NL; ++l) a.lam_init[l] = (float)(0.8 - 0.6 * exp(-0.3 * (double)l));
    {
        auto put = [&](int t, int idx, int K, int N, int NP, size_t off, int roff, int gain, int lay, int first, int cnt) {
            Cv& c = a.cv[t][a.ncv[t]++]; c.idx = idx; c.K = K; c.N = N; c.NP = NP; c.dst = (long long)(WS_W + (size_t)lay * W_LAYER + off); c.roff = roff; c.gain = gain; c.lay = lay;
            c.first = first; c.cnt = cnt < 0 ? (K / 64) * (NP / 64) - first : cnt; };
        struct Wm { int idx, K, N, NP; size_t off; int roff, gain, ks; };
        const Wm IN{4, DM, INC, INP, W_IN, 0, 3, 1}, UQ{14, QRANK, 1536, 1536, W_UQ, 0, -1, 1}, UKV{15, KVRANK, 2048, 2048, W_UKV, 0, -1, 1}, MK{20, DM, 512, 512, W_MKV, 0, -1, 1}, MV{21, DM, 512, 512, W_MKV, 512, -1, 1},
                 OUT{5, DM, DM, DM, W_OUT, 0, -1, 1}, MQ{19, DM, 512, 512, W_MQ, 0, 17, QKS}, MO{22, 512, DM, DM, W_MO, 0, -1, 1}, UP{24, DM, DFF, DFF, W_UP, 0, 23, 1}, DN{25, DFF, DM, DM, W_DN, 0, -1, 1};
        auto items = [](const Wm& w) { return (w.K / 64) * (w.NP / 64); };
        auto place = [&](int t, const Wm& w, int lay, int from, int& cap) { int n = items(w) - from; if (cap >= 0 && n > cap) n = cap; if (n <= 0) return from;
            if (w.ks > 1) { for (int kh = 0; kh < w.ks; ++kh) { put(t, w.idx, w.K / w.ks, w.N, w.NP, w.off, kh * w.NP, w.gain, w.ks * lay + kh, 0, -1); a.cv[t][a.ncv[t] - 1].dst = (long long)(WS_W + (size_t)lay * W_LAYER + w.off); }
                            if (cap >= 0) cap -= items(w); return items(w); }
            put(t, w.idx, w.K, w.N, w.NP, w.off, w.roff, w.gain, lay, from, n); if (cap >= 0) cap -= n; return from + n; };
        const bool idle = (grid == 256);
        int all = -1;
        const Wm* late[5] = {&OUT, &MQ, &MO, &UP, &DN}; const Wm* early[5] = {&IN, &UQ, &UKV, &MK, &MV};
        for (int k = 0; k < 5; ++k) place(0, *late[k], 0, 0, all);
        int cap2 = idle ? UPDEF + P4DEF + P8DEF : 0, cap3 = cap2;
        for (int k = 0; k < 5; ++k) { const int pos = place(2, *early[k], 1, 0, cap2); place(0, *early[k], 1, pos, all); }
        int upos = place(2, UP, 1, 0, cap2); upos = place(3, UP, 1, upos, cap3);
        const int dpos = place(3, DN, 1, 0, cap3);
        for (int k = 0; k < 3; ++k) place(1, *late[k], 1, 0, all);
        place(1, UP, 1, upos, all); place(1, DN, 1, dpos, all);
        for (int t = 0; t < NTB; ++t) { long tot = 0; for (int j = 0; j < a.ncv[t]; ++j) tot += a.cv[t][j].cnt; a.nchunk[t] = (int)((tot + 63) / 64); }
    }
    hipLaunchKernelGGL(mk_fwd, dim3(grid), dim3(NWAVES * 64), LDS_BYTES, stream, a);
    const hipError_t le = hipPeekAtLastError();
    if (le != hipSuccess) fprintf(stderr, "kernel_launch: launch failed: %s\n", hipGetErrorName(le));
}
```
